# Optimizing an MI355X kernel written in HIP

```python
import jax
import jax.numpy as jnp
from jax import lax
import numpy as np


D_MODEL = 1024
BATCH = 2
SEQ = 16384
DEPTH = 4

HEAD_DIM = 64
N_HEADS = D_MODEL // HEAD_DIM
A_KV_HEADS = 4
CMP_BLOCK = 32
CMP_STRIDE = 16
CMP_HIDDEN = 256
SEL_BLOCK = 64
N_SELECT = 16
WINDOW_A = 512
QUERY_BLOCK = 128
B_KV_HEADS = 2
WINDOW_B = 128
N_A_LAYERS = max(1, DEPTH // 2)
D_FF = 2816
CONV_WIDTH = 3
ROPE_THETA = 10000.0
EPS = 1e-6
NEG = -1e30
FORCE = 1e6
A_SPLIT = [N_HEADS * HEAD_DIM] + [A_KV_HEADS * HEAD_DIM] * 6 + [3 * N_HEADS]
A_IN_COLS = sum(A_SPLIT)

kernel_name = 'hybrid_nsa_swa_sink_yoco_convffn'


def rms_norm(x, g):
    xf = x.astype(jnp.float32)
    y = xf * lax.rsqrt(jnp.mean(xf * xf, axis=-1, keepdims=True) + EPS)
    return (y * g.astype(jnp.float32)).astype(x.dtype)


def rope(x, pos):
    half = HEAD_DIM // 2
    inv = jnp.float32(ROPE_THETA) ** (-jnp.arange(half, dtype=jnp.float32) / half)
    ang = pos.astype(jnp.float32)[:, None] * inv[None, :]
    cos = jnp.cos(ang)[None, :, None, :]
    sin = jnp.sin(ang)[None, :, None, :]
    xf = x.astype(jnp.float32)
    x1, x2 = xf[..., :half], xf[..., half:]
    return jnp.concatenate([x1 * cos - x2 * sin, x2 * cos + x1 * sin], axis=-1).astype(x.dtype)


def compress(k, pos_emb, w1, w2):
    b, s, g, dh = k.shape
    nseg = s // CMP_STRIDE
    r = CMP_BLOCK // CMP_STRIDE
    nc = nseg - r + 1
    seg = k.reshape(b, nseg, CMP_STRIDE, g, dh)
    blocks = jnp.concatenate([seg[:, i:i + nc] for i in range(r)], axis=2)
    blocks = blocks + pos_emb[None, None, :, None, :]
    flat = blocks.transpose(0, 1, 3, 2, 4).reshape(b, nc, g, CMP_BLOCK * dh)
    return jax.nn.gelu(flat @ w1) @ w2


def _sel_weights():
    r_c = CMP_BLOCK // CMP_STRIDE
    r_s = SEL_BLOCK // CMP_STRIDE
    ws = []
    for o in range(-(r_c - 1), r_s):
        lo = max(o * CMP_STRIDE, 0)
        hi = min(o * CMP_STRIDE + CMP_BLOCK, SEL_BLOCK)
        ws.append(max(hi - lo, 0) // CMP_STRIDE)
    return ws


def block_importance(p, n_sel):
    r_c = CMP_BLOCK // CMP_STRIDE
    r_s = SEL_BLOCK // CMP_STRIDE
    ws = _sel_weights()
    front = r_c - 1
    span = r_s * (n_sel - 1) + 1
    back = max(len(ws) - 1 + span - front - p.shape[-1], 0)
    pp = jnp.pad(p, [(0, 0)] * (p.ndim - 1) + [(front, back)])
    out = ws[0] * pp[..., 0:span:r_s]
    for i in range(1, len(ws)):
        out = out + ws[i] * pp[..., i:i + span:r_s]
    return out


def nsa_mixer(h, w_in, cmp_pos, cmp_w1, cmp_w2, w_out):
    b, s, _ = h.shape
    g_n = A_KV_HEADS
    r_n = N_HEADS // g_n
    dh = HEAD_DIM
    split_idx = np.cumsum(A_SPLIT)[:-1].tolist()
    q, kc, vc, ks, vs, kw, vw, gl = jnp.split(h @ w_in, split_idx, axis=-1)
    pos = jnp.arange(s)
    q = rope(q.reshape(b, s, N_HEADS, dh), pos)
    kc = kc.reshape(b, s, g_n, dh)
    vc = vc.reshape(b, s, g_n, dh)
    ks = rope(ks.reshape(b, s, g_n, dh), pos)
    vs = vs.reshape(b, s, g_n, dh)
    kw = rope(kw.reshape(b, s, g_n, dh), pos)
    vw = vw.reshape(b, s, g_n, dh)
    kc_c = compress(kc, cmp_pos[0], cmp_w1[0], cmp_w2[0])
    vc_c = compress(vc, cmp_pos[1], cmp_w1[1], cmp_w2[1])
    nc = kc_c.shape[1]
    cmp_end = jnp.arange(nc) * CMP_STRIDE + CMP_BLOCK - 1
    kc_c = rope(kc_c, cmp_end)
    gates = jax.nn.sigmoid(gl.astype(jnp.float32)).astype(h.dtype)
    gh = gates.reshape(b, s, g_n, r_n, 3).transpose(0, 2, 3, 1, 4)
    qh = q.reshape(b, s, g_n, r_n, dh).transpose(0, 2, 3, 1, 4)
    kc_h = kc_c.transpose(0, 2, 1, 3)
    vc_h = vc_c.transpose(0, 2, 1, 3)
    n_sel = s // SEL_BLOCK
    ks_b = ks.transpose(0, 2, 1, 3).reshape(b, g_n, n_sel, SEL_BLOCK, dh)
    vs_b = vs.transpose(0, 2, 1, 3).reshape(b, g_n, n_sel, SEL_BLOCK, dh)
    pad_w = ((0, 0), (0, 0), (WINDOW_A, 0), (0, 0))
    kw_p = jnp.pad(kw.transpose(0, 2, 1, 3), pad_w)
    vw_p = jnp.pad(vw.transpose(0, 2, 1, 3), pad_w)
    top = min(N_SELECT, n_sel)
    scale = dh ** -0.5
    bi = jnp.arange(b)[:, None, None, None]
    gi = jnp.arange(g_n)[None, :, None, None]
    sel_j = jnp.arange(n_sel)
    sel_c = jnp.arange(SEL_BLOCK)

    def one_block(qb):
        start = qb * QUERY_BLOCK
        t = start + jnp.arange(QUERY_BLOCK)
        qq = lax.dynamic_slice_in_dim(qh, start, QUERY_BLOCK, axis=3)
        gg = lax.dynamic_slice_in_dim(gh, start, QUERY_BLOCK, axis=3)
        sc = jnp.einsum('bgrqd,bgnd->bgrqn', qq, kc_h).astype(jnp.float32) * scale
        valid = cmp_end[None, :] <= t[:, None]
        p_c = jax.nn.softmax(jnp.where(valid, sc, NEG), axis=-1) * valid
        o_c = jnp.einsum('bgrqn,bgnd->bgrqd', p_c.astype(vc_h.dtype), vc_h)
        imp = block_importance(p_c.sum(axis=2), n_sel)
        cur = t // SEL_BLOCK
        forced = (sel_j[None, :] == 0) | (sel_j[None, :] == cur[:, None]) | (sel_j[None, :] == cur[:, None] - 1)
        causal_blk = sel_j[None, :] * SEL_BLOCK <= t[:, None]
        imp = jnp.where(forced, FORCE, jnp.where(causal_blk, imp, -FORCE))
        _, idx = lax.top_k(imp, top)
        k_sel = ks_b[bi, gi, idx]
        v_sel = vs_b[bi, gi, idx]
        kpos = idx[..., None] * SEL_BLOCK + sel_c
        m_sel = (kpos <= t[:, None, None])[:, :, None]
        ss = jnp.einsum('bgrqd,bgqkcd->bgrqkc', qq, k_sel).astype(jnp.float32) * scale
        ss = jnp.where(m_sel, ss, NEG).reshape(b, g_n, r_n, QUERY_BLOCK, top * SEL_BLOCK)
        p_s = jax.nn.softmax(ss, axis=-1).reshape(b, g_n, r_n, QUERY_BLOCK, top, SEL_BLOCK)
        o_s = jnp.einsum('bgrqkc,bgqkcd->bgrqd', p_s.astype(v_sel.dtype), v_sel)
        kwb = lax.dynamic_slice_in_dim(kw_p, start, QUERY_BLOCK + WINDOW_A, axis=2)
        vwb = lax.dynamic_slice_in_dim(vw_p, start, QUERY_BLOCK + WINDOW_A, axis=2)
        wpos = start - WINDOW_A + jnp.arange(QUERY_BLOCK + WINDOW_A)
        dist = t[:, None] - wpos[None, :]
        m_w = (dist >= 0) & (dist < WINDOW_A) & (wpos[None, :] >= 0)
        sw = jnp.einsum('bgrqd,bgkd->bgrqk', qq, kwb).astype(jnp.float32) * scale
        p_w = jax.nn.softmax(jnp.where(m_w, sw, NEG), axis=-1)
        o_w = jnp.einsum('bgrqk,bgkd->bgrqd', p_w.astype(vwb.dtype), vwb)
        return gg[..., 0:1] * o_c + gg[..., 1:2] * o_s + gg[..., 2:3] * o_w

    out = lax.map(one_block, jnp.arange(s // QUERY_BLOCK))
    out = out.transpose(1, 0, 4, 2, 3, 5).reshape(b, s, N_HEADS * dh)
    return out @ w_out


def shared_kv(h, kv_norm, w_kv):
    b, s, _ = h.shape
    k, v = jnp.split(rms_norm(h, kv_norm) @ w_kv, 2, axis=-1)
    k = rope(k.reshape(b, s, B_KV_HEADS, HEAD_DIM), jnp.arange(s))
    v = v.reshape(b, s, B_KV_HEADS, HEAD_DIM)
    return k, v


def _with_prev_block(xb):
    pad = [(0, 0), (1, 0)] + [(0, 0)] * (xb.ndim - 2)
    return jnp.concatenate([jnp.pad(xb, pad)[:, :-1], xb], axis=2)


def swa_sink_mixer(h, k, v, w_q, sinks, w_out):
    b, s, _ = h.shape
    g_n = B_KV_HEADS
    r_n = N_HEADS // g_n
    w = WINDOW_B
    nb = s // w
    q = rope((h @ w_q).reshape(b, s, N_HEADS, HEAD_DIM), jnp.arange(s))
    qb = q.reshape(b, nb, w, g_n, r_n, HEAD_DIM)
    kk = _with_prev_block(k.reshape(b, nb, w, g_n, HEAD_DIM))
    vv = _with_prev_block(v.reshape(b, nb, w, g_n, HEAD_DIM))
    sc = jnp.einsum('bnqgrd,bnkgd->bgrnqk', qb, kk).astype(jnp.float32) * (HEAD_DIM ** -0.5)
    qi = jnp.arange(w)[:, None]
    ki = jnp.arange(2 * w)[None, :]
    rel = qi + w - ki
    band = (rel >= 0) & (rel < w)
    exists = (jnp.arange(nb)[:, None, None] > 0) | (ki[None] >= w)
    mask = band[None] & exists
    sc = jnp.where(mask, sc, NEG)
    sink = sinks.astype(jnp.float32).reshape(1, g_n, r_n, 1, 1, 1)
    mx = jnp.maximum(sc.max(axis=-1, keepdims=True), sink)
    e = jnp.exp(sc - mx)
    p = e / (e.sum(axis=-1, keepdims=True) + jnp.exp(sink - mx))
    o = jnp.einsum('bgrnqk,bnkgd->bnqgrd', p.astype(vv.dtype), vv)
    return o.reshape(b, s, N_HEADS * HEAD_DIM) @ w_out


def conv_ffn(h, w_in, conv_w, conv_b, w_out):
    s = h.shape[1]
    u = h @ w_in
    up = jnp.pad(u, ((0, 0), (CONV_WIDTH - 1, 0), (0, 0)))
    c = conv_b + conv_w[0] * up[:, 0:s]
    for i in range(1, CONV_WIDTH):
        c = c + conv_w[i] * up[:, i:i + s]
    a, gate_in = jnp.split(c, 2, axis=-1)
    return (jax.nn.silu(a) * gate_in) @ w_out


def setup_inputs(seed: int = 0) -> dict:
    key = jax.random.key(seed)
    ks = jax.random.split(key, 18)
    d = D_MODEL
    n_a = N_A_LAYERS
    n_b = DEPTH - N_A_LAYERS
    f32 = jnp.float32

    def w(k, shape, fan_in):
        return jax.random.normal(k, shape, f32) * (fan_in ** -0.5)

    def gain(k, shape):
        return 1.0 + 0.02 * jax.random.normal(k, shape, f32)

    return {
        'x': jax.random.normal(ks[0], (BATCH, SEQ, d), f32),
        'norm_attn': gain(ks[1], (DEPTH, d)),
        'norm_ffn': gain(ks[2], (DEPTH, d)),
        'a_w_in': w(ks[3], (n_a, d, A_IN_COLS), d),
        'a_cmp_pos': 0.1 * jax.random.normal(ks[4], (n_a, 2, CMP_BLOCK, HEAD_DIM), f32),
        'a_cmp_w1': w(ks[5], (n_a, 2, CMP_BLOCK * HEAD_DIM, CMP_HIDDEN), CMP_BLOCK * HEAD_DIM),
        'a_cmp_w2': w(ks[6], (n_a, 2, CMP_HIDDEN, HEAD_DIM), CMP_HIDDEN),
        'a_w_out': w(ks[7], (n_a, d, d), d),
        'kv_norm': gain(ks[8], (d,)),
        'b_w_kv': w(ks[9], (d, 2 * B_KV_HEADS * HEAD_DIM), d),
        'b_w_q': w(ks[10], (n_b, d, d), d),
        'b_sinks': jax.random.normal(ks[11], (n_b, N_HEADS), f32),
        'b_w_out': w(ks[12], (n_b, d, d), d),
        'ffn_w_in': w(ks[13], (DEPTH, d, 2 * D_FF), d),
        'ffn_conv_w': w(ks[14], (DEPTH, CONV_WIDTH, 2 * D_FF), CONV_WIDTH),
        'ffn_conv_b': 0.02 * jax.random.normal(ks[15], (DEPTH, 2 * D_FF), f32),
        'ffn_w_out': w(ks[16], (DEPTH, D_FF, d), D_FF),
        'final_norm': gain(ks[17], (d,)),
    }


def reference(x, norm_attn, norm_ffn, a_w_in, a_cmp_pos, a_cmp_w1, a_cmp_w2, a_w_out, kv_norm, b_w_kv, b_w_q, b_sinks, b_w_out, ffn_w_in, ffn_conv_w, ffn_conv_b, ffn_w_out, final_norm):
    h = x
    k_sh = None
    v_sh = None
    for layer in range(DEPTH):
        hn = rms_norm(h, norm_attn[layer])
        if layer < N_A_LAYERS:
            h = h + nsa_mixer(hn, a_w_in[layer], a_cmp_pos[layer], a_cmp_w1[layer], a_cmp_w2[layer], a_w_out[layer])
        else:
            if layer == N_A_LAYERS:
                k_sh, v_sh = shared_kv(h, kv_norm, b_w_kv)
                hn = rms_norm(h, norm_attn[layer])
            j = layer - N_A_LAYERS
            h = h + swa_sink_mixer(hn, k_sh, v_sh, b_w_q[j], b_sinks[j], b_w_out[j])
        h = h + conv_ffn(rms_norm(h, norm_ffn[layer]), ffn_w_in[layer], ffn_conv_w[layer], ffn_conv_b[layer], ffn_w_out[layer])
    return rms_norm(h, final_norm)
```

```cpp
#include <hip/hip_runtime.h>
#include <hip/hip_cooperative_groups.h>
#include <cstdio>
#include <cmath>
namespace cg = cooperative_groups;

typedef unsigned short u16;
typedef short bf16x8 __attribute__((ext_vector_type(8)));
typedef float f32x4 __attribute__((ext_vector_type(4)));

#ifndef NSA_PROBE_REP
#define NSA_PROBE_REP 0
#endif
#ifndef MULTI_LAUNCH
#define MULTI_LAUNCH 0
#endif

constexpr int S_ = 16384, T_ = 32768, D_ = 1024, DFF = 2816, NFF2 = 5632;
constexpr int NTHR = 512, NW = NTHR / 64;
constexpr int LDS_USER = NW * 16384 + NW * 1024 + NW * 256;
constexpr int LDS_BYTES = LDS_USER + 16;
constexpr float LOG2E = 1.4426950408889634f;
constexpr float NEGBIG = -1e30f;

constexpr size_t al256(size_t x) { return (x + 255) & ~(size_t)255; }
constexpr size_t SZ_WT_AIN = (size_t)2688 * 1024 * 2;
constexpr size_t SZ_WT_CW1 = (size_t)256 * 2048 * 2;
constexpr size_t SZ_WT_CW2 = (size_t)64 * 256 * 2;
constexpr size_t SZ_WT_SQ = (size_t)1024 * 1024 * 2;
constexpr size_t SZ_WT_KV = (size_t)256 * 1024 * 2;
constexpr size_t SZ_WT_FIN = (size_t)5632 * 1024 * 2;
constexpr size_t SZ_WT_FOUT = (size_t)1024 * 2816 * 2;
constexpr size_t OFF_WT_AIN = 0;
constexpr size_t OFF_WT_CW1 = OFF_WT_AIN + 2 * SZ_WT_AIN;
constexpr size_t OFF_WT_CW2 = OFF_WT_CW1 + 4 * SZ_WT_CW1;
constexpr size_t OFF_WT_AOUT = OFF_WT_CW2 + 4 * SZ_WT_CW2;
constexpr size_t OFF_WT_KV = OFF_WT_AOUT + 2 * SZ_WT_SQ;
constexpr size_t OFF_WT_BQ = OFF_WT_KV + SZ_WT_KV;
constexpr size_t OFF_WT_BOUT = OFF_WT_BQ + 2 * SZ_WT_SQ;
constexpr size_t OFF_WT_FIN = OFF_WT_BOUT + 2 * SZ_WT_SQ;
constexpr size_t OFF_WT_FOUT = OFF_WT_FIN + 4 * SZ_WT_FIN;
constexpr size_t OFF_COS = OFF_WT_FOUT + 4 * SZ_WT_FOUT;
constexpr size_t OFF_SIN = OFF_COS + (size_t)S_ * 32 * 4;
constexpr size_t OFF_CBIAS = OFF_SIN + (size_t)S_ * 32 * 4;
constexpr size_t OFF_HN = OFF_CBIAS + 4096;
constexpr size_t OFF_KSH = OFF_HN + (size_t)T_ * 1024 * 2;
constexpr size_t OFF_VSHT = OFF_KSH + (size_t)T_ * 128 * 2;
constexpr size_t OFF_HEAD = OFF_VSHT + (size_t)T_ * 128 * 2;
constexpr size_t OFF_HALO = OFF_HEAD + (size_t)256 * 2 * NFF2 * 4;
constexpr size_t OFF_R1 = OFF_HALO + (size_t)256 * 2 * NFF2 * 4;
constexpr size_t OFF_Q = OFF_R1;
constexpr size_t OFF_KC = OFF_Q + (size_t)T_ * 1024 * 2;
constexpr size_t OFF_VC = OFF_KC + (size_t)T_ * 256 * 2;
constexpr size_t OFF_KS = OFF_VC + (size_t)T_ * 256 * 2;
constexpr size_t OFF_VST = OFF_KS + (size_t)T_ * 256 * 2;
constexpr size_t OFF_KW = OFF_VST + (size_t)T_ * 256 * 2;
constexpr size_t OFF_VWT = OFF_KW + (size_t)T_ * 256 * 2;
constexpr size_t OFF_GATES = OFF_VWT + (size_t)T_ * 256 * 2;
constexpr size_t OFF_HID = OFF_GATES + (size_t)T_ * 48 * 4;
constexpr size_t OFF_KCC = OFF_HID + (size_t)2 * 8192 * 256 * 2;
constexpr size_t OFF_VCCT = OFF_KCC + (size_t)8 * 1024 * 64 * 2;
constexpr size_t OFF_O = OFF_VCCT + (size_t)8 * 1024 * 64 * 2;
constexpr size_t OFF_END = OFF_O + (size_t)T_ * 1024 * 2;
constexpr size_t OFF_BAR = OFF_END;
constexpr size_t WS_NEED = OFF_BAR + 16384;
constexpr size_t OFF_ACT = OFF_R1;
static_assert(OFF_ACT + (size_t)T_ * DFF * 2 <= OFF_END, "act alias");

struct Params {
    const float *x, *norm_attn, *norm_ffn, *a_w_in, *a_cmp_pos, *a_cmp_w1, *a_cmp_w2, *a_w_out, *kv_norm, *b_w_kv, *b_w_q, *b_sinks, *b_w_out,
        *ffn_w_in, *ffn_conv_w, *ffn_conv_b, *ffn_w_out, *final_norm;
    float* out;
    unsigned char* ws;
    int desc[48];
    int ph_lo, ph_hi;
};

__device__ __forceinline__ u16 f2bf(float f) {
    unsigned u = __float_as_uint(f);
    u += 0x7fffu + ((u >> 16) & 1u);
    return (u16)(u >> 16);
}
typedef __bf16 bf16x2_t __attribute__((ext_vector_type(2)));
typedef float f32x2_t __attribute__((ext_vector_type(2)));
__device__ __forceinline__ unsigned pack2(float lo, float hi) { f32x2_t v = {lo, hi}; bf16x2_t r = __builtin_convertvector(v, bf16x2_t); return __builtin_bit_cast(unsigned, r); }
typedef unsigned u32x4 __attribute__((ext_vector_type(4)));
__device__ __forceinline__ bf16x8 pack8(const float (&v)[8]) {
    u32x4 r;
    unsigned r0, r1, r2, r3;
    asm("v_cvt_pk_bf16_f32 %0, %4, %5\n\tv_cvt_pk_bf16_f32 %1, %6, %7\n\tv_cvt_pk_bf16_f32 %2, %8, %9\n\tv_cvt_pk_bf16_f32 %3, %10, %11\n\ts_nop 3"
        : "=&v"(r0), "=&v"(r1), "=&v"(r2), "=&v"(r3)
        : "v"(v[0]), "v"(v[1]), "v"(v[2]), "v"(v[3]), "v"(v[4]), "v"(v[5]), "v"(v[6]), "v"(v[7]));
    r[0] = r0; r[1] = r1; r[2] = r2; r[3] = r3;
    return __builtin_bit_cast(bf16x8, r);
}
__device__ __forceinline__ uint2 pack4(f32x4 v) { uint2 r; r.x = pack2(v[0], v[1]); r.y = pack2(v[2], v[3]); return r; }
__device__ __forceinline__ f32x4 unpack4(uint2 v) { return (f32x4){__uint_as_float(v.x << 16), __uint_as_float(v.x & 0xffff0000u), __uint_as_float(v.y << 16), __uint_as_float(v.y & 0xffff0000u)}; }
__device__ __forceinline__ f32x4 mfma16(bf16x8 a, bf16x8 b, f32x4 c) { return __builtin_amdgcn_mfma_f32_16x16x32_bf16(a, b, c, 0, 0, 0); }
__device__ __forceinline__ float fexp2(float x) { return __builtin_amdgcn_exp2f(x); }
__device__ __forceinline__ void wsync() { __builtin_amdgcn_fence(__ATOMIC_ACQ_REL, "wavefront"); asm volatile("s_waitcnt lgkmcnt(0)" ::: "memory"); __builtin_amdgcn_wave_barrier(); }
typedef unsigned u32x2 __attribute__((ext_vector_type(2)));
__device__ __forceinline__ float xmax16(float x) { const unsigned u = __float_as_uint(x); const u32x2 r = __builtin_amdgcn_permlane16_swap(u, u, false, false); return fmaxf(__uint_as_float(r[0]), __uint_as_float(r[1])); }
__device__ __forceinline__ float xmax32(float x) { const unsigned u = __float_as_uint(x); const u32x2 r = __builtin_amdgcn_permlane32_swap(u, u, false, false); return fmaxf(__uint_as_float(r[0]), __uint_as_float(r[1])); }
template <int CTRL> __device__ __forceinline__ float dppf(float x) { return __int_as_float(__builtin_amdgcn_update_dpp(0, __float_as_int(x), CTRL, 0xf, 0xf, true)); }
__device__ __forceinline__ float wave_max(float x) {
    x = fmaxf(x, dppf<0xB1>(x)); x = fmaxf(x, dppf<0x4E>(x)); x = fmaxf(x, dppf<0x141>(x)); x = fmaxf(x, dppf<0x140>(x));
    return xmax32(xmax16(x));
}
__device__ __forceinline__ int kperm(int m) { return ((m >> 2) << 3) + (m & 3); }
__device__ __forceinline__ float sigmoidf_(float x) { return 1.f / (1.f + __expf(-x)); }
__device__ __forceinline__ float gelu_tanh(float x) {
    float u = 0.7978845608028654f * (x + 0.044715f * x * x * x);
    float e = __expf(2.f * u);
    float th = 1.f - 2.f / (e + 1.f);
    return 0.5f * x * (1.f + th);
}

__device__ __forceinline__ void cvt_transpose(const float* __restrict__ src, u16* __restrict__ dst, int K, int N, int Npad, int mode, unsigned char* smem, int tid_, int bid_) {
    const int half = tid_ >> 8, tid = tid_ & 255;
    float* ts = (float*)smem + half * (64 * 65);
    const int ntk = K >> 6, ntn = Npad >> 6, ntiles = ntk * ntn;
    for (int tile2 = bid_ * 2; tile2 < ntiles; tile2 += gridDim.x * 2) {
        const int tile = tile2 + half;
        const bool live = tile < ntiles;
        const int tk = live ? tile % ntk : 0, tn = live ? tile / ntk : 0;
        const int k0 = tk << 6, n0 = tn << 6;
        __syncthreads();
        if (live) {
#pragma unroll
            for (int i = 0; i < 4; ++i) {
                const int k = (tid >> 4) + 16 * i, n = (tid & 15) * 4;
                float4 v = make_float4(0.f, 0.f, 0.f, 0.f);
                if (n0 + n < N) v = *(const float4*)(src + (size_t)(k0 + k) * N + n0 + n);
                ts[k * 65 + n + 0] = v.x; ts[k * 65 + n + 1] = v.y; ts[k * 65 + n + 2] = v.z; ts[k * 65 + n + 3] = v.w;
            }
        }
        __syncthreads();
        if (!live) continue;
        const int n = tid >> 2, kq = (tid & 3) * 16;
        unsigned pk[8];
#pragma unroll
        for (int j = 0; j < 8; ++j) pk[j] = pack2(ts[(kq + 2 * j) * 65 + n], ts[(kq + 2 * j + 1) * 65 + n]);
        int drow;
        if (mode == 0) drow = n0 + n;
        else { const int nn = n0 + n; drow = (nn < DFF) ? ((nn >> 6) * 128 + (nn & 63)) : ((((nn - DFF) >> 6) * 128) + 64 + ((nn - DFF) & 63)); }
        uint4* dp = (uint4*)(dst + (size_t)drow * K + k0 + kq);
        dp[0] = make_uint4(pk[0], pk[1], pk[2], pk[3]);
        dp[1] = make_uint4(pk[4], pk[5], pk[6], pk[7]);
    }
}

__device__ __forceinline__ void prep_phase(const Params& p, unsigned char* smem, int tid_, int bid_) {
    unsigned char* ws = p.ws;
    for (int L = 0; L < 2; ++L) {
        cvt_transpose(p.a_w_in + (size_t)L * 1024 * 2608, (u16*)(ws + OFF_WT_AIN + L * SZ_WT_AIN), 1024, 2608, 2688, 0, smem, tid_, bid_);
        for (int kv = 0; kv < 2; ++kv) {
            cvt_transpose(p.a_cmp_w1 + (size_t)(L * 2 + kv) * 2048 * 256, (u16*)(ws + OFF_WT_CW1 + (L * 2 + kv) * SZ_WT_CW1), 2048, 256, 256, 0, smem, tid_, bid_);
            cvt_transpose(p.a_cmp_w2 + (size_t)(L * 2 + kv) * 256 * 64, (u16*)(ws + OFF_WT_CW2 + (L * 2 + kv) * SZ_WT_CW2), 256, 64, 64, 0, smem, tid_, bid_);
        }
        cvt_transpose(p.a_w_out + (size_t)L * 1024 * 1024, (u16*)(ws + OFF_WT_AOUT + L * SZ_WT_SQ), 1024, 1024, 1024, 0, smem, tid_, bid_);
        cvt_transpose(p.b_w_q + (size_t)L * 1024 * 1024, (u16*)(ws + OFF_WT_BQ + L * SZ_WT_SQ), 1024, 1024, 1024, 0, smem, tid_, bid_);
        cvt_transpose(p.b_w_out + (size_t)L * 1024 * 1024, (u16*)(ws + OFF_WT_BOUT + L * SZ_WT_SQ), 1024, 1024, 1024, 0, smem, tid_, bid_);
    }
    cvt_transpose(p.b_w_kv, (u16*)(ws + OFF_WT_KV), 1024, 256, 256, 0, smem, tid_, bid_);
    for (int L = 0; L < 4; ++L) {
        cvt_transpose(p.ffn_w_in + (size_t)L * 1024 * NFF2, (u16*)(ws + OFF_WT_FIN + L * SZ_WT_FIN), 1024, NFF2, NFF2, 1, smem, tid_, bid_);
        cvt_transpose(p.ffn_w_out + (size_t)L * DFF * 1024, (u16*)(ws + OFF_WT_FOUT + L * SZ_WT_FOUT), DFF, 1024, 1024, 0, smem, tid_, bid_);
    }
    {
        float* cosT = (float*)(ws + OFF_COS); float* sinT = (float*)(ws + OFF_SIN);
        const int gt = bid_ * NTHR + tid_, nt = gridDim.x * NTHR;
        for (int idx = gt; idx < S_ * 32; idx += nt) {
            const int pos = idx >> 5, i = idx & 31;
            const float ang = (float)pos * exp2f(-(float)i * (13.287712379549449f / 32.0f));
            double rev = (double)ang * 0.15915494309189535;
            rev -= rint(rev);
            const float fr = (float)rev;
            cosT[idx] = __builtin_amdgcn_cosf(fr);
            sinT[idx] = __builtin_amdgcn_sinf(fr);
        }
    }
    {
        float* cb = (float*)(ws + OFF_CBIAS);
        const int lane = tid_ & 63, w = tid_ >> 6;
        for (int task = bid_ * NW + w; task < 256; task += gridDim.x * NW) {
            const int lk = task >> 6, j4 = (task & 63) * 4;
            const float* pos = p.a_cmp_pos + (size_t)lk * 2048;
            const float* w1 = p.a_cmp_w1 + (size_t)lk * 2048 * 256;
            float4 a = make_float4(0.f, 0.f, 0.f, 0.f);
            for (int i = 0; i < 32; ++i) {
                const int k = lane + 64 * i;
                const float pv = pos[k];
                const float4 wv = *(const float4*)(w1 + (size_t)k * 256 + j4);
                a.x += pv * wv.x; a.y += pv * wv.y; a.z += pv * wv.z; a.w += pv * wv.w;
            }
#pragma unroll
            for (int off = 32; off >= 1; off >>= 1) {
                a.x += __shfl_xor(a.x, off); a.y += __shfl_xor(a.y, off); a.z += __shfl_xor(a.z, off); a.w += __shfl_xor(a.w, off);
            }
            if (lane == 0) *(float4*)(cb + lk * 256 + j4) = a;
        }
    }
}

template <bool OUT_F32>
__device__ __forceinline__ void norm_phase(const float* __restrict__ src, const float* __restrict__ g, u16* __restrict__ dst, float* __restrict__ dstf, int tid_, int bid_) {
    const int lane = tid_ & 63, w = tid_ >> 6;
    float4 gv[4];
#pragma unroll
    for (int i = 0; i < 4; ++i) gv[i] = *(const float4*)(g + lane * 4 + 256 * i);
    for (int row = bid_ * NW + w; row < T_; row += gridDim.x * NW) {
        const float* sp = src + (size_t)row * 1024;
        float4 v[4];
        float ss = 0.f;
#pragma unroll
        for (int i = 0; i < 4; ++i) { v[i] = *(const float4*)(sp + lane * 4 + 256 * i); ss += v[i].x * v[i].x + v[i].y * v[i].y + v[i].z * v[i].z + v[i].w * v[i].w; }
#pragma unroll
        for (int off = 32; off >= 1; off >>= 1) ss += __shfl_xor(ss, off);
        const float r = rsqrtf(ss * (1.f / 1024.f) + 1e-6f);
#pragma unroll
        for (int i = 0; i < 4; ++i) {
            f32x4 o = {v[i].x * r * gv[i].x, v[i].y * r * gv[i].y, v[i].z * r * gv[i].z, v[i].w * r * gv[i].w};
            if (OUT_F32) *(float4*)(dstf + (size_t)row * 1024 + lane * 4 + 256 * i) = make_float4(o[0], o[1], o[2], o[3]);
            else *(uint2*)(dst + (size_t)row * 1024 + lane * 4 + 256 * i) = pack4(o);
        }
    }
}

enum { AM_PLAIN = 0, AM_GATHER = 1 };
enum { EPI_AIN = 0, EPI_CMP1 = 1, EPI_RESID = 2, EPI_FFNIN = 3, EPI_BQ = 4, EPI_BKV = 5 };

struct EpiArgs {
    const float* resid; float* out;
    const float* bias; u16* hid;
    const float *convw, *convb;
    unsigned char* ws;
};

template <int NM>
__device__ __forceinline__ void rope_store(const f32x4 (&acc)[4][NM], int mi, u16* dstrow  , const float* cosT, const float* sinT, int pos, int q4) {
#pragma unroll
    for (int ni = 0; ni < 2; ++ni) {
        const int d = ni * 16 + q4 * 4;
        const float4 c = *(const float4*)(cosT + pos * 32 + d), s = *(const float4*)(sinT + pos * 32 + d);
        const f32x4 x1 = acc[ni][mi], x2 = acc[ni + 2][mi];
        f32x4 o1 = {x1[0] * c.x - x2[0] * s.x, x1[1] * c.y - x2[1] * s.y, x1[2] * c.z - x2[2] * s.z, x1[3] * c.w - x2[3] * s.w};
        f32x4 o2 = {x2[0] * c.x + x1[0] * s.x, x2[1] * c.y + x1[1] * s.y, x2[2] * c.z + x1[2] * s.z, x2[3] * c.w + x1[3] * s.w};
        *(uint2*)(dstrow + d) = pack4(o1);
        *(uint2*)(dstrow + d + 32) = pack4(o2);
    }
}

template <int AMODE, int EPI>
__device__ __forceinline__ void gemm_phase(const u16* __restrict__ A, int lda, const u16* __restrict__ Bt, int M, int Npad, int K, int vboff, const EpiArgs& e, unsigned char* smem, int tid_, int bid_) {
    const int tid = tid_, lane = tid & 63, w = tid >> 6, wm = w & 3, wn = w >> 2;
    const int c16 = lane & 15, q4 = lane >> 4;
    const int ntm = (M + 255) >> 8, ntn = Npad >> 7, nk = K >> 6;
    const int kstride = (AMODE == AM_GATHER) ? 256 : 64;
    const int ldc = tid & 7, ldr = tid >> 3;
    const unsigned wofs = ldr * 128 + ((ldc ^ ((ldr >> 1) & 7)) << 4);
    const int swz = (c16 >> 1) & 7;
    const float* cosT = (const float*)(e.ws + OFF_COS);
    const float* sinT = (const float*)(e.ws + OFF_SIN);
    int vb = bid_ + vboff; if (vb >= (int)gridDim.x) vb -= gridDim.x;
    const int xcd = vb & 7, loc = vb >> 3, nloc = gridDim.x >> 3;
    const int mpx = ntm >> 3, nfull = (ntn >> 3), bwl = ntn - (nfull << 3);
    const int tfull = nfull * mpx * 8, ttotal = mpx * ntn;
    for (int tl = loc; tl < ttotal; tl += nloc) {
        int mloc, nt;
        if (tl < tfull) { const int band = tl / (mpx * 8), r = tl - band * (mpx * 8); mloc = r >> 3; nt = band * 8 + (r & 7); }
        else { const int r = tl - tfull; mloc = r / bwl; nt = (nfull << 3) + (r - mloc * bwl); }
        const int mt = xcd * mpx + mloc;
        const int m0 = mt << 8, n0 = nt << 7;
        unsigned aoff[4];
#pragma unroll
        for (int i = 0; i < 4; ++i) {
            int m = m0 + ldr + 64 * i; if (m > M - 1) m = M - 1;
            if (AMODE == AM_GATHER) { const int g = m & 3, bn = m >> 2, b = bn / 1023, n = bn - b * 1023; aoff[i] = (unsigned)((b * S_ + n * 16) * 256 + g * 64 + ldc * 8); }
            else aoff[i] = (unsigned)m * (unsigned)lda + ldc * 8;
        }
        const u16* bp = Bt + (size_t)(n0 + ldr) * K + ldc * 8;
        u32x4 ra0[4], rb0[2], ra1[4], rb1[2];
        f32x4 acc[4][4];
#pragma unroll
        for (int a = 0; a < 4; ++a)
#pragma unroll
            for (int b = 0; b < 4; ++b) acc[a][b] = (f32x4){0.f, 0.f, 0.f, 0.f};
        auto g_load = [&](u32x4 (&RA)[4], u32x4 (&RB)[2], int KT) __attribute__((always_inline)) {
#pragma unroll
            for (int i = 0; i < 4; ++i) RA[i] = *(const u32x4*)(A + aoff[i] + KT * kstride);
#pragma unroll
            for (int i = 0; i < 2; ++i) RB[i] = *(const u32x4*)(bp + (size_t)i * 64 * K + KT * 64);
        };
        auto g_store = [&](const u32x4 (&RA)[4], const u32x4 (&RB)[2], int ST) __attribute__((always_inline)) {
            unsigned char* d_ = smem + ST * 49152;
#pragma unroll
            for (int i = 0; i < 4; ++i) *(u32x4*)(d_ + wofs + i * 8192) = RA[i];
#pragma unroll
            for (int i = 0; i < 2; ++i) *(u32x4*)(d_ + 32768 + wofs + i * 8192) = RB[i];
        };
        auto g_compute = [&](int ST) __attribute__((always_inline)) {
            const unsigned char* sA = smem + ST * 49152;
            const unsigned char* sB = sA + 32768;
#pragma unroll
            for (int ks = 0; ks < 2; ++ks) {
                bf16x8 wf[4], af[4];
                const int ch = ((ks * 4 + q4) ^ swz) << 4;
#pragma unroll
                for (int ni = 0; ni < 4; ++ni) wf[ni] = *(const bf16x8*)(sB + (wn * 64 + ni * 16 + c16) * 128 + ch);
#pragma unroll
                for (int mi = 0; mi < 4; ++mi) af[mi] = *(const bf16x8*)(sA + (wm * 64 + mi * 16 + c16) * 128 + ch);
#pragma unroll
                for (int ni = 0; ni < 4; ++ni)
#pragma unroll
                    for (int mi = 0; mi < 4; ++mi) acc[ni][mi] = mfma16(wf[ni], af[mi], acc[ni][mi]);
            }
        };
        g_load(ra0, rb0, 0);
        g_load(ra1, rb1, 1);
        g_store(ra0, rb0, 0);
        __syncthreads();
        for (int kt = 0; kt < nk; kt += 2) {
            if (kt + 2 < nk) g_load(ra0, rb0, kt + 2);
            g_compute(0);
            g_store(ra1, rb1, 1);
            __syncthreads();
            if (kt + 3 < nk) g_load(ra1, rb1, kt + 3);
            g_compute(1);
            if (kt + 2 < nk) g_store(ra0, rb0, 0);
            __syncthreads();
        }
        const int nb = n0 + wn * 64;
        if (EPI == EPI_RESID) {
#pragma unroll
            for (int mi = 0; mi < 4; ++mi) {
                const size_t tok = m0 + wm * 64 + mi * 16 + c16;
#pragma unroll
                for (int ni = 0; ni < 4; ++ni) {
                    const int n = nb + ni * 16 + q4 * 4;
                    float4 r = *(const float4*)(e.resid + tok * 1024 + n);
                    r.x += acc[ni][mi][0]; r.y += acc[ni][mi][1]; r.z += acc[ni][mi][2]; r.w += acc[ni][mi][3];
                    *(float4*)(e.out + tok * 1024 + n) = r;
                }
            }
        } else if (EPI == EPI_CMP1) {
#pragma unroll
            for (int mi = 0; mi < 4; ++mi) {
                const int m = m0 + wm * 64 + mi * 16 + c16;
                if (m < M) {
#pragma unroll
                    for (int ni = 0; ni < 4; ++ni) {
                        const int n = nb + ni * 16 + q4 * 4;
                        const float4 bv = *(const float4*)(e.bias + n);
                        f32x4 o = {gelu_tanh(acc[ni][mi][0] + bv.x), gelu_tanh(acc[ni][mi][1] + bv.y), gelu_tanh(acc[ni][mi][2] + bv.z), gelu_tanh(acc[ni][mi][3] + bv.w)};
                        *(uint2*)(e.hid + (size_t)m * 256 + n) = pack4(o);
                    }
                }
            }
        } else if (EPI == EPI_BQ) {
            u16* Q = (u16*)(e.ws + OFF_Q);
#pragma unroll
            for (int mi = 0; mi < 4; ++mi) {
                const int tok = m0 + wm * 64 + mi * 16 + c16;
                rope_store(acc, mi, Q + (size_t)tok * 1024 + nb, cosT, sinT, tok & (S_ - 1), q4);
            }
        } else if (EPI == EPI_BKV) {
            u16* KSH = (u16*)(e.ws + OFF_KSH); u16* VSHT = (u16*)(e.ws + OFF_VSHT);
#pragma unroll
            for (int mi = 0; mi < 4; ++mi) {
                const int tok = m0 + wm * 64 + mi * 16 + c16, b = tok >> 14, s = tok & (S_ - 1);
                if (nb < 128) {
                    const int g = nb >> 6;
                    rope_store(acc, mi, KSH + ((size_t)(b * 2 + g) * S_ + s) * 64, cosT, sinT, s, q4);
                } else {
                    const int g = (nb - 128) >> 6;
#pragma unroll
                    for (int ni = 0; ni < 4; ++ni)
#pragma unroll
                        for (int i = 0; i < 4; ++i) VSHT[((size_t)(b * 2 + g) * 64 + ni * 16 + q4 * 4 + i) * S_ + s] = f2bf(acc[ni][mi][i]);
                }
            }
        } else if (EPI == EPI_AIN) {
            unsigned char* ws = e.ws;
#pragma unroll
            for (int mi = 0; mi < 4; ++mi) {
                const int tok = m0 + wm * 64 + mi * 16 + c16, b = tok >> 14, s = tok & (S_ - 1);
                if (nb < 1024) {
                    rope_store(acc, mi, (u16*)(ws + OFF_Q) + (size_t)tok * 1024 + nb, cosT, sinT, s, q4);
                } else if (nb < 1536) {
                    u16* dst = (nb < 1280) ? ((u16*)(ws + OFF_KC) + (size_t)tok * 256 + (nb - 1024)) : ((u16*)(ws + OFF_VC) + (size_t)tok * 256 + (nb - 1280));
#pragma unroll
                    for (int ni = 0; ni < 4; ++ni) *(uint2*)(dst + ni * 16 + q4 * 4) = pack4(acc[ni][mi]);
                } else if (nb < 2560) {
                    const int r = (nb - 1536) >> 8;
                    const int g = ((nb - 1536) & 255) >> 6;
                    if ((r & 1) == 0) {
                        u16* base = (u16*)(ws + (r == 0 ? OFF_KS : OFF_KW));
                        rope_store(acc, mi, base + ((size_t)(b * 4 + g) * S_ + s) * 64, cosT, sinT, s, q4);
                    } else {
                        if (r == 1) {
                            u16* base = (u16*)(ws + OFF_VST) + (size_t)(b * 4 + g) * 64 * S_ + (size_t)(s >> 6) * 4096 + (s & 63);
#pragma unroll
                            for (int ni = 0; ni < 4; ++ni)
#pragma unroll
                                for (int i = 0; i < 4; ++i) base[(ni * 16 + q4 * 4 + i) * 64] = f2bf(acc[ni][mi][i]);
                        } else {
                            u16* base = (u16*)(ws + OFF_VWT);
#pragma unroll
                            for (int ni = 0; ni < 4; ++ni)
#pragma unroll
                                for (int i = 0; i < 4; ++i) base[((size_t)(b * 4 + g) * 64 + ni * 16 + q4 * 4 + i) * S_ + s] = f2bf(acc[ni][mi][i]);
                        }
                    }
                } else if (nb == 2560) {
                    float* G = (float*)(ws + OFF_GATES) + (size_t)tok * 48;
#pragma unroll
                    for (int ni = 0; ni < 3; ++ni) {
                        const int n = ni * 16 + q4 * 4;
                        *(float4*)(G + n) = make_float4(sigmoidf_(acc[ni][mi][0]), sigmoidf_(acc[ni][mi][1]), sigmoidf_(acc[ni][mi][2]), sigmoidf_(acc[ni][mi][3]));
                    }
                }
            }
        } else if (EPI == EPI_FFNIN) {
            float* U = (float*)smem;
#pragma unroll
            for (int mi = 0; mi < 4; ++mi) {
                const int row = wm * 64 + mi * 16 + c16;
#pragma unroll
                for (int ni = 0; ni < 4; ++ni) {
                    const int chunk = wn * 16 + ni * 4 + q4;
                    *(f32x4*)(U + row * 128 + ((chunk ^ (row & 31)) << 2)) = acc[ni][mi];
                }
            }
            __syncthreads();
            {
                const int ca = tid & 15, seg = tid >> 4;
                const int ncol = nt * 64 + ca * 4;
                const float4 w0a = *(const float4*)(e.convw + ncol), w1a = *(const float4*)(e.convw + NFF2 + ncol), w2a = *(const float4*)(e.convw + 2 * NFF2 + ncol);
                const float4 w0g = *(const float4*)(e.convw + DFF + ncol), w1g = *(const float4*)(e.convw + NFF2 + DFF + ncol), w2g = *(const float4*)(e.convw + 2 * NFF2 + DFF + ncol);
                const float4 ba = *(const float4*)(e.convb + ncol), bg = *(const float4*)(e.convb + DFF + ncol);
                float* head = (float*)(e.ws + OFF_HEAD); float* halo = (float*)(e.ws + OFF_HALO);
                u16* act = (u16*)(e.ws + OFF_ACT);
                const int r0 = seg * 8;
                float4 a2 = make_float4(0.f, 0.f, 0.f, 0.f), a1 = a2, g2 = a2, g1 = a2;
                if (seg > 0) {
                    const int rA = r0 - 2, rB = r0 - 1;
                    a2 = *(const float4*)(U + rA * 128 + ((ca ^ (rA & 31)) << 2)); g2 = *(const float4*)(U + rA * 128 + (((16 + ca) ^ (rA & 31)) << 2));
                    a1 = *(const float4*)(U + rB * 128 + ((ca ^ (rB & 31)) << 2)); g1 = *(const float4*)(U + rB * 128 + (((16 + ca) ^ (rB & 31)) << 2));
                }
#pragma unroll
                for (int r = 0; r < 8; ++r) {
                    const int row = r0 + r;
                    const float4 ua = *(const float4*)(U + row * 128 + ((ca ^ (row & 31)) << 2));
                    const float4 ug = *(const float4*)(U + row * 128 + (((16 + ca) ^ (row & 31)) << 2));
                    if (seg > 0 || r >= 2) {
                        float ca_[4], cg_[4];
                        ca_[0] = ba.x + w0a.x * a2.x + w1a.x * a1.x + w2a.x * ua.x; ca_[1] = ba.y + w0a.y * a2.y + w1a.y * a1.y + w2a.y * ua.y;
                        ca_[2] = ba.z + w0a.z * a2.z + w1a.z * a1.z + w2a.z * ua.z; ca_[3] = ba.w + w0a.w * a2.w + w1a.w * a1.w + w2a.w * ua.w;
                        cg_[0] = bg.x + w0g.x * g2.x + w1g.x * g1.x + w2g.x * ug.x; cg_[1] = bg.y + w0g.y * g2.y + w1g.y * g1.y + w2g.y * ug.y;
                        cg_[2] = bg.z + w0g.z * g2.z + w1g.z * g1.z + w2g.z * ug.z; cg_[3] = bg.w + w0g.w * g2.w + w1g.w * g1.w + w2g.w * ug.w;
                        f32x4 o = {ca_[0] * sigmoidf_(ca_[0]) * cg_[0], ca_[1] * sigmoidf_(ca_[1]) * cg_[1], ca_[2] * sigmoidf_(ca_[2]) * cg_[2], ca_[3] * sigmoidf_(ca_[3]) * cg_[3]};
                        *(uint2*)(act + (size_t)(m0 + row) * DFF + ncol) = pack4(o);
                    }
                    if (seg == 0 && r < 2) { *(float4*)(head + (size_t)(mt * 2 + r) * NFF2 + ncol) = ua; *(float4*)(head + (size_t)(mt * 2 + r) * NFF2 + DFF + ncol) = ug; }
                    if (seg == 31 && r >= 6) { *(float4*)(halo + (size_t)(mt * 2 + r - 6) * NFF2 + ncol) = ua; *(float4*)(halo + (size_t)(mt * 2 + r - 6) * NFF2 + DFF + ncol) = ug; }
                    a2 = a1; a1 = ua; g2 = g1; g1 = ug;
                }
            }
            __syncthreads();
        }
    }
}

template <int AMODE, int EPI>
__device__ __forceinline__ void gemm_big(const u16* __restrict__ A, int lda, const u16* __restrict__ Bt, int M, int Npad, int K, int vboff, const EpiArgs& e, unsigned char* smem, int tid_, int bid_) {
    const int tid = tid_, lane = tid & 63, w = tid >> 6, wm = w & 1, wn = w >> 1;
    const int c16 = lane & 15, q4 = lane >> 4;
    constexpr int MI = 8;
    const int ntm = (M + 255) >> 8, ntn = Npad >> 8, nk = K >> 5;
    const int kstride = (AMODE == AM_GATHER) ? 128 : 32;
    const float* cosT = (const float*)(e.ws + OFF_COS);
    const float* sinT = (const float*)(e.ws + OFF_SIN);
    int vb = bid_ + vboff; if (vb >= (int)gridDim.x) vb -= gridDim.x;
    const int xcd = vb & 7, loc = vb >> 3, nloc = gridDim.x >> 3;
    const int mpx = ntm >> 3, nfull = (ntn >> 3), bwl = ntn - (nfull << 3);
    const int tfull = nfull * mpx * 8, ttotal = mpx * ntn;
    for (int tl = loc; tl < ttotal; tl += nloc) {
        int mloc, nt;
        if (tl < tfull) { const int band = tl / (mpx * 8), r = tl - band * (mpx * 8); mloc = r >> 3; nt = band * 8 + (r & 7); }
        else { const int r = tl - tfull; mloc = r / bwl; nt = (nfull << 3) + (r - mloc * bwl); }
        const int mt = xcd * mpx + mloc;
        const int m0 = mt << 8, n0 = nt << 8;
        const int prow = ((w & 3) << 6) + (lane >> 2);
        const int pch = lane & 3;
        unsigned goff[4];
#pragma unroll
        for (int i = 0; i < 4; ++i) {
            const int row = prow + 16 * i;
            const int lc = pch ^ ((-(row >> 2)) & 3);
            if (w < 4) {
                int m = m0 + row; if (m > M - 1) m = M - 1;
                if (AMODE == AM_GATHER) { const int gq = m & 3, bn = m >> 2, bb = bn / 1023, n = bn - bb * 1023; goff[i] = (unsigned)((bb * S_ + n * 16) * 256 + gq * 64 + lc * 8); }
                else goff[i] = (unsigned)m * (unsigned)lda + (unsigned)(lc * 8);
            } else goff[i] = (unsigned)(n0 + row) * (unsigned)K + (unsigned)(lc * 8);
        }
        const u16* gbase = (w < 4) ? A : Bt;
        const int kst = (w < 4) ? ((AMODE == AM_GATHER) ? 0 : 32) : 32;
        typedef __attribute__((address_space(3))) unsigned* lds_u32p;
        const unsigned lbase = ((w < 4) ? 0u : 16384u) + (unsigned)(((w & 3) << 6) * 64) + (unsigned)lane * 16u;
        auto kofs = [&](int kt) __attribute__((always_inline)) -> unsigned {
            if (AMODE == AM_GATHER && w < 4) return (unsigned)((kt >> 1) * 256 + (kt & 1) * 32);
            return (unsigned)(kt * kst);
        };
        auto issue = [&](int kt) __attribute__((always_inline)) {
            const unsigned ko = kofs(kt);
            unsigned char* sb = smem + (kt & 3) * 32768 + lbase;
#pragma unroll
            for (int i = 0; i < 4; ++i)
                __builtin_amdgcn_global_load_lds((const unsigned*)(gbase + (goff[i] + ko)), (lds_u32p)(sb + i * 1024), 16, 0, 0);
        };
        f32x4 acc[4][MI];
#pragma unroll
        for (int a2 = 0; a2 < 4; ++a2)
#pragma unroll
            for (int b2 = 0; b2 < MI; ++b2) acc[a2][b2] = (f32x4){0.f, 0.f, 0.f, 0.f};
        const int swz = (-(c16 >> 2)) & 3;
        const int rch = (q4 ^ swz) << 4;
        issue(0); issue(1); issue(2);
        for (int kt = 0; kt < nk; ++kt) {
            if (kt + 2 < nk) asm volatile("s_waitcnt vmcnt(8)" ::: "memory");
            else if (kt + 1 < nk) asm volatile("s_waitcnt vmcnt(4)" ::: "memory");
            else asm volatile("s_waitcnt vmcnt(0)" ::: "memory");
            __builtin_amdgcn_s_barrier();
            if (kt + 3 < nk) issue(kt + 3);
            const unsigned char* sA = smem + (kt & 3) * 32768;
            const unsigned char* sB = sA + 16384;
            bf16x8 wf[4], af[MI];
#pragma unroll
            for (int ni = 0; ni < 4; ++ni) wf[ni] = *(const bf16x8*)(sB + (wn * 64 + ni * 16 + c16) * 64 + rch);
#pragma unroll
            for (int mi = 0; mi < MI; ++mi) af[mi] = *(const bf16x8*)(sA + (wm * 128 + mi * 16 + c16) * 64 + rch);
#pragma unroll
            for (int ni = 0; ni < 4; ++ni)
#pragma unroll
                for (int mi = 0; mi < MI; ++mi) acc[ni][mi] = mfma16(wf[ni], af[mi], acc[ni][mi]);
        }
        __syncthreads();
        const int nb = n0 + wn * 64;
        if (EPI == EPI_RESID) {
#pragma unroll
            for (int mi = 0; mi < MI; ++mi) { __builtin_amdgcn_sched_barrier(0);
                const size_t tok = m0 + wm * 128 + mi * 16 + c16;
#pragma unroll
                for (int ni = 0; ni < 4; ++ni) {
                    const int n = nb + ni * 16 + q4 * 4;
                    float4 r = *(const float4*)(e.resid + tok * 1024 + n);
                    r.x += acc[ni][mi][0]; r.y += acc[ni][mi][1]; r.z += acc[ni][mi][2]; r.w += acc[ni][mi][3];
                    *(float4*)(e.out + tok * 1024 + n) = r;
                }
            }
        } else if (EPI == EPI_CMP1) {
#pragma unroll
            for (int mi = 0; mi < MI; ++mi) { __builtin_amdgcn_sched_barrier(0);
                const int m = m0 + wm * 128 + mi * 16 + c16;
                if (m < M) {
#pragma unroll
                    for (int ni = 0; ni < 4; ++ni) {
                        const int n = nb + ni * 16 + q4 * 4;
                        const float4 bv = *(const float4*)(e.bias + n);
                        f32x4 o = {gelu_tanh(acc[ni][mi][0] + bv.x), gelu_tanh(acc[ni][mi][1] + bv.y), gelu_tanh(acc[ni][mi][2] + bv.z), gelu_tanh(acc[ni][mi][3] + bv.w)};
                        *(uint2*)(e.hid + (size_t)m * 256 + n) = pack4(o);
                    }
                }
            }
        } else if (EPI == EPI_BQ) {
            u16* Q = (u16*)(e.ws + OFF_Q);
#pragma unroll
            for (int mi = 0; mi < MI; ++mi) { __builtin_amdgcn_sched_barrier(0);
                const int tok = m0 + wm * 128 + mi * 16 + c16;
                rope_store(acc, mi, Q + (size_t)tok * 1024 + nb, cosT, sinT, tok & (S_ - 1), q4);
            }
        } else if (EPI == EPI_BKV) {
            u16* KSH = (u16*)(e.ws + OFF_KSH); u16* VSHT = (u16*)(e.ws + OFF_VSHT);
#pragma unroll
            for (int mi = 0; mi < MI; ++mi) { __builtin_amdgcn_sched_barrier(0);
                const int tok = m0 + wm * 128 + mi * 16 + c16, b = tok >> 14, s = tok & (S_ - 1);
                if (nb < 128) {
                    const int g = nb >> 6;
                    rope_store(acc, mi, KSH + ((size_t)(b * 2 + g) * S_ + s) * 64, cosT, sinT, s, q4);
                } else {
                    const int g = (nb - 128) >> 6;
#pragma unroll
                    for (int ni = 0; ni < 4; ++ni)
#pragma unroll
                        for (int i = 0; i < 4; ++i) VSHT[((size_t)(b * 2 + g) * 64 + ni * 16 + q4 * 4 + i) * S_ + s] = f2bf(acc[ni][mi][i]);
                }
            }
        } else if (EPI == EPI_AIN) {
            unsigned char* ws = e.ws;
#pragma unroll
            for (int mi = 0; mi < MI; ++mi) { __builtin_amdgcn_sched_barrier(0);
                const int tok = m0 + wm * 128 + mi * 16 + c16, b = tok >> 14, s = tok & (S_ - 1);
                if (nb < 1024) {
                    rope_store(acc, mi, (u16*)(ws + OFF_Q) + (size_t)tok * 1024 + nb, cosT, sinT, s, q4);
                } else if (nb < 1536) {
                    u16* dst = (nb < 1280) ? ((u16*)(ws + OFF_KC) + (size_t)tok * 256 + (nb - 1024)) : ((u16*)(ws + OFF_VC) + (size_t)tok * 256 + (nb - 1280));
#pragma unroll
                    for (int ni = 0; ni < 4; ++ni) *(uint2*)(dst + ni * 16 + q4 * 4) = pack4(acc[ni][mi]);
                } else if (nb < 2560) {
                    const int r = (nb - 1536) >> 8;
                    const int g = ((nb - 1536) & 255) >> 6;
                    if ((r & 1) == 0) {
                        u16* base = (u16*)(ws + (r == 0 ? OFF_KS : OFF_KW));
                        rope_store(acc, mi, base + ((size_t)(b * 4 + g) * S_ + s) * 64, cosT, sinT, s, q4);
                    } else {
                        if (r == 1) {
                            u16* base = (u16*)(ws + OFF_VST) + (size_t)(b * 4 + g) * 64 * S_ + (size_t)(s >> 6) * 4096 + (s & 63);
#pragma unroll
                            for (int ni = 0; ni < 4; ++ni)
#pragma unroll
                                for (int i = 0; i < 4; ++i) base[(ni * 16 + q4 * 4 + i) * 64] = f2bf(acc[ni][mi][i]);
                        } else {
                            u16* base = (u16*)(ws + OFF_VWT);
#pragma unroll
                            for (int ni = 0; ni < 4; ++ni)
#pragma unroll
                                for (int i = 0; i < 4; ++i) base[((size_t)(b * 4 + g) * 64 + ni * 16 + q4 * 4 + i) * S_ + s] = f2bf(acc[ni][mi][i]);
                        }
                    }
                } else if (nb == 2560) {
                    float* G = (float*)(ws + OFF_GATES) + (size_t)tok * 48;
#pragma unroll
                    for (int ni = 0; ni < 3; ++ni) {
                        const int n = ni * 16 + q4 * 4;
                        *(float4*)(G + n) = make_float4(sigmoidf_(acc[ni][mi][0]), sigmoidf_(acc[ni][mi][1]), sigmoidf_(acc[ni][mi][2]), sigmoidf_(acc[ni][mi][3]));
                    }
                }
            }
        } else if (EPI == EPI_FFNIN) {
            u16* U = (u16*)smem;
#pragma unroll
            for (int mi = 0; mi < MI; ++mi) {
                const int row = wm * 128 + mi * 16 + c16;
#pragma unroll
                for (int ni = 0; ni < 4; ++ni) {
                    const int cch = wn * 16 + ni * 4 + q4;
                    *(uint2*)(U + row * 256 + ((cch ^ (row & 15)) << 2)) = pack4(acc[ni][mi]);
                }
            }
            __syncthreads();
            {
                const int cc = tid & 31, gsel = cc >> 4, ca = cc & 15, seg = tid >> 5;
                const int ncol = (nt * 2 + gsel) * 64 + ca * 4;
                const int cha = gsel * 32 + ca, chg = cha + 16;
                const float4 w0a = *(const float4*)(e.convw + ncol), w1a = *(const float4*)(e.convw + NFF2 + ncol), w2a = *(const float4*)(e.convw + 2 * NFF2 + ncol);
                const float4 w0g = *(const float4*)(e.convw + DFF + ncol), w1g = *(const float4*)(e.convw + NFF2 + DFF + ncol), w2g = *(const float4*)(e.convw + 2 * NFF2 + DFF + ncol);
                const float4 ba = *(const float4*)(e.convb + ncol), bg = *(const float4*)(e.convb + DFF + ncol);
                float* head = (float*)(e.ws + OFF_HEAD); float* halo = (float*)(e.ws + OFF_HALO);
                u16* act = (u16*)(e.ws + OFF_ACT);
                auto ldu = [&](int row, int ch) __attribute__((always_inline)) -> float4 {
                    const uint2 v = *(const uint2*)(U + row * 256 + ((ch ^ (row & 15)) << 2));
                    return make_float4(__uint_as_float(v.x << 16), __uint_as_float(v.x & 0xffff0000u), __uint_as_float(v.y << 16), __uint_as_float(v.y & 0xffff0000u));
                };
                const int r0 = seg * 16;
                float4 a2 = make_float4(0.f, 0.f, 0.f, 0.f), a1 = a2, g2 = a2, g1 = a2;
                if (seg > 0) { a2 = ldu(r0 - 2, cha); g2 = ldu(r0 - 2, chg); a1 = ldu(r0 - 1, cha); g1 = ldu(r0 - 1, chg); }
#pragma unroll 2
                for (int r = 0; r < 16; ++r) {
                    const int row = r0 + r;
                    const float4 ua = ldu(row, cha), ug = ldu(row, chg);
                    if (seg > 0 || r >= 2) {
                        float ca_[4], cg_[4];
                        ca_[0] = ba.x + w0a.x * a2.x + w1a.x * a1.x + w2a.x * ua.x; ca_[1] = ba.y + w0a.y * a2.y + w1a.y * a1.y + w2a.y * ua.y;
                        ca_[2] = ba.z + w0a.z * a2.z + w1a.z * a1.z + w2a.z * ua.z; ca_[3] = ba.w + w0a.w * a2.w + w1a.w * a1.w + w2a.w * ua.w;
                        cg_[0] = bg.x + w0g.x * g2.x + w1g.x * g1.x + w2g.x * ug.x; cg_[1] = bg.y + w0g.y * g2.y + w1g.y * g1.y + w2g.y * ug.y;
                        cg_[2] = bg.z + w0g.z * g2.z + w1g.z * g1.z + w2g.z * ug.z; cg_[3] = bg.w + w0g.w * g2.w + w1g.w * g1.w + w2g.w * ug.w;
                        f32x4 o = {ca_[0] * sigmoidf_(ca_[0]) * cg_[0], ca_[1] * sigmoidf_(ca_[1]) * cg_[1], ca_[2] * sigmoidf_(ca_[2]) * cg_[2], ca_[3] * sigmoidf_(ca_[3]) * cg_[3]};
                        *(uint2*)(act + (size_t)(m0 + row) * DFF + ncol) = pack4(o);
                    }
                    if (seg == 0 && r < 2) { *(float4*)(head + (size_t)(mt * 2 + r) * NFF2 + ncol) = ua; *(float4*)(head + (size_t)(mt * 2 + r) * NFF2 + DFF + ncol) = ug; }
                    if (seg == 15 && r >= 14) { *(float4*)(halo + (size_t)(mt * 2 + r - 14) * NFF2 + ncol) = ua; *(float4*)(halo + (size_t)(mt * 2 + r - 14) * NFF2 + DFF + ncol) = ug; }
                    a2 = a1; a1 = ua; g2 = g1; g1 = ug;
                }
            }
            __syncthreads();
        }
    }
}

__device__ __forceinline__ void fixup_phase(const Params& p, int L, int tid_, int bid_) {
    const float* head = (const float*)(p.ws + OFF_HEAD); const float* halo = (const float*)(p.ws + OFF_HALO);
    u16* act = (u16*)(p.ws + OFF_ACT);
    const float* cw = p.ffn_conv_w + (size_t)L * 3 * NFF2; const float* cb = p.ffn_conv_b + (size_t)L * NFF2;
    const int gt = bid_ * NTHR + tid_, nthr = gridDim.x * NTHR;
    for (int idx = gt; idx < 128 * 704; idx += nthr) {
        const int i = idx / 704, n = (idx - i * 704) * 4;
        const int t0 = i * 256;
        const bool first = (t0 & (S_ - 1)) == 0;
        const float4 z = make_float4(0.f, 0.f, 0.f, 0.f);
        const float4 ha0 = *(const float4*)(head + (size_t)(i * 2) * NFF2 + n), ha1 = *(const float4*)(head + (size_t)(i * 2 + 1) * NFF2 + n);
        const float4 hg0 = *(const float4*)(head + (size_t)(i * 2) * NFF2 + DFF + n), hg1 = *(const float4*)(head + (size_t)(i * 2 + 1) * NFF2 + DFF + n);
        float4 pa0 = z, pa1 = z, pg0 = z, pg1 = z;
        if (!first) {
            pa0 = *(const float4*)(halo + (size_t)(i * 2 - 2) * NFF2 + n); pa1 = *(const float4*)(halo + (size_t)(i * 2 - 1) * NFF2 + n);
            pg0 = *(const float4*)(halo + (size_t)(i * 2 - 2) * NFF2 + DFF + n); pg1 = *(const float4*)(halo + (size_t)(i * 2 - 1) * NFF2 + DFF + n);
        }
        const float4 w0a = *(const float4*)(cw + n), w1a = *(const float4*)(cw + NFF2 + n), w2a = *(const float4*)(cw + 2 * NFF2 + n);
        const float4 w0g = *(const float4*)(cw + DFF + n), w1g = *(const float4*)(cw + NFF2 + DFF + n), w2g = *(const float4*)(cw + 2 * NFF2 + DFF + n);
        const float4 ba = *(const float4*)(cb + n), bg = *(const float4*)(cb + DFF + n);
#define CONV3(b_, w0_, w1_, w2_, x0_, x1_, x2_) make_float4(b_.x + w0_.x * x0_.x + w1_.x * x1_.x + w2_.x * x2_.x, b_.y + w0_.y * x0_.y + w1_.y * x1_.y + w2_.y * x2_.y, \
                                                             b_.z + w0_.z * x0_.z + w1_.z * x1_.z + w2_.z * x2_.z, b_.w + w0_.w * x0_.w + w1_.w * x1_.w + w2_.w * x2_.w)
        const float4 ca0 = CONV3(ba, w0a, w1a, w2a, pa0, pa1, ha0), cg0 = CONV3(bg, w0g, w1g, w2g, pg0, pg1, hg0);
        const float4 ca1 = CONV3(ba, w0a, w1a, w2a, pa1, ha0, ha1), cg1 = CONV3(bg, w0g, w1g, w2g, pg1, hg0, hg1);
        f32x4 o0 = {ca0.x * sigmoidf_(ca0.x) * cg0.x, ca0.y * sigmoidf_(ca0.y) * cg0.y, ca0.z * sigmoidf_(ca0.z) * cg0.z, ca0.w * sigmoidf_(ca0.w) * cg0.w};
        f32x4 o1 = {ca1.x * sigmoidf_(ca1.x) * cg1.x, ca1.y * sigmoidf_(ca1.y) * cg1.y, ca1.z * sigmoidf_(ca1.z) * cg1.z, ca1.w * sigmoidf_(ca1.w) * cg1.w};
        *(uint2*)(act + (size_t)t0 * DFF + n) = pack4(o0);
        *(uint2*)(act + (size_t)(t0 + 1) * DFF + n) = pack4(o1);
    }
}

__device__ __forceinline__ void cmp2_phase(const Params& p, int L, int tid_, int bid_) {
    const int lane = tid_ & 63, w = tid_ >> 6, c16 = lane & 15, q4 = lane >> 4;
    const float* cosT = (const float*)(p.ws + OFF_COS); const float* sinT = (const float*)(p.ws + OFF_SIN);
    u16* KCC = (u16*)(p.ws + OFF_KCC); u16* VCCT = (u16*)(p.ws + OFF_VCCT);
    for (int task = bid_ * NW + w; task < 1024; task += gridDim.x * NW) {
        const int kv = task >> 9, r0 = (task & 511) * 16;
        const u16* hid = (const u16*)(p.ws + OFF_HID) + (size_t)kv * 8192 * 256;
        const u16* w2t = (const u16*)(p.ws + OFF_WT_CW2 + (L * 2 + kv) * SZ_WT_CW2);
        const int row = r0 + c16, rowc = row < 8184 ? row : 8183;
        f32x4 acc[4][1];
        f32x4 accq[4][4];
#pragma unroll
        for (int a = 0; a < 4; ++a) accq[a][0] = (f32x4){0.f, 0.f, 0.f, 0.f};
#pragma unroll
        for (int kk = 0; kk < 8; ++kk) {
            const bf16x8 bfr = *(const bf16x8*)(hid + (size_t)rowc * 256 + kk * 32 + q4 * 8);
#pragma unroll
            for (int nbk = 0; nbk < 4; ++nbk) {
                const bf16x8 afr = *(const bf16x8*)(w2t + (nbk * 16 + c16) * 256 + kk * 32 + q4 * 8);
                accq[nbk][0] = mfma16(afr, bfr, accq[nbk][0]);
            }
        }
        (void)acc;
        if (row < 8184) {
            const int g = row & 3, bn = row >> 2, b = bn / 1023, n = bn - b * 1023, bg = b * 4 + g;
            if (kv == 0) {
                rope_store(accq, 0, KCC + ((size_t)bg * 1024 + n) * 64, cosT, sinT, n * 16 + 31, q4);
            } else {
#pragma unroll
                for (int nbk = 0; nbk < 4; ++nbk)
#pragma unroll
                    for (int i = 0; i < 4; ++i) VCCT[((size_t)bg * 64 + nbk * 16 + q4 * 4 + i) * 1024 + n] = f2bf(accq[nbk][0][i]);
            }
        }
    }
    const int gt = bid_ * NTHR + tid_;
    if (gt < 512) {
        const int bg = gt >> 6, d = gt & 63;
        KCC[((size_t)bg * 1024 + 1023) * 64 + d] = 0;
        VCCT[((size_t)bg * 64 + d) * 1024 + 1023] = 0;
    }
}

template <bool SINK>
__device__ __forceinline__ void band_attn(const u16* __restrict__ qrow, const u16* __restrict__ Kh, const u16* __restrict__ VT, int t0, int W, const float* sinks4,
                                          f32x4 (&O)[4][4], float (&linv)[4], int lane) {
    const int c16 = lane & 15, q4 = lane >> 4;
    const float SC = 0.125f * LOG2E;
    bf16x8 qf[4][2];
#pragma unroll
    for (int h = 0; h < 4; ++h)
#pragma unroll
        for (int ks = 0; ks < 2; ++ks) qf[h][ks] = *(const bf16x8*)(qrow + h * 64 + ks * 32 + q4 * 8);
    float m[4], l[4];
#pragma unroll
    for (int h = 0; h < 4; ++h) {
        if (SINK) { m[h] = sinks4[h] * LOG2E; l[h] = (q4 == 0) ? 1.f : 0.f; }
        else { m[h] = NEGBIG; l[h] = 0.f; }
#pragma unroll
        for (int db = 0; db < 4; ++db) O[h][db] = (f32x4){0.f, 0.f, 0.f, 0.f};
    }
    const int t = t0 + c16;
    int lo = t0 - W + 1; if (lo < 0) lo = 0;
    const int g0 = lo >> 5, g1 = (t0 + 15) >> 5;
    const int kr = kperm(c16);
    for (int grp = g0; grp <= g1; ++grp) {
        const int kb = grp << 5;
        const unsigned kof = (unsigned)(kb + kr) * 64u + (unsigned)q4 * 8u;
        const bf16x8 k1a = *(const bf16x8*)(Kh + kof), k1b = *(const bf16x8*)(Kh + (kof + 32u)), k2a = *(const bf16x8*)(Kh + (kof + 256u)), k2b = *(const bf16x8*)(Kh + (kof + 288u));
        bf16x8 vf[4];
        const unsigned vof = (unsigned)c16 * (unsigned)S_ + (unsigned)kb + (unsigned)q4 * 8u;
#pragma unroll
        for (int db = 0; db < 4; ++db) vf[db] = *(const bf16x8*)(VT + (size_t)(db * 16 * S_) + vof);
        const int kpos = kb + q4 * 8;
#pragma unroll
        for (int h = 0; h < 4; ++h) {
            f32x4 s1 = mfma16(k1a, qf[h][0], (f32x4){0.f, 0.f, 0.f, 0.f}); s1 = mfma16(k1b, qf[h][1], s1);
            f32x4 s2 = mfma16(k2a, qf[h][0], (f32x4){0.f, 0.f, 0.f, 0.f}); s2 = mfma16(k2b, qf[h][1], s2);
            float sv[8]; bool ok[8];
#pragma unroll
            for (int i = 0; i < 4; ++i) {
                const int d1 = t - (kpos + i), d2 = t - (kpos + 4 + i);
                ok[i] = (d1 >= 0) && (d1 < W); ok[4 + i] = (d2 >= 0) && (d2 < W);
                sv[i] = ok[i] ? s1[i] * SC : NEGBIG; sv[4 + i] = ok[4 + i] ? s2[i] * SC : NEGBIG;
            }
            float mx = fmaxf(fmaxf(fmaxf(sv[0], sv[1]), fmaxf(sv[2], sv[3])), fmaxf(fmaxf(sv[4], sv[5]), fmaxf(sv[6], sv[7])));
            mx = xmax32(xmax16(mx));
            const float mn = fmaxf(m[h], mx);
            const float alpha = fexp2(m[h] - mn);
            m[h] = mn;
            float pv[8]; float ps = 0.f;
#pragma unroll
            for (int i = 0; i < 8; ++i) { pv[i] = ok[i] ? fexp2(sv[i] - mn) : 0.f; ps += pv[i]; }
            l[h] = l[h] * alpha + ps;
            const bf16x8 pf = pack8(pv);
#pragma unroll
            for (int db = 0; db < 4; ++db) { O[h][db] = O[h][db] * alpha; O[h][db] = mfma16(vf[db], pf, O[h][db]); }
        }
    }
#pragma unroll
    for (int h = 0; h < 4; ++h) { float lt = l[h]; lt += __shfl_xor(lt, 16); lt += __shfl_xor(lt, 32); linv[h] = 1.f / lt; }
}

__device__ __forceinline__ void swa_phase(const Params& p, int j, int tid_, int bid_) {
    const int lane = tid_ & 63, w = tid_ >> 6, c16 = lane & 15, q4 = lane >> 4;
    const int x = bid_ & 7, b = x >> 2, kvh = (x >> 1) & 1, hq = x & 1;
    const int head0 = kvh * 8 + hq * 4;
    const u16* Q = (const u16*)(p.ws + OFF_Q); u16* Ob = (u16*)(p.ws + OFF_O);
    const u16* Kh = (const u16*)(p.ws + OFF_KSH) + (size_t)(b * 2 + kvh) * S_ * 64;
    const u16* VT = (const u16*)(p.ws + OFF_VSHT) + (size_t)(b * 2 + kvh) * 64 * S_;
    const float* sk = p.b_sinks + j * 16 + head0;
    const int nslots = (gridDim.x >> 3) * NW;
    for (int tile = (bid_ >> 3) * NW + w; tile < 1024; tile += nslots) {
        const int t0 = tile * 16;
        f32x4 O[4][4]; float linv[4];
        band_attn<true>(Q + ((size_t)b * S_ + t0 + c16) * 1024 + head0 * 64, Kh, VT, t0, 128, sk, O, linv, lane);
        u16* op = Ob + ((size_t)b * S_ + t0 + c16) * 1024 + head0 * 64;
#pragma unroll
        for (int h = 0; h < 4; ++h)
#pragma unroll
            for (int db = 0; db < 4; ++db) *(uint2*)(op + h * 64 + db * 16 + q4 * 4) = pack4(O[h][db] * linv[h]);
    }
}

__device__ __forceinline__ void nsa_phase(const Params& p, unsigned char* smem, int tid_, int bid_, int probe_rep) {
    const int lane0 = tid_ & 63, w = tid_ >> 6;
    float* R = (float*)(smem + w * 16384);
    unsigned* tm = (unsigned*)(smem + NW * 16384 + w * 1024);
    unsigned char* sel = smem + NW * 16384 + NW * 1024 + w * 256;
    const int bg = bid_ & 7, b = bg >> 2, g = bg & 3;
    const u16* Q = (const u16*)(p.ws + OFF_Q); u16* Ob = (u16*)(p.ws + OFF_O);
    const u16* KCC = (const u16*)(p.ws + OFF_KCC) + (size_t)bg * 1024 * 64;
    const u16* VCCT = (const u16*)(p.ws + OFF_VCCT) + (size_t)bg * 64 * 1024;
    const u16* KS = (const u16*)(p.ws + OFF_KS) + (size_t)bg * S_ * 64;
    const u16* VST = (const u16*)(p.ws + OFF_VST) + (size_t)bg * 64 * S_;
    const u16* KW = (const u16*)(p.ws + OFF_KW) + (size_t)bg * S_ * 64;
    const u16* VWT = (const u16*)(p.ws + OFF_VWT) + (size_t)bg * 64 * S_;
    const float* GATES = (const float*)(p.ws + OFF_GATES);
    const float SC = 0.125f * LOG2E;
    const int nslots = (gridDim.x >> 3) * NW;
    const int slot_ = (bid_ >> 3) * NW + w;
    for (int rnd = 0; rnd * nslots < 1024; ++rnd) {
        const int tile_ = rnd * nslots + ((rnd & 1) ? (nslots - 1 - slot_) : slot_);
        if (tile_ >= 1024) continue;
        const int tile = __builtin_amdgcn_readfirstlane(tile_);
        int lane = lane0; asm volatile("" : "+v"(lane));
        const int c16 = lane & 15, q4 = lane >> 4, kr = kperm(c16);
        const int t0 = tile * 16, cur = t0 >> 6, t = t0 + c16;
        const u16* qrow = Q + ((size_t)b * S_ + t) * 1024 + g * 256;
        const float* grow = GATES + ((size_t)b * S_ + t) * 48 + g * 12;
        const int nvl = (t >= 31) ? ((t - 31) >> 4) : -1;
        const int nvmax = (t0 + 15 >= 31) ? ((t0 + 15 - 31) >> 4) : -1;
        const int ng = (nvmax >= 0) ? ((nvmax >> 5) + 1) : 0;
        f32x4 Oc[4][4];
#pragma unroll
        for (int h = 0; h < 4; ++h)
#pragma unroll
            for (int db = 0; db < 4; ++db) Oc[h][db] = (f32x4){0.f, 0.f, 0.f, 0.f};
        {
            bf16x8 qf[4][2];
#pragma unroll
            for (int h = 0; h < 4; ++h)
#pragma unroll
                for (int ks = 0; ks < 2; ++ks) qf[h][ks] = *(const bf16x8*)(qrow + h * 64 + ks * 32 + q4 * 8);
            float m[4], l[4];
#pragma unroll
            for (int h = 0; h < 4; ++h) { m[h] = NEGBIG; l[h] = 0.f; }
            for (int grp = 0; grp < ng; ++grp) {
                const int kb = grp << 5;
                const unsigned kof = (unsigned)(kb + kr) * 64u + (unsigned)q4 * 8u;
                const bf16x8 k1a = *(const bf16x8*)(KCC + kof), k1b = *(const bf16x8*)(KCC + (kof + 32u)), k2a = *(const bf16x8*)(KCC + (kof + 256u)), k2b = *(const bf16x8*)(KCC + (kof + 288u));
                const int kpos = kb + q4 * 8;
#pragma unroll
                for (int h = 0; h < 4; ++h) {
                    f32x4 s1 = mfma16(k1a, qf[h][0], (f32x4){0.f, 0.f, 0.f, 0.f}); s1 = mfma16(k1b, qf[h][1], s1);
                    f32x4 s2 = mfma16(k2a, qf[h][0], (f32x4){0.f, 0.f, 0.f, 0.f}); s2 = mfma16(k2b, qf[h][1], s2);
                    float sv[8]; bool ok[8];
#pragma unroll
                    for (int i = 0; i < 4; ++i) {
                        ok[i] = (kpos + i) <= nvl; ok[4 + i] = (kpos + 4 + i) <= nvl;
                        sv[i] = ok[i] ? s1[i] * SC : NEGBIG; sv[4 + i] = ok[4 + i] ? s2[i] * SC : NEGBIG;
                    }
                    float mx = fmaxf(fmaxf(fmaxf(sv[0], sv[1]), fmaxf(sv[2], sv[3])), fmaxf(fmaxf(sv[4], sv[5]), fmaxf(sv[6], sv[7])));
                    mx = xmax32(xmax16(mx));
                    const float mn = fmaxf(m[h], mx);
                    const float alpha = fexp2(m[h] - mn);
                    m[h] = mn;
                    float ps = 0.f;
#pragma unroll
                    for (int i = 0; i < 8; ++i) ps += ok[i] ? fexp2(sv[i] - mn) : 0.f;
                    l[h] = l[h] * alpha + ps;
                }
            }
            float linv[4];
#pragma unroll
            for (int h = 0; h < 4; ++h) { float lt = l[h]; lt += __shfl_xor(lt, 16); lt += __shfl_xor(lt, 32); linv[h] = lt > 0.f ? 1.f / lt : 0.f; }
            float carry = 0.f;
            for (int grp = 0; grp < ng; ++grp) {
                const int kb = grp << 5;
                const unsigned kof = (unsigned)(kb + kr) * 64u + (unsigned)q4 * 8u;
                const bf16x8 k1a = *(const bf16x8*)(KCC + kof), k1b = *(const bf16x8*)(KCC + (kof + 32u)), k2a = *(const bf16x8*)(KCC + (kof + 256u)), k2b = *(const bf16x8*)(KCC + (kof + 288u));
                bf16x8 vf[4];
#pragma unroll
                for (int db = 0; db < 4; ++db) vf[db] = *(const bf16x8*)(VCCT + (unsigned)(db * 16 * 1024) + ((unsigned)c16 * 1024u + (unsigned)kb + (unsigned)q4 * 8u));
                const int kpos = kb + q4 * 8;
                float psum[8];
#pragma unroll
                for (int i = 0; i < 8; ++i) psum[i] = 0.f;
#pragma unroll
                for (int h = 0; h < 4; ++h) {
                    f32x4 s1 = mfma16(k1a, qf[h][0], (f32x4){0.f, 0.f, 0.f, 0.f}); s1 = mfma16(k1b, qf[h][1], s1);
                    f32x4 s2 = mfma16(k2a, qf[h][0], (f32x4){0.f, 0.f, 0.f, 0.f}); s2 = mfma16(k2b, qf[h][1], s2);
                    float pv[8];
#pragma unroll
                    for (int i = 0; i < 4; ++i) {
                        pv[i] = ((kpos + i) <= nvl) ? fexp2(s1[i] * SC - m[h]) * linv[h] : 0.f;
                        pv[4 + i] = ((kpos + 4 + i) <= nvl) ? fexp2(s2[i] * SC - m[h]) * linv[h] : 0.f;
                    }
#pragma unroll
                    for (int i = 0; i < 8; ++i) psum[i] += pv[i];
                    const bf16x8 pf = pack8(pv);
#pragma unroll
                    for (int db = 0; db < 4; ++db) Oc[h][db] = mfma16(vf[db], pf, Oc[h][db]);
                }
                const float prev = __shfl(psum[7], (lane + 48) & 63);
                const float left = (q4 == 0) ? carry : prev;
                carry = prev;
                const float impA = left + 2.f * (psum[0] + psum[1] + psum[2]) + psum[3];
                const float impB = psum[3] + 2.f * (psum[4] + psum[5] + psum[6]) + psum[7];
                *(float2*)(R + c16 * 256 + (kb >> 2) + 2 * q4) = make_float2(impA, impB);
            }
        }
        wsync();
        const int ncand = cur - 2;
        const int npick = ncand < 0 ? 0 : (ncand < 13 ? ncand : 13);
        const int nforced = (cur < 2 ? cur : 2) + 1;
        const int nsel = npick + nforced;
        for (int tk = 0; tk < 16; ++tk) {
            float v0 = -1.f, v1 = -1.f, v2 = -1.f, v3 = -1.f;
            if (npick > 0) {
                const float4 v = *(const float4*)(R + tk * 256 + lane * 4);
                const int j0 = lane * 4;
                v0 = (j0 >= 1 && j0 <= ncand) ? v.x : -1.f; v1 = (j0 + 1 <= ncand) ? v.y : -1.f; v2 = (j0 + 2 <= ncand) ? v.z : -1.f; v3 = (j0 + 3 <= ncand) ? v.w : -1.f;
            }
            for (int it = 0; it < npick; ++it) {
                float mx = fmaxf(fmaxf(v0, v1), fmaxf(v2, v3));
                mx = wave_max(mx);
                const bool has = (v0 == mx) || (v1 == mx) || (v2 == mx) || (v3 == mx);
                const unsigned long long bal = __ballot(has);
                const int first = __ffsll((long long)bal) - 1;
                if (lane == first) {
                    int sl;
                    if (v0 == mx) { sl = 0; v0 = -1.f; } else if (v1 == mx) { sl = 1; v1 = -1.f; } else if (v2 == mx) { sl = 2; v2 = -1.f; } else { sl = 3; v3 = -1.f; }
                    sel[tk * 16 + it] = (unsigned char)(lane * 4 + sl);
                }
            }
            if (lane == 0) {
                sel[tk * 16 + npick] = 0;
                if (cur >= 1) sel[tk * 16 + npick + 1] = (unsigned char)cur;
                if (cur >= 2) sel[tk * 16 + npick + 2] = (unsigned char)(cur - 1);
            }
        }
        { unsigned zz = 0u; asm volatile("" : "+v"(zz)); *(uint4*)(tm + lane * 4) = make_uint4(zz, zz, zz, zz); }
        wsync();
        if (lane < 16) {
            for (int si = 0; si < nsel; ++si) atomicOr(&tm[sel[lane * 16 + si]], 1u << lane);
        }
        wsync();
        int n_act;
        {
            const uint4 mm = *(const uint4*)(tm + lane * 4);
            wsync();
            const bool f0 = mm.x != 0u, f1 = mm.y != 0u, f2 = mm.z != 0u, f3 = mm.w != 0u;
            const unsigned long long b0 = __ballot(f0), b1 = __ballot(f1), b2 = __ballot(f2), b3 = __ballot(f3);
            const unsigned long long below = (1ull << lane) - 1ull;
            int pos = __popcll(b0 & below) + __popcll(b1 & below) + __popcll(b2 & below) + __popcll(b3 & below);
            if (f0) { sel[pos] = (unsigned char)(lane * 4 + 0); ++pos; }
            if (f1) { sel[pos] = (unsigned char)(lane * 4 + 1); ++pos; }
            if (f2) { sel[pos] = (unsigned char)(lane * 4 + 2); ++pos; }
            if (f3) { sel[pos] = (unsigned char)(lane * 4 + 3); ++pos; }
            n_act = __popcll(b0) + __popcll(b1) + __popcll(b2) + __popcll(b3);
        }
        wsync();
        u16* QL = (u16*)R;
        u16* PL = (u16*)R + 4096;
        {
            int t3 = t; asm volatile("" : "+v"(t3));
            const float* grow3 = GATES + ((size_t)b * S_ + t3) * 48 + g * 12;
#pragma unroll
            for (int h = 0; h < 4; ++h) {
                const float g0 = grow3[h * 3 + 0];
#pragma unroll
                for (int db = 0; db < 4; ++db) *(uint2*)(PL + (c16 * 4 + h) * 64 + db * 16 + q4 * 4) = pack4(Oc[h][db] * g0);
            }
#pragma unroll
            for (int i = 0; i < 8; ++i) {
                const int idx = i * 64 + lane, row = idx >> 3, ch = idx & 7;
                const uint4 v = *(const uint4*)(Q + ((size_t)b * S_ + t0 + (row >> 2)) * 1024 + g * 256 + (row & 3) * 64 + ch * 8);
                *(uint4*)(QL + row * 64 + ((ch ^ ((row >> 1) & 7)) << 3)) = v;
            }
        }
        wsync();
        for (int rep = 0; rep <= probe_rep; ++rep) {
            const int tg = c16 >> 2, hh = c16 & 3;
            f32x4 Os[4][4]; float m[4], l[4];
#pragma unroll
            for (int gq = 0; gq < 4; ++gq) {
                m[gq] = NEGBIG; l[gq] = 0.f;
#pragma unroll
                for (int db = 0; db < 4; ++db) Os[gq][db] = (f32x4){0.f, 0.f, 0.f, 0.f};
            }
            const int qsw = (c16 >> 1) & 7;
            auto ld = [&](int s, bf16x8 (&K)[4], bf16x8 (&V)[4]) __attribute__((always_inline)) {
                const int j = __builtin_amdgcn_readfirstlane((int)sel[s >> 1]);
                const int kb = j * 64 + (s & 1) * 32;
                const unsigned kof = (unsigned)(kb + kr) * 64u + (unsigned)q4 * 8u;
                K[0] = *(const bf16x8*)(KS + kof); K[1] = *(const bf16x8*)(KS + (kof + 32u)); K[2] = *(const bf16x8*)(KS + (kof + 256u)); K[3] = *(const bf16x8*)(KS + (kof + 288u));
                const unsigned vof = (unsigned)j * 4096u + (unsigned)c16 * 64u + (unsigned)(s & 1) * 32u + (unsigned)q4 * 8u;
#pragma unroll
                for (int db = 0; db < 4; ++db) V[db] = *(const bf16x8*)(VST + (vof + (unsigned)(db * 1024)));
            };
            auto cp = [&](int s, const bf16x8 (&K)[4], const bf16x8 (&V)[4]) __attribute__((always_inline)) {
                const int j = __builtin_amdgcn_readfirstlane((int)sel[s >> 1]);
                const unsigned mk = __builtin_amdgcn_readfirstlane(tm[j]);
                const int kpos = j * 64 + (s & 1) * 32 + q4 * 8;
#pragma unroll
                for (int gq = 0; gq < 4; ++gq) {
                    const unsigned gm = (mk >> (gq * 4)) & 0xFu;
                    if (gm == 0u) continue;
                    const bf16x8 q0 = *(const bf16x8*)(QL + (gq * 16 + c16) * 64 + ((q4 ^ qsw) << 3));
                    const bf16x8 q1 = *(const bf16x8*)(QL + (gq * 16 + c16) * 64 + (((4 + q4) ^ qsw) << 3));
                    const float cmv = ((gm >> tg) & 1u) ? 0.f : NEGBIG;
                    f32x4 cm1 = {cmv, cmv, cmv, cmv}, cm2 = cm1;
                    if (j == cur) {
                        const int tc = t0 + gq * 4 + tg;
#pragma unroll
                        for (int i = 0; i < 4; ++i) { if (kpos + i > tc) cm1[i] = NEGBIG; if (kpos + 4 + i > tc) cm2[i] = NEGBIG; }
                    }
                    f32x4 s1 = mfma16(K[0], q0, cm1); s1 = mfma16(K[1], q1, s1);
                    f32x4 s2 = mfma16(K[2], q0, cm2); s2 = mfma16(K[3], q1, s2);
                    float mx = fmaxf(fmaxf(fmaxf(s1[0], s1[1]), fmaxf(s1[2], s1[3])), fmaxf(fmaxf(s2[0], s2[1]), fmaxf(s2[2], s2[3])));
                    mx = xmax32(xmax16(mx));
                    const float mn = fmaxf(m[gq], mx * SC);
                    if (__ballot(mn != m[gq])) {
                        const float alpha = fexp2(m[gq] - mn);
                        l[gq] *= alpha;
#pragma unroll
                        for (int db = 0; db < 4; ++db) Os[gq][db] = Os[gq][db] * alpha;
                    }
                    m[gq] = mn;
                    float pv[8]; float ps = 0.f;
#pragma unroll
                    for (int i = 0; i < 4; ++i) { pv[i] = fexp2(fmaf(s1[i], SC, -mn)); pv[4 + i] = fexp2(fmaf(s2[i], SC, -mn)); }
#pragma unroll
                    for (int i = 0; i < 8; ++i) ps += pv[i];
                    l[gq] += ps;
                    const bf16x8 pf = pack8(pv);
#pragma unroll
                    for (int db = 0; db < 4; ++db) Os[gq][db] = mfma16(V[db], pf, Os[gq][db]);
                }
            };
            {
                bf16x8 KA[4], VA[4], KB[4], VB[4];
                const int ns = 2 * n_act;
                ld(0, KA, VA);
                for (int s = 0; s < ns; s += 2) {
                    ld(s + 1, KB, VB);
                    cp(s, KA, VA);
                    if (s + 2 < ns) ld(s + 2, KA, VA);
                    cp(s + 1, KB, VB);
                }
            }
            const float repsc = (rep == 0) ? 1.f : 0.f;
#pragma unroll
            for (int gq = 0; gq < 4; ++gq) {
                float lt = l[gq]; lt += __shfl_xor(lt, 16); lt += __shfl_xor(lt, 32);
                const int tok = gq * 4 + tg;
                const float sc = repsc * GATES[((size_t)b * S_ + t0 + tok) * 48 + g * 12 + hh * 3 + 1] / lt;
#pragma unroll
                for (int db = 0; db < 4; ++db) {
                    u16* rp = PL + (tok * 4 + hh) * 64 + db * 16 + q4 * 4;
                    *(uint2*)rp = pack4(unpack4(*(const uint2*)rp) + Os[gq][db] * sc);
                }
            }
        }
        wsync();
        {
            f32x4 Ow[4][4]; float linv[4];
            int t2 = t; asm volatile("" : "+v"(t2));
            const u16* qrow2 = Q + ((size_t)b * S_ + t2) * 1024 + g * 256;
            const float* grow2 = GATES + ((size_t)b * S_ + t2) * 48 + g * 12;
            band_attn<false>(qrow2, KW, VWT, t0, 512, nullptr, Ow, linv, lane);
            u16* op = Ob + ((size_t)b * S_ + t2) * 1024 + g * 256;
#pragma unroll
            for (int h = 0; h < 4; ++h) {
                const float g2 = grow2[h * 3 + 2] * linv[h];
#pragma unroll
                for (int db = 0; db < 4; ++db) {
                    const f32x4 part = unpack4(*(const uint2*)(PL + (c16 * 4 + h) * 64 + db * 16 + q4 * 4));
                    *(uint2*)(op + h * 64 + db * 16 + q4 * 4) = pack4(part + Ow[h][db] * g2);
                }
            }
        }
        wsync();
    }
}


#define XB_TMO      128
#define XB_XCNT(j)  (256  + 64 * (j))
#define XB_XSUB(j)  (1280 + 64 * (j))
#define XB_XGEN(j)  (2304 + 64 * (j))
#define XB_TOP      3328
#define XB_TOPGEN   3392
#define XCD_BAR_WORDS 3456
#define XB_SPIN_CAP (1u << 22)
#define LAS __attribute__((address_space(3)))
__device__ __forceinline__ unsigned xb_ld(unsigned* p)              { return __hip_atomic_load(p, __ATOMIC_RELAXED, __HIP_MEMORY_SCOPE_AGENT); }
__device__ __forceinline__ unsigned xb_add(unsigned* p, unsigned v) { return __hip_atomic_fetch_add(p, v, __ATOMIC_RELAXED, __HIP_MEMORY_SCOPE_AGENT); }
__device__ __forceinline__ unsigned xb_xcc_id() { return (unsigned)__builtin_amdgcn_s_getreg((3 << 11) | 20) & 0xFu; }
#define XB_SPIN(cond, bar) do { unsigned _sp = 0; while (cond) { __builtin_amdgcn_s_sleep(1); \
    if ((++_sp & 255u) == 0u) { if (xb_ld(&(bar)[XB_TMO])) break; if (_sp > XB_SPIN_CAP) { atomicAdd(&(bar)[XB_TMO], 1u); break; } } } } while (0)
__device__ __forceinline__ void xcd_barrier_complete(unsigned* bar, unsigned x, unsigned& nloc, unsigned& nx) {
    const unsigned G = gridDim.x * gridDim.y * gridDim.z;
    unsigned sum, cnt, mine, sp = 0u;
    for (;;) {
        sum = 0u; cnt = 0u; mine = 0u;
#pragma unroll
        for (unsigned j = 0; j < 16; ++j) { const unsigned c = xb_ld(&bar[XB_XCNT(j)]); sum += c; cnt += (c > 0u) ? 1u : 0u; mine = (j == x) ? c : mine; }
        if (sum == G) break;
        __builtin_amdgcn_s_sleep(1);
        if ((++sp & 255u) == 0u) { if (xb_ld(&bar[XB_TMO])) break; if (sp > XB_SPIN_CAP) { atomicAdd(&bar[XB_TMO], 1u); break; } }
    }
    nloc = mine > 0u ? mine : 1u; nx = cnt > 0u ? cnt : 1u;
}
__device__ __forceinline__ void xcd_barrier(unsigned* bar, unsigned x, volatile LAS unsigned* st, int tid) {
    asm volatile("s_waitcnt vmcnt(0)" ::: "memory");
    __syncthreads();
    if (tid == 0) {
        __builtin_amdgcn_s_waitcnt(0);
        unsigned nloc = st[0], nx = st[1];
        if (nloc == 0u) { xcd_barrier_complete(bar, x, nloc, nx); st[0] = nloc; st[1] = nx; }
        const unsigned old = xb_add(&bar[XB_XSUB(x)], 1u);
        const unsigned gen = old / nloc;
        if (old + 1u == (gen + 1u) * nloc) {
            __builtin_amdgcn_fence(__ATOMIC_RELEASE, "agent");
            asm volatile("s_waitcnt vmcnt(0)" ::: "memory");
            const unsigned og = xb_add(&bar[XB_TOP], 1u);
            const unsigned tg = og / nx;
            if (og + 1u == (tg + 1u) * nx) xb_add(&bar[XB_TOPGEN], 1u);
            else XB_SPIN(xb_ld(&bar[XB_TOPGEN]) == tg, bar);
            __builtin_amdgcn_fence(__ATOMIC_ACQUIRE, "agent");
            xb_add(&bar[XB_XGEN(x)], 1u);
            asm volatile("s_waitcnt vmcnt(0)" ::: "memory");
        } else {
            XB_SPIN(xb_ld(&bar[XB_XGEN(x)]) == gen, bar);
            __builtin_amdgcn_fence(__ATOMIC_ACQUIRE, "agent");
            asm volatile("s_waitcnt vmcnt(0)" ::: "memory");
        }
    }
    __syncthreads();
}

enum { PT_PREP = 0, PT_NORM, PT_AIN, PT_CMP1, PT_CMP2, PT_NSA, PT_BKV, PT_BQ, PT_SWA, PT_AOUT, PT_FFNIN, PT_FIXUP, PT_FOUT, PT_FINAL };

__global__ void __launch_bounds__(NTHR, 2) mega(Params p) {
#if defined(__HIP_DEVICE_COMPILE__)
    extern __shared__ __attribute__((aligned(16))) unsigned char smem[];
    cg::grid_group grid = cg::this_grid();
    typedef const Params __attribute__((address_space(4)))* KP;
    const int ph_lo = p.ph_lo, ph_hi = p.ph_hi;
    const int wave_id = __builtin_amdgcn_readfirstlane((int)(threadIdx.x >> 6));
    unsigned* bar = (unsigned*)(p.ws + OFF_BAR);
    volatile LAS unsigned* xst = (volatile LAS unsigned*)(smem + LDS_USER);
    const unsigned xcc = __builtin_amdgcn_readfirstlane(xb_xcc_id());
    if (ph_hi - ph_lo > 1) {
        if (threadIdx.x == 0) { xst[0] = 0u; xst[1] = 0u; (void)xb_add(&bar[XB_XCNT(xcc)], 1u); }
        __syncthreads();
    }
    for (int ph = ph_lo; ph < ph_hi; ++ph) {
        int tid_, bid_ = blockIdx.x;
        asm volatile("v_mbcnt_lo_u32_b32 %0, -1, 0\n\tv_mbcnt_hi_u32_b32 %0, -1, %0" : "=v"(tid_));
        tid_ += wave_id * 64;
        asm volatile("" : "+s"(bid_));
        KP kp = (KP)__builtin_amdgcn_kernarg_segment_ptr();
        asm volatile("" : "+s"(kp));
        unsigned char* ws = kp->ws;
        u16* HN = (u16*)(ws + OFF_HN);
        const int d = kp->desc[ph], type = d & 255, sub = (d >> 8) & 255, L = d >> 16;
        const float* hsrc = (L == 0) ? kp->x : kp->out;
        EpiArgs e; e.resid = nullptr; e.out = kp->out; e.bias = nullptr; e.hid = nullptr; e.convw = nullptr; e.convb = nullptr; e.ws = ws;
        switch (type) {
        case PT_PREP: { const Params pl = *kp; prep_phase(pl, smem, tid_, bid_); } break;
        case PT_NORM: {
            const float* src = (sub == 1) ? kp->out : hsrc;
            const float* g = (sub == 0) ? kp->norm_attn + L * 1024 : (sub == 1) ? kp->norm_ffn + L * 1024 : kp->kv_norm;
            norm_phase<false>(src, g, HN, nullptr, tid_, bid_);
        } break;
        case PT_AIN: gemm_phase<AM_PLAIN, EPI_AIN>(HN, 1024, (const u16*)(ws + OFF_WT_AIN + L * SZ_WT_AIN), T_, 2688, 1024, 0, e, smem, tid_, bid_); break;
        case PT_CMP1:
            for (int kv = 0; kv < 2; ++kv) {
                e.bias = (const float*)(ws + OFF_CBIAS) + (L * 2 + kv) * 256; e.hid = (u16*)(ws + OFF_HID) + (size_t)kv * 8192 * 256;
                gemm_phase<AM_GATHER, EPI_CMP1>((const u16*)(ws + (kv == 0 ? OFF_KC : OFF_VC)), 0, (const u16*)(ws + OFF_WT_CW1 + (L * 2 + kv) * SZ_WT_CW1), 8184, 256, 2048,
                                                kv == 0 ? 0 : (int)(gridDim.x >> 1), e, smem, tid_, bid_);
            }
            break;
        case PT_CMP2: { const Params pl = *kp; cmp2_phase(pl, L, tid_, bid_); } break;
        case PT_NSA: { const Params pl = *kp; nsa_phase(pl, smem, tid_, bid_, sub); } break;
        case PT_BKV: gemm_phase<AM_PLAIN, EPI_BKV>(HN, 1024, (const u16*)(ws + OFF_WT_KV), T_, 256, 1024, 0, e, smem, tid_, bid_); break;
        case PT_BQ: gemm_phase<AM_PLAIN, EPI_BQ>(HN, 1024, (const u16*)(ws + OFF_WT_BQ + (L - 2) * SZ_WT_SQ), T_, 1024, 1024, 0, e, smem, tid_, bid_); break;
        case PT_SWA: { const Params pl = *kp; swa_phase(pl, L - 2, tid_, bid_); } break;
        case PT_AOUT:
        case PT_FOUT: {
            const bool ff = (type == PT_FOUT);
            e.resid = ff ? kp->out : hsrc;
            const u16* A = (const u16*)(ws + (ff ? OFF_ACT : OFF_O));
            const u16* Bt = (const u16*)(ws + (ff ? OFF_WT_FOUT + L * SZ_WT_FOUT : (L < 2 ? OFF_WT_AOUT + L * SZ_WT_SQ : OFF_WT_BOUT + (L - 2) * SZ_WT_SQ)));
            const int K = ff ? DFF : 1024;
            gemm_big<AM_PLAIN, EPI_RESID>(A, K, Bt, T_, 1024, K, 0, e, smem, tid_, bid_);
        } break;
        case PT_FFNIN:
            e.convw = kp->ffn_conv_w + (size_t)L * 3 * NFF2; e.convb = kp->ffn_conv_b + (size_t)L * NFF2;
            gemm_big<AM_PLAIN, EPI_FFNIN>(HN, 1024, (const u16*)(ws + OFF_WT_FIN + L * SZ_WT_FIN), T_, NFF2, 1024, 0, e, smem, tid_, bid_);
            break;
        case PT_FIXUP: { const Params pl = *kp; fixup_phase(pl, L, tid_, bid_); } break;
        case PT_FINAL: norm_phase<true>(kp->out, kp->final_norm, nullptr, kp->out, tid_, bid_); break;
        default: break;
        }
        if (ph + 1 < ph_hi) { if (ph == ph_lo) grid.sync(); else xcd_barrier(bar, xcc, xst, tid_); }
    }
#endif
}

static int build_program(int* desc) {
    int n = 0;
    auto add = [&](int type, int sub, int L) { desc[n++] = type | (sub << 8) | (L << 16); };
    add(PT_PREP, 0, 0);
    for (int L = 0; L < 4; ++L) {
        if (L < 2) {
            add(PT_NORM, 0, L); add(PT_AIN, 0, L); add(PT_CMP1, 0, L); add(PT_CMP2, 0, L); add(PT_NSA, NSA_PROBE_REP, L);
        } else {
            if (L == 2) { add(PT_NORM, 2, L); add(PT_BKV, 0, L); }
            add(PT_NORM, 0, L); add(PT_BQ, 0, L); add(PT_SWA, 0, L);
        }
        add(PT_AOUT, 0, L); add(PT_NORM, 1, L); add(PT_FFNIN, 0, L); add(PT_FIXUP, 0, L); add(PT_FOUT, 0, L);
    }
    add(PT_FINAL, 0, 0);
    return n;
}

extern "C" void kernel_launch(void* const* d_in, const int* in_sizes, int n_in, void* d_out, int out_size, void* d_ws, size_t ws_size, hipStream_t stream) {
    (void)in_sizes; (void)n_in; (void)out_size;
    static int grid_blocks = 0;
    if (!grid_blocks) {
        (void)hipFuncSetAttribute((const void*)mega, hipFuncAttributeMaxDynamicSharedMemorySize, LDS_BYTES);
        int dev = 0, cus = 0, per_cu = 0;
        (void)hipGetDevice(&dev);
        (void)hipDeviceGetAttribute(&cus, hipDeviceAttributeMultiprocessorCount, dev);
        (void)hipOccupancyMaxActiveBlocksPerMultiprocessor(&per_cu, mega, NTHR, LDS_BYTES);
        if (per_cu > 1) per_cu = 1;
        if (per_cu < 1) per_cu = 1;
        grid_blocks = (cus * per_cu) & ~7;
        if (grid_blocks < 8) grid_blocks = 8;
        if (ws_size < WS_NEED) fprintf(stderr, "workspace too small: %zu < %zu\n", ws_size, (size_t)WS_NEED);
    }
    Params p{};
    const float** pp = (const float**)&p;
    for (int i = 0; i < 18; ++i) pp[i] = (const float*)d_in[i];
    p.out = (float*)d_out;
    p.ws = (unsigned char*)d_ws;
    const int nph = build_program(p.desc);
#if MULTI_LAUNCH
    for (int ph = 0; ph < nph; ++ph) {
        p.ph_lo = ph; p.ph_hi = ph + 1;
        hipLaunchKernelGGL(mega, dim3(grid_blocks), dim3(NTHR), LDS_BYTES, stream, p);
    }
#else
    p.ph_lo = 0; p.ph_hi = nph;
    (void)hipMemsetAsync((unsigned char*)d_ws + OFF_BAR, 0, 16384, stream);
    void* args[] = {&p};
    hipError_t err = hipLaunchCooperativeKernel((const void*)mega, dim3(grid_blocks), dim3(NTHR), args, LDS_BYTES, stream);
    if (err != hipSuccess) fprintf(stderr, "cooperative launch failed: %s (grid %d)\n", hipGetErrorString(err), grid_blocks);
#endif
}
```

```cpp
#include <hip/hip_runtime.h>
#include <hip/hip_cooperative_groups.h>
#include <cstdio>
#include <cmath>
namespace cg = cooperative_groups;

typedef unsigned short u16;
typedef short bf16x8 __attribute__((ext_vector_type(8)));
typedef float f32x4 __attribute__((ext_vector_type(4)));

#ifndef NSA_PROBE_REP
#define NSA_PROBE_REP 0
#endif
#ifndef MULTI_LAUNCH
#define MULTI_LAUNCH 0
#endif

constexpr int S_ = 16384, T_ = 32768, D_ = 1024, DFF = 2816, NFF2 = 5632;
constexpr int NTHR = 512, NW = NTHR / 64;
constexpr int LDS_USER = NW * 16384 + NW * 1024 + NW * 256;
constexpr int LDS_BYTES = LDS_USER + 16;
constexpr float LOG2E = 1.4426950408889634f;
constexpr float NEGBIG = -1e30f;

constexpr size_t al256(size_t x) { return (x + 255) & ~(size_t)255; }
constexpr size_t SZ_WT_AIN = (size_t)2688 * 1024 * 2;
constexpr size_t SZ_WT_CW1 = (size_t)256 * 2048 * 2;
constexpr size_t SZ_WT_CW2 = (size_t)64 * 256 * 2;
constexpr size_t SZ_WT_SQ = (size_t)1024 * 1024 * 2;
constexpr size_t SZ_WT_KV = (size_t)256 * 1024 * 2;
constexpr size_t SZ_WT_FIN = (size_t)5632 * 1024 * 2;
constexpr size_t SZ_WT_FOUT = (size_t)1024 * 2816 * 2;
constexpr size_t OFF_WT_AIN = 0;
constexpr size_t OFF_WT_CW1 = OFF_WT_AIN + 2 * SZ_WT_AIN;
constexpr size_t OFF_WT_CW2 = OFF_WT_CW1 + 4 * SZ_WT_CW1;
constexpr size_t OFF_WT_AOUT = OFF_WT_CW2 + 4 * SZ_WT_CW2;
constexpr size_t OFF_WT_KV = OFF_WT_AOUT + 2 * SZ_WT_SQ;
constexpr size_t OFF_WT_BQ = OFF_WT_KV + SZ_WT_KV;
constexpr size_t OFF_WT_BOUT = OFF_WT_BQ + 2 * SZ_WT_SQ;
constexpr size_t OFF_WT_FIN = OFF_WT_BOUT + 2 * SZ_WT_SQ;
constexpr size_t OFF_WT_FOUT = OFF_WT_FIN + 4 * SZ_WT_FIN;
constexpr size_t OFF_COS = OFF_WT_FOUT + 4 * SZ_WT_FOUT;
constexpr size_t OFF_SIN = OFF_COS + (size_t)S_ * 32 * 4;
constexpr size_t OFF_CBIAS = OFF_SIN + (size_t)S_ * 32 * 4;
constexpr size_t OFF_HN = OFF_CBIAS + 4096;
constexpr size_t OFF_KSH = OFF_HN + (size_t)T_ * 1024 * 2;
constexpr size_t OFF_VSHT = OFF_KSH + (size_t)T_ * 128 * 2;
constexpr size_t OFF_HEAD = OFF_VSHT + (size_t)T_ * 128 * 2;
constexpr size_t OFF_HALO = OFF_HEAD + (size_t)256 * 2 * NFF2 * 4;
constexpr size_t OFF_R1 = OFF_HALO + (size_t)256 * 2 * NFF2 * 4;
constexpr size_t OFF_Q = OFF_R1;
constexpr size_t OFF_KC = OFF_Q + (size_t)T_ * 1024 * 2;
constexpr size_t OFF_VC = OFF_KC + (size_t)T_ * 256 * 2;
constexpr size_t OFF_KS = OFF_VC + (size_t)T_ * 256 * 2;
constexpr size_t OFF_VST = OFF_KS + (size_t)T_ * 256 * 2;
constexpr size_t OFF_KW = OFF_VST + (size_t)T_ * 256 * 2;
constexpr size_t OFF_VWT = OFF_KW + (size_t)T_ * 256 * 2;
constexpr size_t OFF_GATES = OFF_VWT + (size_t)T_ * 256 * 2;
constexpr size_t OFF_HID = OFF_GATES + (size_t)T_ * 48 * 4;
constexpr size_t OFF_KCC = OFF_HID + (size_t)2 * 8192 * 256 * 2;
constexpr size_t OFF_VCCT = OFF_KCC + (size_t)8 * 1024 * 64 * 2;
constexpr size_t OFF_O = OFF_VCCT + (size_t)8 * 1024 * 64 * 2;
constexpr size_t OFF_END = OFF_O + (size_t)T_ * 1024 * 2;
constexpr size_t OFF_BAR = OFF_END;
constexpr size_t WS_NEED = OFF_BAR + 16384;
constexpr size_t OFF_ACT = OFF_R1;
static_assert(OFF_ACT + (size_t)T_ * DFF * 2 <= OFF_END, "act alias");

struct Params {
    const float *x, *norm_attn, *norm_ffn, *a_w_in, *a_cmp_pos, *a_cmp_w1, *a_cmp_w2, *a_w_out, *kv_norm, *b_w_kv, *b_w_q, *b_sinks, *b_w_out,
        *ffn_w_in, *ffn_conv_w, *ffn_conv_b, *ffn_w_out, *final_norm;
    float* out;
    unsigned char* ws;
    int desc[48];
    int ph_lo, ph_hi;
};

__device__ __forceinline__ u16 f2bf(float f) {
    unsigned u = __float_as_uint(f);
    u += 0x7fffu + ((u >> 16) & 1u);
    return (u16)(u >> 16);
}
typedef __bf16 bf16x2_t __attribute__((ext_vector_type(2)));
typedef float f32x2_t __attribute__((ext_vector_type(2)));
__device__ __forceinline__ unsigned pack2(float lo, float hi) { f32x2_t v = {lo, hi}; bf16x2_t r = __builtin_convertvector(v, bf16x2_t); return __builtin_bit_cast(unsigned, r); }
typedef unsigned u32x4 __attribute__((ext_vector_type(4)));
__device__ __forceinline__ bf16x8 pack8(const float (&v)[8]) {
    u32x4 r;
    unsigned r0, r1, r2, r3;
    asm("v_cvt_pk_bf16_f32 %0, %4, %5\n\tv_cvt_pk_bf16_f32 %1, %6, %7\n\tv_cvt_pk_bf16_f32 %2, %8, %9\n\tv_cvt_pk_bf16_f32 %3, %10, %11\n\ts_nop 3"
        : "=&v"(r0), "=&v"(r1), "=&v"(r2), "=&v"(r3)
        : "v"(v[0]), "v"(v[1]), "v"(v[2]), "v"(v[3]), "v"(v[4]), "v"(v[5]), "v"(v[6]), "v"(v[7]));
    r[0] = r0; r[1] = r1; r[2] = r2; r[3] = r3;
    return __builtin_bit_cast(bf16x8, r);
}
__device__ __forceinline__ uint2 pack4(f32x4 v) { uint2 r; r.x = pack2(v[0], v[1]); r.y = pack2(v[2], v[3]); return r; }
__device__ __forceinline__ f32x4 unpack4(uint2 v) { return (f32x4){__uint_as_float(v.x << 16), __uint_as_float(v.x & 0xffff0000u), __uint_as_float(v.y << 16), __uint_as_float(v.y & 0xffff0000u)}; }
__device__ __forceinline__ unsigned pk4_fp8(float a, float b, float c, float d) { int r = __builtin_amdgcn_cvt_pk_fp8_f32(a, b, 0, false); r = __builtin_amdgcn_cvt_pk_fp8_f32(c, d, r, true); return (unsigned)r; }
__device__ __forceinline__ long pk8_fp8(const float (&v)[8]) { const unsigned lo = pk4_fp8(v[0], v[1], v[2], v[3]), hi = pk4_fp8(v[4], v[5], v[6], v[7]); return (long)(((unsigned long long)hi << 32) | lo); }
__device__ __forceinline__ f32x4 mfma8(long a, long b, f32x4 c) { return __builtin_amdgcn_mfma_f32_16x16x32_fp8_fp8(a, b, c, 0, 0, 0); }
__device__ __forceinline__ f32x4 mfma16(bf16x8 a, bf16x8 b, f32x4 c) { return __builtin_amdgcn_mfma_f32_16x16x32_bf16(a, b, c, 0, 0, 0); }
__device__ __forceinline__ float fexp2(float x) { return __builtin_amdgcn_exp2f(x); }
__device__ __forceinline__ void wsync() { __builtin_amdgcn_fence(__ATOMIC_ACQ_REL, "wavefront"); asm volatile("s_waitcnt lgkmcnt(0)" ::: "memory"); __builtin_amdgcn_wave_barrier(); }
typedef unsigned u32x2 __attribute__((ext_vector_type(2)));
__device__ __forceinline__ float xmax16(float x) { const unsigned u = __float_as_uint(x); const u32x2 r = __builtin_amdgcn_permlane16_swap(u, u, false, false); return fmaxf(__uint_as_float(r[0]), __uint_as_float(r[1])); }
__device__ __forceinline__ float xmax32(float x) { const unsigned u = __float_as_uint(x); const u32x2 r = __builtin_amdgcn_permlane32_swap(u, u, false, false); return fmaxf(__uint_as_float(r[0]), __uint_as_float(r[1])); }
template <int CTRL> __device__ __forceinline__ float dppf(float x) { return __int_as_float(__builtin_amdgcn_update_dpp(0, __float_as_int(x), CTRL, 0xf, 0xf, true)); }
__device__ __forceinline__ float wave_max(float x) {
    x = fmaxf(x, dppf<0xB1>(x)); x = fmaxf(x, dppf<0x4E>(x)); x = fmaxf(x, dppf<0x141>(x)); x = fmaxf(x, dppf<0x140>(x));
    return xmax32(xmax16(x));
}
__device__ __forceinline__ int kperm(int m) { return ((m >> 2) << 3) + (m & 3); }
__device__ __forceinline__ float sigmoidf_(float x) { return 1.f / (1.f + __expf(-x)); }
__device__ __forceinline__ float gelu_tanh(float x) {
    float u = 0.7978845608028654f * (x + 0.044715f * x * x * x);
    float e = __expf(2.f * u);
    float th = 1.f - 2.f / (e + 1.f);
    return 0.5f * x * (1.f + th);
}

__device__ __forceinline__ void cvt_transpose(const float* __restrict__ src, u16* __restrict__ dst, int K, int N, int Npad, int mode, unsigned char* smem, int tid_, int bid_) {
    const int half = tid_ >> 8, tid = tid_ & 255;
    float* ts = (float*)smem + half * (64 * 65);
    const int ntk = K >> 6, ntn = Npad >> 6, ntiles = ntk * ntn;
    for (int tile2 = bid_ * 2; tile2 < ntiles; tile2 += gridDim.x * 2) {
        const int tile = tile2 + half;
        const bool live = tile < ntiles;
        const int tk = live ? tile % ntk : 0, tn = live ? tile / ntk : 0;
        const int k0 = tk << 6, n0 = tn << 6;
        __syncthreads();
        if (live) {
#pragma unroll
            for (int i = 0; i < 4; ++i) {
                const int k = (tid >> 4) + 16 * i, n = (tid & 15) * 4;
                float4 v = make_float4(0.f, 0.f, 0.f, 0.f);
                if (n0 + n < N) v = *(const float4*)(src + (size_t)(k0 + k) * N + n0 + n);
                ts[k * 65 + n + 0] = v.x; ts[k * 65 + n + 1] = v.y; ts[k * 65 + n + 2] = v.z; ts[k * 65 + n + 3] = v.w;
            }
        }
        __syncthreads();
        if (!live) continue;
        const int n = tid >> 2, kq = (tid & 3) * 16;
        unsigned pk[8];
#pragma unroll
        for (int j = 0; j < 8; ++j) pk[j] = pack2(ts[(kq + 2 * j) * 65 + n], ts[(kq + 2 * j + 1) * 65 + n]);
        int drow;
        if (mode == 0) drow = n0 + n;
        else { const int nn = n0 + n; drow = (nn < DFF) ? ((nn >> 6) * 128 + (nn & 63)) : ((((nn - DFF) >> 6) * 128) + 64 + ((nn - DFF) & 63)); }
        uint4* dp = (uint4*)(dst + (size_t)drow * K + k0 + kq);
        dp[0] = make_uint4(pk[0], pk[1], pk[2], pk[3]);
        dp[1] = make_uint4(pk[4], pk[5], pk[6], pk[7]);
    }
}

__device__ __forceinline__ void prep_phase(const Params& p, unsigned char* smem, int tid_, int bid_) {
    unsigned char* ws = p.ws;
    for (int L = 0; L < 2; ++L) {
        cvt_transpose(p.a_w_in + (size_t)L * 1024 * 2608, (u16*)(ws + OFF_WT_AIN + L * SZ_WT_AIN), 1024, 2608, 2688, 0, smem, tid_, bid_);
        for (int kv = 0; kv < 2; ++kv) {
            cvt_transpose(p.a_cmp_w1 + (size_t)(L * 2 + kv) * 2048 * 256, (u16*)(ws + OFF_WT_CW1 + (L * 2 + kv) * SZ_WT_CW1), 2048, 256, 256, 0, smem, tid_, bid_);
            cvt_transpose(p.a_cmp_w2 + (size_t)(L * 2 + kv) * 256 * 64, (u16*)(ws + OFF_WT_CW2 + (L * 2 + kv) * SZ_WT_CW2), 256, 64, 64, 0, smem, tid_, bid_);
        }
        cvt_transpose(p.a_w_out + (size_t)L * 1024 * 1024, (u16*)(ws + OFF_WT_AOUT + L * SZ_WT_SQ), 1024, 1024, 1024, 0, smem, tid_, bid_);
        cvt_transpose(p.b_w_q + (size_t)L * 1024 * 1024, (u16*)(ws + OFF_WT_BQ + L * SZ_WT_SQ), 1024, 1024, 1024, 0, smem, tid_, bid_);
        cvt_transpose(p.b_w_out + (size_t)L * 1024 * 1024, (u16*)(ws + OFF_WT_BOUT + L * SZ_WT_SQ), 1024, 1024, 1024, 0, smem, tid_, bid_);
    }
    cvt_transpose(p.b_w_kv, (u16*)(ws + OFF_WT_KV), 1024, 256, 256, 0, smem, tid_, bid_);
    for (int L = 0; L < 4; ++L) {
        cvt_transpose(p.ffn_w_in + (size_t)L * 1024 * NFF2, (u16*)(ws + OFF_WT_FIN + L * SZ_WT_FIN), 1024, NFF2, NFF2, 1, smem, tid_, bid_);
        cvt_transpose(p.ffn_w_out + (size_t)L * DFF * 1024, (u16*)(ws + OFF_WT_FOUT + L * SZ_WT_FOUT), DFF, 1024, 1024, 0, smem, tid_, bid_);
    }
    {
        float* cosT = (float*)(ws + OFF_COS); float* sinT = (float*)(ws + OFF_SIN);
        const int gt = bid_ * NTHR + tid_, nt = gridDim.x * NTHR;
        for (int idx = gt; idx < S_ * 32; idx += nt) {
            const int pos = idx >> 5, i = idx & 31;
            const float ang = (float)pos * exp2f(-(float)i * (13.287712379549449f / 32.0f));
            double rev = (double)ang * 0.15915494309189535;
            rev -= rint(rev);
            const float fr = (float)rev;
            cosT[idx] = __builtin_amdgcn_cosf(fr);
            sinT[idx] = __builtin_amdgcn_sinf(fr);
        }
    }
    {
        float* cb = (float*)(ws + OFF_CBIAS);
        const int lane = tid_ & 63, w = tid_ >> 6;
        for (int task = bid_ * NW + w; task < 256; task += gridDim.x * NW) {
            const int lk = task >> 6, j4 = (task & 63) * 4;
            const float* pos = p.a_cmp_pos + (size_t)lk * 2048;
            const float* w1 = p.a_cmp_w1 + (size_t)lk * 2048 * 256;
            float4 a = make_float4(0.f, 0.f, 0.f, 0.f);
            for (int i = 0; i < 32; ++i) {
                const int k = lane + 64 * i;
                const float pv = pos[k];
                const float4 wv = *(const float4*)(w1 + (size_t)k * 256 + j4);
                a.x += pv * wv.x; a.y += pv * wv.y; a.z += pv * wv.z; a.w += pv * wv.w;
            }
#pragma unroll
            for (int off = 32; off >= 1; off >>= 1) {
                a.x += __shfl_xor(a.x, off); a.y += __shfl_xor(a.y, off); a.z += __shfl_xor(a.z, off); a.w += __shfl_xor(a.w, off);
            }
            if (lane == 0) *(float4*)(cb + lk * 256 + j4) = a;
        }
    }
}

template <bool OUT_F32>
__device__ __forceinline__ void norm_phase(const float* __restrict__ src, const float* __restrict__ g, u16* __restrict__ dst, float* __restrict__ dstf, int tid_, int bid_) {
    const int lane = tid_ & 63, w = tid_ >> 6;
    float4 gv[4];
#pragma unroll
    for (int i = 0; i < 4; ++i) gv[i] = *(const float4*)(g + lane * 4 + 256 * i);
    for (int row = bid_ * NW + w; row < T_; row += gridDim.x * NW) {
        const float* sp = src + (size_t)row * 1024;
        float4 v[4];
        float ss = 0.f;
#pragma unroll
        for (int i = 0; i < 4; ++i) { v[i] = *(const float4*)(sp + lane * 4 + 256 * i); ss += v[i].x * v[i].x + v[i].y * v[i].y + v[i].z * v[i].z + v[i].w * v[i].w; }
#pragma unroll
        for (int off = 32; off >= 1; off >>= 1) ss += __shfl_xor(ss, off);
        const float r = rsqrtf(ss * (1.f / 1024.f) + 1e-6f);
#pragma unroll
        for (int i = 0; i < 4; ++i) {
            f32x4 o = {v[i].x * r * gv[i].x, v[i].y * r * gv[i].y, v[i].z * r * gv[i].z, v[i].w * r * gv[i].w};
            if (OUT_F32) *(float4*)(dstf + (size_t)row * 1024 + lane * 4 + 256 * i) = make_float4(o[0], o[1], o[2], o[3]);
            else *(uint2*)(dst + (size_t)row * 1024 + lane * 4 + 256 * i) = pack4(o);
        }
    }
}

enum { AM_PLAIN = 0, AM_GATHER = 1 };
enum { EPI_AIN = 0, EPI_CMP1 = 1, EPI_RESID = 2, EPI_FFNIN = 3, EPI_BQ = 4, EPI_BKV = 5 };

struct EpiArgs {
    const float* resid; float* out;
    const float* bias; u16* hid;
    const float *convw, *convb;
    unsigned char* ws;
};

template <int NM>
__device__ __forceinline__ void rope_store(const f32x4 (&acc)[4][NM], int mi, u16* dstrow  , const float* cosT, const float* sinT, int pos, int q4) {
#pragma unroll
    for (int ni = 0; ni < 2; ++ni) {
        const int d = ni * 16 + q4 * 4;
        const float4 c = *(const float4*)(cosT + pos * 32 + d), s = *(const float4*)(sinT + pos * 32 + d);
        const f32x4 x1 = acc[ni][mi], x2 = acc[ni + 2][mi];
        f32x4 o1 = {x1[0] * c.x - x2[0] * s.x, x1[1] * c.y - x2[1] * s.y, x1[2] * c.z - x2[2] * s.z, x1[3] * c.w - x2[3] * s.w};
        f32x4 o2 = {x2[0] * c.x + x1[0] * s.x, x2[1] * c.y + x1[1] * s.y, x2[2] * c.z + x1[2] * s.z, x2[3] * c.w + x1[3] * s.w};
        *(uint2*)(dstrow + d) = pack4(o1);
        *(uint2*)(dstrow + d + 32) = pack4(o2);
    }
}

template <int AMODE, int EPI>
__device__ __forceinline__ void gemm_phase(const u16* __restrict__ A, int lda, const u16* __restrict__ Bt, int M, int Npad, int K, int vboff, const EpiArgs& e, unsigned char* smem, int tid_, int bid_) {
    const int tid = tid_, lane = tid & 63, w = tid >> 6, wm = w & 3, wn = w >> 2;
    const int c16 = lane & 15, q4 = lane >> 4;
    const int ntm = (M + 255) >> 8, ntn = Npad >> 7, nk = K >> 6;
    const int kstride = (AMODE == AM_GATHER) ? 256 : 64;
    const int ldc = tid & 7, ldr = tid >> 3;
    const unsigned wofs = ldr * 128 + ((ldc ^ ((ldr >> 1) & 7)) << 4);
    const int swz = (c16 >> 1) & 7;
    const float* cosT = (const float*)(e.ws + OFF_COS);
    const float* sinT = (const float*)(e.ws + OFF_SIN);
    int vb = bid_ + vboff; if (vb >= (int)gridDim.x) vb -= gridDim.x;
    const int xcd = vb & 7, loc = vb >> 3, nloc = gridDim.x >> 3;
    const int mpx = ntm >> 3, nfull = (ntn >> 3), bwl = ntn - (nfull << 3);
    const int tfull = nfull * mpx * 8, ttotal = mpx * ntn;
    for (int tl = loc; tl < ttotal; tl += nloc) {
        int mloc, nt;
        if (tl < tfull) { const int band = tl / (mpx * 8), r = tl - band * (mpx * 8); mloc = r >> 3; nt = band * 8 + (r & 7); }
        else { const int r = tl - tfull; mloc = r / bwl; nt = (nfull << 3) + (r - mloc * bwl); }
        const int mt = xcd * mpx + mloc;
        const int m0 = mt << 8, n0 = nt << 7;
        unsigned aoff[4];
#pragma unroll
        for (int i = 0; i < 4; ++i) {
            int m = m0 + ldr + 64 * i; if (m > M - 1) m = M - 1;
            if (AMODE == AM_GATHER) { const int g = m & 3, bn = m >> 2, b = bn / 1023, n = bn - b * 1023; aoff[i] = (unsigned)((b * S_ + n * 16) * 256 + g * 64 + ldc * 8); }
            else aoff[i] = (unsigned)m * (unsigned)lda + ldc * 8;
        }
        const u16* bp = Bt + (size_t)(n0 + ldr) * K + ldc * 8;
        u32x4 ra0[4], rb0[2], ra1[4], rb1[2];
        f32x4 acc[4][4];
#pragma unroll
        for (int a = 0; a < 4; ++a)
#pragma unroll
            for (int b = 0; b < 4; ++b) acc[a][b] = (f32x4){0.f, 0.f, 0.f, 0.f};
        auto g_load = [&](u32x4 (&RA)[4], u32x4 (&RB)[2], int KT) __attribute__((always_inline)) {
#pragma unroll
            for (int i = 0; i < 4; ++i) RA[i] = *(const u32x4*)(A + aoff[i] + KT * kstride);
#pragma unroll
            for (int i = 0; i < 2; ++i) RB[i] = *(const u32x4*)(bp + (size_t)i * 64 * K + KT * 64);
        };
        auto g_store = [&](const u32x4 (&RA)[4], const u32x4 (&RB)[2], int ST) __attribute__((always_inline)) {
            unsigned char* d_ = smem + ST * 49152;
#pragma unroll
            for (int i = 0; i < 4; ++i) *(u32x4*)(d_ + wofs + i * 8192) = RA[i];
#pragma unroll
            for (int i = 0; i < 2; ++i) *(u32x4*)(d_ + 32768 + wofs + i * 8192) = RB[i];
        };
        auto g_compute = [&](int ST) __attribute__((always_inline)) {
            const unsigned char* sA = smem + ST * 49152;
            const unsigned char* sB = sA + 32768;
#pragma unroll
            for (int ks = 0; ks < 2; ++ks) {
                bf16x8 wf[4], af[4];
                const int ch = ((ks * 4 + q4) ^ swz) << 4;
#pragma unroll
                for (int ni = 0; ni < 4; ++ni) wf[ni] = *(const bf16x8*)(sB + (wn * 64 + ni * 16 + c16) * 128 + ch);
#pragma unroll
                for (int mi = 0; mi < 4; ++mi) af[mi] = *(const bf16x8*)(sA + (wm * 64 + mi * 16 + c16) * 128 + ch);
#pragma unroll
                for (int ni = 0; ni < 4; ++ni)
#pragma unroll
                    for (int mi = 0; mi < 4; ++mi) acc[ni][mi] = mfma16(wf[ni], af[mi], acc[ni][mi]);
            }
        };
        g_load(ra0, rb0, 0);
        g_load(ra1, rb1, 1);
        g_store(ra0, rb0, 0);
        __syncthreads();
        for (int kt = 0; kt < nk; kt += 2) {
            if (kt + 2 < nk) g_load(ra0, rb0, kt + 2);
            g_compute(0);
            g_store(ra1, rb1, 1);
            __syncthreads();
            if (kt + 3 < nk) g_load(ra1, rb1, kt + 3);
            g_compute(1);
            if (kt + 2 < nk) g_store(ra0, rb0, 0);
            __syncthreads();
        }
        const int nb = n0 + wn * 64;
        if (EPI == EPI_RESID) {
#pragma unroll
            for (int mi = 0; mi < 4; ++mi) {
                const size_t tok = m0 + wm * 64 + mi * 16 + c16;
#pragma unroll
                for (int ni = 0; ni < 4; ++ni) {
                    const int n = nb + ni * 16 + q4 * 4;
                    float4 r = *(const float4*)(e.resid + tok * 1024 + n);
                    r.x += acc[ni][mi][0]; r.y += acc[ni][mi][1]; r.z += acc[ni][mi][2]; r.w += acc[ni][mi][3];
                    *(float4*)(e.out + tok * 1024 + n) = r;
                }
            }
        } else if (EPI == EPI_CMP1) {
#pragma unroll
            for (int mi = 0; mi < 4; ++mi) {
                const int m = m0 + wm * 64 + mi * 16 + c16;
                if (m < M) {
#pragma unroll
                    for (int ni = 0; ni < 4; ++ni) {
                        const int n = nb + ni * 16 + q4 * 4;
                        const float4 bv = *(const float4*)(e.bias + n);
                        f32x4 o = {gelu_tanh(acc[ni][mi][0] + bv.x), gelu_tanh(acc[ni][mi][1] + bv.y), gelu_tanh(acc[ni][mi][2] + bv.z), gelu_tanh(acc[ni][mi][3] + bv.w)};
                        *(uint2*)(e.hid + (size_t)m * 256 + n) = pack4(o);
                    }
                }
            }
        } else if (EPI == EPI_BQ) {
            u16* Q = (u16*)(e.ws + OFF_Q);
#pragma unroll
            for (int mi = 0; mi < 4; ++mi) {
                const int tok = m0 + wm * 64 + mi * 16 + c16;
                rope_store(acc, mi, Q + (size_t)tok * 1024 + nb, cosT, sinT, tok & (S_ - 1), q4);
            }
        } else if (EPI == EPI_BKV) {
            u16* KSH = (u16*)(e.ws + OFF_KSH); u16* VSHT = (u16*)(e.ws + OFF_VSHT);
#pragma unroll
            for (int mi = 0; mi < 4; ++mi) {
                const int tok = m0 + wm * 64 + mi * 16 + c16, b = tok >> 14, s = tok & (S_ - 1);
                if (nb < 128) {
                    const int g = nb >> 6;
                    rope_store(acc, mi, KSH + ((size_t)(b * 2 + g) * S_ + s) * 64, cosT, sinT, s, q4);
                } else {
                    const int g = (nb - 128) >> 6;
#pragma unroll
                    for (int ni = 0; ni < 4; ++ni)
#pragma unroll
                        for (int i = 0; i < 4; ++i) VSHT[((size_t)(b * 2 + g) * 64 + ni * 16 + q4 * 4 + i) * S_ + s] = f2bf(acc[ni][mi][i]);
                }
            }
        } else if (EPI == EPI_AIN) {
            unsigned char* ws = e.ws;
#pragma unroll
            for (int mi = 0; mi < 4; ++mi) {
                const int tok = m0 + wm * 64 + mi * 16 + c16, b = tok >> 14, s = tok & (S_ - 1);
                if (nb < 1024) {
                    rope_store(acc, mi, (u16*)(ws + OFF_Q) + (size_t)tok * 1024 + nb, cosT, sinT, s, q4);
                } else if (nb < 1536) {
                    u16* dst = (nb < 1280) ? ((u16*)(ws + OFF_KC) + (size_t)tok * 256 + (nb - 1024)) : ((u16*)(ws + OFF_VC) + (size_t)tok * 256 + (nb - 1280));
#pragma unroll
                    for (int ni = 0; ni < 4; ++ni) *(uint2*)(dst + ni * 16 + q4 * 4) = pack4(acc[ni][mi]);
                } else if (nb < 2560) {
                    const int r = (nb - 1536) >> 8;
                    const int g = ((nb - 1536) & 255) >> 6;
                    if (r == 0) {
                        unsigned char* kd = (unsigned char*)(ws + OFF_KS) + (size_t)(b * 4 + g) * S_ * 128 + (size_t)s * 64;
#pragma unroll
                        for (int ni = 0; ni < 2; ++ni) {
                            const int d = ni * 16 + q4 * 4;
                            const float4 c = *(const float4*)(cosT + s * 32 + d), sn = *(const float4*)(sinT + s * 32 + d);
                            const f32x4 x1 = acc[ni][mi], x2 = acc[ni + 2][mi];
                            *(unsigned*)(kd + d) = pk4_fp8(x1[0] * c.x - x2[0] * sn.x, x1[1] * c.y - x2[1] * sn.y, x1[2] * c.z - x2[2] * sn.z, x1[3] * c.w - x2[3] * sn.w);
                            *(unsigned*)(kd + d + 32) = pk4_fp8(x2[0] * c.x + x1[0] * sn.x, x2[1] * c.y + x1[1] * sn.y, x2[2] * c.z + x1[2] * sn.z, x2[3] * c.w + x1[3] * sn.w);
                        }
                    } else if (r == 2) {
                        u16* base = (u16*)(ws + OFF_KW);
                        rope_store(acc, mi, base + ((size_t)(b * 4 + g) * S_ + s) * 64, cosT, sinT, s, q4);
                    } else {
                        if (r == 1) {
                            unsigned char* base = (unsigned char*)(ws + OFF_VST) + (size_t)(b * 4 + g) * 128 * S_ + (size_t)(s >> 6) * 4096 + (s & 63);
#pragma unroll
                            for (int ni = 0; ni < 4; ++ni) {
                                const unsigned pk = pk4_fp8(acc[ni][mi][0], acc[ni][mi][1], acc[ni][mi][2], acc[ni][mi][3]);
#pragma unroll
                                for (int i = 0; i < 4; ++i) base[(ni * 16 + q4 * 4 + i) * 64] = (unsigned char)(pk >> (8 * i));
                            }
                        } else {
                            u16* base = (u16*)(ws + OFF_VWT);
#pragma unroll
                            for (int ni = 0; ni < 4; ++ni)
#pragma unroll
                                for (int i = 0; i < 4; ++i) base[((size_t)(b * 4 + g) * 64 + ni * 16 + q4 * 4 + i) * S_ + s] = f2bf(acc[ni][mi][i]);
                        }
                    }
                } else if (nb == 2560) {
                    float* G = (float*)(ws + OFF_GATES) + (size_t)tok * 48;
#pragma unroll
                    for (int ni = 0; ni < 3; ++ni) {
                        const int n = ni * 16 + q4 * 4;
                        *(float4*)(G + n) = make_float4(sigmoidf_(acc[ni][mi][0]), sigmoidf_(acc[ni][mi][1]), sigmoidf_(acc[ni][mi][2]), sigmoidf_(acc[ni][mi][3]));
                    }
                }
            }
        } else if (EPI == EPI_FFNIN) {
            float* U = (float*)smem;
#pragma unroll
            for (int mi = 0; mi < 4; ++mi) {
                const int row = wm * 64 + mi * 16 + c16;
#pragma unroll
                for (int ni = 0; ni < 4; ++ni) {
                    const int chunk = wn * 16 + ni * 4 + q4;
                    *(f32x4*)(U + row * 128 + ((chunk ^ (row & 31)) << 2)) = acc[ni][mi];
                }
            }
            __syncthreads();
            {
                const int ca = tid & 15, seg = tid >> 4;
                const int ncol = nt * 64 + ca * 4;
                const float4 w0a = *(const float4*)(e.convw + ncol), w1a = *(const float4*)(e.convw + NFF2 + ncol), w2a = *(const float4*)(e.convw + 2 * NFF2 + ncol);
                const float4 w0g = *(const float4*)(e.convw + DFF + ncol), w1g = *(const float4*)(e.convw + NFF2 + DFF + ncol), w2g = *(const float4*)(e.convw + 2 * NFF2 + DFF + ncol);
                const float4 ba = *(const float4*)(e.convb + ncol), bg = *(const float4*)(e.convb + DFF + ncol);
                float* head = (float*)(e.ws + OFF_HEAD); float* halo = (float*)(e.ws + OFF_HALO);
                u16* act = (u16*)(e.ws + OFF_ACT);
                const int r0 = seg * 8;
                float4 a2 = make_float4(0.f, 0.f, 0.f, 0.f), a1 = a2, g2 = a2, g1 = a2;
                if (seg > 0) {
                    const int rA = r0 - 2, rB = r0 - 1;
                    a2 = *(const float4*)(U + rA * 128 + ((ca ^ (rA & 31)) << 2)); g2 = *(const float4*)(U + rA * 128 + (((16 + ca) ^ (rA & 31)) << 2));
                    a1 = *(const float4*)(U + rB * 128 + ((ca ^ (rB & 31)) << 2)); g1 = *(const float4*)(U + rB * 128 + (((16 + ca) ^ (rB & 31)) << 2));
                }
#pragma unroll
                for (int r = 0; r < 8; ++r) {
                    const int row = r0 + r;
                    const float4 ua = *(const float4*)(U + row * 128 + ((ca ^ (row & 31)) << 2));
                    const float4 ug = *(const float4*)(U + row * 128 + (((16 + ca) ^ (row & 31)) << 2));
                    if (seg > 0 || r >= 2) {
                        float ca_[4], cg_[4];
                        ca_[0] = ba.x + w0a.x * a2.x + w1a.x * a1.x + w2a.x * ua.x; ca_[1] = ba.y + w0a.y * a2.y + w1a.y * a1.y + w2a.y * ua.y;
                        ca_[2] = ba.z + w0a.z * a2.z + w1a.z * a1.z + w2a.z * ua.z; ca_[3] = ba.w + w0a.w * a2.w + w1a.w * a1.w + w2a.w * ua.w;
                        cg_[0] = bg.x + w0g.x * g2.x + w1g.x * g1.x + w2g.x * ug.x; cg_[1] = bg.y + w0g.y * g2.y + w1g.y * g1.y + w2g.y * ug.y;
                        cg_[2] = bg.z + w0g.z * g2.z + w1g.z * g1.z + w2g.z * ug.z; cg_[3] = bg.w + w0g.w * g2.w + w1g.w * g1.w + w2g.w * ug.w;
                        f32x4 o = {ca_[0] * sigmoidf_(ca_[0]) * cg_[0], ca_[1] * sigmoidf_(ca_[1]) * cg_[1], ca_[2] * sigmoidf_(ca_[2]) * cg_[2], ca_[3] * sigmoidf_(ca_[3]) * cg_[3]};
                        *(uint2*)(act + (size_t)(m0 + row) * DFF + ncol) = pack4(o);
                    }
                    if (seg == 0 && r < 2) { *(float4*)(head + (size_t)(mt * 2 + r) * NFF2 + ncol) = ua; *(float4*)(head + (size_t)(mt * 2 + r) * NFF2 + DFF + ncol) = ug; }
                    if (seg == 31 && r >= 6) { *(float4*)(halo + (size_t)(mt * 2 + r - 6) * NFF2 + ncol) = ua; *(float4*)(halo + (size_t)(mt * 2 + r - 6) * NFF2 + DFF + ncol) = ug; }
                    a2 = a1; a1 = ua; g2 = g1; g1 = ug;
                }
            }
            __syncthreads();
        }
    }
}

template <int AMODE, int EPI>
__device__ __forceinline__ void gemm_big(const u16* __restrict__ A, int lda, const u16* __restrict__ Bt, int M, int Npad, int K, int vboff, const EpiArgs& e, unsigned char* smem, int tid_, int bid_) {
    const int tid = tid_, lane = tid & 63, w = tid >> 6, wm = w & 1, wn = w >> 1;
    const int c16 = lane & 15, q4 = lane >> 4;
    constexpr int MI = 8;
    const int ntm = (M + 255) >> 8, ntn = Npad >> 8, nk = K >> 5;
    const int kstride = (AMODE == AM_GATHER) ? 128 : 32;
    const float* cosT = (const float*)(e.ws + OFF_COS);
    const float* sinT = (const float*)(e.ws + OFF_SIN);
    int vb = bid_ + vboff; if (vb >= (int)gridDim.x) vb -= gridDim.x;
    const int xcd = vb & 7, loc = vb >> 3, nloc = gridDim.x >> 3;
    const int mpx = ntm >> 3, nfull = (ntn >> 3), bwl = ntn - (nfull << 3);
    const int tfull = nfull * mpx * 8, ttotal = mpx * ntn;
    for (int tl = loc; tl < ttotal; tl += nloc) {
        int mloc, nt;
        if (tl < tfull) { const int band = tl / (mpx * 8), r = tl - band * (mpx * 8); mloc = r >> 3; nt = band * 8 + (r & 7); }
        else { const int r = tl - tfull; mloc = r / bwl; nt = (nfull << 3) + (r - mloc * bwl); }
        const int mt = xcd * mpx + mloc;
        const int m0 = mt << 8, n0 = nt << 8;
        const int prow = ((w & 3) << 6) + (lane >> 2);
        const int pch = lane & 3;
        unsigned goff[4];
#pragma unroll
        for (int i = 0; i < 4; ++i) {
            const int row = prow + 16 * i;
            const int lc = pch ^ ((-(row >> 2)) & 3);
            if (w < 4) {
                int m = m0 + row; if (m > M - 1) m = M - 1;
                if (AMODE == AM_GATHER) { const int gq = m & 3, bn = m >> 2, bb = bn / 1023, n = bn - bb * 1023; goff[i] = (unsigned)((bb * S_ + n * 16) * 256 + gq * 64 + lc * 8); }
                else goff[i] = (unsigned)m * (unsigned)lda + (unsigned)(lc * 8);
            } else goff[i] = (unsigned)(n0 + row) * (unsigned)K + (unsigned)(lc * 8);
        }
        const u16* gbase = (w < 4) ? A : Bt;
        const int kst = (w < 4) ? ((AMODE == AM_GATHER) ? 0 : 32) : 32;
        typedef __attribute__((address_space(3))) unsigned* lds_u32p;
        const unsigned lbase = ((w < 4) ? 0u : 16384u) + (unsigned)(((w & 3) << 6) * 64) + (unsigned)lane * 16u;
        auto kofs = [&](int kt) __attribute__((always_inline)) -> unsigned {
            if (AMODE == AM_GATHER && w < 4) return (unsigned)((kt >> 1) * 256 + (kt & 1) * 32);
            return (unsigned)(kt * kst);
        };
        auto issue = [&](int kt) __attribute__((always_inline)) {
            const unsigned ko = kofs(kt);
            unsigned char* sb = smem + (kt & 3) * 32768 + lbase;
#pragma unroll
            for (int i = 0; i < 4; ++i)
                __builtin_amdgcn_global_load_lds((const unsigned*)(gbase + (goff[i] + ko)), (lds_u32p)(sb + i * 1024), 16, 0, 0);
        };
        f32x4 acc[4][MI];
#pragma unroll
        for (int a2 = 0; a2 < 4; ++a2)
#pragma unroll
            for (int b2 = 0; b2 < MI; ++b2) acc[a2][b2] = (f32x4){0.f, 0.f, 0.f, 0.f};
        const int swz = (-(c16 >> 2)) & 3;
        const int rch = (q4 ^ swz) << 4;
        issue(0); issue(1); issue(2);
        for (int kt = 0; kt < nk; ++kt) {
            if (kt + 2 < nk) asm volatile("s_waitcnt vmcnt(8)" ::: "memory");
            else if (kt + 1 < nk) asm volatile("s_waitcnt vmcnt(4)" ::: "memory");
            else asm volatile("s_waitcnt vmcnt(0)" ::: "memory");
            __builtin_amdgcn_s_barrier();
            if (kt + 3 < nk) issue(kt + 3);
            const unsigned char* sA = smem + (kt & 3) * 32768;
            const unsigned char* sB = sA + 16384;
            bf16x8 wf[4], af[MI];
#pragma unroll
            for (int ni = 0; ni < 4; ++ni) wf[ni] = *(const bf16x8*)(sB + (wn * 64 + ni * 16 + c16) * 64 + rch);
#pragma unroll
            for (int mi = 0; mi < MI; ++mi) af[mi] = *(const bf16x8*)(sA + (wm * 128 + mi * 16 + c16) * 64 + rch);
#pragma unroll
            for (int ni = 0; ni < 4; ++ni)
#pragma unroll
                for (int mi = 0; mi < MI; ++mi) acc[ni][mi] = mfma16(wf[ni], af[mi], acc[ni][mi]);
        }
        __syncthreads();
        const int nb = n0 + wn * 64;
        if (EPI == EPI_RESID) {
#pragma unroll
            for (int mi = 0; mi < MI; ++mi) { __builtin_amdgcn_sched_barrier(0);
                const size_t tok = m0 + wm * 128 + mi * 16 + c16;
#pragma unroll
                for (int ni = 0; ni < 4; ++ni) {
                    const int n = nb + ni * 16 + q4 * 4;
                    float4 r = *(const float4*)(e.resid + tok * 1024 + n);
                    r.x += acc[ni][mi][0]; r.y += acc[ni][mi][1]; r.z += acc[ni][mi][2]; r.w += acc[ni][mi][3];
                    *(float4*)(e.out + tok * 1024 + n) = r;
                }
            }
        } else if (EPI == EPI_CMP1) {
#pragma unroll
            for (int mi = 0; mi < MI; ++mi) { __builtin_amdgcn_sched_barrier(0);
                const int m = m0 + wm * 128 + mi * 16 + c16;
                if (m < M) {
#pragma unroll
                    for (int ni = 0; ni < 4; ++ni) {
                        const int n = nb + ni * 16 + q4 * 4;
                        const float4 bv = *(const float4*)(e.bias + n);
                        f32x4 o = {gelu_tanh(acc[ni][mi][0] + bv.x), gelu_tanh(acc[ni][mi][1] + bv.y), gelu_tanh(acc[ni][mi][2] + bv.z), gelu_tanh(acc[ni][mi][3] + bv.w)};
                        *(uint2*)(e.hid + (size_t)m * 256 + n) = pack4(o);
                    }
                }
            }
        } else if (EPI == EPI_BQ) {
            u16* Q = (u16*)(e.ws + OFF_Q);
#pragma unroll
            for (int mi = 0; mi < MI; ++mi) { __builtin_amdgcn_sched_barrier(0);
                const int tok = m0 + wm * 128 + mi * 16 + c16;
                rope_store(acc, mi, Q + (size_t)tok * 1024 + nb, cosT, sinT, tok & (S_ - 1), q4);
            }
        } else if (EPI == EPI_BKV) {
            u16* KSH = (u16*)(e.ws + OFF_KSH); u16* VSHT = (u16*)(e.ws + OFF_VSHT);
#pragma unroll
            for (int mi = 0; mi < MI; ++mi) { __builtin_amdgcn_sched_barrier(0);
                const int tok = m0 + wm * 128 + mi * 16 + c16, b = tok >> 14, s = tok & (S_ - 1);
                if (nb < 128) {
                    const int g = nb >> 6;
                    rope_store(acc, mi, KSH + ((size_t)(b * 2 + g) * S_ + s) * 64, cosT, sinT, s, q4);
                } else {
                    const int g = (nb - 128) >> 6;
#pragma unroll
                    for (int ni = 0; ni < 4; ++ni)
#pragma unroll
                        for (int i = 0; i < 4; ++i) VSHT[((size_t)(b * 2 + g) * 64 + ni * 16 + q4 * 4 + i) * S_ + s] = f2bf(acc[ni][mi][i]);
                }
            }
        } else if (EPI == EPI_AIN) {
            unsigned char* ws = e.ws;
#pragma unroll
            for (int mi = 0; mi < MI; ++mi) { __builtin_amdgcn_sched_barrier(0);
                const int tok = m0 + wm * 128 + mi * 16 + c16, b = tok >> 14, s = tok & (S_ - 1);
                if (nb < 1024) {
                    rope_store(acc, mi, (u16*)(ws + OFF_Q) + (size_t)tok * 1024 + nb, cosT, sinT, s, q4);
                } else if (nb < 1536) {
                    u16* dst = (nb < 1280) ? ((u16*)(ws + OFF_KC) + (size_t)tok * 256 + (nb - 1024)) : ((u16*)(ws + OFF_VC) + (size_t)tok * 256 + (nb - 1280));
#pragma unroll
                    for (int ni = 0; ni < 4; ++ni) *(uint2*)(dst + ni * 16 + q4 * 4) = pack4(acc[ni][mi]);
                } else if (nb < 2560) {
                    const int r = (nb - 1536) >> 8;
                    const int g = ((nb - 1536) & 255) >> 6;
                    if (r == 0) {
                        unsigned char* kd = (unsigned char*)(ws + OFF_KS) + (size_t)(b * 4 + g) * S_ * 128 + (size_t)s * 64;
#pragma unroll
                        for (int ni = 0; ni < 2; ++ni) {
                            const int d = ni * 16 + q4 * 4;
                            const float4 c = *(const float4*)(cosT + s * 32 + d), sn = *(const float4*)(sinT + s * 32 + d);
                            const f32x4 x1 = acc[ni][mi], x2 = acc[ni + 2][mi];
                            *(unsigned*)(kd + d) = pk4_fp8(x1[0] * c.x - x2[0] * sn.x, x1[1] * c.y - x2[1] * sn.y, x1[2] * c.z - x2[2] * sn.z, x1[3] * c.w - x2[3] * sn.w);
                            *(unsigned*)(kd + d + 32) = pk4_fp8(x2[0] * c.x + x1[0] * sn.x, x2[1] * c.y + x1[1] * sn.y, x2[2] * c.z + x1[2] * sn.z, x2[3] * c.w + x1[3] * sn.w);
                        }
                    } else if (r == 2) {
                        u16* base = (u16*)(ws + OFF_KW);
                        rope_store(acc, mi, base + ((size_t)(b * 4 + g) * S_ + s) * 64, cosT, sinT, s, q4);
                    } else {
                        if (r == 1) {
                            unsigned char* base = (unsigned char*)(ws + OFF_VST) + (size_t)(b * 4 + g) * 128 * S_ + (size_t)(s >> 6) * 4096 + (s & 63);
#pragma unroll
                            for (int ni = 0; ni < 4; ++ni) {
                                const unsigned pk = pk4_fp8(acc[ni][mi][0], acc[ni][mi][1], acc[ni][mi][2], acc[ni][mi][3]);
#pragma unroll
                                for (int i = 0; i < 4; ++i) base[(ni * 16 + q4 * 4 + i) * 64] = (unsigned char)(pk >> (8 * i));
                            }
                        } else {
                            u16* base = (u16*)(ws + OFF_VWT);
#pragma unroll
                            for (int ni = 0; ni < 4; ++ni)
#pragma unroll
                                for (int i = 0; i < 4; ++i) base[((size_t)(b * 4 + g) * 64 + ni * 16 + q4 * 4 + i) * S_ + s] = f2bf(acc[ni][mi][i]);
                        }
                    }
                } else if (nb == 2560) {
                    float* G = (float*)(ws + OFF_GATES) + (size_t)tok * 48;
#pragma unroll
                    for (int ni = 0; ni < 3; ++ni) {
                        const int n = ni * 16 + q4 * 4;
                        *(float4*)(G + n) = make_float4(sigmoidf_(acc[ni][mi][0]), sigmoidf_(acc[ni][mi][1]), sigmoidf_(acc[ni][mi][2]), sigmoidf_(acc[ni][mi][3]));
                    }
                }
            }
        } else if (EPI == EPI_FFNIN) {
            u16* U = (u16*)smem;
#pragma unroll
            for (int mi = 0; mi < MI; ++mi) {
                const int row = wm * 128 + mi * 16 + c16;
#pragma unroll
                for (int ni = 0; ni < 4; ++ni) {
                    const int cch = wn * 16 + ni * 4 + q4;
                    *(uint2*)(U + row * 256 + ((cch ^ (row & 15)) << 2)) = pack4(acc[ni][mi]);
                }
            }
            __syncthreads();
            {
                const int cc = tid & 31, gsel = cc >> 4, ca = cc & 15, seg = tid >> 5;
                const int ncol = (nt * 2 + gsel) * 64 + ca * 4;
                const int cha = gsel * 32 + ca, chg = cha + 16;
                const float4 w0a = *(const float4*)(e.convw + ncol), w1a = *(const float4*)(e.convw + NFF2 + ncol), w2a = *(const float4*)(e.convw + 2 * NFF2 + ncol);
                const float4 w0g = *(const float4*)(e.convw + DFF + ncol), w1g = *(const float4*)(e.convw + NFF2 + DFF + ncol), w2g = *(const float4*)(e.convw + 2 * NFF2 + DFF + ncol);
                const float4 ba = *(const float4*)(e.convb + ncol), bg = *(const float4*)(e.convb + DFF + ncol);
                float* head = (float*)(e.ws + OFF_HEAD); float* halo = (float*)(e.ws + OFF_HALO);
                u16* act = (u16*)(e.ws + OFF_ACT);
                auto ldu = [&](int row, int ch) __attribute__((always_inline)) -> float4 {
                    const uint2 v = *(const uint2*)(U + row * 256 + ((ch ^ (row & 15)) << 2));
                    return make_float4(__uint_as_float(v.x << 16), __uint_as_float(v.x & 0xffff0000u), __uint_as_float(v.y << 16), __uint_as_float(v.y & 0xffff0000u));
                };
                const int r0 = seg * 16;
                float4 a2 = make_float4(0.f, 0.f, 0.f, 0.f), a1 = a2, g2 = a2, g1 = a2;
                if (seg > 0) { a2 = ldu(r0 - 2, cha); g2 = ldu(r0 - 2, chg); a1 = ldu(r0 - 1, cha); g1 = ldu(r0 - 1, chg); }
#pragma unroll 2
                for (int r = 0; r < 16; ++r) {
                    const int row = r0 + r;
                    const float4 ua = ldu(row, cha), ug = ldu(row, chg);
                    if (seg > 0 || r >= 2) {
                        float ca_[4], cg_[4];
                        ca_[0] = ba.x + w0a.x * a2.x + w1a.x * a1.x + w2a.x * ua.x; ca_[1] = ba.y + w0a.y * a2.y + w1a.y * a1.y + w2a.y * ua.y;
                        ca_[2] = ba.z + w0a.z * a2.z + w1a.z * a1.z + w2a.z * ua.z; ca_[3] = ba.w + w0a.w * a2.w + w1a.w * a1.w + w2a.w * ua.w;
                        cg_[0] = bg.x + w0g.x * g2.x + w1g.x * g1.x + w2g.x * ug.x; cg_[1] = bg.y + w0g.y * g2.y + w1g.y * g1.y + w2g.y * ug.y;
                        cg_[2] = bg.z + w0g.z * g2.z + w1g.z * g1.z + w2g.z * ug.z; cg_[3] = bg.w + w0g.w * g2.w + w1g.w * g1.w + w2g.w * ug.w;
                        f32x4 o = {ca_[0] * sigmoidf_(ca_[0]) * cg_[0], ca_[1] * sigmoidf_(ca_[1]) * cg_[1], ca_[2] * sigmoidf_(ca_[2]) * cg_[2], ca_[3] * sigmoidf_(ca_[3]) * cg_[3]};
                        *(uint2*)(act + (size_t)(m0 + row) * DFF + ncol) = pack4(o);
                    }
                    if (seg == 0 && r < 2) { *(float4*)(head + (size_t)(mt * 2 + r) * NFF2 + ncol) = ua; *(float4*)(head + (size_t)(mt * 2 + r) * NFF2 + DFF + ncol) = ug; }
                    if (seg == 15 && r >= 14) { *(float4*)(halo + (size_t)(mt * 2 + r - 14) * NFF2 + ncol) = ua; *(float4*)(halo + (size_t)(mt * 2 + r - 14) * NFF2 + DFF + ncol) = ug; }
                    a2 = a1; a1 = ua; g2 = g1; g1 = ug;
                }
            }
            __syncthreads();
        }
    }
}

__device__ __forceinline__ void fixup_phase(const Params& p, int L, int tid_, int bid_) {
    const float* head = (const float*)(p.ws + OFF_HEAD); const float* halo = (const float*)(p.ws + OFF_HALO);
    u16* act = (u16*)(p.ws + OFF_ACT);
    const float* cw = p.ffn_conv_w + (size_t)L * 3 * NFF2; const float* cb = p.ffn_conv_b + (size_t)L * NFF2;
    const int gt = bid_ * NTHR + tid_, nthr = gridDim.x * NTHR;
    for (int idx = gt; idx < 128 * 704; idx += nthr) {
        const int i = idx / 704, n = (idx - i * 704) * 4;
        const int t0 = i * 256;
        const bool first = (t0 & (S_ - 1)) == 0;
        const float4 z = make_float4(0.f, 0.f, 0.f, 0.f);
        const float4 ha0 = *(const float4*)(head + (size_t)(i * 2) * NFF2 + n), ha1 = *(const float4*)(head + (size_t)(i * 2 + 1) * NFF2 + n);
        const float4 hg0 = *(const float4*)(head + (size_t)(i * 2) * NFF2 + DFF + n), hg1 = *(const float4*)(head + (size_t)(i * 2 + 1) * NFF2 + DFF + n);
        float4 pa0 = z, pa1 = z, pg0 = z, pg1 = z;
        if (!first) {
            pa0 = *(const float4*)(halo + (size_t)(i * 2 - 2) * NFF2 + n); pa1 = *(const float4*)(halo + (size_t)(i * 2 - 1) * NFF2 + n);
            pg0 = *(const float4*)(halo + (size_t)(i * 2 - 2) * NFF2 + DFF + n); pg1 = *(const float4*)(halo + (size_t)(i * 2 - 1) * NFF2 + DFF + n);
        }
        const float4 w0a = *(const float4*)(cw + n), w1a = *(const float4*)(cw + NFF2 + n), w2a = *(const float4*)(cw + 2 * NFF2 + n);
        const float4 w0g = *(const float4*)(cw + DFF + n), w1g = *(const float4*)(cw + NFF2 + DFF + n), w2g = *(const float4*)(cw + 2 * NFF2 + DFF + n);
        const float4 ba = *(const float4*)(cb + n), bg = *(const float4*)(cb + DFF + n);
#define CONV3(b_, w0_, w1_, w2_, x0_, x1_, x2_) make_float4(b_.x + w0_.x * x0_.x + w1_.x * x1_.x + w2_.x * x2_.x, b_.y + w0_.y * x0_.y + w1_.y * x1_.y + w2_.y * x2_.y, \
                                                             b_.z + w0_.z * x0_.z + w1_.z * x1_.z + w2_.z * x2_.z, b_.w + w0_.w * x0_.w + w1_.w * x1_.w + w2_.w * x2_.w)
        const float4 ca0 = CONV3(ba, w0a, w1a, w2a, pa0, pa1, ha0), cg0 = CONV3(bg, w0g, w1g, w2g, pg0, pg1, hg0);
        const float4 ca1 = CONV3(ba, w0a, w1a, w2a, pa1, ha0, ha1), cg1 = CONV3(bg, w0g, w1g, w2g, pg1, hg0, hg1);
        f32x4 o0 = {ca0.x * sigmoidf_(ca0.x) * cg0.x, ca0.y * sigmoidf_(ca0.y) * cg0.y, ca0.z * sigmoidf_(ca0.z) * cg0.z, ca0.w * sigmoidf_(ca0.w) * cg0.w};
        f32x4 o1 = {ca1.x * sigmoidf_(ca1.x) * cg1.x, ca1.y * sigmoidf_(ca1.y) * cg1.y, ca1.z * sigmoidf_(ca1.z) * cg1.z, ca1.w * sigmoidf_(ca1.w) * cg1.w};
        *(uint2*)(act + (size_t)t0 * DFF + n) = pack4(o0);
        *(uint2*)(act + (size_t)(t0 + 1) * DFF + n) = pack4(o1);
    }
}

__device__ __forceinline__ void cmp2_phase(const Params& p, int L, int tid_, int bid_) {
    const int lane = tid_ & 63, w = tid_ >> 6, c16 = lane & 15, q4 = lane >> 4;
    const float* cosT = (const float*)(p.ws + OFF_COS); const float* sinT = (const float*)(p.ws + OFF_SIN);
    u16* KCC = (u16*)(p.ws + OFF_KCC); u16* VCCT = (u16*)(p.ws + OFF_VCCT);
    for (int task = bid_ * NW + w; task < 1024; task += gridDim.x * NW) {
        const int kv = task >> 9, r0 = (task & 511) * 16;
        const u16* hid = (const u16*)(p.ws + OFF_HID) + (size_t)kv * 8192 * 256;
        const u16* w2t = (const u16*)(p.ws + OFF_WT_CW2 + (L * 2 + kv) * SZ_WT_CW2);
        const int row = r0 + c16, rowc = row < 8184 ? row : 8183;
        f32x4 acc[4][1];
        f32x4 accq[4][4];
#pragma unroll
        for (int a = 0; a < 4; ++a) accq[a][0] = (f32x4){0.f, 0.f, 0.f, 0.f};
#pragma unroll
        for (int kk = 0; kk < 8; ++kk) {
            const bf16x8 bfr = *(const bf16x8*)(hid + (size_t)rowc * 256 + kk * 32 + q4 * 8);
#pragma unroll
            for (int nbk = 0; nbk < 4; ++nbk) {
                const bf16x8 afr = *(const bf16x8*)(w2t + (nbk * 16 + c16) * 256 + kk * 32 + q4 * 8);
                accq[nbk][0] = mfma16(afr, bfr, accq[nbk][0]);
            }
        }
        (void)acc;
        if (row < 8184) {
            const int g = row & 3, bn = row >> 2, b = bn / 1023, n = bn - b * 1023, bg = b * 4 + g;
            if (kv == 0) {
                rope_store(accq, 0, KCC + ((size_t)bg * 1024 + n) * 64, cosT, sinT, n * 16 + 31, q4);
            } else {
#pragma unroll
                for (int nbk = 0; nbk < 4; ++nbk)
#pragma unroll
                    for (int i = 0; i < 4; ++i) VCCT[((size_t)bg * 64 + nbk * 16 + q4 * 4 + i) * 1024 + n] = f2bf(accq[nbk][0][i]);
            }
        }
    }
    const int gt = bid_ * NTHR + tid_;
    if (gt < 512) {
        const int bg = gt >> 6, d = gt & 63;
        KCC[((size_t)bg * 1024 + 1023) * 64 + d] = 0;
        VCCT[((size_t)bg * 64 + d) * 1024 + 1023] = 0;
    }
}

template <bool SINK>
__device__ __forceinline__ void band_attn(const u16* __restrict__ qrow, const u16* __restrict__ Kh, const u16* __restrict__ VT, int t0, int W, const float* sinks4,
                                          f32x4 (&O)[4][4], float (&linv)[4], int lane) {
    const int c16 = lane & 15, q4 = lane >> 4;
    const float SC = 0.125f * LOG2E;
    bf16x8 qf[4][2];
#pragma unroll
    for (int h = 0; h < 4; ++h)
#pragma unroll
        for (int ks = 0; ks < 2; ++ks) qf[h][ks] = *(const bf16x8*)(qrow + h * 64 + ks * 32 + q4 * 8);
    float m[4], l[4];
#pragma unroll
    for (int h = 0; h < 4; ++h) {
        if (SINK) { m[h] = sinks4[h] * LOG2E; l[h] = (q4 == 0) ? 1.f : 0.f; }
        else { m[h] = NEGBIG; l[h] = 0.f; }
#pragma unroll
        for (int db = 0; db < 4; ++db) O[h][db] = (f32x4){0.f, 0.f, 0.f, 0.f};
    }
    const int t = t0 + c16;
    int lo = t0 - W + 1; if (lo < 0) lo = 0;
    const int g0 = lo >> 5, g1 = (t0 + 15) >> 5;
    const int kr = kperm(c16);
    for (int grp = g0; grp <= g1; ++grp) {
        const int kb = grp << 5;
        const unsigned kof = (unsigned)(kb + kr) * 64u + (unsigned)q4 * 8u;
        const bf16x8 k1a = *(const bf16x8*)(Kh + kof), k1b = *(const bf16x8*)(Kh + (kof + 32u)), k2a = *(const bf16x8*)(Kh + (kof + 256u)), k2b = *(const bf16x8*)(Kh + (kof + 288u));
        bf16x8 vf[4];
        const unsigned vof = (unsigned)c16 * (unsigned)S_ + (unsigned)kb + (unsigned)q4 * 8u;
#pragma unroll
        for (int db = 0; db < 4; ++db) vf[db] = *(const bf16x8*)(VT + (size_t)(db * 16 * S_) + vof);
        const int kpos = kb + q4 * 8;
#pragma unroll
        for (int h = 0; h < 4; ++h) {
            f32x4 s1 = mfma16(k1a, qf[h][0], (f32x4){0.f, 0.f, 0.f, 0.f}); s1 = mfma16(k1b, qf[h][1], s1);
            f32x4 s2 = mfma16(k2a, qf[h][0], (f32x4){0.f, 0.f, 0.f, 0.f}); s2 = mfma16(k2b, qf[h][1], s2);
            float sv[8]; bool ok[8];
#pragma unroll
            for (int i = 0; i < 4; ++i) {
                const int d1 = t - (kpos + i), d2 = t - (kpos + 4 + i);
                ok[i] = (d1 >= 0) && (d1 < W); ok[4 + i] = (d2 >= 0) && (d2 < W);
                sv[i] = ok[i] ? s1[i] * SC : NEGBIG; sv[4 + i] = ok[4 + i] ? s2[i] * SC : NEGBIG;
            }
            float mx = fmaxf(fmaxf(fmaxf(sv[0], sv[1]), fmaxf(sv[2], sv[3])), fmaxf(fmaxf(sv[4], sv[5]), fmaxf(sv[6], sv[7])));
            mx = xmax32(xmax16(mx));
            const float mn = fmaxf(m[h], mx);
            const float alpha = fexp2(m[h] - mn);
            m[h] = mn;
            float pv[8]; float ps = 0.f;
#pragma unroll
            for (int i = 0; i < 8; ++i) { pv[i] = ok[i] ? fexp2(sv[i] - mn) : 0.f; ps += pv[i]; }
            l[h] = l[h] * alpha + ps;
            const bf16x8 pf = pack8(pv);
#pragma unroll
            for (int db = 0; db < 4; ++db) { O[h][db] = O[h][db] * alpha; O[h][db] = mfma16(vf[db], pf, O[h][db]); }
        }
    }
#pragma unroll
    for (int h = 0; h < 4; ++h) { float lt = l[h]; lt += __shfl_xor(lt, 16); lt += __shfl_xor(lt, 32); linv[h] = 1.f / lt; }
}

__device__ __forceinline__ void swa_phase(const Params& p, int j, int tid_, int bid_) {
    const int lane = tid_ & 63, w = tid_ >> 6, c16 = lane & 15, q4 = lane >> 4;
    const int x = bid_ & 7, b = x >> 2, kvh = (x >> 1) & 1, hq = x & 1;
    const int head0 = kvh * 8 + hq * 4;
    const u16* Q = (const u16*)(p.ws + OFF_Q); u16* Ob = (u16*)(p.ws + OFF_O);
    const u16* Kh = (const u16*)(p.ws + OFF_KSH) + (size_t)(b * 2 + kvh) * S_ * 64;
    const u16* VT = (const u16*)(p.ws + OFF_VSHT) + (size_t)(b * 2 + kvh) * 64 * S_;
    const float* sk = p.b_sinks + j * 16 + head0;
    const int nslots = (gridDim.x >> 3) * NW;
    for (int tile = (bid_ >> 3) * NW + w; tile < 1024; tile += nslots) {
        const int t0 = tile * 16;
        f32x4 O[4][4]; float linv[4];
        band_attn<true>(Q + ((size_t)b * S_ + t0 + c16) * 1024 + head0 * 64, Kh, VT, t0, 128, sk, O, linv, lane);
        u16* op = Ob + ((size_t)b * S_ + t0 + c16) * 1024 + head0 * 64;
#pragma unroll
        for (int h = 0; h < 4; ++h)
#pragma unroll
            for (int db = 0; db < 4; ++db) *(uint2*)(op + h * 64 + db * 16 + q4 * 4) = pack4(O[h][db] * linv[h]);
    }
}

__device__ __forceinline__ void nsa_phase(const Params& p, unsigned char* smem, int tid_, int bid_, int probe_rep) {
    const int lane0 = tid_ & 63, w = tid_ >> 6;
    float* R = (float*)(smem + w * 16384);
    unsigned* tm = (unsigned*)(smem + NW * 16384 + w * 1024);
    unsigned char* sel = smem + NW * 16384 + NW * 1024 + w * 256;
    const int bg = bid_ & 7, b = bg >> 2, g = bg & 3;
    const u16* Q = (const u16*)(p.ws + OFF_Q); u16* Ob = (u16*)(p.ws + OFF_O);
    const u16* KCC = (const u16*)(p.ws + OFF_KCC) + (size_t)bg * 1024 * 64;
    const u16* VCCT = (const u16*)(p.ws + OFF_VCCT) + (size_t)bg * 64 * 1024;
    const u16* KS = (const u16*)(p.ws + OFF_KS) + (size_t)bg * S_ * 64;
    const u16* VST = (const u16*)(p.ws + OFF_VST) + (size_t)bg * 64 * S_;
    const u16* KW = (const u16*)(p.ws + OFF_KW) + (size_t)bg * S_ * 64;
    const u16* VWT = (const u16*)(p.ws + OFF_VWT) + (size_t)bg * 64 * S_;
    const float* GATES = (const float*)(p.ws + OFF_GATES);
    const float SC = 0.125f * LOG2E;
    const int nslots = (gridDim.x >> 3) * NW;
    const int slot_ = (bid_ >> 3) * NW + w;
    for (int rnd = 0; rnd * nslots < 1024; ++rnd) {
        const int tile_ = rnd * nslots + ((rnd & 1) ? (nslots - 1 - slot_) : slot_);
        if (tile_ >= 1024) continue;
        const int tile = __builtin_amdgcn_readfirstlane(tile_);
        int lane = lane0; asm volatile("" : "+v"(lane));
        const int c16 = lane & 15, q4 = lane >> 4, kr = kperm(c16);
        const int t0 = tile * 16, cur = t0 >> 6, t = t0 + c16;
        const u16* qrow = Q + ((size_t)b * S_ + t) * 1024 + g * 256;
        const float* grow = GATES + ((size_t)b * S_ + t) * 48 + g * 12;
        const int nvl = (t >= 31) ? ((t - 31) >> 4) : -1;
        const int nvmax = (t0 + 15 >= 31) ? ((t0 + 15 - 31) >> 4) : -1;
        const int ng = (nvmax >= 0) ? ((nvmax >> 5) + 1) : 0;
        f32x4 Oc[4][4];
#pragma unroll
        for (int h = 0; h < 4; ++h)
#pragma unroll
            for (int db = 0; db < 4; ++db) Oc[h][db] = (f32x4){0.f, 0.f, 0.f, 0.f};
        {
            bf16x8 qf[4][2];
#pragma unroll
            for (int h = 0; h < 4; ++h)
#pragma unroll
                for (int ks = 0; ks < 2; ++ks) qf[h][ks] = *(const bf16x8*)(qrow + h * 64 + ks * 32 + q4 * 8);
            float m[4], l[4];
#pragma unroll
            for (int h = 0; h < 4; ++h) { m[h] = NEGBIG; l[h] = 0.f; }
            for (int grp = 0; grp < ng; ++grp) {
                const int kb = grp << 5;
                const unsigned kof = (unsigned)(kb + kr) * 64u + (unsigned)q4 * 8u;
                const bf16x8 k1a = *(const bf16x8*)(KCC + kof), k1b = *(const bf16x8*)(KCC + (kof + 32u)), k2a = *(const bf16x8*)(KCC + (kof + 256u)), k2b = *(const bf16x8*)(KCC + (kof + 288u));
                const int kpos = kb + q4 * 8;
#pragma unroll
                for (int h = 0; h < 4; ++h) {
                    f32x4 s1 = mfma16(k1a, qf[h][0], (f32x4){0.f, 0.f, 0.f, 0.f}); s1 = mfma16(k1b, qf[h][1], s1);
                    f32x4 s2 = mfma16(k2a, qf[h][0], (f32x4){0.f, 0.f, 0.f, 0.f}); s2 = mfma16(k2b, qf[h][1], s2);
                    float sv[8]; bool ok[8];
#pragma unroll
                    for (int i = 0; i < 4; ++i) {
                        ok[i] = (kpos + i) <= nvl; ok[4 + i] = (kpos + 4 + i) <= nvl;
                        sv[i] = ok[i] ? s1[i] * SC : NEGBIG; sv[4 + i] = ok[4 + i] ? s2[i] * SC : NEGBIG;
                    }
                    float mx = fmaxf(fmaxf(fmaxf(sv[0], sv[1]), fmaxf(sv[2], sv[3])), fmaxf(fmaxf(sv[4], sv[5]), fmaxf(sv[6], sv[7])));
                    mx = xmax32(xmax16(mx));
                    const float mn = fmaxf(m[h], mx);
                    const float alpha = fexp2(m[h] - mn);
                    m[h] = mn;
                    float ps = 0.f;
#pragma unroll
                    for (int i = 0; i < 8; ++i) ps += ok[i] ? fexp2(sv[i] - mn) : 0.f;
                    l[h] = l[h] * alpha + ps;
                }
            }
            float linv[4];
#pragma unroll
            for (int h = 0; h < 4; ++h) { float lt = l[h]; lt += __shfl_xor(lt, 16); lt += __shfl_xor(lt, 32); linv[h] = lt > 0.f ? 1.f / lt : 0.f; }
            float carry = 0.f;
            for (int grp = 0; grp < ng; ++grp) {
                const int kb = grp << 5;
                const unsigned kof = (unsigned)(kb + kr) * 64u + (unsigned)q4 * 8u;
                const bf16x8 k1a = *(const bf16x8*)(KCC + kof), k1b = *(const bf16x8*)(KCC + (kof + 32u)), k2a = *(const bf16x8*)(KCC + (kof + 256u)), k2b = *(const bf16x8*)(KCC + (kof + 288u));
                bf16x8 vf[4];
#pragma unroll
                for (int db = 0; db < 4; ++db) vf[db] = *(const bf16x8*)(VCCT + (unsigned)(db * 16 * 1024) + ((unsigned)c16 * 1024u + (unsigned)kb + (unsigned)q4 * 8u));
                const int kpos = kb + q4 * 8;
                float psum[8];
#pragma unroll
                for (int i = 0; i < 8; ++i) psum[i] = 0.f;
#pragma unroll
                for (int h = 0; h < 4; ++h) {
                    f32x4 s1 = mfma16(k1a, qf[h][0], (f32x4){0.f, 0.f, 0.f, 0.f}); s1 = mfma16(k1b, qf[h][1], s1);
                    f32x4 s2 = mfma16(k2a, qf[h][0], (f32x4){0.f, 0.f, 0.f, 0.f}); s2 = mfma16(k2b, qf[h][1], s2);
                    float pv[8];
#pragma unroll
                    for (int i = 0; i < 4; ++i) {
                        pv[i] = ((kpos + i) <= nvl) ? fexp2(s1[i] * SC - m[h]) * linv[h] : 0.f;
                        pv[4 + i] = ((kpos + 4 + i) <= nvl) ? fexp2(s2[i] * SC - m[h]) * linv[h] : 0.f;
                    }
#pragma unroll
                    for (int i = 0; i < 8; ++i) psum[i] += pv[i];
                    const bf16x8 pf = pack8(pv);
#pragma unroll
                    for (int db = 0; db < 4; ++db) Oc[h][db] = mfma16(vf[db], pf, Oc[h][db]);
                }
                const float prev = __shfl(psum[7], (lane + 48) & 63);
                const float left = (q4 == 0) ? carry : prev;
                carry = prev;
                const float impA = left + 2.f * (psum[0] + psum[1] + psum[2]) + psum[3];
                const float impB = psum[3] + 2.f * (psum[4] + psum[5] + psum[6]) + psum[7];
                *(float2*)(R + c16 * 256 + (kb >> 2) + 2 * q4) = make_float2(impA, impB);
            }
        }
        wsync();
        const int ncand = cur - 2;
        const int npick = ncand < 0 ? 0 : (ncand < 13 ? ncand : 13);
        const int nforced = (cur < 2 ? cur : 2) + 1;
        const int nsel = npick + nforced;
        for (int tk = 0; tk < 16; ++tk) {
            float v0 = -1.f, v1 = -1.f, v2 = -1.f, v3 = -1.f;
            if (npick > 0) {
                const float4 v = *(const float4*)(R + tk * 256 + lane * 4);
                const int j0 = lane * 4;
                v0 = (j0 >= 1 && j0 <= ncand) ? v.x : -1.f; v1 = (j0 + 1 <= ncand) ? v.y : -1.f; v2 = (j0 + 2 <= ncand) ? v.z : -1.f; v3 = (j0 + 3 <= ncand) ? v.w : -1.f;
            }
            for (int it = 0; it < npick; ++it) {
                float mx = fmaxf(fmaxf(v0, v1), fmaxf(v2, v3));
                mx = wave_max(mx);
                const bool has = (v0 == mx) || (v1 == mx) || (v2 == mx) || (v3 == mx);
                const unsigned long long bal = __ballot(has);
                const int first = __ffsll((long long)bal) - 1;
                if (lane == first) {
                    int sl;
                    if (v0 == mx) { sl = 0; v0 = -1.f; } else if (v1 == mx) { sl = 1; v1 = -1.f; } else if (v2 == mx) { sl = 2; v2 = -1.f; } else { sl = 3; v3 = -1.f; }
                    sel[tk * 16 + it] = (unsigned char)(lane * 4 + sl);
                }
            }
            if (lane == 0) {
                sel[tk * 16 + npick] = 0;
                if (cur >= 1) sel[tk * 16 + npick + 1] = (unsigned char)cur;
                if (cur >= 2) sel[tk * 16 + npick + 2] = (unsigned char)(cur - 1);
            }
        }
        { unsigned zz = 0u; asm volatile("" : "+v"(zz)); *(uint4*)(tm + lane * 4) = make_uint4(zz, zz, zz, zz); }
        wsync();
        if (lane < 16) {
            for (int si = 0; si < nsel; ++si) atomicOr(&tm[sel[lane * 16 + si]], 1u << lane);
        }
        wsync();
        int n_act;
        {
            const uint4 mm = *(const uint4*)(tm + lane * 4);
            wsync();
            const bool f0 = mm.x != 0u, f1 = mm.y != 0u, f2 = mm.z != 0u, f3 = mm.w != 0u;
            const unsigned long long b0 = __ballot(f0), b1 = __ballot(f1), b2 = __ballot(f2), b3 = __ballot(f3);
            const unsigned long long below = (1ull << lane) - 1ull;
            int pos = __popcll(b0 & below) + __popcll(b1 & below) + __popcll(b2 & below) + __popcll(b3 & below);
            if (f0) { sel[pos] = (unsigned char)(lane * 4 + 0); ++pos; }
            if (f1) { sel[pos] = (unsigned char)(lane * 4 + 1); ++pos; }
            if (f2) { sel[pos] = (unsigned char)(lane * 4 + 2); ++pos; }
            if (f3) { sel[pos] = (unsigned char)(lane * 4 + 3); ++pos; }
            n_act = __popcll(b0) + __popcll(b1) + __popcll(b2) + __popcll(b3);
        }
        wsync();
        u16* QL = (u16*)R;
        u16* PL = (u16*)R + 4096;
        {
            int t3 = t; asm volatile("" : "+v"(t3));
            const float* grow3 = GATES + ((size_t)b * S_ + t3) * 48 + g * 12;
#pragma unroll
            for (int h = 0; h < 4; ++h) {
                const float g0 = grow3[h * 3 + 0];
#pragma unroll
                for (int db = 0; db < 4; ++db) *(uint2*)(PL + (c16 * 4 + h) * 64 + db * 16 + q4 * 4) = pack4(Oc[h][db] * g0);
            }
#pragma unroll
            for (int i = 0; i < 8; ++i) {
                const int idx = i * 64 + lane, row = idx >> 3, ch = idx & 7;
                const uint4 v = *(const uint4*)(Q + ((size_t)b * S_ + t0 + (row >> 2)) * 1024 + g * 256 + (row & 3) * 64 + ch * 8);
                *(uint4*)(QL + row * 64 + ((ch ^ ((row >> 1) & 7)) << 3)) = v;
            }
        }
        wsync();
        for (int rep = 0; rep <= probe_rep; ++rep) {
            const int tg = c16 >> 2, hh = c16 & 3;
            f32x4 Os[4][4]; float m[4], l[4];
#pragma unroll
            for (int gq = 0; gq < 4; ++gq) {
                m[gq] = NEGBIG; l[gq] = 0.f;
#pragma unroll
                for (int db = 0; db < 4; ++db) Os[gq][db] = (f32x4){0.f, 0.f, 0.f, 0.f};
            }
            long qf8[4][2];
#pragma unroll
            for (int gq = 0; gq < 4; ++gq)
#pragma unroll
                for (int ks = 0; ks < 2; ++ks) {
                    const uint4 qv = *(const uint4*)(Q + ((size_t)b * S_ + t0 + gq * 4 + tg) * 1024 + g * 256 + hh * 64 + ks * 32 + q4 * 8);
                    const float f[8] = {__uint_as_float(qv.x << 16), __uint_as_float(qv.x & 0xffff0000u), __uint_as_float(qv.y << 16), __uint_as_float(qv.y & 0xffff0000u),
                                        __uint_as_float(qv.z << 16), __uint_as_float(qv.z & 0xffff0000u), __uint_as_float(qv.w << 16), __uint_as_float(qv.w & 0xffff0000u)};
                    qf8[gq][ks] = pk8_fp8(f);
                }
            const unsigned char* KS8 = (const unsigned char*)KS;
            const unsigned char* VS8 = (const unsigned char*)VST;
            auto ld = [&](int s, long (&K)[4], long (&V)[4]) __attribute__((always_inline)) {
                const int j = __builtin_amdgcn_readfirstlane((int)sel[s >> 1]);
                const int kb = j * 64 + (s & 1) * 32;
                const unsigned kof = (unsigned)(kb + kr) * 64u + (unsigned)q4 * 8u;
                K[0] = *(const long*)(KS8 + kof); K[1] = *(const long*)(KS8 + (kof + 32u)); K[2] = *(const long*)(KS8 + (kof + 256u)); K[3] = *(const long*)(KS8 + (kof + 288u));
                const unsigned vof = (unsigned)j * 4096u + (unsigned)c16 * 64u + (unsigned)(s & 1) * 32u + (unsigned)q4 * 8u;
#pragma unroll
                for (int db = 0; db < 4; ++db) V[db] = *(const long*)(VS8 + (vof + (unsigned)(db * 1024)));
            };
            auto cp = [&](int s, const long (&K)[4], const long (&V)[4]) __attribute__((always_inline)) {
                const int j = __builtin_amdgcn_readfirstlane((int)sel[s >> 1]);
                const unsigned mk = __builtin_amdgcn_readfirstlane(tm[j]);
                const int kpos = j * 64 + (s & 1) * 32 + q4 * 8;
#pragma unroll
                for (int gq = 0; gq < 4; ++gq) {
                    const unsigned gm = (mk >> (gq * 4)) & 0xFu;
                    if (gm == 0u) continue;
                    const float cmv = ((gm >> tg) & 1u) ? 0.f : NEGBIG;
                    f32x4 cm1 = {cmv, cmv, cmv, cmv}, cm2 = cm1;
                    if (j == cur) {
                        const int tc = t0 + gq * 4 + tg;
#pragma unroll
                        for (int i = 0; i < 4; ++i) { if (kpos + i > tc) cm1[i] = NEGBIG; if (kpos + 4 + i > tc) cm2[i] = NEGBIG; }
                    }
                    f32x4 s1 = mfma8(K[0], qf8[gq][0], cm1); s1 = mfma8(K[1], qf8[gq][1], s1);
                    f32x4 s2 = mfma8(K[2], qf8[gq][0], cm2); s2 = mfma8(K[3], qf8[gq][1], s2);
                    float mx = fmaxf(fmaxf(fmaxf(s1[0], s1[1]), fmaxf(s1[2], s1[3])), fmaxf(fmaxf(s2[0], s2[1]), fmaxf(s2[2], s2[3])));
                    mx = xmax32(xmax16(mx));
                    const float mn = fmaxf(m[gq], mx * SC);
                    if (__ballot(mn != m[gq])) {
                        const float alpha = fexp2(m[gq] - mn);
                        l[gq] *= alpha;
#pragma unroll
                        for (int db = 0; db < 4; ++db) Os[gq][db] = Os[gq][db] * alpha;
                    }
                    m[gq] = mn;
                    float pv[8]; float ps = 0.f;
#pragma unroll
                    for (int i = 0; i < 4; ++i) { pv[i] = fexp2(fmaf(s1[i], SC, 7.f - mn)); pv[4 + i] = fexp2(fmaf(s2[i], SC, 7.f - mn)); }
#pragma unroll
                    for (int i = 0; i < 8; ++i) ps += pv[i];
                    l[gq] += ps;
                    const long pf = pk8_fp8(pv);
#pragma unroll
                    for (int db = 0; db < 4; ++db) Os[gq][db] = mfma8(V[db], pf, Os[gq][db]);
                }
            };
            {
                long KA[4], VA[4], KB[4], VB[4];
                const int ns = 2 * n_act;
                ld(0, KA, VA);
                for (int s = 0; s < ns; s += 2) {
                    ld(s + 1, KB, VB);
                    cp(s, KA, VA);
                    if (s + 2 < ns) ld(s + 2, KA, VA);
                    cp(s + 1, KB, VB);
                }
            }
            const float repsc = (rep == 0) ? 1.f : 0.f;
#pragma unroll
            for (int gq = 0; gq < 4; ++gq) {
                float lt = l[gq]; lt += __shfl_xor(lt, 16); lt += __shfl_xor(lt, 32);
                const int tok = gq * 4 + tg;
                const float sc = repsc * GATES[((size_t)b * S_ + t0 + tok) * 48 + g * 12 + hh * 3 + 1] / lt;
#pragma unroll
                for (int db = 0; db < 4; ++db) {
                    u16* rp = PL + (tok * 4 + hh) * 64 + db * 16 + q4 * 4;
                    *(uint2*)rp = pack4(unpack4(*(const uint2*)rp) + Os[gq][db] * sc);
                }
            }
        }
        wsync();
        {
            f32x4 Ow[4][4]; float linv[4];
            int t2 = t; asm volatile("" : "+v"(t2));
            const u16* qrow2 = Q + ((size_t)b * S_ + t2) * 1024 + g * 256;
            const float* grow2 = GATES + ((size_t)b * S_ + t2) * 48 + g * 12;
            band_attn<false>(qrow2, KW, VWT, t0, 512, nullptr, Ow, linv, lane);
            u16* op = Ob + ((size_t)b * S_ + t2) * 1024 + g * 256;
#pragma unroll
            for (int h = 0; h < 4; ++h) {
                const float g2 = grow2[h * 3 + 2] * linv[h];
#pragma unroll
                for (int db = 0; db < 4; ++db) {
                    const f32x4 part = unpack4(*(const uint2*)(PL + (c16 * 4 + h) * 64 + db * 16 + q4 * 4));
                    *(uint2*)(op + h * 64 + db * 16 + q4 * 4) = pack4(part + Ow[h][db] * g2);
                }
            }
        }
        wsync();
    }
}


#define XB_TMO      128
#define XB_XCNT(j)  (256  + 64 * (j))
#define XB_XSUB(j)  (1280 + 64 * (j))
#define XB_XGEN(j)  (2304 + 64 * (j))
#define XB_TOP      3328
#define XB_TOPGEN   3392
#define XCD_BAR_WORDS 3456
#define XB_SPIN_CAP (1u << 22)
#define LAS __attribute__((address_space(3)))
__device__ __forceinline__ unsigned xb_ld(unsigned* p)              { return __hip_atomic_load(p, __ATOMIC_RELAXED, __HIP_MEMORY_SCOPE_AGENT); }
__device__ __forceinline__ unsigned xb_add(unsigned* p, unsigned v) { return __hip_atomic_fetch_add(p, v, __ATOMIC_RELAXED, __HIP_MEMORY_SCOPE_AGENT); }
__device__ __forceinline__ unsigned xb_xcc_id() { return (unsigned)__builtin_amdgcn_s_getreg((3 << 11) | 20) & 0xFu; }
#define XB_SPIN(cond, bar) do { unsigned _sp = 0; while (cond) { __builtin_amdgcn_s_sleep(1); \
    if ((++_sp & 255u) == 0u) { if (xb_ld(&(bar)[XB_TMO])) break; if (_sp > XB_SPIN_CAP) { atomicAdd(&(bar)[XB_TMO], 1u); break; } } } } while (0)
__device__ __forceinline__ void xcd_barrier_complete(unsigned* bar, unsigned x, unsigned& nloc, unsigned& nx) {
    const unsigned G = gridDim.x * gridDim.y * gridDim.z;
    unsigned sum, cnt, mine, sp = 0u;
    for (;;) {
        sum = 0u; cnt = 0u; mine = 0u;
#pragma unroll
        for (unsigned j = 0; j < 16; ++j) { const unsigned c = xb_ld(&bar[XB_XCNT(j)]); sum += c; cnt += (c > 0u) ? 1u : 0u; mine = (j == x) ? c : mine; }
        if (sum == G) break;
        __builtin_amdgcn_s_sleep(1);
        if ((++sp & 255u) == 0u) { if (xb_ld(&bar[XB_TMO])) break; if (sp > XB_SPIN_CAP) { atomicAdd(&bar[XB_TMO], 1u); break; } }
    }
    nloc = mine > 0u ? mine : 1u; nx = cnt > 0u ? cnt : 1u;
}
__device__ __forceinline__ void xcd_barrier(unsigned* bar, unsigned x, volatile LAS unsigned* st, int tid) {
    asm volatile("s_waitcnt vmcnt(0)" ::: "memory");
    __syncthreads();
    if (tid == 0) {
        __builtin_amdgcn_s_waitcnt(0);
        unsigned nloc = st[0], nx = st[1];
        if (nloc == 0u) { xcd_barrier_complete(bar, x, nloc, nx); st[0] = nloc; st[1] = nx; }
        const unsigned old = xb_add(&bar[XB_XSUB(x)], 1u);
        const unsigned gen = old / nloc;
        if (old + 1u == (gen + 1u) * nloc) {
            __builtin_amdgcn_fence(__ATOMIC_RELEASE, "agent");
            asm volatile("s_waitcnt vmcnt(0)" ::: "memory");
            const unsigned og = xb_add(&bar[XB_TOP], 1u);
            const unsigned tg = og / nx;
            if (og + 1u == (tg + 1u) * nx) xb_add(&bar[XB_TOPGEN], 1u);
            else XB_SPIN(xb_ld(&bar[XB_TOPGEN]) == tg, bar);
            __builtin_amdgcn_fence(__ATOMIC_ACQUIRE, "agent");
            xb_add(&bar[XB_XGEN(x)], 1u);
            asm volatile("s_waitcnt vmcnt(0)" ::: "memory");
        } else {
            XB_SPIN(xb_ld(&bar[XB_XGEN(x)]) == gen, bar);
            __builtin_amdgcn_fence(__ATOMIC_ACQUIRE, "agent");
            asm volatile("s_waitcnt vmcnt(0)" ::: "memory");
        }
    }
    __syncthreads();
}

enum { PT_PREP = 0, PT_NORM, PT_AIN, PT_CMP1, PT_CMP2, PT_NSA, PT_BKV, PT_BQ, PT_SWA, PT_AOUT, PT_FFNIN, PT_FIXUP, PT_FOUT, PT_FINAL };

__global__ void __launch_bounds__(NTHR, 2) mega(Params p) {
#if defined(__HIP_DEVICE_COMPILE__)
    extern __shared__ __attribute__((aligned(16))) unsigned char smem[];
    cg::grid_group grid = cg::this_grid();
    typedef const Params __attribute__((address_space(4)))* KP;
    const int ph_lo = p.ph_lo, ph_hi = p.ph_hi;
    const int wave_id = __builtin_amdgcn_readfirstlane((int)(threadIdx.x >> 6));
    unsigned* bar = (unsigned*)(p.ws + OFF_BAR);
    volatile LAS unsigned* xst = (volatile LAS unsigned*)(smem + LDS_USER);
    const unsigned xcc = __builtin_amdgcn_readfirstlane(xb_xcc_id());
    if (ph_hi - ph_lo > 1) {
        if (threadIdx.x == 0) { xst[0] = 0u; xst[1] = 0u; (void)xb_add(&bar[XB_XCNT(xcc)], 1u); }
        __syncthreads();
    }
    for (int ph = ph_lo; ph < ph_hi; ++ph) {
        int tid_, bid_ = blockIdx.x;
        asm volatile("v_mbcnt_lo_u32_b32 %0, -1, 0\n\tv_mbcnt_hi_u32_b32 %0, -1, %0" : "=v"(tid_));
        tid_ += wave_id * 64;
        asm volatile("" : "+s"(bid_));
        KP kp = (KP)__builtin_amdgcn_kernarg_segment_ptr();
        asm volatile("" : "+s"(kp));
        unsigned char* ws = kp->ws;
        u16* HN = (u16*)(ws + OFF_HN);
        const int d = kp->desc[ph], type = d & 255, sub = (d >> 8) & 255, L = d >> 16;
        const float* hsrc = (L == 0) ? kp->x : kp->out;
        EpiArgs e; e.resid = nullptr; e.out = kp->out; e.bias = nullptr; e.hid = nullptr; e.convw = nullptr; e.convb = nullptr; e.ws = ws;
        switch (type) {
        case PT_PREP: { const Params pl = *kp; prep_phase(pl, smem, tid_, bid_); } break;
        case PT_NORM: {
            const float* src = (sub == 1) ? kp->out : hsrc;
            const float* g = (sub == 0) ? kp->norm_attn + L * 1024 : (sub == 1) ? kp->norm_ffn + L * 1024 : kp->kv_norm;
            norm_phase<false>(src, g, HN, nullptr, tid_, bid_);
        } break;
        case PT_AIN: gemm_phase<AM_PLAIN, EPI_AIN>(HN, 1024, (const u16*)(ws + OFF_WT_AIN + L * SZ_WT_AIN), T_, 2688, 1024, 0, e, smem, tid_, bid_); break;
        case PT_CMP1:
            for (int kv = 0; kv < 2; ++kv) {
                e.bias = (const float*)(ws + OFF_CBIAS) + (L * 2 + kv) * 256; e.hid = (u16*)(ws + OFF_HID) + (size_t)kv * 8192 * 256;
                gemm_phase<AM_GATHER, EPI_CMP1>((const u16*)(ws + (kv == 0 ? OFF_KC : OFF_VC)), 0, (const u16*)(ws + OFF_WT_CW1 + (L * 2 + kv) * SZ_WT_CW1), 8184, 256, 2048,
                                                kv == 0 ? 0 : (int)(gridDim.x >> 1), e, smem, tid_, bid_);
            }
            break;
        case PT_CMP2: { const Params pl = *kp; cmp2_phase(pl, L, tid_, bid_); } break;
        case PT_NSA: { const Params pl = *kp; nsa_phase(pl, smem, tid_, bid_, sub); } break;
        case PT_BKV: gemm_phase<AM_PLAIN, EPI_BKV>(HN, 1024, (const u16*)(ws + OFF_WT_KV), T_, 256, 1024, 0, e, smem, tid_, bid_); break;
        case PT_BQ: gemm_phase<AM_PLAIN, EPI_BQ>(HN, 1024, (const u16*)(ws + OFF_WT_BQ + (L - 2) * SZ_WT_SQ), T_, 1024, 1024, 0, e, smem, tid_, bid_); break;
        case PT_SWA: { const Params pl = *kp; swa_phase(pl, L - 2, tid_, bid_); } break;
        case PT_AOUT:
        case PT_FOUT: {
            const bool ff = (type == PT_FOUT);
            e.resid = ff ? kp->out : hsrc;
            const u16* A = (const u16*)(ws + (ff ? OFF_ACT : OFF_O));
            const u16* Bt = (const u16*)(ws + (ff ? OFF_WT_FOUT + L * SZ_WT_FOUT : (L < 2 ? OFF_WT_AOUT + L * SZ_WT_SQ : OFF_WT_BOUT + (L - 2) * SZ_WT_SQ)));
            const int K = ff ? DFF : 1024;
            gemm_big<AM_PLAIN, EPI_RESID>(A, K, Bt, T_, 1024, K, 0, e, smem, tid_, bid_);
        } break;
        case PT_FFNIN:
            e.convw = kp->ffn_conv_w + (size_t)L * 3 * NFF2; e.convb = kp->ffn_conv_b + (size_t)L * NFF2;
            gemm_big<AM_PLAIN, EPI_FFNIN>(HN, 1024, (const u16*)(ws + OFF_WT_FIN + L * SZ_WT_FIN), T_, NFF2, 1024, 0, e, smem, tid_, bid_);
            break;
        case PT_FIXUP: { const Params pl = *kp; fixup_phase(pl, L, tid_, bid_); } break;
        case PT_FINAL: norm_phase<true>(kp->out, kp->final_norm, nullptr, kp->out, tid_, bid_); break;
        default: break;
        }
        if (ph + 1 < ph_hi) { if (ph == ph_lo) grid.sync(); else xcd_barrier(bar, xcc, xst, tid_); }
    }
#endif
}

static int build_program(int* desc) {
    int n = 0;
    auto add = [&](int type, int sub, int L) { desc[n++] = type | (sub << 8) | (L << 16); };
    add(PT_PREP, 0, 0);
    for (int L = 0; L < 4; ++L) {
        if (L < 2) {
            add(PT_NORM, 0, L); add(PT_AIN, 0, L); add(PT_CMP1, 0, L); add(PT_CMP2, 0, L); add(PT_NSA, NSA_PROBE_REP, L);
        } else {
            if (L == 2) { add(PT_NORM, 2, L); add(PT_BKV, 0, L); }
            add(PT_NORM, 0, L); add(PT_BQ, 0, L); add(PT_SWA, 0, L);
        }
        add(PT_AOUT, 0, L); add(PT_NORM, 1, L); add(PT_FFNIN, 0, L); add(PT_FIXUP, 0, L); add(PT_FOUT, 0, L);
    }
    add(PT_FINAL, 0, 0);
    return n;
}

extern "C" void kernel_launch(void* const* d_in, const int* in_sizes, int n_in, void* d_out, int out_size, void* d_ws, size_t ws_size, hipStream_t stream) {
    (void)in_sizes; (void)n_in; (void)out_size;
    static int grid_blocks = 0;
    if (!grid_blocks) {
        (void)hipFuncSetAttribute((const void*)mega, hipFuncAttributeMaxDynamicSharedMemorySize, LDS_BYTES);
        int dev = 0, cus = 0, per_cu = 0;
        (void)hipGetDevice(&dev);
        (void)hipDeviceGetAttribute(&cus, hipDeviceAttributeMultiprocessorCount, dev);
        (void)hipOccupancyMaxActiveBlocksPerMultiprocessor(&per_cu, mega, NTHR, LDS_BYTES);
        if (per_cu > 1) per_cu = 1;
        if (per_cu < 1) per_cu = 1;
        grid_blocks = (cus * per_cu) & ~7;
        if (grid_blocks < 8) grid_blocks = 8;
        if (ws_size < WS_NEED) fprintf(stderr, "workspace too small: %zu < %zu\n", ws_size, (size_t)WS_NEED);
    }
    Params p{};
    const float** pp = (const float**)&p;
    for (int i = 0; i < 18; ++i) pp[i] = (const float*)d_in[i];
    p.out = (float*)d_out;
    p.ws = (unsigned char*)d_ws;
    const int nph = build_program(p.desc);
#if MULTI_LAUNCH
    for (int ph = 0; ph < nph; ++ph) {
        p.ph_lo = ph; p.ph_hi = ph + 1;
        hipLaunchKernelGGL(mega, dim3(grid_blocks), dim3(NTHR), LDS_BYTES, stream, p);
    }
#else
    p.ph_lo = 0; p.ph_hi = nph;
    (void)hipMemsetAsync((unsigned char*)d_ws + OFF_BAR, 0, 16384, stream);
    void* args[] = {&p};
    hipError_t err = hipLaunchCooperativeKernel((const void*)mega, dim3(grid_blocks), dim3(NTHR), args, LDS_BYTES, stream);
    if (err != hipSuccess) fprintf(stderr, "cooperative launch failed: %s (grid %d)\n", hipGetErrorString(err), grid_blocks);
#endif
}
```

```cpp
#include <hip/hip_runtime.h>
#include <hip/hip_cooperative_groups.h>
#include <cstdio>
#include <cmath>
namespace cg = cooperative_groups;

typedef unsigned short u16;
typedef short bf16x8 __attribute__((ext_vector_type(8)));
typedef float f32x4 __attribute__((ext_vector_type(4)));

#ifndef NSA_PROBE_REP
#define NSA_PROBE_REP 0
#endif
#ifndef MULTI_LAUNCH
#define MULTI_LAUNCH 0
#endif

constexpr int S_ = 16384, T_ = 32768, D_ = 1024, DFF = 2816, NFF2 = 5632;
constexpr int NTHR = 512, NW = NTHR / 64;
constexpr int LDS_USER = NW * 16384 + NW * 1024 + NW * 256;
constexpr int LDS_BYTES = LDS_USER + 16;
constexpr float LOG2E = 1.4426950408889634f;
constexpr float NEGBIG = -1e30f;

constexpr size_t al256(size_t x) { return (x + 255) & ~(size_t)255; }
constexpr size_t SZ_WT_AIN = (size_t)2688 * 1024 * 2;
constexpr size_t SZ_WT_CW1 = (size_t)256 * 2048 * 2;
constexpr size_t SZ_WT_CW2 = (size_t)64 * 256 * 2;
constexpr size_t SZ_WT_SQ = (size_t)1024 * 1024 * 2;
constexpr size_t SZ_WT_KV = (size_t)256 * 1024 * 2;
constexpr size_t SZ_WT_FIN = (size_t)5632 * 1024 * 2;
constexpr size_t SZ_WT_FOUT = (size_t)1024 * 2816 * 2;
constexpr size_t OFF_WT_AIN = 0;
constexpr size_t OFF_WT_CW1 = OFF_WT_AIN + 2 * SZ_WT_AIN;
constexpr size_t OFF_WT_CW2 = OFF_WT_CW1 + 4 * SZ_WT_CW1;
constexpr size_t OFF_WT_AOUT = OFF_WT_CW2 + 4 * SZ_WT_CW2;
constexpr size_t OFF_WT_KV = OFF_WT_AOUT + 2 * SZ_WT_SQ;
constexpr size_t OFF_WT_BQ = OFF_WT_KV + SZ_WT_KV;
constexpr size_t OFF_WT_BOUT = OFF_WT_BQ + 2 * SZ_WT_SQ;
constexpr size_t OFF_WT_FIN = OFF_WT_BOUT + 2 * SZ_WT_SQ;
constexpr size_t OFF_WT_FOUT = OFF_WT_FIN + 4 * SZ_WT_FIN;
constexpr size_t OFF_COS = OFF_WT_FOUT + 4 * SZ_WT_FOUT;
constexpr size_t OFF_SIN = OFF_COS + (size_t)S_ * 32 * 4;
constexpr size_t OFF_CBIAS = OFF_SIN + (size_t)S_ * 32 * 4;
constexpr size_t OFF_HN = OFF_CBIAS + 4096;
constexpr size_t OFF_KSH = OFF_HN + (size_t)T_ * 1024 * 2;
constexpr size_t OFF_VSHT = OFF_KSH + (size_t)T_ * 128 * 2;
constexpr size_t OFF_HEAD = OFF_VSHT + (size_t)T_ * 128 * 2;
constexpr size_t OFF_HALO = OFF_HEAD + (size_t)256 * 2 * NFF2 * 4;
constexpr size_t OFF_R1 = OFF_HALO + (size_t)256 * 2 * NFF2 * 4;
constexpr size_t OFF_Q = OFF_R1;
constexpr size_t OFF_KC = OFF_Q + (size_t)T_ * 1024 * 2;
constexpr size_t OFF_VC = OFF_KC + (size_t)T_ * 256 * 2;
constexpr size_t OFF_KS = OFF_VC + (size_t)T_ * 256 * 2;
constexpr size_t OFF_VST = OFF_KS + (size_t)T_ * 256 * 2;
constexpr size_t OFF_KW = OFF_VST + (size_t)T_ * 256 * 2;
constexpr size_t OFF_VWT = OFF_KW + (size_t)T_ * 256 * 2;
constexpr size_t OFF_GATES = OFF_VWT + (size_t)T_ * 256 * 2;
constexpr size_t OFF_HID = OFF_GATES + (size_t)T_ * 48 * 4;
constexpr size_t OFF_KCC = OFF_HID + (size_t)2 * 8192 * 256 * 2;
constexpr size_t OFF_VCCT = OFF_KCC + (size_t)8 * 1024 * 64 * 2;
constexpr size_t OFF_O = OFF_VCCT + (size_t)8 * 1024 * 64 * 2;
constexpr size_t OFF_END = OFF_O + (size_t)T_ * 1024 * 2;
constexpr size_t OFF_BAR = OFF_END;
constexpr size_t WS_NEED = OFF_BAR + 16384;
constexpr size_t OFF_ACT = OFF_R1;
static_assert(OFF_ACT + (size_t)T_ * DFF * 2 <= OFF_END, "act alias");

struct Params {
    const float *x, *norm_attn, *norm_ffn, *a_w_in, *a_cmp_pos, *a_cmp_w1, *a_cmp_w2, *a_w_out, *kv_norm, *b_w_kv, *b_w_q, *b_sinks, *b_w_out,
        *ffn_w_in, *ffn_conv_w, *ffn_conv_b, *ffn_w_out, *final_norm;
    float* out;
    unsigned char* ws;
    int desc[48];
    int ph_lo, ph_hi;
};

__device__ __forceinline__ u16 f2bf(float f) {
    unsigned u = __float_as_uint(f);
    u += 0x7fffu + ((u >> 16) & 1u);
    return (u16)(u >> 16);
}
typedef __bf16 bf16x2_t __attribute__((ext_vector_type(2)));
typedef float f32x2_t __attribute__((ext_vector_type(2)));
__device__ __forceinline__ unsigned pack2(float lo, float hi) { f32x2_t v = {lo, hi}; bf16x2_t r = __builtin_convertvector(v, bf16x2_t); return __builtin_bit_cast(unsigned, r); }
typedef unsigned u32x4 __attribute__((ext_vector_type(4)));
__device__ __forceinline__ bf16x8 pack8(const float (&v)[8]) {
    u32x4 r;
    unsigned r0, r1, r2, r3;
    asm("v_cvt_pk_bf16_f32 %0, %4, %5\n\tv_cvt_pk_bf16_f32 %1, %6, %7\n\tv_cvt_pk_bf16_f32 %2, %8, %9\n\tv_cvt_pk_bf16_f32 %3, %10, %11\n\ts_nop 3"
        : "=&v"(r0), "=&v"(r1), "=&v"(r2), "=&v"(r3)
        : "v"(v[0]), "v"(v[1]), "v"(v[2]), "v"(v[3]), "v"(v[4]), "v"(v[5]), "v"(v[6]), "v"(v[7]));
    r[0] = r0; r[1] = r1; r[2] = r2; r[3] = r3;
    return __builtin_bit_cast(bf16x8, r);
}
__device__ __forceinline__ uint2 pack4(f32x4 v) { uint2 r; r.x = pack2(v[0], v[1]); r.y = pack2(v[2], v[3]); return r; }
__device__ __forceinline__ f32x4 unpack4(uint2 v) { return (f32x4){__uint_as_float(v.x << 16), __uint_as_float(v.x & 0xffff0000u), __uint_as_float(v.y << 16), __uint_as_float(v.y & 0xffff0000u)}; }
__device__ __forceinline__ unsigned pk4_fp8(float a, float b, float c, float d) { int r = __builtin_amdgcn_cvt_pk_fp8_f32(a, b, 0, false); r = __builtin_amdgcn_cvt_pk_fp8_f32(c, d, r, true); return (unsigned)r; }
__device__ __forceinline__ long pk8_fp8(const float (&v)[8]) { const unsigned lo = pk4_fp8(v[0], v[1], v[2], v[3]), hi = pk4_fp8(v[4], v[5], v[6], v[7]); return (long)(((unsigned long long)hi << 32) | lo); }
__device__ __forceinline__ f32x4 mfma8(long a, long b, f32x4 c) { return __builtin_amdgcn_mfma_f32_16x16x32_fp8_fp8(a, b, c, 0, 0, 0); }
__device__ __forceinline__ f32x4 mfma16(bf16x8 a, bf16x8 b, f32x4 c) { return __builtin_amdgcn_mfma_f32_16x16x32_bf16(a, b, c, 0, 0, 0); }
__device__ __forceinline__ float fexp2(float x) { return __builtin_amdgcn_exp2f(x); }
__device__ __forceinline__ void wsync() { __builtin_amdgcn_fence(__ATOMIC_ACQ_REL, "wavefront"); asm volatile("s_waitcnt lgkmcnt(0)" ::: "memory"); __builtin_amdgcn_wave_barrier(); }
typedef unsigned u32x2 __attribute__((ext_vector_type(2)));
__device__ __forceinline__ float xmax16(float x) { const unsigned u = __float_as_uint(x); const u32x2 r = __builtin_amdgcn_permlane16_swap(u, u, false, false); return fmaxf(__uint_as_float(r[0]), __uint_as_float(r[1])); }
__device__ __forceinline__ float xmax32(float x) { const unsigned u = __float_as_uint(x); const u32x2 r = __builtin_amdgcn_permlane32_swap(u, u, false, false); return fmaxf(__uint_as_float(r[0]), __uint_as_float(r[1])); }
template <int CTRL> __device__ __forceinline__ float dppf(float x) { return __int_as_float(__builtin_amdgcn_update_dpp(0, __float_as_int(x), CTRL, 0xf, 0xf, true)); }
__device__ __forceinline__ float wave_max(float x) {
    x = fmaxf(x, dppf<0xB1>(x)); x = fmaxf(x, dppf<0x4E>(x)); x = fmaxf(x, dppf<0x141>(x)); x = fmaxf(x, dppf<0x140>(x));
    return xmax32(xmax16(x));
}
__device__ __forceinline__ int kperm(int m) { return ((m >> 2) << 3) + (m & 3); }
__device__ __forceinline__ float sigmoidf_(float x) { return 1.f / (1.f + __expf(-x)); }
__device__ __forceinline__ float gelu_tanh(float x) {
    float u = 0.7978845608028654f * (x + 0.044715f * x * x * x);
    float e = __expf(2.f * u);
    float th = 1.f - 2.f / (e + 1.f);
    return 0.5f * x * (1.f + th);
}

__device__ __forceinline__ void cvt_transpose(const float* __restrict__ src, u16* __restrict__ dst, int K, int N, int Npad, int mode, unsigned char* smem, int tid_, int bid_) {
    const int half = tid_ >> 8, tid = tid_ & 255;
    float* ts = (float*)smem + half * (64 * 65);
    const int ntk = K >> 6, ntn = Npad >> 6, ntiles = ntk * ntn;
    for (int tile2 = bid_ * 2; tile2 < ntiles; tile2 += gridDim.x * 2) {
        const int tile = tile2 + half;
        const bool live = tile < ntiles;
        const int tk = live ? tile % ntk : 0, tn = live ? tile / ntk : 0;
        const int k0 = tk << 6, n0 = tn << 6;
        __syncthreads();
        if (live) {
#pragma unroll
            for (int i = 0; i < 4; ++i) {
                const int k = (tid >> 4) + 16 * i, n = (tid & 15) * 4;
                float4 v = make_float4(0.f, 0.f, 0.f, 0.f);
                if (n0 + n < N) v = *(const float4*)(src + (size_t)(k0 + k) * N + n0 + n);
                ts[k * 65 + n + 0] = v.x; ts[k * 65 + n + 1] = v.y; ts[k * 65 + n + 2] = v.z; ts[k * 65 + n + 3] = v.w;
            }
        }
        __syncthreads();
        if (!live) continue;
        const int n = tid >> 2, kq = (tid & 3) * 16;
        unsigned pk[8];
#pragma unroll
        for (int j = 0; j < 8; ++j) pk[j] = pack2(ts[(kq + 2 * j) * 65 + n], ts[(kq + 2 * j + 1) * 65 + n]);
        int drow;
        if (mode == 0) drow = n0 + n;
        else { const int nn = n0 + n; drow = (nn < DFF) ? ((nn >> 6) * 128 + (nn & 63)) : ((((nn - DFF) >> 6) * 128) + 64 + ((nn - DFF) & 63)); }
        uint4* dp = (uint4*)(dst + (size_t)drow * K + k0 + kq);
        dp[0] = make_uint4(pk[0], pk[1], pk[2], pk[3]);
        dp[1] = make_uint4(pk[4], pk[5], pk[6], pk[7]);
    }
}

__device__ __forceinline__ void prep_phase(const Params& p, unsigned char* smem, int tid_, int bid_) {
    unsigned char* ws = p.ws;
    for (int L = 0; L < 2; ++L) {
        cvt_transpose(p.a_w_in + (size_t)L * 1024 * 2608, (u16*)(ws + OFF_WT_AIN + L * SZ_WT_AIN), 1024, 2608, 2688, 0, smem, tid_, bid_);
        for (int kv = 0; kv < 2; ++kv) {
            cvt_transpose(p.a_cmp_w1 + (size_t)(L * 2 + kv) * 2048 * 256, (u16*)(ws + OFF_WT_CW1 + (L * 2 + kv) * SZ_WT_CW1), 2048, 256, 256, 0, smem, tid_, bid_);
            cvt_transpose(p.a_cmp_w2 + (size_t)(L * 2 + kv) * 256 * 64, (u16*)(ws + OFF_WT_CW2 + (L * 2 + kv) * SZ_WT_CW2), 256, 64, 64, 0, smem, tid_, bid_);
        }
        cvt_transpose(p.a_w_out + (size_t)L * 1024 * 1024, (u16*)(ws + OFF_WT_AOUT + L * SZ_WT_SQ), 1024, 1024, 1024, 0, smem, tid_, bid_);
        cvt_transpose(p.b_w_q + (size_t)L * 1024 * 1024, (u16*)(ws + OFF_WT_BQ + L * SZ_WT_SQ), 1024, 1024, 1024, 0, smem, tid_, bid_);
        cvt_transpose(p.b_w_out + (size_t)L * 1024 * 1024, (u16*)(ws + OFF_WT_BOUT + L * SZ_WT_SQ), 1024, 1024, 1024, 0, smem, tid_, bid_);
    }
    cvt_transpose(p.b_w_kv, (u16*)(ws + OFF_WT_KV), 1024, 256, 256, 0, smem, tid_, bid_);
    for (int L = 0; L < 4; ++L) {
        cvt_transpose(p.ffn_w_in + (size_t)L * 1024 * NFF2, (u16*)(ws + OFF_WT_FIN + L * SZ_WT_FIN), 1024, NFF2, NFF2, 1, smem, tid_, bid_);
        cvt_transpose(p.ffn_w_out + (size_t)L * DFF * 1024, (u16*)(ws + OFF_WT_FOUT + L * SZ_WT_FOUT), DFF, 1024, 1024, 0, smem, tid_, bid_);
    }
    {
        float* cosT = (float*)(ws + OFF_COS); float* sinT = (float*)(ws + OFF_SIN);
        const int gt = bid_ * NTHR + tid_, nt = gridDim.x * NTHR;
        for (int idx = gt; idx < S_ * 32; idx += nt) {
            const int pos = idx >> 5, i = idx & 31;
            const float ang = (float)pos * exp2f(-(float)i * (13.287712379549449f / 32.0f));
            double rev = (double)ang * 0.15915494309189535;
            rev -= rint(rev);
            const float fr = (float)rev;
            cosT[idx] = __builtin_amdgcn_cosf(fr);
            sinT[idx] = __builtin_amdgcn_sinf(fr);
        }
    }
    {
        float* cb = (float*)(ws + OFF_CBIAS);
        const int lane = tid_ & 63, w = tid_ >> 6;
        for (int task = bid_ * NW + w; task < 256; task += gridDim.x * NW) {
            const int lk = task >> 6, j4 = (task & 63) * 4;
            const float* pos = p.a_cmp_pos + (size_t)lk * 2048;
            const float* w1 = p.a_cmp_w1 + (size_t)lk * 2048 * 256;
            float4 a = make_float4(0.f, 0.f, 0.f, 0.f);
            for (int i = 0; i < 32; ++i) {
                const int k = lane + 64 * i;
                const float pv = pos[k];
                const float4 wv = *(const float4*)(w1 + (size_t)k * 256 + j4);
                a.x += pv * wv.x; a.y += pv * wv.y; a.z += pv * wv.z; a.w += pv * wv.w;
            }
#pragma unroll
            for (int off = 32; off >= 1; off >>= 1) {
                a.x += __shfl_xor(a.x, off); a.y += __shfl_xor(a.y, off); a.z += __shfl_xor(a.z, off); a.w += __shfl_xor(a.w, off);
            }
            if (lane == 0) *(float4*)(cb + lk * 256 + j4) = a;
        }
    }
}

template <bool OUT_F32>
__device__ __forceinline__ void norm_phase(const float* __restrict__ src, const float* __restrict__ g, u16* __restrict__ dst, float* __restrict__ dstf, int tid_, int bid_) {
    const int lane = tid_ & 63, w = tid_ >> 6;
    float4 gv[4];
#pragma unroll
    for (int i = 0; i < 4; ++i) gv[i] = *(const float4*)(g + lane * 4 + 256 * i);
    for (int row = bid_ * NW + w; row < T_; row += gridDim.x * NW) {
        const float* sp = src + (size_t)row * 1024;
        float4 v[4];
        float ss = 0.f;
#pragma unroll
        for (int i = 0; i < 4; ++i) { v[i] = *(const float4*)(sp + lane * 4 + 256 * i); ss += v[i].x * v[i].x + v[i].y * v[i].y + v[i].z * v[i].z + v[i].w * v[i].w; }
#pragma unroll
        for (int off = 32; off >= 1; off >>= 1) ss += __shfl_xor(ss, off);
        const float r = rsqrtf(ss * (1.f / 1024.f) + 1e-6f);
#pragma unroll
        for (int i = 0; i < 4; ++i) {
            f32x4 o = {v[i].x * r * gv[i].x, v[i].y * r * gv[i].y, v[i].z * r * gv[i].z, v[i].w * r * gv[i].w};
            if (OUT_F32) *(float4*)(dstf + (size_t)row * 1024 + lane * 4 + 256 * i) = make_float4(o[0], o[1], o[2], o[3]);
            else *(uint2*)(dst + (size_t)row * 1024 + lane * 4 + 256 * i) = pack4(o);
        }
    }
}

enum { AM_PLAIN = 0, AM_GATHER = 1 };
enum { EPI_AIN = 0, EPI_CMP1 = 1, EPI_RESID = 2, EPI_FFNIN = 3, EPI_BQ = 4, EPI_BKV = 5 };

struct EpiArgs {
    const float* resid; float* out;
    const float* bias; u16* hid;
    const float *convw, *convb;
    unsigned char* ws;
};

template <int NM>
__device__ __forceinline__ void rope_store(const f32x4 (&acc)[4][NM], int mi, u16* dstrow  , const float* cosT, const float* sinT, int pos, int q4) {
#pragma unroll
    for (int ni = 0; ni < 2; ++ni) {
        const int d = ni * 16 + q4 * 4;
        const float4 c = *(const float4*)(cosT + pos * 32 + d), s = *(const float4*)(sinT + pos * 32 + d);
        const f32x4 x1 = acc[ni][mi], x2 = acc[ni + 2][mi];
        f32x4 o1 = {x1[0] * c.x - x2[0] * s.x, x1[1] * c.y - x2[1] * s.y, x1[2] * c.z - x2[2] * s.z, x1[3] * c.w - x2[3] * s.w};
        f32x4 o2 = {x2[0] * c.x + x1[0] * s.x, x2[1] * c.y + x1[1] * s.y, x2[2] * c.z + x1[2] * s.z, x2[3] * c.w + x1[3] * s.w};
        *(uint2*)(dstrow + d) = pack4(o1);
        *(uint2*)(dstrow + d + 32) = pack4(o2);
    }
}

template <int AMODE, int EPI>
__device__ __forceinline__ void gemm_phase(const u16* __restrict__ A, int lda, const u16* __restrict__ Bt, int M, int Npad, int K, int vboff, const EpiArgs& e, unsigned char* smem, int tid_, int bid_) {
    const int tid = tid_, lane = tid & 63, w = tid >> 6, wm = w & 3, wn = w >> 2;
    const int c16 = lane & 15, q4 = lane >> 4;
    const int ntm = (M + 255) >> 8, ntn = Npad >> 7, nk = K >> 6;
    const int kstride = (AMODE == AM_GATHER) ? 256 : 64;
    const int ldc = tid & 7, ldr = tid >> 3;
    const unsigned wofs = ldr * 128 + ((ldc ^ ((ldr >> 1) & 7)) << 4);
    const int swz = (c16 >> 1) & 7;
    const float* cosT = (const float*)(e.ws + OFF_COS);
    const float* sinT = (const float*)(e.ws + OFF_SIN);
    int vb = bid_ + vboff; if (vb >= (int)gridDim.x) vb -= gridDim.x;
    const int xcd = vb & 7, loc = vb >> 3, nloc = gridDim.x >> 3;
    const int mpx = ntm >> 3, nfull = (ntn >> 3), bwl = ntn - (nfull << 3);
    const int tfull = nfull * mpx * 8, ttotal = mpx * ntn;
    for (int tl = loc; tl < ttotal; tl += nloc) {
        int mloc, nt;
        if (tl < tfull) { const int band = tl / (mpx * 8), r = tl - band * (mpx * 8); mloc = r >> 3; nt = band * 8 + (r & 7); }
        else { const int r = tl - tfull; mloc = r / bwl; nt = (nfull << 3) + (r - mloc * bwl); }
        const int mt = xcd * mpx + mloc;
        const int m0 = mt << 8, n0 = nt << 7;
        unsigned aoff[4];
#pragma unroll
        for (int i = 0; i < 4; ++i) {
            int m = m0 + ldr + 64 * i; if (m > M - 1) m = M - 1;
            if (AMODE == AM_GATHER) { const int g = m & 3, bn = m >> 2, b = bn / 1023, n = bn - b * 1023; aoff[i] = (unsigned)((b * S_ + n * 16) * 256 + g * 64 + ldc * 8); }
            else aoff[i] = (unsigned)m * (unsigned)lda + ldc * 8;
        }
        const u16* bp = Bt + (size_t)(n0 + ldr) * K + ldc * 8;
        u32x4 ra0[4], rb0[2], ra1[4], rb1[2];
        f32x4 acc[4][4];
#pragma unroll
        for (int a = 0; a < 4; ++a)
#pragma unroll
            for (int b = 0; b < 4; ++b) acc[a][b] = (f32x4){0.f, 0.f, 0.f, 0.f};
        auto g_load = [&](u32x4 (&RA)[4], u32x4 (&RB)[2], int KT) __attribute__((always_inline)) {
#pragma unroll
            for (int i = 0; i < 4; ++i) RA[i] = *(const u32x4*)(A + aoff[i] + KT * kstride);
#pragma unroll
            for (int i = 0; i < 2; ++i) RB[i] = *(const u32x4*)(bp + (size_t)i * 64 * K + KT * 64);
        };
        auto g_store = [&](const u32x4 (&RA)[4], const u32x4 (&RB)[2], int ST) __attribute__((always_inline)) {
            unsigned char* d_ = smem + ST * 49152;
#pragma unroll
            for (int i = 0; i < 4; ++i) *(u32x4*)(d_ + wofs + i * 8192) = RA[i];
#pragma unroll
            for (int i = 0; i < 2; ++i) *(u32x4*)(d_ + 32768 + wofs + i * 8192) = RB[i];
        };
        auto g_compute = [&](int ST) __attribute__((always_inline)) {
            const unsigned char* sA = smem + ST * 49152;
            const unsigned char* sB = sA + 32768;
#pragma unroll
            for (int ks = 0; ks < 2; ++ks) {
                bf16x8 wf[4], af[4];
                const int ch = ((ks * 4 + q4) ^ swz) << 4;
#pragma unroll
                for (int ni = 0; ni < 4; ++ni) wf[ni] = *(const bf16x8*)(sB + (wn * 64 + ni * 16 + c16) * 128 + ch);
#pragma unroll
                for (int mi = 0; mi < 4; ++mi) af[mi] = *(const bf16x8*)(sA + (wm * 64 + mi * 16 + c16) * 128 + ch);
#pragma unroll
                for (int ni = 0; ni < 4; ++ni)
#pragma unroll
                    for (int mi = 0; mi < 4; ++mi) acc[ni][mi] = mfma16(wf[ni], af[mi], acc[ni][mi]);
            }
        };
        g_load(ra0, rb0, 0);
        g_load(ra1, rb1, 1);
        g_store(ra0, rb0, 0);
        __syncthreads();
        for (int kt = 0; kt < nk; kt += 2) {
            if (kt + 2 < nk) g_load(ra0, rb0, kt + 2);
            g_compute(0);
            g_store(ra1, rb1, 1);
            __syncthreads();
            if (kt + 3 < nk) g_load(ra1, rb1, kt + 3);
            g_compute(1);
            if (kt + 2 < nk) g_store(ra0, rb0, 0);
            __syncthreads();
        }
        const int nb = n0 + wn * 64;
        if (EPI == EPI_RESID) {
#pragma unroll
            for (int mi = 0; mi < 4; ++mi) {
                const size_t tok = m0 + wm * 64 + mi * 16 + c16;
#pragma unroll
                for (int ni = 0; ni < 4; ++ni) {
                    const int n = nb + ni * 16 + q4 * 4;
                    float4 r = *(const float4*)(e.resid + tok * 1024 + n);
                    r.x += acc[ni][mi][0]; r.y += acc[ni][mi][1]; r.z += acc[ni][mi][2]; r.w += acc[ni][mi][3];
                    *(float4*)(e.out + tok * 1024 + n) = r;
                }
            }
        } else if (EPI == EPI_CMP1) {
#pragma unroll
            for (int mi = 0; mi < 4; ++mi) {
                const int m = m0 + wm * 64 + mi * 16 + c16;
                if (m < M) {
#pragma unroll
                    for (int ni = 0; ni < 4; ++ni) {
                        const int n = nb + ni * 16 + q4 * 4;
                        const float4 bv = *(const float4*)(e.bias + n);
                        f32x4 o = {gelu_tanh(acc[ni][mi][0] + bv.x), gelu_tanh(acc[ni][mi][1] + bv.y), gelu_tanh(acc[ni][mi][2] + bv.z), gelu_tanh(acc[ni][mi][3] + bv.w)};
                        *(uint2*)(e.hid + (size_t)m * 256 + n) = pack4(o);
                    }
                }
            }
        } else if (EPI == EPI_BQ) {
            u16* Q = (u16*)(e.ws + OFF_Q);
#pragma unroll
            for (int mi = 0; mi < 4; ++mi) {
                const int tok = m0 + wm * 64 + mi * 16 + c16;
                rope_store(acc, mi, Q + (size_t)tok * 1024 + nb, cosT, sinT, tok & (S_ - 1), q4);
            }
        } else if (EPI == EPI_BKV) {
            u16* KSH = (u16*)(e.ws + OFF_KSH); u16* VSHT = (u16*)(e.ws + OFF_VSHT);
#pragma unroll
            for (int mi = 0; mi < 4; ++mi) {
                const int tok = m0 + wm * 64 + mi * 16 + c16, b = tok >> 14, s = tok & (S_ - 1);
                if (nb < 128) {
                    const int g = nb >> 6;
                    rope_store(acc, mi, KSH + ((size_t)(b * 2 + g) * S_ + s) * 64, cosT, sinT, s, q4);
                } else {
                    const int g = (nb - 128) >> 6;
#pragma unroll
                    for (int ni = 0; ni < 4; ++ni)
#pragma unroll
                        for (int i = 0; i < 4; ++i) VSHT[((size_t)(b * 2 + g) * 64 + ni * 16 + q4 * 4 + i) * S_ + s] = f2bf(acc[ni][mi][i]);
                }
            }
        } else if (EPI == EPI_AIN) {
            unsigned char* ws = e.ws;
#pragma unroll
            for (int mi = 0; mi < 4; ++mi) {
                const int tok = m0 + wm * 64 + mi * 16 + c16, b = tok >> 14, s = tok & (S_ - 1);
                if (nb < 1024) {
                    rope_store(acc, mi, (u16*)(ws + OFF_Q) + (size_t)tok * 1024 + nb, cosT, sinT, s, q4);
                } else if (nb < 1536) {
                    u16* dst = (nb < 1280) ? ((u16*)(ws + OFF_KC) + (size_t)tok * 256 + (nb - 1024)) : ((u16*)(ws + OFF_VC) + (size_t)tok * 256 + (nb - 1280));
#pragma unroll
                    for (int ni = 0; ni < 4; ++ni) *(uint2*)(dst + ni * 16 + q4 * 4) = pack4(acc[ni][mi]);
                } else if (nb < 2560) {
                    const int r = (nb - 1536) >> 8;
                    const int g = ((nb - 1536) & 255) >> 6;
                    if (r == 0) {
                        unsigned char* kd = (unsigned char*)(ws + OFF_KS) + (size_t)(b * 4 + g) * S_ * 128 + (size_t)s * 64;
#pragma unroll
                        for (int ni = 0; ni < 2; ++ni) {
                            const int d = ni * 16 + q4 * 4;
                            const float4 c = *(const float4*)(cosT + s * 32 + d), sn = *(const float4*)(sinT + s * 32 + d);
                            const f32x4 x1 = acc[ni][mi], x2 = acc[ni + 2][mi];
                            *(unsigned*)(kd + d) = pk4_fp8(x1[0] * c.x - x2[0] * sn.x, x1[1] * c.y - x2[1] * sn.y, x1[2] * c.z - x2[2] * sn.z, x1[3] * c.w - x2[3] * sn.w);
                            *(unsigned*)(kd + d + 32) = pk4_fp8(x2[0] * c.x + x1[0] * sn.x, x2[1] * c.y + x1[1] * sn.y, x2[2] * c.z + x1[2] * sn.z, x2[3] * c.w + x1[3] * sn.w);
                        }
                    } else if (r == 2) {
                        u16* base = (u16*)(ws + OFF_KW);
                        rope_store(acc, mi, base + ((size_t)(b * 4 + g) * S_ + s) * 64, cosT, sinT, s, q4);
                    } else {
                        if (r == 1) {
                            unsigned char* base = (unsigned char*)(ws + OFF_VST) + (size_t)(b * 4 + g) * 128 * S_ + (size_t)(s >> 6) * 4096 + (s & 63);
#pragma unroll
                            for (int ni = 0; ni < 4; ++ni) {
                                const unsigned pk = pk4_fp8(acc[ni][mi][0], acc[ni][mi][1], acc[ni][mi][2], acc[ni][mi][3]);
#pragma unroll
                                for (int i = 0; i < 4; ++i) base[(ni * 16 + q4 * 4 + i) * 64] = (unsigned char)(pk >> (8 * i));
                            }
                        } else {
                            u16* base = (u16*)(ws + OFF_VWT);
#pragma unroll
                            for (int ni = 0; ni < 4; ++ni)
#pragma unroll
                                for (int i = 0; i < 4; ++i) base[((size_t)(b * 4 + g) * 64 + ni * 16 + q4 * 4 + i) * S_ + s] = f2bf(acc[ni][mi][i]);
                        }
                    }
                } else if (nb == 2560) {
                    float* G = (float*)(ws + OFF_GATES) + (size_t)tok * 48;
#pragma unroll
                    for (int ni = 0; ni < 3; ++ni) {
                        const int n = ni * 16 + q4 * 4;
                        *(float4*)(G + n) = make_float4(sigmoidf_(acc[ni][mi][0]), sigmoidf_(acc[ni][mi][1]), sigmoidf_(acc[ni][mi][2]), sigmoidf_(acc[ni][mi][3]));
                    }
                }
            }
        } else if (EPI == EPI_FFNIN) {
            float* U = (float*)smem;
#pragma unroll
            for (int mi = 0; mi < 4; ++mi) {
                const int row = wm * 64 + mi * 16 + c16;
#pragma unroll
                for (int ni = 0; ni < 4; ++ni) {
                    const int chunk = wn * 16 + ni * 4 + q4;
                    *(f32x4*)(U + row * 128 + ((chunk ^ (row & 31)) << 2)) = acc[ni][mi];
                }
            }
            __syncthreads();
            {
                const int ca = tid & 15, seg = tid >> 4;
                const int ncol = nt * 64 + ca * 4;
                const float4 w0a = *(const float4*)(e.convw + ncol), w1a = *(const float4*)(e.convw + NFF2 + ncol), w2a = *(const float4*)(e.convw + 2 * NFF2 + ncol);
                const float4 w0g = *(const float4*)(e.convw + DFF + ncol), w1g = *(const float4*)(e.convw + NFF2 + DFF + ncol), w2g = *(const float4*)(e.convw + 2 * NFF2 + DFF + ncol);
                const float4 ba = *(const float4*)(e.convb + ncol), bg = *(const float4*)(e.convb + DFF + ncol);
                float* head = (float*)(e.ws + OFF_HEAD); float* halo = (float*)(e.ws + OFF_HALO);
                u16* act = (u16*)(e.ws + OFF_ACT);
                const int r0 = seg * 8;
                float4 a2 = make_float4(0.f, 0.f, 0.f, 0.f), a1 = a2, g2 = a2, g1 = a2;
                if (seg > 0) {
                    const int rA = r0 - 2, rB = r0 - 1;
                    a2 = *(const float4*)(U + rA * 128 + ((ca ^ (rA & 31)) << 2)); g2 = *(const float4*)(U + rA * 128 + (((16 + ca) ^ (rA & 31)) << 2));
                    a1 = *(const float4*)(U + rB * 128 + ((ca ^ (rB & 31)) << 2)); g1 = *(const float4*)(U + rB * 128 + (((16 + ca) ^ (rB & 31)) << 2));
                }
#pragma unroll
                for (int r = 0; r < 8; ++r) {
                    const int row = r0 + r;
                    const float4 ua = *(const float4*)(U + row * 128 + ((ca ^ (row & 31)) << 2));
                    const float4 ug = *(const float4*)(U + row * 128 + (((16 + ca) ^ (row & 31)) << 2));
                    if (seg > 0 || r >= 2) {
                        float ca_[4], cg_[4];
                        ca_[0] = ba.x + w0a.x * a2.x + w1a.x * a1.x + w2a.x * ua.x; ca_[1] = ba.y + w0a.y * a2.y + w1a.y * a1.y + w2a.y * ua.y;
                        ca_[2] = ba.z + w0a.z * a2.z + w1a.z * a1.z + w2a.z * ua.z; ca_[3] = ba.w + w0a.w * a2.w + w1a.w * a1.w + w2a.w * ua.w;
                        cg_[0] = bg.x + w0g.x * g2.x + w1g.x * g1.x + w2g.x * ug.x; cg_[1] = bg.y + w0g.y * g2.y + w1g.y * g1.y + w2g.y * ug.y;
                        cg_[2] = bg.z + w0g.z * g2.z + w1g.z * g1.z + w2g.z * ug.z; cg_[3] = bg.w + w0g.w * g2.w + w1g.w * g1.w + w2g.w * ug.w;
                        f32x4 o = {ca_[0] * sigmoidf_(ca_[0]) * cg_[0], ca_[1] * sigmoidf_(ca_[1]) * cg_[1], ca_[2] * sigmoidf_(ca_[2]) * cg_[2], ca_[3] * sigmoidf_(ca_[3]) * cg_[3]};
                        *(uint2*)(act + (size_t)(m0 + row) * DFF + ncol) = pack4(o);
                    }
                    if (seg == 0 && r < 2) { *(float4*)(head + (size_t)(mt * 2 + r) * NFF2 + ncol) = ua; *(float4*)(head + (size_t)(mt * 2 + r) * NFF2 + DFF + ncol) = ug; }
                    if (seg == 31 && r >= 6) { *(float4*)(halo + (size_t)(mt * 2 + r - 6) * NFF2 + ncol) = ua; *(float4*)(halo + (size_t)(mt * 2 + r - 6) * NFF2 + DFF + ncol) = ug; }
                    a2 = a1; a1 = ua; g2 = g1; g1 = ug;
                }
            }
            __syncthreads();
        }
    }
}

template <int AMODE, int EPI>
__device__ __forceinline__ void gemm_big(const u16* __restrict__ A, int lda, const u16* __restrict__ Bt, int M, int Npad, int K, int vboff, const EpiArgs& e, unsigned char* smem, int tid_, int bid_) {
    const int tid = tid_, lane = tid & 63, w = tid >> 6, wm = w & 1, wn = w >> 1;
    const int c16 = lane & 15, q4 = lane >> 4;
    constexpr int MI = 8;
    const int ntm = (M + 255) >> 8, ntn = Npad >> 8, nk = K >> 5;
    const int kstride = (AMODE == AM_GATHER) ? 128 : 32;
    const float* cosT = (const float*)(e.ws + OFF_COS);
    const float* sinT = (const float*)(e.ws + OFF_SIN);
    int vb = bid_ + vboff; if (vb >= (int)gridDim.x) vb -= gridDim.x;
    const int xcd = vb & 7, loc = vb >> 3, nloc = gridDim.x >> 3;
    const int mpx = ntm >> 3, nfull = (ntn >> 3), bwl = ntn - (nfull << 3);
    const int tfull = nfull * mpx * 8, ttotal = mpx * ntn;
    for (int tl = loc; tl < ttotal; tl += nloc) {
        int mloc, nt;
        if (tl < tfull) { const int band = tl / (mpx * 8), r = tl - band * (mpx * 8); mloc = r >> 3; nt = band * 8 + (r & 7); }
        else { const int r = tl - tfull; mloc = r / bwl; nt = (nfull << 3) + (r - mloc * bwl); }
        const int mt = xcd * mpx + mloc;
        const int m0 = mt << 8, n0 = nt << 8;
        const int prow = ((w & 3) << 6) + (lane >> 2);
        const int pch = lane & 3;
        unsigned goff[4];
#pragma unroll
        for (int i = 0; i < 4; ++i) {
            const int row = prow + 16 * i;
            const int lc = pch ^ ((-(row >> 2)) & 3);
            if (w < 4) {
                int m = m0 + row; if (m > M - 1) m = M - 1;
                if (AMODE == AM_GATHER) { const int gq = m & 3, bn = m >> 2, bb = bn / 1023, n = bn - bb * 1023; goff[i] = (unsigned)((bb * S_ + n * 16) * 256 + gq * 64 + lc * 8); }
                else goff[i] = (unsigned)m * (unsigned)lda + (unsigned)(lc * 8);
            } else goff[i] = (unsigned)(n0 + row) * (unsigned)K + (unsigned)(lc * 8);
        }
        const u16* gbase = (w < 4) ? A : Bt;
        const int kst = (w < 4) ? ((AMODE == AM_GATHER) ? 0 : 32) : 32;
        typedef __attribute__((address_space(3))) unsigned* lds_u32p;
        const unsigned lbase = ((w < 4) ? 0u : 16384u) + (unsigned)(((w & 3) << 6) * 64) + (unsigned)lane * 16u;
        auto kofs = [&](int kt) __attribute__((always_inline)) -> unsigned {
            if (AMODE == AM_GATHER && w < 4) return (unsigned)((kt >> 1) * 256 + (kt & 1) * 32);
            return (unsigned)(kt * kst);
        };
        auto issue = [&](int kt) __attribute__((always_inline)) {
            const unsigned ko = kofs(kt);
            unsigned char* sb = smem + (kt & 3) * 32768 + lbase;
#pragma unroll
            for (int i = 0; i < 4; ++i)
                __builtin_amdgcn_global_load_lds((const unsigned*)(gbase + (goff[i] + ko)), (lds_u32p)(sb + i * 1024), 16, 0, 0);
        };
        f32x4 acc[4][MI];
#pragma unroll
        for (int a2 = 0; a2 < 4; ++a2)
#pragma unroll
            for (int b2 = 0; b2 < MI; ++b2) acc[a2][b2] = (f32x4){0.f, 0.f, 0.f, 0.f};
        const int swz = (-(c16 >> 2)) & 3;
        const int rch = (q4 ^ swz) << 4;
        issue(0); issue(1); issue(2);
        for (int kt = 0; kt < nk; ++kt) {
            if (kt + 2 < nk) asm volatile("s_waitcnt vmcnt(8)" ::: "memory");
            else if (kt + 1 < nk) asm volatile("s_waitcnt vmcnt(4)" ::: "memory");
            else asm volatile("s_waitcnt vmcnt(0)" ::: "memory");
            __builtin_amdgcn_s_barrier();
            const unsigned char* sA = smem + (kt & 3) * 32768;
            const unsigned char* sB = sA + 16384;
            bf16x8 wf[4], af[MI];
#pragma unroll
            for (int ni = 0; ni < 4; ++ni) wf[ni] = *(const bf16x8*)(sB + (wn * 64 + ni * 16 + c16) * 64 + rch);
#pragma unroll
            for (int mi = 0; mi < MI; ++mi) af[mi] = *(const bf16x8*)(sA + (wm * 128 + mi * 16 + c16) * 64 + rch);
            const bool more = kt + 3 < nk;
            const unsigned ko3 = kofs(kt + 3);
            unsigned char* sb3 = smem + ((kt + 3) & 3) * 32768 + lbase;
#pragma unroll
            for (int ni = 0; ni < 4; ++ni) {
                if (more) __builtin_amdgcn_global_load_lds((const unsigned*)(gbase + (goff[ni] + ko3)), (lds_u32p)(sb3 + ni * 1024), 16, 0, 0);
#pragma unroll
                for (int mi = 0; mi < MI; ++mi) acc[ni][mi] = mfma16(wf[ni], af[mi], acc[ni][mi]);
            }
        }
        __syncthreads();
        const int nb = n0 + wn * 64;
        if (EPI == EPI_RESID) {
#pragma unroll
            for (int mi = 0; mi < MI; ++mi) { __builtin_amdgcn_sched_barrier(0);
                const size_t tok = m0 + wm * 128 + mi * 16 + c16;
#pragma unroll
                for (int ni = 0; ni < 4; ++ni) {
                    const int n = nb + ni * 16 + q4 * 4;
                    float4 r = *(const float4*)(e.resid + tok * 1024 + n);
                    r.x += acc[ni][mi][0]; r.y += acc[ni][mi][1]; r.z += acc[ni][mi][2]; r.w += acc[ni][mi][3];
                    *(float4*)(e.out + tok * 1024 + n) = r;
                }
            }
        } else if (EPI == EPI_CMP1) {
#pragma unroll
            for (int mi = 0; mi < MI; ++mi) { __builtin_amdgcn_sched_barrier(0);
                const int m = m0 + wm * 128 + mi * 16 + c16;
                if (m < M) {
#pragma unroll
                    for (int ni = 0; ni < 4; ++ni) {
                        const int n = nb + ni * 16 + q4 * 4;
                        const float4 bv = *(const float4*)(e.bias + n);
                        f32x4 o = {gelu_tanh(acc[ni][mi][0] + bv.x), gelu_tanh(acc[ni][mi][1] + bv.y), gelu_tanh(acc[ni][mi][2] + bv.z), gelu_tanh(acc[ni][mi][3] + bv.w)};
                        *(uint2*)(e.hid + (size_t)m * 256 + n) = pack4(o);
                    }
                }
            }
        } else if (EPI == EPI_BQ) {
            u16* Q = (u16*)(e.ws + OFF_Q);
#pragma unroll
            for (int mi = 0; mi < MI; ++mi) { __builtin_amdgcn_sched_barrier(0);
                const int tok = m0 + wm * 128 + mi * 16 + c16;
                rope_store(acc, mi, Q + (size_t)tok * 1024 + nb, cosT, sinT, tok & (S_ - 1), q4);
            }
        } else if (EPI == EPI_BKV) {
            u16* KSH = (u16*)(e.ws + OFF_KSH); u16* VSHT = (u16*)(e.ws + OFF_VSHT);
#pragma unroll
            for (int mi = 0; mi < MI; ++mi) { __builtin_amdgcn_sched_barrier(0);
                const int tok = m0 + wm * 128 + mi * 16 + c16, b = tok >> 14, s = tok & (S_ - 1);
                if (nb < 128) {
                    const int g = nb >> 6;
                    rope_store(acc, mi, KSH + ((size_t)(b * 2 + g) * S_ + s) * 64, cosT, sinT, s, q4);
                } else {
                    const int g = (nb - 128) >> 6;
#pragma unroll
                    for (int ni = 0; ni < 4; ++ni)
#pragma unroll
                        for (int i = 0; i < 4; ++i) VSHT[((size_t)(b * 2 + g) * 64 + ni * 16 + q4 * 4 + i) * S_ + s] = f2bf(acc[ni][mi][i]);
                }
            }
        } else if (EPI == EPI_AIN) {
            unsigned char* ws = e.ws;
#pragma unroll
            for (int mi = 0; mi < MI; ++mi) { __builtin_amdgcn_sched_barrier(0);
                const int tok = m0 + wm * 128 + mi * 16 + c16, b = tok >> 14, s = tok & (S_ - 1);
                if (nb < 1024) {
                    rope_store(acc, mi, (u16*)(ws + OFF_Q) + (size_t)tok * 1024 + nb, cosT, sinT, s, q4);
                } else if (nb < 1536) {
                    u16* dst = (nb < 1280) ? ((u16*)(ws + OFF_KC) + (size_t)tok * 256 + (nb - 1024)) : ((u16*)(ws + OFF_VC) + (size_t)tok * 256 + (nb - 1280));
#pragma unroll
                    for (int ni = 0; ni < 4; ++ni) *(uint2*)(dst + ni * 16 + q4 * 4) = pack4(acc[ni][mi]);
                } else if (nb < 2560) {
                    const int r = (nb - 1536) >> 8;
                    const int g = ((nb - 1536) & 255) >> 6;
                    if (r == 0) {
                        unsigned char* kd = (unsigned char*)(ws + OFF_KS) + (size_t)(b * 4 + g) * S_ * 128 + (size_t)s * 64;
#pragma unroll
                        for (int ni = 0; ni < 2; ++ni) {
                            const int d = ni * 16 + q4 * 4;
                            const float4 c = *(const float4*)(cosT + s * 32 + d), sn = *(const float4*)(sinT + s * 32 + d);
                            const f32x4 x1 = acc[ni][mi], x2 = acc[ni + 2][mi];
                            *(unsigned*)(kd + d) = pk4_fp8(x1[0] * c.x - x2[0] * sn.x, x1[1] * c.y - x2[1] * sn.y, x1[2] * c.z - x2[2] * sn.z, x1[3] * c.w - x2[3] * sn.w);
                            *(unsigned*)(kd + d + 32) = pk4_fp8(x2[0] * c.x + x1[0] * sn.x, x2[1] * c.y + x1[1] * sn.y, x2[2] * c.z + x1[2] * sn.z, x2[3] * c.w + x1[3] * sn.w);
                        }
                    } else if (r == 2) {
                        u16* base = (u16*)(ws + OFF_KW);
                        rope_store(acc, mi, base + ((size_t)(b * 4 + g) * S_ + s) * 64, cosT, sinT, s, q4);
                    } else {
                        if (r == 1) {
                            unsigned char* base = (unsigned char*)(ws + OFF_VST) + (size_t)(b * 4 + g) * 128 * S_ + (size_t)(s >> 6) * 4096 + (s & 63);
#pragma unroll
                            for (int ni = 0; ni < 4; ++ni) {
                                const unsigned pk = pk4_fp8(acc[ni][mi][0], acc[ni][mi][1], acc[ni][mi][2], acc[ni][mi][3]);
#pragma unroll
                                for (int i = 0; i < 4; ++i) base[(ni * 16 + q4 * 4 + i) * 64] = (unsigned char)(pk >> (8 * i));
                            }
                        } else {
                            u16* base = (u16*)(ws + OFF_VWT);
#pragma unroll
                            for (int ni = 0; ni < 4; ++ni)
#pragma unroll
                                for (int i = 0; i < 4; ++i) base[((size_t)(b * 4 + g) * 64 + ni * 16 + q4 * 4 + i) * S_ + s] = f2bf(acc[ni][mi][i]);
                        }
                    }
                } else if (nb == 2560) {
                    float* G = (float*)(ws + OFF_GATES) + (size_t)tok * 48;
#pragma unroll
                    for (int ni = 0; ni < 3; ++ni) {
                        const int n = ni * 16 + q4 * 4;
                        *(float4*)(G + n) = make_float4(sigmoidf_(acc[ni][mi][0]), sigmoidf_(acc[ni][mi][1]), sigmoidf_(acc[ni][mi][2]), sigmoidf_(acc[ni][mi][3]));
                    }
                }
            }
        } else if (EPI == EPI_FFNIN) {
            u16* U = (u16*)smem;
#pragma unroll
            for (int mi = 0; mi < MI; ++mi) {
                const int row = wm * 128 + mi * 16 + c16;
#pragma unroll
                for (int ni = 0; ni < 4; ++ni) {
                    const int cch = wn * 16 + ni * 4 + q4;
                    *(uint2*)(U + row * 256 + ((cch ^ (row & 15)) << 2)) = pack4(acc[ni][mi]);
                }
            }
            __syncthreads();
            {
                const int cc = tid & 31, gsel = cc >> 4, ca = cc & 15, seg = tid >> 5;
                const int ncol = (nt * 2 + gsel) * 64 + ca * 4;
                const int cha = gsel * 32 + ca, chg = cha + 16;
                const float4 w0a = *(const float4*)(e.convw + ncol), w1a = *(const float4*)(e.convw + NFF2 + ncol), w2a = *(const float4*)(e.convw + 2 * NFF2 + ncol);
                const float4 w0g = *(const float4*)(e.convw + DFF + ncol), w1g = *(const float4*)(e.convw + NFF2 + DFF + ncol), w2g = *(const float4*)(e.convw + 2 * NFF2 + DFF + ncol);
                const float4 ba = *(const float4*)(e.convb + ncol), bg = *(const float4*)(e.convb + DFF + ncol);
                float* head = (float*)(e.ws + OFF_HEAD); float* halo = (float*)(e.ws + OFF_HALO);
                u16* act = (u16*)(e.ws + OFF_ACT);
                auto ldu = [&](int row, int ch) __attribute__((always_inline)) -> float4 {
                    const uint2 v = *(const uint2*)(U + row * 256 + ((ch ^ (row & 15)) << 2));
                    return make_float4(__uint_as_float(v.x << 16), __uint_as_float(v.x & 0xffff0000u), __uint_as_float(v.y << 16), __uint_as_float(v.y & 0xffff0000u));
                };
                const int r0 = seg * 16;
                float4 a2 = make_float4(0.f, 0.f, 0.f, 0.f), a1 = a2, g2 = a2, g1 = a2;
                if (seg > 0) { a2 = ldu(r0 - 2, cha); g2 = ldu(r0 - 2, chg); a1 = ldu(r0 - 1, cha); g1 = ldu(r0 - 1, chg); }
#pragma unroll 2
                for (int r = 0; r < 16; ++r) {
                    const int row = r0 + r;
                    const float4 ua = ldu(row, cha), ug = ldu(row, chg);
                    if (seg > 0 || r >= 2) {
                        float ca_[4], cg_[4];
                        ca_[0] = ba.x + w0a.x * a2.x + w1a.x * a1.x + w2a.x * ua.x; ca_[1] = ba.y + w0a.y * a2.y + w1a.y * a1.y + w2a.y * ua.y;
                        ca_[2] = ba.z + w0a.z * a2.z + w1a.z * a1.z + w2a.z * ua.z; ca_[3] = ba.w + w0a.w * a2.w + w1a.w * a1.w + w2a.w * ua.w;
                        cg_[0] = bg.x + w0g.x * g2.x + w1g.x * g1.x + w2g.x * ug.x; cg_[1] = bg.y + w0g.y * g2.y + w1g.y * g1.y + w2g.y * ug.y;
                        cg_[2] = bg.z + w0g.z * g2.z + w1g.z * g1.z + w2g.z * ug.z; cg_[3] = bg.w + w0g.w * g2.w + w1g.w * g1.w + w2g.w * ug.w;
                        f32x4 o = {ca_[0] * sigmoidf_(ca_[0]) * cg_[0], ca_[1] * sigmoidf_(ca_[1]) * cg_[1], ca_[2] * sigmoidf_(ca_[2]) * cg_[2], ca_[3] * sigmoidf_(ca_[3]) * cg_[3]};
                        *(uint2*)(act + (size_t)(m0 + row) * DFF + ncol) = pack4(o);
                    }
                    if (seg == 0 && r < 2) { *(float4*)(head + (size_t)(mt * 2 + r) * NFF2 + ncol) = ua; *(float4*)(head + (size_t)(mt * 2 + r) * NFF2 + DFF + ncol) = ug; }
                    if (seg == 15 && r >= 14) { *(float4*)(halo + (size_t)(mt * 2 + r - 14) * NFF2 + ncol) = ua; *(float4*)(halo + (size_t)(mt * 2 + r - 14) * NFF2 + DFF + ncol) = ug; }
                    a2 = a1; a1 = ua; g2 = g1; g1 = ug;
                }
            }
            __syncthreads();
        }
    }
}

__device__ __forceinline__ void fixup_phase(const Params& p, int L, int tid_, int bid_) {
    const float* head = (const float*)(p.ws + OFF_HEAD); const float* halo = (const float*)(p.ws + OFF_HALO);
    u16* act = (u16*)(p.ws + OFF_ACT);
    const float* cw = p.ffn_conv_w + (size_t)L * 3 * NFF2; const float* cb = p.ffn_conv_b + (size_t)L * NFF2;
    const int gt = bid_ * NTHR + tid_, nthr = gridDim.x * NTHR;
    for (int idx = gt; idx < 128 * 704; idx += nthr) {
        const int i = idx / 704, n = (idx - i * 704) * 4;
        const int t0 = i * 256;
        const bool first = (t0 & (S_ - 1)) == 0;
        const float4 z = make_float4(0.f, 0.f, 0.f, 0.f);
        const float4 ha0 = *(const float4*)(head + (size_t)(i * 2) * NFF2 + n), ha1 = *(const float4*)(head + (size_t)(i * 2 + 1) * NFF2 + n);
        const float4 hg0 = *(const float4*)(head + (size_t)(i * 2) * NFF2 + DFF + n), hg1 = *(const float4*)(head + (size_t)(i * 2 + 1) * NFF2 + DFF + n);
        float4 pa0 = z, pa1 = z, pg0 = z, pg1 = z;
        if (!first) {
            pa0 = *(const float4*)(halo + (size_t)(i * 2 - 2) * NFF2 + n); pa1 = *(const float4*)(halo + (size_t)(i * 2 - 1) * NFF2 + n);
            pg0 = *(const float4*)(halo + (size_t)(i * 2 - 2) * NFF2 + DFF + n); pg1 = *(const float4*)(halo + (size_t)(i * 2 - 1) * NFF2 + DFF + n);
        }
        const float4 w0a = *(const float4*)(cw + n), w1a = *(const float4*)(cw + NFF2 + n), w2a = *(const float4*)(cw + 2 * NFF2 + n);
        const float4 w0g = *(const float4*)(cw + DFF + n), w1g = *(const float4*)(cw + NFF2 + DFF + n), w2g = *(const float4*)(cw + 2 * NFF2 + DFF + n);
        const float4 ba = *(const float4*)(cb + n), bg = *(const float4*)(cb + DFF + n);
#define CONV3(b_, w0_, w1_, w2_, x0_, x1_, x2_) make_float4(b_.x + w0_.x * x0_.x + w1_.x * x1_.x + w2_.x * x2_.x, b_.y + w0_.y * x0_.y + w1_.y * x1_.y + w2_.y * x2_.y, \
                                                             b_.z + w0_.z * x0_.z + w1_.z * x1_.z + w2_.z * x2_.z, b_.w + w0_.w * x0_.w + w1_.w * x1_.w + w2_.w * x2_.w)
        const float4 ca0 = CONV3(ba, w0a, w1a, w2a, pa0, pa1, ha0), cg0 = CONV3(bg, w0g, w1g, w2g, pg0, pg1, hg0);
        const float4 ca1 = CONV3(ba, w0a, w1a, w2a, pa1, ha0, ha1), cg1 = CONV3(bg, w0g, w1g, w2g, pg1, hg0, hg1);
        f32x4 o0 = {ca0.x * sigmoidf_(ca0.x) * cg0.x, ca0.y * sigmoidf_(ca0.y) * cg0.y, ca0.z * sigmoidf_(ca0.z) * cg0.z, ca0.w * sigmoidf_(ca0.w) * cg0.w};
        f32x4 o1 = {ca1.x * sigmoidf_(ca1.x) * cg1.x, ca1.y * sigmoidf_(ca1.y) * cg1.y, ca1.z * sigmoidf_(ca1.z) * cg1.z, ca1.w * sigmoidf_(ca1.w) * cg1.w};
        *(uint2*)(act + (size_t)t0 * DFF + n) = pack4(o0);
        *(uint2*)(act + (size_t)(t0 + 1) * DFF + n) = pack4(o1);
    }
}

__device__ __forceinline__ void cmp2_phase(const Params& p, int L, int tid_, int bid_) {
    const int lane = tid_ & 63, w = tid_ >> 6, c16 = lane & 15, q4 = lane >> 4;
    const float* cosT = (const float*)(p.ws + OFF_COS); const float* sinT = (const float*)(p.ws + OFF_SIN);
    u16* KCC = (u16*)(p.ws + OFF_KCC); u16* VCCT = (u16*)(p.ws + OFF_VCCT);
    for (int task = bid_ * NW + w; task < 1024; task += gridDim.x * NW) {
        const int kv = task >> 9, r0 = (task & 511) * 16;
        const u16* hid = (const u16*)(p.ws + OFF_HID) + (size_t)kv * 8192 * 256;
        const u16* w2t = (const u16*)(p.ws + OFF_WT_CW2 + (L * 2 + kv) * SZ_WT_CW2);
        const int row = r0 + c16, rowc = row < 8184 ? row : 8183;
        f32x4 acc[4][1];
        f32x4 accq[4][4];
#pragma unroll
        for (int a = 0; a < 4; ++a) accq[a][0] = (f32x4){0.f, 0.f, 0.f, 0.f};
#pragma unroll
        for (int kk = 0; kk < 8; ++kk) {
            const bf16x8 bfr = *(const bf16x8*)(hid + (size_t)rowc * 256 + kk * 32 + q4 * 8);
#pragma unroll
            for (int nbk = 0; nbk < 4; ++nbk) {
                const bf16x8 afr = *(const bf16x8*)(w2t + (nbk * 16 + c16) * 256 + kk * 32 + q4 * 8);
                accq[nbk][0] = mfma16(afr, bfr, accq[nbk][0]);
            }
        }
        (void)acc;
        if (row < 8184) {
            const int g = row & 3, bn = row >> 2, b = bn / 1023, n = bn - b * 1023, bg = b * 4 + g;
            if (kv == 0) {
                rope_store(accq, 0, KCC + ((size_t)bg * 1024 + n) * 64, cosT, sinT, n * 16 + 31, q4);
            } else {
#pragma unroll
                for (int nbk = 0; nbk < 4; ++nbk)
#pragma unroll
                    for (int i = 0; i < 4; ++i) VCCT[((size_t)bg * 64 + nbk * 16 + q4 * 4 + i) * 1024 + n] = f2bf(accq[nbk][0][i]);
            }
        }
    }
    const int gt = bid_ * NTHR + tid_;
    if (gt < 512) {
        const int bg = gt >> 6, d = gt & 63;
        KCC[((size_t)bg * 1024 + 1023) * 64 + d] = 0;
        VCCT[((size_t)bg * 64 + d) * 1024 + 1023] = 0;
    }
}

template <bool SINK>
__device__ __forceinline__ void band_attn(const u16* __restrict__ qrow, const u16* __restrict__ Kh, const u16* __restrict__ VT, int t0, int W, const float* sinks4,
                                          f32x4 (&O)[4][4], float (&linv)[4], int lane) {
    const int c16 = lane & 15, q4 = lane >> 4;
    const float SC = 0.125f * LOG2E;
    bf16x8 qf[4][2];
#pragma unroll
    for (int h = 0; h < 4; ++h)
#pragma unroll
        for (int ks = 0; ks < 2; ++ks) qf[h][ks] = *(const bf16x8*)(qrow + h * 64 + ks * 32 + q4 * 8);
    float m[4], l[4];
#pragma unroll
    for (int h = 0; h < 4; ++h) {
        if (SINK) { m[h] = sinks4[h] * LOG2E; l[h] = (q4 == 0) ? 1.f : 0.f; }
        else { m[h] = NEGBIG; l[h] = 0.f; }
#pragma unroll
        for (int db = 0; db < 4; ++db) O[h][db] = (f32x4){0.f, 0.f, 0.f, 0.f};
    }
    const int t = t0 + c16;
    int lo = t0 - W + 1; if (lo < 0) lo = 0;
    const int g0 = lo >> 5, g1 = (t0 + 15) >> 5;
    const int kr = kperm(c16);
    for (int grp = g0; grp <= g1; ++grp) {
        const int kb = grp << 5;
        const unsigned kof = (unsigned)(kb + kr) * 64u + (unsigned)q4 * 8u;
        const bf16x8 k1a = *(const bf16x8*)(Kh + kof), k1b = *(const bf16x8*)(Kh + (kof + 32u)), k2a = *(const bf16x8*)(Kh + (kof + 256u)), k2b = *(const bf16x8*)(Kh + (kof + 288u));
        bf16x8 vf[4];
        const unsigned vof = (unsigned)c16 * (unsigned)S_ + (unsigned)kb + (unsigned)q4 * 8u;
#pragma unroll
        for (int db = 0; db < 4; ++db) vf[db] = *(const bf16x8*)(VT + (size_t)(db * 16 * S_) + vof);
        const int kpos = kb + q4 * 8;
        f32x4 cm1 = {0.f, 0.f, 0.f, 0.f}, cm2 = cm1;
        if (!((kb + 31 <= t0) && (kb > t0 + 15 - W))) {
#pragma unroll
            for (int i = 0; i < 4; ++i) {
                const int d1 = t - (kpos + i), d2 = t - (kpos + 4 + i);
                if (!((d1 >= 0) && (d1 < W))) cm1[i] = NEGBIG;
                if (!((d2 >= 0) && (d2 < W))) cm2[i] = NEGBIG;
            }
        }
#pragma unroll
        for (int h = 0; h < 4; ++h) {
            f32x4 s1 = mfma16(k1a, qf[h][0], cm1); s1 = mfma16(k1b, qf[h][1], s1);
            f32x4 s2 = mfma16(k2a, qf[h][0], cm2); s2 = mfma16(k2b, qf[h][1], s2);
            float mx = fmaxf(fmaxf(fmaxf(s1[0], s1[1]), fmaxf(s1[2], s1[3])), fmaxf(fmaxf(s2[0], s2[1]), fmaxf(s2[2], s2[3])));
            mx = xmax32(xmax16(mx));
            const float mn = fmaxf(fmaxf(m[h], mx * SC), -1e20f);
            if (__ballot(mn != m[h])) {
                const float alpha = fexp2(m[h] - mn);
                l[h] *= alpha;
#pragma unroll
                for (int db = 0; db < 4; ++db) O[h][db] = O[h][db] * alpha;
            }
            m[h] = mn;
            float pv[8]; float ps = 0.f;
#pragma unroll
            for (int i = 0; i < 4; ++i) { pv[i] = fexp2(fmaf(s1[i], SC, -mn)); pv[4 + i] = fexp2(fmaf(s2[i], SC, -mn)); }
#pragma unroll
            for (int i = 0; i < 8; ++i) ps += pv[i];
            l[h] += ps;
            const bf16x8 pf = pack8(pv);
#pragma unroll
            for (int db = 0; db < 4; ++db) O[h][db] = mfma16(vf[db], pf, O[h][db]);
        }
    }
#pragma unroll
    for (int h = 0; h < 4; ++h) { float lt = l[h]; lt += __shfl_xor(lt, 16); lt += __shfl_xor(lt, 32); linv[h] = 1.f / lt; }
}

__device__ __forceinline__ void swa_phase(const Params& p, int j, int tid_, int bid_) {
    const int lane = tid_ & 63, w = tid_ >> 6, c16 = lane & 15, q4 = lane >> 4;
    const int x = bid_ & 7, b = x >> 2, kvh = (x >> 1) & 1, hq = x & 1;
    const int head0 = kvh * 8 + hq * 4;
    const u16* Q = (const u16*)(p.ws + OFF_Q); u16* Ob = (u16*)(p.ws + OFF_O);
    const u16* Kh = (const u16*)(p.ws + OFF_KSH) + (size_t)(b * 2 + kvh) * S_ * 64;
    const u16* VT = (const u16*)(p.ws + OFF_VSHT) + (size_t)(b * 2 + kvh) * 64 * S_;
    const float* sk = p.b_sinks + j * 16 + head0;
    const int nslots = (gridDim.x >> 3) * NW;
    for (int tile = (bid_ >> 3) * NW + w; tile < 1024; tile += nslots) {
        const int t0 = tile * 16;
        f32x4 O[4][4]; float linv[4];
        band_attn<true>(Q + ((size_t)b * S_ + t0 + c16) * 1024 + head0 * 64, Kh, VT, t0, 128, sk, O, linv, lane);
        u16* op = Ob + ((size_t)b * S_ + t0 + c16) * 1024 + head0 * 64;
#pragma unroll
        for (int h = 0; h < 4; ++h)
#pragma unroll
            for (int db = 0; db < 4; ++db) *(uint2*)(op + h * 64 + db * 16 + q4 * 4) = pack4(O[h][db] * linv[h]);
    }
}

__device__ __forceinline__ void nsa_phase(const Params& p, unsigned char* smem, int tid_, int bid_, int probe_rep) {
    const int lane0 = tid_ & 63, w = tid_ >> 6;
    float* R = (float*)(smem + w * 16384);
    unsigned* tm = (unsigned*)(smem + NW * 16384 + w * 1024);
    unsigned char* sel = smem + NW * 16384 + NW * 1024 + w * 256;
    const int bg = bid_ & 7, b = bg >> 2, g = bg & 3;
    const u16* Q = (const u16*)(p.ws + OFF_Q); u16* Ob = (u16*)(p.ws + OFF_O);
    const u16* KCC = (const u16*)(p.ws + OFF_KCC) + (size_t)bg * 1024 * 64;
    const u16* VCCT = (const u16*)(p.ws + OFF_VCCT) + (size_t)bg * 64 * 1024;
    const u16* KS = (const u16*)(p.ws + OFF_KS) + (size_t)bg * S_ * 64;
    const u16* VST = (const u16*)(p.ws + OFF_VST) + (size_t)bg * 64 * S_;
    const u16* KW = (const u16*)(p.ws + OFF_KW) + (size_t)bg * S_ * 64;
    const u16* VWT = (const u16*)(p.ws + OFF_VWT) + (size_t)bg * 64 * S_;
    const float* GATES = (const float*)(p.ws + OFF_GATES);
    const float SC = 0.125f * LOG2E;
    const int nslots = (gridDim.x >> 3) * NW;
    const int slot_ = (bid_ >> 3) * NW + w;
    for (int rnd = 0; rnd * nslots < 1024; ++rnd) {
        const int tile_ = rnd * nslots + ((rnd & 1) ? (nslots - 1 - slot_) : slot_);
        if (tile_ >= 1024) continue;
        const int tile = __builtin_amdgcn_readfirstlane(tile_);
        int lane = lane0; asm volatile("" : "+v"(lane));
        const int c16 = lane & 15, q4 = lane >> 4, kr = kperm(c16);
        const int t0 = tile * 16, cur = t0 >> 6, t = t0 + c16;
        const u16* qrow = Q + ((size_t)b * S_ + t) * 1024 + g * 256;
        const float* grow = GATES + ((size_t)b * S_ + t) * 48 + g * 12;
        const int nvl = (t >= 31) ? ((t - 31) >> 4) : -1;
        const int nvmax = (t0 + 15 >= 31) ? ((t0 + 15 - 31) >> 4) : -1;
        const int ng = (nvmax >= 0) ? ((nvmax >> 5) + 1) : 0;
        f32x4 Oc[4][4];
#pragma unroll
        for (int h = 0; h < 4; ++h)
#pragma unroll
            for (int db = 0; db < 4; ++db) Oc[h][db] = (f32x4){0.f, 0.f, 0.f, 0.f};
        {
            bf16x8 qf[4][2];
#pragma unroll
            for (int h = 0; h < 4; ++h)
#pragma unroll
                for (int ks = 0; ks < 2; ++ks) qf[h][ks] = *(const bf16x8*)(qrow + h * 64 + ks * 32 + q4 * 8);
            float m[4], l[4];
#pragma unroll
            for (int h = 0; h < 4; ++h) { m[h] = NEGBIG; l[h] = 0.f; }
            const int nvmin = (t0 >= 31) ? ((t0 - 31) >> 4) : -1;
            for (int grp = 0; grp < ng; ++grp) {
                const int kb = grp << 5;
                const unsigned kof = (unsigned)(kb + kr) * 64u + (unsigned)q4 * 8u;
                const bf16x8 k1a = *(const bf16x8*)(KCC + kof), k1b = *(const bf16x8*)(KCC + (kof + 32u)), k2a = *(const bf16x8*)(KCC + (kof + 256u)), k2b = *(const bf16x8*)(KCC + (kof + 288u));
                const int kpos = kb + q4 * 8;
                f32x4 cm1 = {0.f, 0.f, 0.f, 0.f}, cm2 = cm1;
                if (kb + 31 > nvmin) {
#pragma unroll
                    for (int i = 0; i < 4; ++i) { if (kpos + i > nvl) cm1[i] = NEGBIG; if (kpos + 4 + i > nvl) cm2[i] = NEGBIG; }
                }
#pragma unroll
                for (int h = 0; h < 4; ++h) {
                    f32x4 s1 = mfma16(k1a, qf[h][0], cm1); s1 = mfma16(k1b, qf[h][1], s1);
                    f32x4 s2 = mfma16(k2a, qf[h][0], cm2); s2 = mfma16(k2b, qf[h][1], s2);
                    float mx = fmaxf(fmaxf(fmaxf(s1[0], s1[1]), fmaxf(s1[2], s1[3])), fmaxf(fmaxf(s2[0], s2[1]), fmaxf(s2[2], s2[3])));
                    mx = xmax32(xmax16(mx));
                    const float mn = fmaxf(fmaxf(m[h], mx * SC), -1e20f);
                    if (__ballot(mn != m[h])) l[h] *= fexp2(m[h] - mn);
                    m[h] = mn;
                    float ps = 0.f;
#pragma unroll
                    for (int i = 0; i < 4; ++i) ps += fexp2(fmaf(s1[i], SC, -mn)) + fexp2(fmaf(s2[i], SC, -mn));
                    l[h] += ps;
                }
            }
            float linv[4];
#pragma unroll
            for (int h = 0; h < 4; ++h) { float lt = l[h]; lt += __shfl_xor(lt, 16); lt += __shfl_xor(lt, 32); linv[h] = lt > 0.f ? 1.f / lt : 0.f; }
            float carry = 0.f;
            for (int grp = 0; grp < ng; ++grp) {
                const int kb = grp << 5;
                const unsigned kof = (unsigned)(kb + kr) * 64u + (unsigned)q4 * 8u;
                const bf16x8 k1a = *(const bf16x8*)(KCC + kof), k1b = *(const bf16x8*)(KCC + (kof + 32u)), k2a = *(const bf16x8*)(KCC + (kof + 256u)), k2b = *(const bf16x8*)(KCC + (kof + 288u));
                bf16x8 vf[4];
#pragma unroll
                for (int db = 0; db < 4; ++db) vf[db] = *(const bf16x8*)(VCCT + (unsigned)(db * 16 * 1024) + ((unsigned)c16 * 1024u + (unsigned)kb + (unsigned)q4 * 8u));
                const int kpos = kb + q4 * 8;
                float psum[8];
#pragma unroll
                for (int i = 0; i < 8; ++i) psum[i] = 0.f;
                f32x4 cm1 = {0.f, 0.f, 0.f, 0.f}, cm2 = cm1;
                if (kb + 31 > nvmin) {
#pragma unroll
                    for (int i = 0; i < 4; ++i) { if (kpos + i > nvl) cm1[i] = NEGBIG; if (kpos + 4 + i > nvl) cm2[i] = NEGBIG; }
                }
#pragma unroll
                for (int h = 0; h < 4; ++h) {
                    f32x4 s1 = mfma16(k1a, qf[h][0], cm1); s1 = mfma16(k1b, qf[h][1], s1);
                    f32x4 s2 = mfma16(k2a, qf[h][0], cm2); s2 = mfma16(k2b, qf[h][1], s2);
                    float pv[8];
#pragma unroll
                    for (int i = 0; i < 4; ++i) {
                        pv[i] = fexp2(fmaf(s1[i], SC, -m[h])) * linv[h];
                        pv[4 + i] = fexp2(fmaf(s2[i], SC, -m[h])) * linv[h];
                    }
#pragma unroll
                    for (int i = 0; i < 8; ++i) psum[i] += pv[i];
                    const bf16x8 pf = pack8(pv);
#pragma unroll
                    for (int db = 0; db < 4; ++db) Oc[h][db] = mfma16(vf[db], pf, Oc[h][db]);
                }
                const float prev = __shfl(psum[7], (lane + 48) & 63);
                const float left = (q4 == 0) ? carry : prev;
                carry = prev;
                const float impA = left + 2.f * (psum[0] + psum[1] + psum[2]) + psum[3];
                const float impB = psum[3] + 2.f * (psum[4] + psum[5] + psum[6]) + psum[7];
                *(float2*)(R + c16 * 256 + (kb >> 2) + 2 * q4) = make_float2(impA, impB);
            }
        }
        wsync();
        const int ncand = cur - 2;
        const int npick = ncand < 0 ? 0 : (ncand < 13 ? ncand : 13);
        const int nforced = (cur < 2 ? cur : 2) + 1;
        const int nsel = npick + nforced;
        for (int tk = 0; tk < 8; ++tk) {
            float a0 = -1.f, a1 = -1.f, a2 = -1.f, a3 = -1.f, b0 = -1.f, b1 = -1.f, b2 = -1.f, b3 = -1.f;
            if (npick > 0) {
                const float4 va = *(const float4*)(R + tk * 256 + lane * 4), vb = *(const float4*)(R + (tk + 8) * 256 + lane * 4);
                const int j0 = lane * 4;
                const bool k0 = (j0 >= 1 && j0 <= ncand), k1 = (j0 + 1 <= ncand), k2 = (j0 + 2 <= ncand), k3 = (j0 + 3 <= ncand);
                a0 = k0 ? va.x : -1.f; a1 = k1 ? va.y : -1.f; a2 = k2 ? va.z : -1.f; a3 = k3 ? va.w : -1.f;
                b0 = k0 ? vb.x : -1.f; b1 = k1 ? vb.y : -1.f; b2 = k2 ? vb.z : -1.f; b3 = k3 ? vb.w : -1.f;
            }
            for (int it = 0; it < npick; ++it) {
                const float ma = wave_max(fmaxf(fmaxf(a0, a1), fmaxf(a2, a3)));
                const float mb = wave_max(fmaxf(fmaxf(b0, b1), fmaxf(b2, b3)));
                const unsigned long long bala = __ballot((a0 == ma) || (a1 == ma) || (a2 == ma) || (a3 == ma));
                const unsigned long long balb = __ballot((b0 == mb) || (b1 == mb) || (b2 == mb) || (b3 == mb));
                const int fa = __ffsll((long long)bala) - 1, fb = __ffsll((long long)balb) - 1;
                if (lane == fa) {
                    int sl;
                    if (a0 == ma) { sl = 0; a0 = -1.f; } else if (a1 == ma) { sl = 1; a1 = -1.f; } else if (a2 == ma) { sl = 2; a2 = -1.f; } else { sl = 3; a3 = -1.f; }
                    sel[tk * 16 + it] = (unsigned char)(lane * 4 + sl);
                }
                if (lane == fb) {
                    int sl;
                    if (b0 == mb) { sl = 0; b0 = -1.f; } else if (b1 == mb) { sl = 1; b1 = -1.f; } else if (b2 == mb) { sl = 2; b2 = -1.f; } else { sl = 3; b3 = -1.f; }
                    sel[(tk + 8) * 16 + it] = (unsigned char)(lane * 4 + sl);
                }
            }
            if (lane < 2) {
                const int tq = tk + lane * 8;
                sel[tq * 16 + npick] = 0;
                if (cur >= 1) sel[tq * 16 + npick + 1] = (unsigned char)cur;
                if (cur >= 2) sel[tq * 16 + npick + 2] = (unsigned char)(cur - 1);
            }
        }
        { unsigned zz = 0u; asm volatile("" : "+v"(zz)); *(uint4*)(tm + lane * 4) = make_uint4(zz, zz, zz, zz); }
        wsync();
        if (lane < 16) {
            for (int si = 0; si < nsel; ++si) atomicOr(&tm[sel[lane * 16 + si]], 1u << lane);
        }
        wsync();
        int n_act;
        {
            const uint4 mm = *(const uint4*)(tm + lane * 4);
            wsync();
            const bool f0 = mm.x != 0u, f1 = mm.y != 0u, f2 = mm.z != 0u, f3 = mm.w != 0u;
            const unsigned long long b0 = __ballot(f0), b1 = __ballot(f1), b2 = __ballot(f2), b3 = __ballot(f3);
            const unsigned long long below = (1ull << lane) - 1ull;
            int pos = __popcll(b0 & below) + __popcll(b1 & below) + __popcll(b2 & below) + __popcll(b3 & below);
            if (f0) { sel[pos] = (unsigned char)(lane * 4 + 0); ++pos; }
            if (f1) { sel[pos] = (unsigned char)(lane * 4 + 1); ++pos; }
            if (f2) { sel[pos] = (unsigned char)(lane * 4 + 2); ++pos; }
            if (f3) { sel[pos] = (unsigned char)(lane * 4 + 3); ++pos; }
            n_act = __popcll(b0) + __popcll(b1) + __popcll(b2) + __popcll(b3);
        }
        wsync();
        u16* QL = (u16*)R;
        u16* PL = (u16*)R + 4096;
        {
            int t3 = t; asm volatile("" : "+v"(t3));
            const float* grow3 = GATES + ((size_t)b * S_ + t3) * 48 + g * 12;
#pragma unroll
            for (int h = 0; h < 4; ++h) {
                const float g0 = grow3[h * 3 + 0];
#pragma unroll
                for (int db = 0; db < 4; ++db) *(uint2*)(PL + (c16 * 4 + h) * 64 + db * 16 + q4 * 4) = pack4(Oc[h][db] * g0);
            }
#pragma unroll
            for (int i = 0; i < 8; ++i) {
                const int idx = i * 64 + lane, row = idx >> 3, ch = idx & 7;
                const uint4 v = *(const uint4*)(Q + ((size_t)b * S_ + t0 + (row >> 2)) * 1024 + g * 256 + (row & 3) * 64 + ch * 8);
                *(uint4*)(QL + row * 64 + ((ch ^ ((row >> 1) & 7)) << 3)) = v;
            }
        }
        wsync();
        for (int rep = 0; rep <= probe_rep; ++rep) {
            const int tg = c16 >> 2, hh = c16 & 3;
            f32x4 Os[4][4]; float m[4], l[4];
#pragma unroll
            for (int gq = 0; gq < 4; ++gq) {
                m[gq] = NEGBIG; l[gq] = 0.f;
#pragma unroll
                for (int db = 0; db < 4; ++db) Os[gq][db] = (f32x4){0.f, 0.f, 0.f, 0.f};
            }
            long qf8[4][2];
#pragma unroll
            for (int gq = 0; gq < 4; ++gq)
#pragma unroll
                for (int ks = 0; ks < 2; ++ks) {
                    const uint4 qv = *(const uint4*)(Q + ((size_t)b * S_ + t0 + gq * 4 + tg) * 1024 + g * 256 + hh * 64 + ks * 32 + q4 * 8);
                    const float f[8] = {__uint_as_float(qv.x << 16), __uint_as_float(qv.x & 0xffff0000u), __uint_as_float(qv.y << 16), __uint_as_float(qv.y & 0xffff0000u),
                                        __uint_as_float(qv.z << 16), __uint_as_float(qv.z & 0xffff0000u), __uint_as_float(qv.w << 16), __uint_as_float(qv.w & 0xffff0000u)};
                    qf8[gq][ks] = pk8_fp8(f);
                }
            const unsigned char* KS8 = (const unsigned char*)KS;
            const unsigned char* VS8 = (const unsigned char*)VST;
            auto ld = [&](int s, long (&K)[4], long (&V)[4]) __attribute__((always_inline)) {
                const int j = __builtin_amdgcn_readfirstlane((int)sel[s >> 1]);
                const int kb = j * 64 + (s & 1) * 32;
                const unsigned kof = (unsigned)(kb + kr) * 64u + (unsigned)q4 * 8u;
                K[0] = *(const long*)(KS8 + kof); K[1] = *(const long*)(KS8 + (kof + 32u)); K[2] = *(const long*)(KS8 + (kof + 256u)); K[3] = *(const long*)(KS8 + (kof + 288u));
                const unsigned vof = (unsigned)j * 4096u + (unsigned)c16 * 64u + (unsigned)(s & 1) * 32u + (unsigned)q4 * 8u;
#pragma unroll
                for (int db = 0; db < 4; ++db) V[db] = *(const long*)(VS8 + (vof + (unsigned)(db * 1024)));
            };
            auto cp = [&](int s, const long (&K)[4], const long (&V)[4]) __attribute__((always_inline)) {
                const int j = __builtin_amdgcn_readfirstlane((int)sel[s >> 1]);
                const unsigned mk = __builtin_amdgcn_readfirstlane(tm[j]);
                const int kpos = j * 64 + (s & 1) * 32 + q4 * 8;
#pragma unroll
                for (int gq = 0; gq < 4; ++gq) {
                    const unsigned gm = (mk >> (gq * 4)) & 0xFu;
                    if (gm == 0u) continue;
                    const float cmv = ((gm >> tg) & 1u) ? 0.f : NEGBIG;
                    f32x4 cm1 = {cmv, cmv, cmv, cmv}, cm2 = cm1;
                    if (j == cur) {
                        const int tc = t0 + gq * 4 + tg;
#pragma unroll
                        for (int i = 0; i < 4; ++i) { if (kpos + i > tc) cm1[i] = NEGBIG; if (kpos + 4 + i > tc) cm2[i] = NEGBIG; }
                    }
                    f32x4 s1 = mfma8(K[0], qf8[gq][0], cm1); s1 = mfma8(K[1], qf8[gq][1], s1);
                    f32x4 s2 = mfma8(K[2], qf8[gq][0], cm2); s2 = mfma8(K[3], qf8[gq][1], s2);
                    float mx = fmaxf(fmaxf(fmaxf(s1[0], s1[1]), fmaxf(s1[2], s1[3])), fmaxf(fmaxf(s2[0], s2[1]), fmaxf(s2[2], s2[3])));
                    mx = xmax32(xmax16(mx));
                    const float mn = fmaxf(m[gq], mx * SC);
                    if (__ballot(mn != m[gq])) {
                        const float alpha = fexp2(m[gq] - mn);
                        l[gq] *= alpha;
#pragma unroll
                        for (int db = 0; db < 4; ++db) Os[gq][db] = Os[gq][db] * alpha;
                    }
                    m[gq] = mn;
                    float pv[8]; float ps = 0.f;
#pragma unroll
                    for (int i = 0; i < 4; ++i) { pv[i] = fexp2(fmaf(s1[i], SC, 7.f - mn)); pv[4 + i] = fexp2(fmaf(s2[i], SC, 7.f - mn)); }
#pragma unroll
                    for (int i = 0; i < 8; ++i) ps += pv[i];
                    l[gq] += ps;
                    const long pf = pk8_fp8(pv);
#pragma unroll
                    for (int db = 0; db < 4; ++db) Os[gq][db] = mfma8(V[db], pf, Os[gq][db]);
                }
            };
            {
                long KA[4], VA[4], KB[4], VB[4];
                const int ns = 2 * n_act;
                ld(0, KA, VA);
                for (int s = 0; s < ns; s += 2) {
                    ld(s + 1, KB, VB);
                    cp(s, KA, VA);
                    if (s + 2 < ns) ld(s + 2, KA, VA);
                    cp(s + 1, KB, VB);
                }
            }
            const float repsc = (rep == 0) ? 1.f : 0.f;
#pragma unroll
            for (int gq = 0; gq < 4; ++gq) {
                float lt = l[gq]; lt += __shfl_xor(lt, 16); lt += __shfl_xor(lt, 32);
                const int tok = gq * 4 + tg;
                const float sc = repsc * GATES[((size_t)b * S_ + t0 + tok) * 48 + g * 12 + hh * 3 + 1] / lt;
#pragma unroll
                for (int db = 0; db < 4; ++db) {
                    u16* rp = PL + (tok * 4 + hh) * 64 + db * 16 + q4 * 4;
                    *(uint2*)rp = pack4(unpack4(*(const uint2*)rp) + Os[gq][db] * sc);
                }
            }
        }
        wsync();
        {
            f32x4 Ow[4][4]; float linv[4];
            int t2 = t; asm volatile("" : "+v"(t2));
            const u16* qrow2 = Q + ((size_t)b * S_ + t2) * 1024 + g * 256;
            const float* grow2 = GATES + ((size_t)b * S_ + t2) * 48 + g * 12;
            band_attn<false>(qrow2, KW, VWT, t0, 512, nullptr, Ow, linv, lane);
            u16* op = Ob + ((size_t)b * S_ + t2) * 1024 + g * 256;
#pragma unroll
            for (int h = 0; h < 4; ++h) {
                const float g2 = grow2[h * 3 + 2] * linv[h];
#pragma unroll
                for (int db = 0; db < 4; ++db) {
                    const f32x4 part = unpack4(*(const uint2*)(PL + (c16 * 4 + h) * 64 + db * 16 + q4 * 4));
                    *(uint2*)(op + h * 64 + db * 16 + q4 * 4) = pack4(part + Ow[h][db] * g2);
                }
            }
        }
        wsync();
    }
}


#define XB_TMO      128
#define XB_XCNT(j)  (256  + 64 * (j))
#define XB_XSUB(j)  (1280 + 64 * (j))
#define XB_XGEN(j)  (2304 + 64 * (j))
#define XB_TOP      3328
#define XB_TOPGEN   3392
#define XCD_BAR_WORDS 3456
#define XB_SPIN_CAP (1u << 22)
#define LAS __attribute__((address_space(3)))
__device__ __forceinline__ unsigned xb_ld(unsigned* p)              { return __hip_atomic_load(p, __ATOMIC_RELAXED, __HIP_MEMORY_SCOPE_AGENT); }
__device__ __forceinline__ unsigned xb_add(unsigned* p, unsigned v) { return __hip_atomic_fetch_add(p, v, __ATOMIC_RELAXED, __HIP_MEMORY_SCOPE_AGENT); }
__device__ __forceinline__ unsigned xb_xcc_id() { return (unsigned)__builtin_amdgcn_s_getreg((3 << 11) | 20) & 0xFu; }
#define XB_SPIN(cond, bar) do { unsigned _sp = 0; while (cond) { __builtin_amdgcn_s_sleep(1); \
    if ((++_sp & 255u) == 0u) { if (xb_ld(&(bar)[XB_TMO])) break; if (_sp > XB_SPIN_CAP) { atomicAdd(&(bar)[XB_TMO], 1u); break; } } } } while (0)
__device__ __forceinline__ void xcd_barrier_complete(unsigned* bar, unsigned x, unsigned& nloc, unsigned& nx) {
    const unsigned G = gridDim.x * gridDim.y * gridDim.z;
    unsigned sum, cnt, mine, sp = 0u;
    for (;;) {
        sum = 0u; cnt = 0u; mine = 0u;
#pragma unroll
        for (unsigned j = 0; j < 16; ++j) { const unsigned c = xb_ld(&bar[XB_XCNT(j)]); sum += c; cnt += (c > 0u) ? 1u : 0u; mine = (j == x) ? c : mine; }
        if (sum == G) break;
        __builtin_amdgcn_s_sleep(1);
        if ((++sp & 255u) == 0u) { if (xb_ld(&bar[XB_TMO])) break; if (sp > XB_SPIN_CAP) { atomicAdd(&bar[XB_TMO], 1u); break; } }
    }
    nloc = mine > 0u ? mine : 1u; nx = cnt > 0u ? cnt : 1u;
}
__device__ __forceinline__ void xcd_barrier(unsigned* bar, unsigned x, volatile LAS unsigned* st, int tid) {
    asm volatile("s_waitcnt vmcnt(0)" ::: "memory");
    __syncthreads();
    if (tid == 0) {
        __builtin_amdgcn_s_waitcnt(0);
        unsigned nloc = st[0], nx = st[1];
        if (nloc == 0u) { xcd_barrier_complete(bar, x, nloc, nx); st[0] = nloc; st[1] = nx; }
        const unsigned old = xb_add(&bar[XB_XSUB(x)], 1u);
        const unsigned gen = old / nloc;
        if (old + 1u == (gen + 1u) * nloc) {
            __builtin_amdgcn_fence(__ATOMIC_RELEASE, "agent");
            asm volatile("s_waitcnt vmcnt(0)" ::: "memory");
            const unsigned og = xb_add(&bar[XB_TOP], 1u);
            const unsigned tg = og / nx;
            if (og + 1u == (tg + 1u) * nx) xb_add(&bar[XB_TOPGEN], 1u);
            else XB_SPIN(xb_ld(&bar[XB_TOPGEN]) == tg, bar);
            __builtin_amdgcn_fence(__ATOMIC_ACQUIRE, "agent");
            xb_add(&bar[XB_XGEN(x)], 1u);
            asm volatile("s_waitcnt vmcnt(0)" ::: "memory");
        } else {
            XB_SPIN(xb_ld(&bar[XB_XGEN(x)]) == gen, bar);
            __builtin_amdgcn_fence(__ATOMIC_ACQUIRE, "agent");
            asm volatile("s_waitcnt vmcnt(0)" ::: "memory");
        }
    }
    __syncthreads();
}

enum { PT_PREP = 0, PT_NORM, PT_AIN, PT_CMP1, PT_CMP2, PT_NSA, PT_BKV, PT_BQ, PT_SWA, PT_AOUT, PT_FFNIN, PT_FIXUP, PT_FOUT, PT_FINAL };

__global__ void __launch_bounds__(NTHR, 2) mega(Params p) {
#if defined(__HIP_DEVICE_COMPILE__)
    extern __shared__ __attribute__((aligned(16))) unsigned char smem[];
    cg::grid_group grid = cg::this_grid();
    typedef const Params __attribute__((address_space(4)))* KP;
    const int ph_lo = p.ph_lo, ph_hi = p.ph_hi;
    const int wave_id = __builtin_amdgcn_readfirstlane((int)(threadIdx.x >> 6));
    unsigned* bar = (unsigned*)(p.ws + OFF_BAR);
    volatile LAS unsigned* xst = (volatile LAS unsigned*)(smem + LDS_USER);
    const unsigned xcc = __builtin_amdgcn_readfirstlane(xb_xcc_id());
    if (ph_hi - ph_lo > 1) {
        if (threadIdx.x == 0) { xst[0] = 0u; xst[1] = 0u; (void)xb_add(&bar[XB_XCNT(xcc)], 1u); }
        __syncthreads();
    }
    for (int ph = ph_lo; ph < ph_hi; ++ph) {
        int tid_, bid_ = blockIdx.x;
        asm volatile("v_mbcnt_lo_u32_b32 %0, -1, 0\n\tv_mbcnt_hi_u32_b32 %0, -1, %0" : "=v"(tid_));
        tid_ += wave_id * 64;
        asm volatile("" : "+s"(bid_));
        KP kp = (KP)__builtin_amdgcn_kernarg_segment_ptr();
        asm volatile("" : "+s"(kp));
        unsigned char* ws = kp->ws;
        u16* HN = (u16*)(ws + OFF_HN);
        const int d = kp->desc[ph], type = d & 255, sub = (d >> 8) & 255, L = d >> 16;
        const float* hsrc = (L == 0) ? kp->x : kp->out;
        EpiArgs e; e.resid = nullptr; e.out = kp->out; e.bias = nullptr; e.hid = nullptr; e.convw = nullptr; e.convb = nullptr; e.ws = ws;
        switch (type) {
        case PT_PREP: { const Params pl = *kp; prep_phase(pl, smem, tid_, bid_); } break;
        case PT_NORM: {
            const float* src = (sub == 1) ? kp->out : hsrc;
            const float* g = (sub == 0) ? kp->norm_attn + L * 1024 : (sub == 1) ? kp->norm_ffn + L * 1024 : kp->kv_norm;
            norm_phase<false>(src, g, HN, nullptr, tid_, bid_);
        } break;
        case PT_AIN: gemm_phase<AM_PLAIN, EPI_AIN>(HN, 1024, (const u16*)(ws + OFF_WT_AIN + L * SZ_WT_AIN), T_, 2688, 1024, 0, e, smem, tid_, bid_); break;
        case PT_CMP1:
            for (int kv = 0; kv < 2; ++kv) {
                e.bias = (const float*)(ws + OFF_CBIAS) + (L * 2 + kv) * 256; e.hid = (u16*)(ws + OFF_HID) + (size_t)kv * 8192 * 256;
                gemm_phase<AM_GATHER, EPI_CMP1>((const u16*)(ws + (kv == 0 ? OFF_KC : OFF_VC)), 0, (const u16*)(ws + OFF_WT_CW1 + (L * 2 + kv) * SZ_WT_CW1), 8184, 256, 2048,
                                                kv == 0 ? 0 : (int)(gridDim.x >> 1), e, smem, tid_, bid_);
            }
            break;
        case PT_CMP2: { const Params pl = *kp; cmp2_phase(pl, L, tid_, bid_); } break;
        case PT_NSA: { const Params pl = *kp; nsa_phase(pl, smem, tid_, bid_, sub); } break;
        case PT_BKV: gemm_phase<AM_PLAIN, EPI_BKV>(HN, 1024, (const u16*)(ws + OFF_WT_KV), T_, 256, 1024, 0, e, smem, tid_, bid_); break;
        case PT_BQ: gemm_phase<AM_PLAIN, EPI_BQ>(HN, 1024, (const u16*)(ws + OFF_WT_BQ + (L - 2) * SZ_WT_SQ), T_, 1024, 1024, 0, e, smem, tid_, bid_); break;
        case PT_SWA: { const Params pl = *kp; swa_phase(pl, L - 2, tid_, bid_); } break;
        case PT_AOUT:
        case PT_FOUT: {
            const bool ff = (type == PT_FOUT);
            e.resid = ff ? kp->out : hsrc;
            const u16* A = (const u16*)(ws + (ff ? OFF_ACT : OFF_O));
            const u16* Bt = (const u16*)(ws + (ff ? OFF_WT_FOUT + L * SZ_WT_FOUT : (L < 2 ? OFF_WT_AOUT + L * SZ_WT_SQ : OFF_WT_BOUT + (L - 2) * SZ_WT_SQ)));
            const int K = ff ? DFF : 1024;
            gemm_big<AM_PLAIN, EPI_RESID>(A, K, Bt, T_, 1024, K, 0, e, smem, tid_, bid_);
        } break;
        case PT_FFNIN:
            e.convw = kp->ffn_conv_w + (size_t)L * 3 * NFF2; e.convb = kp->ffn_conv_b + (size_t)L * NFF2;
            gemm_big<AM_PLAIN, EPI_FFNIN>(HN, 1024, (const u16*)(ws + OFF_WT_FIN + L * SZ_WT_FIN), T_, NFF2, 1024, 0, e, smem, tid_, bid_);
            break;
        case PT_FIXUP: { const Params pl = *kp; fixup_phase(pl, L, tid_, bid_); } break;
        case PT_FINAL: norm_phase<true>(kp->out, kp->final_norm, nullptr, kp->out, tid_, bid_); break;
        default: break;
        }
        if (ph + 1 < ph_hi) { if (ph == ph_lo) grid.sync(); else xcd_barrier(bar, xcc, xst, tid_); }
    }
#endif
}

static int build_program(int* desc) {
    int n = 0;
    auto add = [&](int type, int sub, int L) { desc[n++] = type | (sub << 8) | (L << 16); };
    add(PT_PREP, 0, 0);
    for (int L = 0; L < 4; ++L) {
        if (L < 2) {
            add(PT_NORM, 0, L); add(PT_AIN, 0, L); add(PT_CMP1, 0, L); add(PT_CMP2, 0, L); add(PT_NSA, NSA_PROBE_REP, L);
        } else {
            if (L == 2) { add(PT_NORM, 2, L); add(PT_BKV, 0, L); }
            add(PT_NORM, 0, L); add(PT_BQ, 0, L); add(PT_SWA, 0, L);
        }
        add(PT_AOUT, 0, L); add(PT_NORM, 1, L); add(PT_FFNIN, 0, L); add(PT_FIXUP, 0, L); add(PT_FOUT, 0, L);
    }
    add(PT_FINAL, 0, 0);
    return n;
}

extern "C" void kernel_launch(void* const* d_in, const int* in_sizes, int n_in, void* d_out, int out_size, void* d_ws, size_t ws_size, hipStream_t stream) {
    (void)in_sizes; (void)n_in; (void)out_size;
    static int grid_blocks = 0;
    if (!grid_blocks) {
        (void)hipFuncSetAttribute((const void*)mega, hipFuncAttributeMaxDynamicSharedMemorySize, LDS_BYTES);
        int dev = 0, cus = 0, per_cu = 0;
        (void)hipGetDevice(&dev);
        (void)hipDeviceGetAttribute(&cus, hipDeviceAttributeMultiprocessorCount, dev);
        (void)hipOccupancyMaxActiveBlocksPerMultiprocessor(&per_cu, mega, NTHR, LDS_BYTES);
        if (per_cu > 1) per_cu = 1;
        if (per_cu < 1) per_cu = 1;
        grid_blocks = (cus * per_cu) & ~7;
        if (grid_blocks < 8) grid_blocks = 8;
        if (ws_size < WS_NEED) fprintf(stderr, "workspace too small: %zu < %zu\n", ws_size, (size_t)WS_NEED);
    }
    Params p{};
    const float** pp = (const float**)&p;
    for (int i = 0; i < 18; ++i) pp[i] = (const float*)d_in[i];
    p.out = (float*)d_out;
    p.ws = (unsigned char*)d_ws;
    const int nph = build_program(p.desc);
#if MULTI_LAUNCH
    for (int ph = 0; ph < nph; ++ph) {
        p.ph_lo = ph; p.ph_hi = ph + 1;
        hipLaunchKernelGGL(mega, dim3(grid_blocks), dim3(NTHR), LDS_BYTES, stream, p);
    }
#else
    p.ph_lo = 0; p.ph_hi = nph;
    (void)hipMemsetAsync((unsigned char*)d_ws + OFF_BAR, 0, 16384, stream);
    void* args[] = {&p};
    hipError_t err = hipLaunchCooperativeKernel((const void*)mega, dim3(grid_blocks), dim3(NTHR), args, LDS_BYTES, stream);
    if (err != hipSuccess) fprintf(stderr, "cooperative launch failed: %s (grid %d)\n", hipGetErrorString(err), grid_blocks);
#endif
}
```

```cpp
#include <hip/hip_runtime.h>
#include <hip/hip_cooperative_groups.h>
#include <cstdio>
#include <cmath>
namespace cg = cooperative_groups;

typedef unsigned short u16;
typedef short bf16x8 __attribute__((ext_vector_type(8)));
typedef float f32x4 __attribute__((ext_vector_type(4)));

#ifndef NSA_PROBE_REP
#define NSA_PROBE_REP 0
#endif
#ifndef MULTI_LAUNCH
#define MULTI_LAUNCH 0
#endif

constexpr int S_ = 16384, T_ = 32768, D_ = 1024, DFF = 2816, NFF2 = 5632;
constexpr int NTHR = 512, NW = NTHR / 64;
constexpr int LDS_USER = NW * 16384 + NW * 1024 + NW * 256;
constexpr int LDS_BYTES = LDS_USER + 16;
constexpr float LOG2E = 1.4426950408889634f;
constexpr float NEGBIG = -1e30f;

constexpr size_t al256(size_t x) { return (x + 255) & ~(size_t)255; }
constexpr size_t SZ_WT_AIN = (size_t)2688 * 1024 * 2;
constexpr size_t SZ_WT_CW1 = (size_t)256 * 2048 * 2;
constexpr size_t SZ_WT_CW2 = (size_t)64 * 256 * 2;
constexpr size_t SZ_WT_SQ = (size_t)1024 * 1024 * 2;
constexpr size_t SZ_WT_KV = (size_t)256 * 1024 * 2;
constexpr size_t SZ_WT_FIN = (size_t)5632 * 1024 * 2;
constexpr size_t SZ_WT_FOUT = (size_t)1024 * 2816 * 2;
constexpr size_t OFF_WT_AIN = 0;
constexpr size_t OFF_WT_CW1 = OFF_WT_AIN + 2 * SZ_WT_AIN;
constexpr size_t OFF_WT_CW2 = OFF_WT_CW1 + 4 * SZ_WT_CW1;
constexpr size_t OFF_WT_AOUT = OFF_WT_CW2 + 4 * SZ_WT_CW2;
constexpr size_t OFF_WT_KV = OFF_WT_AOUT + 2 * SZ_WT_SQ;
constexpr size_t OFF_WT_BQ = OFF_WT_KV + SZ_WT_KV;
constexpr size_t OFF_WT_BOUT = OFF_WT_BQ + 2 * SZ_WT_SQ;
constexpr size_t OFF_WT_FIN = OFF_WT_BOUT + 2 * SZ_WT_SQ;
constexpr size_t OFF_WT_FOUT = OFF_WT_FIN + 4 * SZ_WT_FIN;
constexpr size_t OFF_COS = OFF_WT_FOUT + 4 * SZ_WT_FOUT;
constexpr size_t OFF_SIN = OFF_COS + (size_t)S_ * 32 * 4;
constexpr size_t OFF_CBIAS = OFF_SIN + (size_t)S_ * 32 * 4;
constexpr size_t OFF_HN = OFF_CBIAS + 4096;
constexpr size_t OFF_KSH = OFF_HN + (size_t)T_ * 1024 * 2;
constexpr size_t OFF_VSHT = OFF_KSH + (size_t)T_ * 128 * 2;
constexpr size_t OFF_HEAD = OFF_VSHT + (size_t)T_ * 128 * 2;
constexpr size_t OFF_HALO = OFF_HEAD + (size_t)256 * 2 * NFF2 * 4;
constexpr size_t OFF_R1 = OFF_HALO + (size_t)256 * 2 * NFF2 * 4;
constexpr size_t OFF_Q = OFF_R1;
constexpr size_t OFF_KC = OFF_Q + (size_t)T_ * 1024 * 2;
constexpr size_t OFF_VC = OFF_KC + (size_t)T_ * 256 * 2;
constexpr size_t OFF_KS = OFF_VC + (size_t)T_ * 256 * 2;
constexpr size_t OFF_VST = OFF_KS + (size_t)T_ * 256 * 2;
constexpr size_t OFF_KW = OFF_VST + (size_t)T_ * 256 * 2;
constexpr size_t OFF_VWT = OFF_KW + (size_t)T_ * 256 * 2;
constexpr size_t OFF_GATES = OFF_VWT + (size_t)T_ * 256 * 2;
constexpr size_t OFF_HID = OFF_GATES + (size_t)T_ * 48 * 4;
constexpr size_t OFF_KCC = OFF_HID + (size_t)2 * 8192 * 256 * 2;
constexpr size_t OFF_VCCT = OFF_KCC + (size_t)8 * 1024 * 64 * 2;
constexpr size_t OFF_O = OFF_VCCT + (size_t)8 * 1024 * 64 * 2;
constexpr size_t OFF_END = OFF_O + (size_t)T_ * 1024 * 2;
constexpr size_t OFF_BAR = OFF_END;
constexpr size_t WS_NEED = OFF_BAR + 16384;
constexpr size_t OFF_ACT = OFF_R1;
static_assert(OFF_ACT + (size_t)T_ * DFF * 2 <= OFF_END, "act alias");

struct Params {
    const float *x, *norm_attn, *norm_ffn, *a_w_in, *a_cmp_pos, *a_cmp_w1, *a_cmp_w2, *a_w_out, *kv_norm, *b_w_kv, *b_w_q, *b_sinks, *b_w_out,
        *ffn_w_in, *ffn_conv_w, *ffn_conv_b, *ffn_w_out, *final_norm;
    float* out;
    unsigned char* ws;
    int desc[48];
    int ph_lo, ph_hi;
};

__device__ __forceinline__ u16 f2bf(float f) {
    unsigned u = __float_as_uint(f);
    u += 0x7fffu + ((u >> 16) & 1u);
    return (u16)(u >> 16);
}
typedef __bf16 bf16x2_t __attribute__((ext_vector_type(2)));
typedef float f32x2_t __attribute__((ext_vector_type(2)));
__device__ __forceinline__ unsigned pack2(float lo, float hi) { f32x2_t v = {lo, hi}; bf16x2_t r = __builtin_convertvector(v, bf16x2_t); return __builtin_bit_cast(unsigned, r); }
typedef unsigned u32x4 __attribute__((ext_vector_type(4)));
__device__ __forceinline__ bf16x8 pack8(const float (&v)[8]) {
    u32x4 r;
    unsigned r0, r1, r2, r3;
    asm("v_cvt_pk_bf16_f32 %0, %4, %5\n\tv_cvt_pk_bf16_f32 %1, %6, %7\n\tv_cvt_pk_bf16_f32 %2, %8, %9\n\tv_cvt_pk_bf16_f32 %3, %10, %11\n\ts_nop 3"
        : "=&v"(r0), "=&v"(r1), "=&v"(r2), "=&v"(r3)
        : "v"(v[0]), "v"(v[1]), "v"(v[2]), "v"(v[3]), "v"(v[4]), "v"(v[5]), "v"(v[6]), "v"(v[7]));
    r[0] = r0; r[1] = r1; r[2] = r2; r[3] = r3;
    return __builtin_bit_cast(bf16x8, r);
}
__device__ __forceinline__ uint2 pack4(f32x4 v) { uint2 r; r.x = pack2(v[0], v[1]); r.y = pack2(v[2], v[3]); return r; }
__device__ __forceinline__ f32x4 unpack4(uint2 v) { return (f32x4){__uint_as_float(v.x << 16), __uint_as_float(v.x & 0xffff0000u), __uint_as_float(v.y << 16), __uint_as_float(v.y & 0xffff0000u)}; }
__device__ __forceinline__ unsigned pk4_fp8(float a, float b, float c, float d) { int r = __builtin_amdgcn_cvt_pk_fp8_f32(a, b, 0, false); r = __builtin_amdgcn_cvt_pk_fp8_f32(c, d, r, true); return (unsigned)r; }
__device__ __forceinline__ long pk8_fp8(const float (&v)[8]) { const unsigned lo = pk4_fp8(v[0], v[1], v[2], v[3]), hi = pk4_fp8(v[4], v[5], v[6], v[7]); return (long)(((unsigned long long)hi << 32) | lo); }
__device__ __forceinline__ f32x4 mfma8(long a, long b, f32x4 c) { return __builtin_amdgcn_mfma_f32_16x16x32_fp8_fp8(a, b, c, 0, 0, 0); }
__device__ __forceinline__ f32x4 mfma16(bf16x8 a, bf16x8 b, f32x4 c) { return __builtin_amdgcn_mfma_f32_16x16x32_bf16(a, b, c, 0, 0, 0); }
__device__ __forceinline__ float fexp2(float x) { return __builtin_amdgcn_exp2f(x); }
__device__ __forceinline__ void wsync() { __builtin_amdgcn_fence(__ATOMIC_ACQ_REL, "wavefront"); asm volatile("s_waitcnt lgkmcnt(0)" ::: "memory"); __builtin_amdgcn_wave_barrier(); }
typedef unsigned u32x2 __attribute__((ext_vector_type(2)));
__device__ __forceinline__ float xmax16(float x) { const unsigned u = __float_as_uint(x); const u32x2 r = __builtin_amdgcn_permlane16_swap(u, u, false, false); return fmaxf(__uint_as_float(r[0]), __uint_as_float(r[1])); }
__device__ __forceinline__ float xmax32(float x) { const unsigned u = __float_as_uint(x); const u32x2 r = __builtin_amdgcn_permlane32_swap(u, u, false, false); return fmaxf(__uint_as_float(r[0]), __uint_as_float(r[1])); }
template <int CTRL> __device__ __forceinline__ float dppf(float x) { return __int_as_float(__builtin_amdgcn_update_dpp(0, __float_as_int(x), CTRL, 0xf, 0xf, true)); }
__device__ __forceinline__ float wave_max(float x) {
    x = fmaxf(x, dppf<0xB1>(x)); x = fmaxf(x, dppf<0x4E>(x)); x = fmaxf(x, dppf<0x141>(x)); x = fmaxf(x, dppf<0x140>(x));
    return xmax32(xmax16(x));
}
__device__ __forceinline__ int kperm(int m) { return ((m >> 2) << 3) + (m & 3); }
__device__ __forceinline__ float sigmoidf_(float x) { return 1.f / (1.f + __expf(-x)); }
__device__ __forceinline__ float gelu_tanh(float x) {
    float u = 0.7978845608028654f * (x + 0.044715f * x * x * x);
    float e = __expf(2.f * u);
    float th = 1.f - 2.f / (e + 1.f);
    return 0.5f * x * (1.f + th);
}

__device__ __forceinline__ void cvt_transpose(const float* __restrict__ src, u16* __restrict__ dst, int K, int N, int Npad, int mode, unsigned char* smem, int tid_, int bid_) {
    const int half = tid_ >> 8, tid = tid_ & 255;
    float* ts = (float*)smem + half * (64 * 65);
    const int ntk = K >> 6, ntn = Npad >> 6, ntiles = ntk * ntn;
    for (int tile2 = bid_ * 2; tile2 < ntiles; tile2 += gridDim.x * 2) {
        const int tile = tile2 + half;
        const bool live = tile < ntiles;
        const int tk = live ? tile % ntk : 0, tn = live ? tile / ntk : 0;
        const int k0 = tk << 6, n0 = tn << 6;
        __syncthreads();
        if (live) {
#pragma unroll
            for (int i = 0; i < 4; ++i) {
                const int k = (tid >> 4) + 16 * i, n = (tid & 15) * 4;
                float4 v = make_float4(0.f, 0.f, 0.f, 0.f);
                if (n0 + n < N) v = *(const float4*)(src + (size_t)(k0 + k) * N + n0 + n);
                ts[k * 65 + n + 0] = v.x; ts[k * 65 + n + 1] = v.y; ts[k * 65 + n + 2] = v.z; ts[k * 65 + n + 3] = v.w;
            }
        }
        __syncthreads();
        if (!live) continue;
        const int n = tid >> 2, kq = (tid & 3) * 16;
        unsigned pk[8];
#pragma unroll
        for (int j = 0; j < 8; ++j) pk[j] = pack2(ts[(kq + 2 * j) * 65 + n], ts[(kq + 2 * j + 1) * 65 + n]);
        int drow;
        if (mode == 0) drow = n0 + n;
        else { const int nn = n0 + n; drow = (nn < DFF) ? ((nn >> 6) * 128 + (nn & 63)) : ((((nn - DFF) >> 6) * 128) + 64 + ((nn - DFF) & 63)); }
        uint4* dp = (uint4*)(dst + (size_t)drow * K + k0 + kq);
        dp[0] = make_uint4(pk[0], pk[1], pk[2], pk[3]);
        dp[1] = make_uint4(pk[4], pk[5], pk[6], pk[7]);
    }
}

__device__ __forceinline__ void prep_phase(const Params& p, unsigned char* smem, int tid_, int bid_) {
    unsigned char* ws = p.ws;
    for (int L = 0; L < 2; ++L) {
        cvt_transpose(p.a_w_in + (size_t)L * 1024 * 2608, (u16*)(ws + OFF_WT_AIN + L * SZ_WT_AIN), 1024, 2608, 2688, 0, smem, tid_, bid_);
        for (int kv = 0; kv < 2; ++kv) {
            cvt_transpose(p.a_cmp_w1 + (size_t)(L * 2 + kv) * 2048 * 256, (u16*)(ws + OFF_WT_CW1 + (L * 2 + kv) * SZ_WT_CW1), 2048, 256, 256, 0, smem, tid_, bid_);
            cvt_transpose(p.a_cmp_w2 + (size_t)(L * 2 + kv) * 256 * 64, (u16*)(ws + OFF_WT_CW2 + (L * 2 + kv) * SZ_WT_CW2), 256, 64, 64, 0, smem, tid_, bid_);
        }
        cvt_transpose(p.a_w_out + (size_t)L * 1024 * 1024, (u16*)(ws + OFF_WT_AOUT + L * SZ_WT_SQ), 1024, 1024, 1024, 0, smem, tid_, bid_);
        cvt_transpose(p.b_w_q + (size_t)L * 1024 * 1024, (u16*)(ws + OFF_WT_BQ + L * SZ_WT_SQ), 1024, 1024, 1024, 0, smem, tid_, bid_);
        cvt_transpose(p.b_w_out + (size_t)L * 1024 * 1024, (u16*)(ws + OFF_WT_BOUT + L * SZ_WT_SQ), 1024, 1024, 1024, 0, smem, tid_, bid_);
    }
    cvt_transpose(p.b_w_kv, (u16*)(ws + OFF_WT_KV), 1024, 256, 256, 0, smem, tid_, bid_);
    for (int L = 0; L < 4; ++L) {
        cvt_transpose(p.ffn_w_in + (size_t)L * 1024 * NFF2, (u16*)(ws + OFF_WT_FIN + L * SZ_WT_FIN), 1024, NFF2, NFF2, 1, smem, tid_, bid_);
        cvt_transpose(p.ffn_w_out + (size_t)L * DFF * 1024, (u16*)(ws + OFF_WT_FOUT + L * SZ_WT_FOUT), DFF, 1024, 1024, 0, smem, tid_, bid_);
    }
    {
        float* cosT = (float*)(ws + OFF_COS); float* sinT = (float*)(ws + OFF_SIN);
        const int gt = bid_ * NTHR + tid_, nt = gridDim.x * NTHR;
        for (int idx = gt; idx < S_ * 32; idx += nt) {
            const int pos = idx >> 5, i = idx & 31;
            const float ang = (float)pos * exp2f(-(float)i * (13.287712379549449f / 32.0f));
            double rev = (double)ang * 0.15915494309189535;
            rev -= rint(rev);
            const float fr = (float)rev;
            cosT[idx] = __builtin_amdgcn_cosf(fr);
            sinT[idx] = __builtin_amdgcn_sinf(fr);
        }
    }
    {
        float* cb = (float*)(ws + OFF_CBIAS);
        const int lane = tid_ & 63, w = tid_ >> 6;
        for (int task = bid_ * NW + w; task < 256; task += gridDim.x * NW) {
            const int lk = task >> 6, j4 = (task & 63) * 4;
            const float* pos = p.a_cmp_pos + (size_t)lk * 2048;
            const float* w1 = p.a_cmp_w1 + (size_t)lk * 2048 * 256;
            float4 a = make_float4(0.f, 0.f, 0.f, 0.f);
            for (int i = 0; i < 32; ++i) {
                const int k = lane + 64 * i;
                const float pv = pos[k];
                const float4 wv = *(const float4*)(w1 + (size_t)k * 256 + j4);
                a.x += pv * wv.x; a.y += pv * wv.y; a.z += pv * wv.z; a.w += pv * wv.w;
            }
#pragma unroll
            for (int off = 32; off >= 1; off >>= 1) {
                a.x += __shfl_xor(a.x, off); a.y += __shfl_xor(a.y, off); a.z += __shfl_xor(a.z, off); a.w += __shfl_xor(a.w, off);
            }
            if (lane == 0) *(float4*)(cb + lk * 256 + j4) = a;
        }
    }
}

template <bool OUT_F32>
__device__ __forceinline__ void norm_phase(const float* __restrict__ src, const float* __restrict__ g, u16* __restrict__ dst, float* __restrict__ dstf, int tid_, int bid_) {
    const int lane = tid_ & 63, w = tid_ >> 6;
    float4 gv[4];
#pragma unroll
    for (int i = 0; i < 4; ++i) gv[i] = *(const float4*)(g + lane * 4 + 256 * i);
    for (int row = bid_ * NW + w; row < T_; row += gridDim.x * NW) {
        const float* sp = src + (size_t)row * 1024;
        float4 v[4];
        float ss = 0.f;
#pragma unroll
        for (int i = 0; i < 4; ++i) { v[i] = *(const float4*)(sp + lane * 4 + 256 * i); ss += v[i].x * v[i].x + v[i].y * v[i].y + v[i].z * v[i].z + v[i].w * v[i].w; }
#pragma unroll
        for (int off = 32; off >= 1; off >>= 1) ss += __shfl_xor(ss, off);
        const float r = rsqrtf(ss * (1.f / 1024.f) + 1e-6f);
#pragma unroll
        for (int i = 0; i < 4; ++i) {
            f32x4 o = {v[i].x * r * gv[i].x, v[i].y * r * gv[i].y, v[i].z * r * gv[i].z, v[i].w * r * gv[i].w};
            if (OUT_F32) *(float4*)(dstf + (size_t)row * 1024 + lane * 4 + 256 * i) = make_float4(o[0], o[1], o[2], o[3]);
            else *(uint2*)(dst + (size_t)row * 1024 + lane * 4 + 256 * i) = pack4(o);
        }
    }
}

enum { AM_PLAIN = 0, AM_GATHER = 1 };
enum { EPI_AIN = 0, EPI_CMP1 = 1, EPI_RESID = 2, EPI_FFNIN = 3, EPI_BQ = 4, EPI_BKV = 5 };

struct EpiArgs {
    const float* resid; float* out;
    const float* bias; u16* hid;
    const float *convw, *convb;
    unsigned char* ws;
};

template <int NM>
__device__ __forceinline__ void rope_store(const f32x4 (&acc)[4][NM], int mi, u16* dstrow  , const float* cosT, const float* sinT, int pos, int q4) {
#pragma unroll
    for (int ni = 0; ni < 2; ++ni) {
        const int d = ni * 16 + q4 * 4;
        const float4 c = *(const float4*)(cosT + pos * 32 + d), s = *(const float4*)(sinT + pos * 32 + d);
        const f32x4 x1 = acc[ni][mi], x2 = acc[ni + 2][mi];
        f32x4 o1 = {x1[0] * c.x - x2[0] * s.x, x1[1] * c.y - x2[1] * s.y, x1[2] * c.z - x2[2] * s.z, x1[3] * c.w - x2[3] * s.w};
        f32x4 o2 = {x2[0] * c.x + x1[0] * s.x, x2[1] * c.y + x1[1] * s.y, x2[2] * c.z + x1[2] * s.z, x2[3] * c.w + x1[3] * s.w};
        *(uint2*)(dstrow + d) = pack4(o1);
        *(uint2*)(dstrow + d + 32) = pack4(o2);
    }
}

template <int AMODE, int EPI>
__device__ __forceinline__ void gemm_phase(const u16* __restrict__ A, int lda, const u16* __restrict__ Bt, int M, int Npad, int K, int vboff, const EpiArgs& e, unsigned char* smem, int tid_, int bid_) {
    const int tid = tid_, lane = tid & 63, w = tid >> 6, wm = w & 3, wn = w >> 2;
    const int c16 = lane & 15, q4 = lane >> 4;
    const int ntm = (M + 255) >> 8, ntn = Npad >> 7, nk = K >> 6;
    const int kstride = (AMODE == AM_GATHER) ? 256 : 64;
    const int ldc = tid & 7, ldr = tid >> 3;
    const unsigned wofs = ldr * 128 + ((ldc ^ ((ldr >> 1) & 7)) << 4);
    const int swz = (c16 >> 1) & 7;
    const float* cosT = (const float*)(e.ws + OFF_COS);
    const float* sinT = (const float*)(e.ws + OFF_SIN);
    int vb = bid_ + vboff; if (vb >= (int)gridDim.x) vb -= gridDim.x;
    const int xcd = vb & 7, loc = vb >> 3, nloc = gridDim.x >> 3;
    const int mpx = ntm >> 3, nfull = (ntn >> 3), bwl = ntn - (nfull << 3);
    const int tfull = nfull * mpx * 8, ttotal = mpx * ntn;
    for (int tl = loc; tl < ttotal; tl += nloc) {
        int mloc, nt;
        if (tl < tfull) { const int band = tl / (mpx * 8), r = tl - band * (mpx * 8); mloc = r >> 3; nt = band * 8 + (r & 7); }
        else { const int r = tl - tfull; mloc = r / bwl; nt = (nfull << 3) + (r - mloc * bwl); }
        const int mt = xcd * mpx + mloc;
        const int m0 = mt << 8, n0 = nt << 7;
        unsigned aoff[4];
#pragma unroll
        for (int i = 0; i < 4; ++i) {
            int m = m0 + ldr + 64 * i; if (m > M - 1) m = M - 1;
            if (AMODE == AM_GATHER) { const int g = m & 3, bn = m >> 2, b = bn / 1023, n = bn - b * 1023; aoff[i] = (unsigned)((b * S_ + n * 16) * 256 + g * 64 + ldc * 8); }
            else aoff[i] = (unsigned)m * (unsigned)lda + ldc * 8;
        }
        const u16* bp = Bt + (size_t)(n0 + ldr) * K + ldc * 8;
        u32x4 ra0[4], rb0[2], ra1[4], rb1[2];
        f32x4 acc[4][4];
#pragma unroll
        for (int a = 0; a < 4; ++a)
#pragma unroll
            for (int b = 0; b < 4; ++b) acc[a][b] = (f32x4){0.f, 0.f, 0.f, 0.f};
        auto g_load = [&](u32x4 (&RA)[4], u32x4 (&RB)[2], int KT) __attribute__((always_inline)) {
#pragma unroll
            for (int i = 0; i < 4; ++i) RA[i] = *(const u32x4*)(A + aoff[i] + KT * kstride);
#pragma unroll
            for (int i = 0; i < 2; ++i) RB[i] = *(const u32x4*)(bp + (size_t)i * 64 * K + KT * 64);
        };
        auto g_store = [&](const u32x4 (&RA)[4], const u32x4 (&RB)[2], int ST) __attribute__((always_inline)) {
            unsigned char* d_ = smem + ST * 49152;
#pragma unroll
            for (int i = 0; i < 4; ++i) *(u32x4*)(d_ + wofs + i * 8192) = RA[i];
#pragma unroll
            for (int i = 0; i < 2; ++i) *(u32x4*)(d_ + 32768 + wofs + i * 8192) = RB[i];
        };
        auto g_compute = [&](int ST) __attribute__((always_inline)) {
            const unsigned char* sA = smem + ST * 49152;
            const unsigned char* sB = sA + 32768;
#pragma unroll
            for (int ks = 0; ks < 2; ++ks) {
                bf16x8 wf[4], af[4];
                const int ch = ((ks * 4 + q4) ^ swz) << 4;
#pragma unroll
                for (int ni = 0; ni < 4; ++ni) wf[ni] = *(const bf16x8*)(sB + (wn * 64 + ni * 16 + c16) * 128 + ch);
#pragma unroll
                for (int mi = 0; mi < 4; ++mi) af[mi] = *(const bf16x8*)(sA + (wm * 64 + mi * 16 + c16) * 128 + ch);
#pragma unroll
                for (int ni = 0; ni < 4; ++ni)
#pragma unroll
                    for (int mi = 0; mi < 4; ++mi) acc[ni][mi] = mfma16(wf[ni], af[mi], acc[ni][mi]);
            }
        };
        g_load(ra0, rb0, 0);
        g_load(ra1, rb1, 1);
        g_store(ra0, rb0, 0);
        __syncthreads();
        for (int kt = 0; kt < nk; kt += 2) {
            if (kt + 2 < nk) g_load(ra0, rb0, kt + 2);
            g_compute(0);
            g_store(ra1, rb1, 1);
            __syncthreads();
            if (kt + 3 < nk) g_load(ra1, rb1, kt + 3);
            g_compute(1);
            if (kt + 2 < nk) g_store(ra0, rb0, 0);
            __syncthreads();
        }
        const int nb = n0 + wn * 64;
        if (EPI == EPI_RESID) {
#pragma unroll
            for (int mi = 0; mi < 4; ++mi) {
                const size_t tok = m0 + wm * 64 + mi * 16 + c16;
#pragma unroll
                for (int ni = 0; ni < 4; ++ni) {
                    const int n = nb + ni * 16 + q4 * 4;
                    float4 r = *(const float4*)(e.resid + tok * 1024 + n);
                    r.x += acc[ni][mi][0]; r.y += acc[ni][mi][1]; r.z += acc[ni][mi][2]; r.w += acc[ni][mi][3];
                    *(float4*)(e.out + tok * 1024 + n) = r;
                }
            }
        } else if (EPI == EPI_CMP1) {
#pragma unroll
            for (int mi = 0; mi < 4; ++mi) {
                const int m = m0 + wm * 64 + mi * 16 + c16;
                if (m < M) {
#pragma unroll
                    for (int ni = 0; ni < 4; ++ni) {
                        const int n = nb + ni * 16 + q4 * 4;
                        const float4 bv = *(const float4*)(e.bias + n);
                        f32x4 o = {gelu_tanh(acc[ni][mi][0] + bv.x), gelu_tanh(acc[ni][mi][1] + bv.y), gelu_tanh(acc[ni][mi][2] + bv.z), gelu_tanh(acc[ni][mi][3] + bv.w)};
                        *(uint2*)(e.hid + (size_t)m * 256 + n) = pack4(o);
                    }
                }
            }
        } else if (EPI == EPI_BQ) {
            u16* Q = (u16*)(e.ws + OFF_Q);
#pragma unroll
            for (int mi = 0; mi < 4; ++mi) {
                const int tok = m0 + wm * 64 + mi * 16 + c16;
                rope_store(acc, mi, Q + (size_t)tok * 1024 + nb, cosT, sinT, tok & (S_ - 1), q4);
            }
        } else if (EPI == EPI_BKV) {
            u16* KSH = (u16*)(e.ws + OFF_KSH); u16* VSHT = (u16*)(e.ws + OFF_VSHT);
#pragma unroll
            for (int mi = 0; mi < 4; ++mi) {
                const int tok = m0 + wm * 64 + mi * 16 + c16, b = tok >> 14, s = tok & (S_ - 1);
                if (nb < 128) {
                    const int g = nb >> 6;
                    rope_store(acc, mi, KSH + ((size_t)(b * 2 + g) * S_ + s) * 64, cosT, sinT, s, q4);
                } else {
                    const int g = (nb - 128) >> 6;
#pragma unroll
                    for (int ni = 0; ni < 4; ++ni)
#pragma unroll
                        for (int i = 0; i < 4; ++i) VSHT[((size_t)(b * 2 + g) * 64 + ni * 16 + q4 * 4 + i) * S_ + s] = f2bf(acc[ni][mi][i]);
                }
            }
        } else if (EPI == EPI_AIN) {
            unsigned char* ws = e.ws;
#pragma unroll
            for (int mi = 0; mi < 4; ++mi) {
                const int tok = m0 + wm * 64 + mi * 16 + c16, b = tok >> 14, s = tok & (S_ - 1);
                if (nb < 1024) {
                    rope_store(acc, mi, (u16*)(ws + OFF_Q) + (size_t)tok * 1024 + nb, cosT, sinT, s, q4);
                } else if (nb < 1536) {
                    u16* dst = (nb < 1280) ? ((u16*)(ws + OFF_KC) + (size_t)tok * 256 + (nb - 1024)) : ((u16*)(ws + OFF_VC) + (size_t)tok * 256 + (nb - 1280));
#pragma unroll
                    for (int ni = 0; ni < 4; ++ni) *(uint2*)(dst + ni * 16 + q4 * 4) = pack4(acc[ni][mi]);
                } else if (nb < 2560) {
                    const int r = (nb - 1536) >> 8;
                    const int g = ((nb - 1536) & 255) >> 6;
                    if (r == 0) {
                        unsigned char* kd = (unsigned char*)(ws + OFF_KS) + (size_t)(b * 4 + g) * S_ * 128 + (size_t)s * 64;
#pragma unroll
                        for (int ni = 0; ni < 2; ++ni) {
                            const int d = ni * 16 + q4 * 4;
                            const float4 c = *(const float4*)(cosT + s * 32 + d), sn = *(const float4*)(sinT + s * 32 + d);
                            const f32x4 x1 = acc[ni][mi], x2 = acc[ni + 2][mi];
                            *(unsigned*)(kd + d) = pk4_fp8(x1[0] * c.x - x2[0] * sn.x, x1[1] * c.y - x2[1] * sn.y, x1[2] * c.z - x2[2] * sn.z, x1[3] * c.w - x2[3] * sn.w);
                            *(unsigned*)(kd + d + 32) = pk4_fp8(x2[0] * c.x + x1[0] * sn.x, x2[1] * c.y + x1[1] * sn.y, x2[2] * c.z + x1[2] * sn.z, x2[3] * c.w + x1[3] * sn.w);
                        }
                    } else if (r == 2) {
                        u16* base = (u16*)(ws + OFF_KW);
                        rope_store(acc, mi, base + ((size_t)(b * 4 + g) * S_ + s) * 64, cosT, sinT, s, q4);
                    } else {
                        if (r == 1) {
                            unsigned char* base = (unsigned char*)(ws + OFF_VST) + (size_t)(b * 4 + g) * 128 * S_ + (size_t)(s >> 6) * 4096 + (s & 63);
#pragma unroll
                            for (int ni = 0; ni < 4; ++ni) {
                                const unsigned pk = pk4_fp8(acc[ni][mi][0], acc[ni][mi][1], acc[ni][mi][2], acc[ni][mi][3]);
#pragma unroll
                                for (int i = 0; i < 4; ++i) base[(ni * 16 + q4 * 4 + i) * 64] = (unsigned char)(pk >> (8 * i));
                            }
                        } else {
                            u16* base = (u16*)(ws + OFF_VWT);
#pragma unroll
                            for (int ni = 0; ni < 4; ++ni)
#pragma unroll
                                for (int i = 0; i < 4; ++i) base[((size_t)(b * 4 + g) * 64 + ni * 16 + q4 * 4 + i) * S_ + s] = f2bf(acc[ni][mi][i]);
                        }
                    }
                } else if (nb == 2560) {
                    float* G = (float*)(ws + OFF_GATES) + (size_t)tok * 48;
#pragma unroll
                    for (int ni = 0; ni < 3; ++ni) {
                        const int n = ni * 16 + q4 * 4;
                        *(float4*)(G + n) = make_float4(sigmoidf_(acc[ni][mi][0]), sigmoidf_(acc[ni][mi][1]), sigmoidf_(acc[ni][mi][2]), sigmoidf_(acc[ni][mi][3]));
                    }
                }
            }
        } else if (EPI == EPI_FFNIN) {
            float* U = (float*)smem;
#pragma unroll
            for (int mi = 0; mi < 4; ++mi) {
                const int row = wm * 64 + mi * 16 + c16;
#pragma unroll
                for (int ni = 0; ni < 4; ++ni) {
                    const int chunk = wn * 16 + ni * 4 + q4;
                    *(f32x4*)(U + row * 128 + ((chunk ^ (row & 31)) << 2)) = acc[ni][mi];
                }
            }
            __syncthreads();
            {
                const int ca = tid & 15, seg = tid >> 4;
                const int ncol = nt * 64 + ca * 4;
                const float4 w0a = *(const float4*)(e.convw + ncol), w1a = *(const float4*)(e.convw + NFF2 + ncol), w2a = *(const float4*)(e.convw + 2 * NFF2 + ncol);
                const float4 w0g = *(const float4*)(e.convw + DFF + ncol), w1g = *(const float4*)(e.convw + NFF2 + DFF + ncol), w2g = *(const float4*)(e.convw + 2 * NFF2 + DFF + ncol);
                const float4 ba = *(const float4*)(e.convb + ncol), bg = *(const float4*)(e.convb + DFF + ncol);
                float* head = (float*)(e.ws + OFF_HEAD); float* halo = (float*)(e.ws + OFF_HALO);
                u16* act = (u16*)(e.ws + OFF_ACT);
                const int r0 = seg * 8;
                float4 a2 = make_float4(0.f, 0.f, 0.f, 0.f), a1 = a2, g2 = a2, g1 = a2;
                if (seg > 0) {
                    const int rA = r0 - 2, rB = r0 - 1;
                    a2 = *(const float4*)(U + rA * 128 + ((ca ^ (rA & 31)) << 2)); g2 = *(const float4*)(U + rA * 128 + (((16 + ca) ^ (rA & 31)) << 2));
                    a1 = *(const float4*)(U + rB * 128 + ((ca ^ (rB & 31)) << 2)); g1 = *(const float4*)(U + rB * 128 + (((16 + ca) ^ (rB & 31)) << 2));
                }
#pragma unroll
                for (int r = 0; r < 8; ++r) {
                    const int row = r0 + r;
                    const float4 ua = *(const float4*)(U + row * 128 + ((ca ^ (row & 31)) << 2));
                    const float4 ug = *(const float4*)(U + row * 128 + (((16 + ca) ^ (row & 31)) << 2));
                    if (seg > 0 || r >= 2) {
                        float ca_[4], cg_[4];
                        ca_[0] = ba.x + w0a.x * a2.x + w1a.x * a1.x + w2a.x * ua.x; ca_[1] = ba.y + w0a.y * a2.y + w1a.y * a1.y + w2a.y * ua.y;
                        ca_[2] = ba.z + w0a.z * a2.z + w1a.z * a1.z + w2a.z * ua.z; ca_[3] = ba.w + w0a.w * a2.w + w1a.w * a1.w + w2a.w * ua.w;
                        cg_[0] = bg.x + w0g.x * g2.x + w1g.x * g1.x + w2g.x * ug.x; cg_[1] = bg.y + w0g.y * g2.y + w1g.y * g1.y + w2g.y * ug.y;
                        cg_[2] = bg.z + w0g.z * g2.z + w1g.z * g1.z + w2g.z * ug.z; cg_[3] = bg.w + w0g.w * g2.w + w1g.w * g1.w + w2g.w * ug.w;
                        f32x4 o = {ca_[0] * sigmoidf_(ca_[0]) * cg_[0], ca_[1] * sigmoidf_(ca_[1]) * cg_[1], ca_[2] * sigmoidf_(ca_[2]) * cg_[2], ca_[3] * sigmoidf_(ca_[3]) * cg_[3]};
                        *(uint2*)(act + (size_t)(m0 + row) * DFF + ncol) = pack4(o);
                    }
                    if (seg == 0 && r < 2) { *(float4*)(head + (size_t)(mt * 2 + r) * NFF2 + ncol) = ua; *(float4*)(head + (size_t)(mt * 2 + r) * NFF2 + DFF + ncol) = ug; }
                    if (seg == 31 && r >= 6) { *(float4*)(halo + (size_t)(mt * 2 + r - 6) * NFF2 + ncol) = ua; *(float4*)(halo + (size_t)(mt * 2 + r - 6) * NFF2 + DFF + ncol) = ug; }
                    a2 = a1; a1 = ua; g2 = g1; g1 = ug;
                }
            }
            __syncthreads();
        }
    }
}

template <int AMODE, int EPI>
__device__ __forceinline__ void gemm_big(const u16* __restrict__ A, int lda, const u16* __restrict__ Bt, int M, int Npad, int K, int vboff, const EpiArgs& e, unsigned char* smem, int tid_, int bid_) {
    const int tid = tid_, lane = tid & 63, w = tid >> 6, wm = w & 1, wn = w >> 1;
    const int c16 = lane & 15, q4 = lane >> 4;
    constexpr int MI = 8;
    const int ntm = (M + 255) >> 8, ntn = Npad >> 8, nk = K >> 5;
    const int kstride = (AMODE == AM_GATHER) ? 128 : 32;
    const float* cosT = (const float*)(e.ws + OFF_COS);
    const float* sinT = (const float*)(e.ws + OFF_SIN);
    int vb = bid_ + vboff; if (vb >= (int)gridDim.x) vb -= gridDim.x;
    const int xcd = vb & 7, loc = vb >> 3, nloc = gridDim.x >> 3;
    const int mpx = ntm >> 3, nfull = (ntn >> 3), bwl = ntn - (nfull << 3);
    const int tfull = nfull * mpx * 8, ttotal = mpx * ntn;
    for (int tl = loc; tl < ttotal; tl += nloc) {
        int mloc, nt;
        if (tl < tfull) { const int band = tl / (mpx * 8), r = tl - band * (mpx * 8); mloc = r >> 3; nt = band * 8 + (r & 7); }
        else { const int r = tl - tfull; mloc = r / bwl; nt = (nfull << 3) + (r - mloc * bwl); }
        const int mt = xcd * mpx + mloc;
        const int m0 = mt << 8, n0 = nt << 8;
        const int prow = ((w & 3) << 6) + (lane >> 3);
        const int pch = lane & 7;
        unsigned goff[8];
#pragma unroll
        for (int i = 0; i < 8; ++i) {
            const int row = prow + 8 * i;
            const int lc = pch ^ ((row >> 1) & 7);
            if (w < 4) {
                int m = m0 + row; if (m > M - 1) m = M - 1;
                if (AMODE == AM_GATHER) { const int gq = m & 3, bn = m >> 2, bb = bn / 1023, n = bn - bb * 1023; goff[i] = (unsigned)((bb * S_ + n * 16) * 256 + gq * 64 + lc * 8); }
                else goff[i] = (unsigned)m * (unsigned)lda + (unsigned)(lc * 8);
            } else goff[i] = (unsigned)(n0 + row) * (unsigned)K + (unsigned)(lc * 8);
        }
        const u16* gbase = (w < 4) ? A : Bt;
        const unsigned kst = (w < 4 && AMODE == AM_GATHER) ? 256u : 64u;
        typedef __attribute__((address_space(3))) unsigned* lds_u32p;
        const unsigned lbase = ((w < 4) ? 0u : 32768u) + (unsigned)(((w & 3) << 6) * 128) + (unsigned)lane * 16u;
        f32x4 acc[4][MI];
#pragma unroll
        for (int a2 = 0; a2 < 4; ++a2)
#pragma unroll
            for (int b2 = 0; b2 < MI; ++b2) acc[a2][b2] = (f32x4){0.f, 0.f, 0.f, 0.f};
        const int swz = (c16 >> 1) & 7;
        const int nk2 = nk >> 1;
#pragma unroll
        for (int i = 0; i < 8; ++i) __builtin_amdgcn_global_load_lds((const unsigned*)(gbase + goff[i]), (lds_u32p)(smem + lbase + i * 1024), 16, 0, 0);
        for (int kt = 0; kt < nk2; ++kt) {
            asm volatile("s_waitcnt vmcnt(0)" ::: "memory");
            __builtin_amdgcn_s_barrier();
            const unsigned char* sA = smem + (kt & 1) * 65536;
            const unsigned char* sB = sA + 32768;
            const bool more = kt + 1 < nk2;
            const unsigned ko = (unsigned)(kt + 1) * kst;
            unsigned char* sbn = smem + ((kt + 1) & 1) * 65536 + lbase;
#pragma unroll
            for (int ks = 0; ks < 2; ++ks) {
                bf16x8 wf[4], af[MI];
                const int ch = ((ks * 4 + q4) ^ swz) << 4;
#pragma unroll
                for (int ni = 0; ni < 4; ++ni) wf[ni] = *(const bf16x8*)(sB + (wn * 64 + ni * 16 + c16) * 128 + ch);
#pragma unroll
                for (int mi = 0; mi < MI; ++mi) af[mi] = *(const bf16x8*)(sA + (wm * 128 + mi * 16 + c16) * 128 + ch);
#pragma unroll
                for (int ni = 0; ni < 4; ++ni) {
                    if (more) __builtin_amdgcn_global_load_lds((const unsigned*)(gbase + (goff[ks * 4 + ni] + ko)), (lds_u32p)(sbn + (ks * 4 + ni) * 1024), 16, 0, 0);
#pragma unroll
                    for (int mi = 0; mi < MI; ++mi) acc[ni][mi] = mfma16(wf[ni], af[mi], acc[ni][mi]);
                }
            }
        }
        __syncthreads();
        const int nb = n0 + wn * 64;
        if (EPI == EPI_RESID) {
#pragma unroll
            for (int mi = 0; mi < MI; ++mi) { __builtin_amdgcn_sched_barrier(0);
                const size_t tok = m0 + wm * 128 + mi * 16 + c16;
#pragma unroll
                for (int ni = 0; ni < 4; ++ni) {
                    const int n = nb + ni * 16 + q4 * 4;
                    float4 r = *(const float4*)(e.resid + tok * 1024 + n);
                    r.x += acc[ni][mi][0]; r.y += acc[ni][mi][1]; r.z += acc[ni][mi][2]; r.w += acc[ni][mi][3];
                    *(float4*)(e.out + tok * 1024 + n) = r;
                }
            }
        } else if (EPI == EPI_CMP1) {
#pragma unroll
            for (int mi = 0; mi < MI; ++mi) { __builtin_amdgcn_sched_barrier(0);
                const int m = m0 + wm * 128 + mi * 16 + c16;
                if (m < M) {
#pragma unroll
                    for (int ni = 0; ni < 4; ++ni) {
                        const int n = nb + ni * 16 + q4 * 4;
                        const float4 bv = *(const float4*)(e.bias + n);
                        f32x4 o = {gelu_tanh(acc[ni][mi][0] + bv.x), gelu_tanh(acc[ni][mi][1] + bv.y), gelu_tanh(acc[ni][mi][2] + bv.z), gelu_tanh(acc[ni][mi][3] + bv.w)};
                        *(uint2*)(e.hid + (size_t)m * 256 + n) = pack4(o);
                    }
                }
            }
        } else if (EPI == EPI_BQ) {
            u16* Q = (u16*)(e.ws + OFF_Q);
#pragma unroll
            for (int mi = 0; mi < MI; ++mi) { __builtin_amdgcn_sched_barrier(0);
                const int tok = m0 + wm * 128 + mi * 16 + c16;
                rope_store(acc, mi, Q + (size_t)tok * 1024 + nb, cosT, sinT, tok & (S_ - 1), q4);
            }
        } else if (EPI == EPI_BKV) {
            u16* KSH = (u16*)(e.ws + OFF_KSH); u16* VSHT = (u16*)(e.ws + OFF_VSHT);
#pragma unroll
            for (int mi = 0; mi < MI; ++mi) { __builtin_amdgcn_sched_barrier(0);
                const int tok = m0 + wm * 128 + mi * 16 + c16, b = tok >> 14, s = tok & (S_ - 1);
                if (nb < 128) {
                    const int g = nb >> 6;
                    rope_store(acc, mi, KSH + ((size_t)(b * 2 + g) * S_ + s) * 64, cosT, sinT, s, q4);
                } else {
                    const int g = (nb - 128) >> 6;
#pragma unroll
                    for (int ni = 0; ni < 4; ++ni)
#pragma unroll
                        for (int i = 0; i < 4; ++i) VSHT[((size_t)(b * 2 + g) * 64 + ni * 16 + q4 * 4 + i) * S_ + s] = f2bf(acc[ni][mi][i]);
                }
            }
        } else if (EPI == EPI_AIN) {
            unsigned char* ws = e.ws;
#pragma unroll
            for (int mi = 0; mi < MI; ++mi) { __builtin_amdgcn_sched_barrier(0);
                const int tok = m0 + wm * 128 + mi * 16 + c16, b = tok >> 14, s = tok & (S_ - 1);
                if (nb < 1024) {
                    rope_store(acc, mi, (u16*)(ws + OFF_Q) + (size_t)tok * 1024 + nb, cosT, sinT, s, q4);
                } else if (nb < 1536) {
                    u16* dst = (nb < 1280) ? ((u16*)(ws + OFF_KC) + (size_t)tok * 256 + (nb - 1024)) : ((u16*)(ws + OFF_VC) + (size_t)tok * 256 + (nb - 1280));
#pragma unroll
                    for (int ni = 0; ni < 4; ++ni) *(uint2*)(dst + ni * 16 + q4 * 4) = pack4(acc[ni][mi]);
                } else if (nb < 2560) {
                    const int r = (nb - 1536) >> 8;
                    const int g = ((nb - 1536) & 255) >> 6;
                    if (r == 0) {
                        unsigned char* kd = (unsigned char*)(ws + OFF_KS) + (size_t)(b * 4 + g) * S_ * 128 + (size_t)s * 64;
#pragma unroll
                        for (int ni = 0; ni < 2; ++ni) {
                            const int d = ni * 16 + q4 * 4;
                            const float4 c = *(const float4*)(cosT + s * 32 + d), sn = *(const float4*)(sinT + s * 32 + d);
                            const f32x4 x1 = acc[ni][mi], x2 = acc[ni + 2][mi];
                            *(unsigned*)(kd + d) = pk4_fp8(x1[0] * c.x - x2[0] * sn.x, x1[1] * c.y - x2[1] * sn.y, x1[2] * c.z - x2[2] * sn.z, x1[3] * c.w - x2[3] * sn.w);
                            *(unsigned*)(kd + d + 32) = pk4_fp8(x2[0] * c.x + x1[0] * sn.x, x2[1] * c.y + x1[1] * sn.y, x2[2] * c.z + x1[2] * sn.z, x2[3] * c.w + x1[3] * sn.w);
                        }
                    } else if (r == 2) {
                        u16* base = (u16*)(ws + OFF_KW);
                        rope_store(acc, mi, base + ((size_t)(b * 4 + g) * S_ + s) * 64, cosT, sinT, s, q4);
                    } else {
                        if (r == 1) {
                            unsigned char* base = (unsigned char*)(ws + OFF_VST) + (size_t)(b * 4 + g) * 128 * S_ + (size_t)(s >> 6) * 4096 + (s & 63);
#pragma unroll
                            for (int ni = 0; ni < 4; ++ni) {
                                const unsigned pk = pk4_fp8(acc[ni][mi][0], acc[ni][mi][1], acc[ni][mi][2], acc[ni][mi][3]);
#pragma unroll
                                for (int i = 0; i < 4; ++i) base[(ni * 16 + q4 * 4 + i) * 64] = (unsigned char)(pk >> (8 * i));
                            }
                        } else {
                            u16* base = (u16*)(ws + OFF_VWT);
#pragma unroll
                            for (int ni = 0; ni < 4; ++ni)
#pragma unroll
                                for (int i = 0; i < 4; ++i) base[((size_t)(b * 4 + g) * 64 + ni * 16 + q4 * 4 + i) * S_ + s] = f2bf(acc[ni][mi][i]);
                        }
                    }
                } else if (nb == 2560) {
                    float* G = (float*)(ws + OFF_GATES) + (size_t)tok * 48;
#pragma unroll
                    for (int ni = 0; ni < 3; ++ni) {
                        const int n = ni * 16 + q4 * 4;
                        *(float4*)(G + n) = make_float4(sigmoidf_(acc[ni][mi][0]), sigmoidf_(acc[ni][mi][1]), sigmoidf_(acc[ni][mi][2]), sigmoidf_(acc[ni][mi][3]));
                    }
                }
            }
        } else if (EPI == EPI_FFNIN) {
            u16* U = (u16*)smem;
#pragma unroll
            for (int mi = 0; mi < MI; ++mi) {
                const int row = wm * 128 + mi * 16 + c16;
#pragma unroll
                for (int ni = 0; ni < 4; ++ni) {
                    const int cch = wn * 16 + ni * 4 + q4;
                    *(uint2*)(U + row * 256 + ((cch ^ (row & 15)) << 2)) = pack4(acc[ni][mi]);
                }
            }
            __syncthreads();
            {
                const int cc = tid & 31, gsel = cc >> 4, ca = cc & 15, seg = tid >> 5;
                const int ncol = (nt * 2 + gsel) * 64 + ca * 4;
                const int cha = gsel * 32 + ca, chg = cha + 16;
                const float4 w0a = *(const float4*)(e.convw + ncol), w1a = *(const float4*)(e.convw + NFF2 + ncol), w2a = *(const float4*)(e.convw + 2 * NFF2 + ncol);
                const float4 w0g = *(const float4*)(e.convw + DFF + ncol), w1g = *(const float4*)(e.convw + NFF2 + DFF + ncol), w2g = *(const float4*)(e.convw + 2 * NFF2 + DFF + ncol);
                const float4 ba = *(const float4*)(e.convb + ncol), bg = *(const float4*)(e.convb + DFF + ncol);
                float* head = (float*)(e.ws + OFF_HEAD); float* halo = (float*)(e.ws + OFF_HALO);
                u16* act = (u16*)(e.ws + OFF_ACT);
                auto ldu = [&](int row, int ch) __attribute__((always_inline)) -> float4 {
                    const uint2 v = *(const uint2*)(U + row * 256 + ((ch ^ (row & 15)) << 2));
                    return make_float4(__uint_as_float(v.x << 16), __uint_as_float(v.x & 0xffff0000u), __uint_as_float(v.y << 16), __uint_as_float(v.y & 0xffff0000u));
                };
                const int r0 = seg * 16;
                float4 a2 = make_float4(0.f, 0.f, 0.f, 0.f), a1 = a2, g2 = a2, g1 = a2;
                if (seg > 0) { a2 = ldu(r0 - 2, cha); g2 = ldu(r0 - 2, chg); a1 = ldu(r0 - 1, cha); g1 = ldu(r0 - 1, chg); }
#pragma unroll 2
                for (int r = 0; r < 16; ++r) {
                    const int row = r0 + r;
                    const float4 ua = ldu(row, cha), ug = ldu(row, chg);
                    if (seg > 0 || r >= 2) {
                        float ca_[4], cg_[4];
                        ca_[0] = ba.x + w0a.x * a2.x + w1a.x * a1.x + w2a.x * ua.x; ca_[1] = ba.y + w0a.y * a2.y + w1a.y * a1.y + w2a.y * ua.y;
                        ca_[2] = ba.z + w0a.z * a2.z + w1a.z * a1.z + w2a.z * ua.z; ca_[3] = ba.w + w0a.w * a2.w + w1a.w * a1.w + w2a.w * ua.w;
                        cg_[0] = bg.x + w0g.x * g2.x + w1g.x * g1.x + w2g.x * ug.x; cg_[1] = bg.y + w0g.y * g2.y + w1g.y * g1.y + w2g.y * ug.y;
                        cg_[2] = bg.z + w0g.z * g2.z + w1g.z * g1.z + w2g.z * ug.z; cg_[3] = bg.w + w0g.w * g2.w + w1g.w * g1.w + w2g.w * ug.w;
                        f32x4 o = {ca_[0] * sigmoidf_(ca_[0]) * cg_[0], ca_[1] * sigmoidf_(ca_[1]) * cg_[1], ca_[2] * sigmoidf_(ca_[2]) * cg_[2], ca_[3] * sigmoidf_(ca_[3]) * cg_[3]};
                        *(uint2*)(act + (size_t)(m0 + row) * DFF + ncol) = pack4(o);
                    }
                    if (seg == 0 && r < 2) { *(float4*)(head + (size_t)(mt * 2 + r) * NFF2 + ncol) = ua; *(float4*)(head + (size_t)(mt * 2 + r) * NFF2 + DFF + ncol) = ug; }
                    if (seg == 15 && r >= 14) { *(float4*)(halo + (size_t)(mt * 2 + r - 14) * NFF2 + ncol) = ua; *(float4*)(halo + (size_t)(mt * 2 + r - 14) * NFF2 + DFF + ncol) = ug; }
                    a2 = a1; a1 = ua; g2 = g1; g1 = ug;
                }
            }
            __syncthreads();
        }
    }
}

__device__ __forceinline__ void fixup_phase(const Params& p, int L, int tid_, int bid_) {
    const float* head = (const float*)(p.ws + OFF_HEAD); const float* halo = (const float*)(p.ws + OFF_HALO);
    u16* act = (u16*)(p.ws + OFF_ACT);
    const float* cw = p.ffn_conv_w + (size_t)L * 3 * NFF2; const float* cb = p.ffn_conv_b + (size_t)L * NFF2;
    const int gt = bid_ * NTHR + tid_, nthr = gridDim.x * NTHR;
    for (int idx = gt; idx < 128 * 704; idx += nthr) {
        const int i = idx / 704, n = (idx - i * 704) * 4;
        const int t0 = i * 256;
        const bool first = (t0 & (S_ - 1)) == 0;
        const float4 z = make_float4(0.f, 0.f, 0.f, 0.f);
        const float4 ha0 = *(const float4*)(head + (size_t)(i * 2) * NFF2 + n), ha1 = *(const float4*)(head + (size_t)(i * 2 + 1) * NFF2 + n);
        const float4 hg0 = *(const float4*)(head + (size_t)(i * 2) * NFF2 + DFF + n), hg1 = *(const float4*)(head + (size_t)(i * 2 + 1) * NFF2 + DFF + n);
        float4 pa0 = z, pa1 = z, pg0 = z, pg1 = z;
        if (!first) {
            pa0 = *(const float4*)(halo + (size_t)(i * 2 - 2) * NFF2 + n); pa1 = *(const float4*)(halo + (size_t)(i * 2 - 1) * NFF2 + n);
            pg0 = *(const float4*)(halo + (size_t)(i * 2 - 2) * NFF2 + DFF + n); pg1 = *(const float4*)(halo + (size_t)(i * 2 - 1) * NFF2 + DFF + n);
        }
        const float4 w0a = *(const float4*)(cw + n), w1a = *(const float4*)(cw + NFF2 + n), w2a = *(const float4*)(cw + 2 * NFF2 + n);
        const float4 w0g = *(const float4*)(cw + DFF + n), w1g = *(const float4*)(cw + NFF2 + DFF + n), w2g = *(const float4*)(cw + 2 * NFF2 + DFF + n);
        const float4 ba = *(const float4*)(cb + n), bg = *(const float4*)(cb + DFF + n);
#define CONV3(b_, w0_, w1_, w2_, x0_, x1_, x2_) make_float4(b_.x + w0_.x * x0_.x + w1_.x * x1_.x + w2_.x * x2_.x, b_.y + w0_.y * x0_.y + w1_.y * x1_.y + w2_.y * x2_.y, \
                                                             b_.z + w0_.z * x0_.z + w1_.z * x1_.z + w2_.z * x2_.z, b_.w + w0_.w * x0_.w + w1_.w * x1_.w + w2_.w * x2_.w)
        const float4 ca0 = CONV3(ba, w0a, w1a, w2a, pa0, pa1, ha0), cg0 = CONV3(bg, w0g, w1g, w2g, pg0, pg1, hg0);
        const float4 ca1 = CONV3(ba, w0a, w1a, w2a, pa1, ha0, ha1), cg1 = CONV3(bg, w0g, w1g, w2g, pg1, hg0, hg1);
        f32x4 o0 = {ca0.x * sigmoidf_(ca0.x) * cg0.x, ca0.y * sigmoidf_(ca0.y) * cg0.y, ca0.z * sigmoidf_(ca0.z) * cg0.z, ca0.w * sigmoidf_(ca0.w) * cg0.w};
        f32x4 o1 = {ca1.x * sigmoidf_(ca1.x) * cg1.x, ca1.y * sigmoidf_(ca1.y) * cg1.y, ca1.z * sigmoidf_(ca1.z) * cg1.z, ca1.w * sigmoidf_(ca1.w) * cg1.w};
        *(uint2*)(act + (size_t)t0 * DFF + n) = pack4(o0);
        *(uint2*)(act + (size_t)(t0 + 1) * DFF + n) = pack4(o1);
    }
}

__device__ __forceinline__ void cmp2_phase(const Params& p, int L, int tid_, int bid_) {
    const int lane = tid_ & 63, w = tid_ >> 6, c16 = lane & 15, q4 = lane >> 4;
    const float* cosT = (const float*)(p.ws + OFF_COS); const float* sinT = (const float*)(p.ws + OFF_SIN);
    u16* KCC = (u16*)(p.ws + OFF_KCC); u16* VCCT = (u16*)(p.ws + OFF_VCCT);
    for (int task = bid_ * NW + w; task < 1024; task += gridDim.x * NW) {
        const int kv = task >> 9, r0 = (task & 511) * 16;
        const u16* hid = (const u16*)(p.ws + OFF_HID) + (size_t)kv * 8192 * 256;
        const u16* w2t = (const u16*)(p.ws + OFF_WT_CW2 + (L * 2 + kv) * SZ_WT_CW2);
        const int row = r0 + c16, rowc = row < 8184 ? row : 8183;
        f32x4 acc[4][1];
        f32x4 accq[4][4];
#pragma unroll
        for (int a = 0; a < 4; ++a) accq[a][0] = (f32x4){0.f, 0.f, 0.f, 0.f};
#pragma unroll
        for (int kk = 0; kk < 8; ++kk) {
            const bf16x8 bfr = *(const bf16x8*)(hid + (size_t)rowc * 256 + kk * 32 + q4 * 8);
#pragma unroll
            for (int nbk = 0; nbk < 4; ++nbk) {
                const bf16x8 afr = *(const bf16x8*)(w2t + (nbk * 16 + c16) * 256 + kk * 32 + q4 * 8);
                accq[nbk][0] = mfma16(afr, bfr, accq[nbk][0]);
            }
        }
        (void)acc;
        if (row < 8184) {
            const int g = row & 3, bn = row >> 2, b = bn / 1023, n = bn - b * 1023, bg = b * 4 + g;
            if (kv == 0) {
                rope_store(accq, 0, KCC + ((size_t)bg * 1024 + n) * 64, cosT, sinT, n * 16 + 31, q4);
            } else {
#pragma unroll
                for (int nbk = 0; nbk < 4; ++nbk)
#pragma unroll
                    for (int i = 0; i < 4; ++i) VCCT[((size_t)bg * 64 + nbk * 16 + q4 * 4 + i) * 1024 + n] = f2bf(accq[nbk][0][i]);
            }
        }
    }
    const int gt = bid_ * NTHR + tid_;
    if (gt < 512) {
        const int bg = gt >> 6, d = gt & 63;
        KCC[((size_t)bg * 1024 + 1023) * 64 + d] = 0;
        VCCT[((size_t)bg * 64 + d) * 1024 + 1023] = 0;
    }
}

template <bool SINK>
__device__ __forceinline__ void band_attn(const u16* __restrict__ qrow, const u16* __restrict__ Kh, const u16* __restrict__ VT, int t0, int W, const float* sinks4,
                                          f32x4 (&O)[4][4], float (&linv)[4], int lane) {
    const int c16 = lane & 15, q4 = lane >> 4;
    const float SC = 0.125f * LOG2E;
    bf16x8 qf[4][2];
#pragma unroll
    for (int h = 0; h < 4; ++h)
#pragma unroll
        for (int ks = 0; ks < 2; ++ks) qf[h][ks] = *(const bf16x8*)(qrow + h * 64 + ks * 32 + q4 * 8);
    float m[4], l[4];
#pragma unroll
    for (int h = 0; h < 4; ++h) {
        if (SINK) { m[h] = sinks4[h] * LOG2E; l[h] = (q4 == 0) ? 1.f : 0.f; }
        else { m[h] = NEGBIG; l[h] = 0.f; }
#pragma unroll
        for (int db = 0; db < 4; ++db) O[h][db] = (f32x4){0.f, 0.f, 0.f, 0.f};
    }
    const int t = t0 + c16;
    int lo = t0 - W + 1; if (lo < 0) lo = 0;
    const int g0 = lo >> 5, g1 = (t0 + 15) >> 5;
    const int kr = kperm(c16);
    for (int grp = g0; grp <= g1; ++grp) {
        const int kb = grp << 5;
        const unsigned kof = (unsigned)(kb + kr) * 64u + (unsigned)q4 * 8u;
        const bf16x8 k1a = *(const bf16x8*)(Kh + kof), k1b = *(const bf16x8*)(Kh + (kof + 32u)), k2a = *(const bf16x8*)(Kh + (kof + 256u)), k2b = *(const bf16x8*)(Kh + (kof + 288u));
        bf16x8 vf[4];
        const unsigned vof = (unsigned)c16 * (unsigned)S_ + (unsigned)kb + (unsigned)q4 * 8u;
#pragma unroll
        for (int db = 0; db < 4; ++db) vf[db] = *(const bf16x8*)(VT + (size_t)(db * 16 * S_) + vof);
        const int kpos = kb + q4 * 8;
        f32x4 cm1 = {0.f, 0.f, 0.f, 0.f}, cm2 = cm1;
        if (!((kb + 31 <= t0) && (kb > t0 + 15 - W))) {
#pragma unroll
            for (int i = 0; i < 4; ++i) {
                const int d1 = t - (kpos + i), d2 = t - (kpos + 4 + i);
                if (!((d1 >= 0) && (d1 < W))) cm1[i] = NEGBIG;
                if (!((d2 >= 0) && (d2 < W))) cm2[i] = NEGBIG;
            }
        }
#pragma unroll
        for (int h = 0; h < 4; ++h) {
            f32x4 s1 = mfma16(k1a, qf[h][0], cm1); s1 = mfma16(k1b, qf[h][1], s1);
            f32x4 s2 = mfma16(k2a, qf[h][0], cm2); s2 = mfma16(k2b, qf[h][1], s2);
            float mx = fmaxf(fmaxf(fmaxf(s1[0], s1[1]), fmaxf(s1[2], s1[3])), fmaxf(fmaxf(s2[0], s2[1]), fmaxf(s2[2], s2[3])));
            mx = xmax32(xmax16(mx));
            const float mn = fmaxf(fmaxf(m[h], mx * SC), -1e20f);
            if (__ballot(mn != m[h])) {
                const float alpha = fexp2(m[h] - mn);
                l[h] *= alpha;
#pragma unroll
                for (int db = 0; db < 4; ++db) O[h][db] = O[h][db] * alpha;
            }
            m[h] = mn;
            float pv[8]; float ps = 0.f;
#pragma unroll
            for (int i = 0; i < 4; ++i) { pv[i] = fexp2(fmaf(s1[i], SC, -mn)); pv[4 + i] = fexp2(fmaf(s2[i], SC, -mn)); }
#pragma unroll
            for (int i = 0; i < 8; ++i) ps += pv[i];
            l[h] += ps;
            const bf16x8 pf = pack8(pv);
#pragma unroll
            for (int db = 0; db < 4; ++db) O[h][db] = mfma16(vf[db], pf, O[h][db]);
        }
    }
#pragma unroll
    for (int h = 0; h < 4; ++h) { float lt = l[h]; lt += __shfl_xor(lt, 16); lt += __shfl_xor(lt, 32); linv[h] = 1.f / lt; }
}

__device__ __forceinline__ void swa_phase(const Params& p, int j, int tid_, int bid_) {
    const int lane = tid_ & 63, w = tid_ >> 6, c16 = lane & 15, q4 = lane >> 4;
    const int x = bid_ & 7, b = x >> 2, kvh = (x >> 1) & 1, hq = x & 1;
    const int head0 = kvh * 8 + hq * 4;
    const u16* Q = (const u16*)(p.ws + OFF_Q); u16* Ob = (u16*)(p.ws + OFF_O);
    const u16* Kh = (const u16*)(p.ws + OFF_KSH) + (size_t)(b * 2 + kvh) * S_ * 64;
    const u16* VT = (const u16*)(p.ws + OFF_VSHT) + (size_t)(b * 2 + kvh) * 64 * S_;
    const float* sk = p.b_sinks + j * 16 + head0;
    const int nslots = (gridDim.x >> 3) * NW;
    for (int tile = (bid_ >> 3) * NW + w; tile < 1024; tile += nslots) {
        const int t0 = tile * 16;
        f32x4 O[4][4]; float linv[4];
        band_attn<true>(Q + ((size_t)b * S_ + t0 + c16) * 1024 + head0 * 64, Kh, VT, t0, 128, sk, O, linv, lane);
        u16* op = Ob + ((size_t)b * S_ + t0 + c16) * 1024 + head0 * 64;
#pragma unroll
        for (int h = 0; h < 4; ++h)
#pragma unroll
            for (int db = 0; db < 4; ++db) *(uint2*)(op + h * 64 + db * 16 + q4 * 4) = pack4(O[h][db] * linv[h]);
    }
}

__device__ __forceinline__ void nsa_phase(const Params& p, unsigned char* smem, int tid_, int bid_, int probe_rep) {
    const int lane0 = tid_ & 63, w = tid_ >> 6;
    float* R = (float*)(smem + w * 16384);
    unsigned* tm = (unsigned*)(smem + NW * 16384 + w * 1024);
    unsigned char* sel = smem + NW * 16384 + NW * 1024 + w * 256;
    const int bg = bid_ & 7, b = bg >> 2, g = bg & 3;
    const u16* Q = (const u16*)(p.ws + OFF_Q); u16* Ob = (u16*)(p.ws + OFF_O);
    const u16* KCC = (const u16*)(p.ws + OFF_KCC) + (size_t)bg * 1024 * 64;
    const u16* VCCT = (const u16*)(p.ws + OFF_VCCT) + (size_t)bg * 64 * 1024;
    const u16* KS = (const u16*)(p.ws + OFF_KS) + (size_t)bg * S_ * 64;
    const u16* VST = (const u16*)(p.ws + OFF_VST) + (size_t)bg * 64 * S_;
    const u16* KW = (const u16*)(p.ws + OFF_KW) + (size_t)bg * S_ * 64;
    const u16* VWT = (const u16*)(p.ws + OFF_VWT) + (size_t)bg * 64 * S_;
    const float* GATES = (const float*)(p.ws + OFF_GATES);
    const float SC = 0.125f * LOG2E;
    const int nslots = (gridDim.x >> 3) * NW;
    const int slot_ = (bid_ >> 3) * NW + w;
    for (int rnd = 0; rnd * nslots < 1024; ++rnd) {
        const int tile_ = rnd * nslots + ((rnd & 1) ? (nslots - 1 - slot_) : slot_);
        if (tile_ >= 1024) continue;
        const int tile = __builtin_amdgcn_readfirstlane(tile_);
        int lane = lane0; asm volatile("" : "+v"(lane));
        const int c16 = lane & 15, q4 = lane >> 4, kr = kperm(c16);
        const int t0 = tile * 16, cur = t0 >> 6, t = t0 + c16;
        const u16* qrow = Q + ((size_t)b * S_ + t) * 1024 + g * 256;
        const float* grow = GATES + ((size_t)b * S_ + t) * 48 + g * 12;
        const int nvl = (t >= 31) ? ((t - 31) >> 4) : -1;
        const int nvmax = (t0 + 15 >= 31) ? ((t0 + 15 - 31) >> 4) : -1;
        const int ng = (nvmax >= 0) ? ((nvmax >> 5) + 1) : 0;
        f32x4 Oc[4][4];
#pragma unroll
        for (int h = 0; h < 4; ++h)
#pragma unroll
            for (int db = 0; db < 4; ++db) Oc[h][db] = (f32x4){0.f, 0.f, 0.f, 0.f};
        {
            bf16x8 qf[4][2];
#pragma unroll
            for (int h = 0; h < 4; ++h)
#pragma unroll
                for (int ks = 0; ks < 2; ++ks) qf[h][ks] = *(const bf16x8*)(qrow + h * 64 + ks * 32 + q4 * 8);
            float m[4], l[4];
#pragma unroll
            for (int h = 0; h < 4; ++h) { m[h] = NEGBIG; l[h] = 0.f; }
            const int nvmin = (t0 >= 31) ? ((t0 - 31) >> 4) : -1;
            for (int grp = 0; grp < ng; ++grp) {
                const int kb = grp << 5;
                const unsigned kof = (unsigned)(kb + kr) * 64u + (unsigned)q4 * 8u;
                const bf16x8 k1a = *(const bf16x8*)(KCC + kof), k1b = *(const bf16x8*)(KCC + (kof + 32u)), k2a = *(const bf16x8*)(KCC + (kof + 256u)), k2b = *(const bf16x8*)(KCC + (kof + 288u));
                const int kpos = kb + q4 * 8;
                f32x4 cm1 = {0.f, 0.f, 0.f, 0.f}, cm2 = cm1;
                if (kb + 31 > nvmin) {
#pragma unroll
                    for (int i = 0; i < 4; ++i) { if (kpos + i > nvl) cm1[i] = NEGBIG; if (kpos + 4 + i > nvl) cm2[i] = NEGBIG; }
                }
#pragma unroll
                for (int h = 0; h < 4; ++h) {
                    f32x4 s1 = mfma16(k1a, qf[h][0], cm1); s1 = mfma16(k1b, qf[h][1], s1);
                    f32x4 s2 = mfma16(k2a, qf[h][0], cm2); s2 = mfma16(k2b, qf[h][1], s2);
                    float mx = fmaxf(fmaxf(fmaxf(s1[0], s1[1]), fmaxf(s1[2], s1[3])), fmaxf(fmaxf(s2[0], s2[1]), fmaxf(s2[2], s2[3])));
                    mx = xmax32(xmax16(mx));
                    const float mn = fmaxf(fmaxf(m[h], mx * SC), -1e20f);
                    if (__ballot(mn != m[h])) l[h] *= fexp2(m[h] - mn);
                    m[h] = mn;
                    float ps = 0.f;
#pragma unroll
                    for (int i = 0; i < 4; ++i) ps += fexp2(fmaf(s1[i], SC, -mn)) + fexp2(fmaf(s2[i], SC, -mn));
                    l[h] += ps;
                }
            }
            float linv[4];
#pragma unroll
            for (int h = 0; h < 4; ++h) { float lt = l[h]; lt += __shfl_xor(lt, 16); lt += __shfl_xor(lt, 32); linv[h] = lt > 0.f ? 1.f / lt : 0.f; }
            float carry = 0.f;
            for (int grp = 0; grp < ng; ++grp) {
                const int kb = grp << 5;
                const unsigned kof = (unsigned)(kb + kr) * 64u + (unsigned)q4 * 8u;
                const bf16x8 k1a = *(const bf16x8*)(KCC + kof), k1b = *(const bf16x8*)(KCC + (kof + 32u)), k2a = *(const bf16x8*)(KCC + (kof + 256u)), k2b = *(const bf16x8*)(KCC + (kof + 288u));
                bf16x8 vf[4];
#pragma unroll
                for (int db = 0; db < 4; ++db) vf[db] = *(const bf16x8*)(VCCT + (unsigned)(db * 16 * 1024) + ((unsigned)c16 * 1024u + (unsigned)kb + (unsigned)q4 * 8u));
                const int kpos = kb + q4 * 8;
                float psum[8];
#pragma unroll
                for (int i = 0; i < 8; ++i) psum[i] = 0.f;
                f32x4 cm1 = {0.f, 0.f, 0.f, 0.f}, cm2 = cm1;
                if (kb + 31 > nvmin) {
#pragma unroll
                    for (int i = 0; i < 4; ++i) { if (kpos + i > nvl) cm1[i] = NEGBIG; if (kpos + 4 + i > nvl) cm2[i] = NEGBIG; }
                }
#pragma unroll
                for (int h = 0; h < 4; ++h) {
                    f32x4 s1 = mfma16(k1a, qf[h][0], cm1); s1 = mfma16(k1b, qf[h][1], s1);
                    f32x4 s2 = mfma16(k2a, qf[h][0], cm2); s2 = mfma16(k2b, qf[h][1], s2);
                    float pv[8];
#pragma unroll
                    for (int i = 0; i < 4; ++i) {
                        pv[i] = fexp2(fmaf(s1[i], SC, -m[h])) * linv[h];
                        pv[4 + i] = fexp2(fmaf(s2[i], SC, -m[h])) * linv[h];
                    }
#pragma unroll
                    for (int i = 0; i < 8; ++i) psum[i] += pv[i];
                    const bf16x8 pf = pack8(pv);
#pragma unroll
                    for (int db = 0; db < 4; ++db) Oc[h][db] = mfma16(vf[db], pf, Oc[h][db]);
                }
                const float prev = __shfl(psum[7], (lane + 48) & 63);
                const float left = (q4 == 0) ? carry : prev;
                carry = prev;
                const float impA = left + 2.f * (psum[0] + psum[1] + psum[2]) + psum[3];
                const float impB = psum[3] + 2.f * (psum[4] + psum[5] + psum[6]) + psum[7];
                *(float2*)(R + c16 * 256 + (kb >> 2) + 2 * q4) = make_float2(impA, impB);
            }
        }
        wsync();
        const int ncand = cur - 2;
        const int npick = ncand < 0 ? 0 : (ncand < 13 ? ncand : 13);
        const int nforced = (cur < 2 ? cur : 2) + 1;
        const int nsel = npick + nforced;
        for (int tk = 0; tk < 8; ++tk) {
            float a0 = -1.f, a1 = -1.f, a2 = -1.f, a3 = -1.f, b0 = -1.f, b1 = -1.f, b2 = -1.f, b3 = -1.f;
            if (npick > 0) {
                const float4 va = *(const float4*)(R + tk * 256 + lane * 4), vb = *(const float4*)(R + (tk + 8) * 256 + lane * 4);
                const int j0 = lane * 4;
                const bool k0 = (j0 >= 1 && j0 <= ncand), k1 = (j0 + 1 <= ncand), k2 = (j0 + 2 <= ncand), k3 = (j0 + 3 <= ncand);
                a0 = k0 ? va.x : -1.f; a1 = k1 ? va.y : -1.f; a2 = k2 ? va.z : -1.f; a3 = k3 ? va.w : -1.f;
                b0 = k0 ? vb.x : -1.f; b1 = k1 ? vb.y : -1.f; b2 = k2 ? vb.z : -1.f; b3 = k3 ? vb.w : -1.f;
            }
            for (int it = 0; it < npick; ++it) {
                const float ma = wave_max(fmaxf(fmaxf(a0, a1), fmaxf(a2, a3)));
                const float mb = wave_max(fmaxf(fmaxf(b0, b1), fmaxf(b2, b3)));
                const unsigned long long bala = __ballot((a0 == ma) || (a1 == ma) || (a2 == ma) || (a3 == ma));
                const unsigned long long balb = __ballot((b0 == mb) || (b1 == mb) || (b2 == mb) || (b3 == mb));
                const int fa = __ffsll((long long)bala) - 1, fb = __ffsll((long long)balb) - 1;
                if (lane == fa) {
                    int sl;
                    if (a0 == ma) { sl = 0; a0 = -1.f; } else if (a1 == ma) { sl = 1; a1 = -1.f; } else if (a2 == ma) { sl = 2; a2 = -1.f; } else { sl = 3; a3 = -1.f; }
                    sel[tk * 16 + it] = (unsigned char)(lane * 4 + sl);
                }
                if (lane == fb) {
                    int sl;
                    if (b0 == mb) { sl = 0; b0 = -1.f; } else if (b1 == mb) { sl = 1; b1 = -1.f; } else if (b2 == mb) { sl = 2; b2 = -1.f; } else { sl = 3; b3 = -1.f; }
                    sel[(tk + 8) * 16 + it] = (unsigned char)(lane * 4 + sl);
                }
            }
            if (lane < 2) {
                const int tq = tk + lane * 8;
                sel[tq * 16 + npick] = 0;
                if (cur >= 1) sel[tq * 16 + npick + 1] = (unsigned char)cur;
                if (cur >= 2) sel[tq * 16 + npick + 2] = (unsigned char)(cur - 1);
            }
        }
        { unsigned zz = 0u; asm volatile("" : "+v"(zz)); *(uint4*)(tm + lane * 4) = make_uint4(zz, zz, zz, zz); }
        wsync();
        if (lane < 16) {
            for (int si = 0; si < nsel; ++si) atomicOr(&tm[sel[lane * 16 + si]], 1u << lane);
        }
        wsync();
        int n_act;
        {
            const uint4 mm = *(const uint4*)(tm + lane * 4);
            wsync();
            const bool f0 = mm.x != 0u, f1 = mm.y != 0u, f2 = mm.z != 0u, f3 = mm.w != 0u;
            const unsigned long long b0 = __ballot(f0), b1 = __ballot(f1), b2 = __ballot(f2), b3 = __ballot(f3);
            const unsigned long long below = (1ull << lane) - 1ull;
            int pos = __popcll(b0 & below) + __popcll(b1 & below) + __popcll(b2 & below) + __popcll(b3 & below);
            if (f0) { sel[pos] = (unsigned char)(lane * 4 + 0); ++pos; }
            if (f1) { sel[pos] = (unsigned char)(lane * 4 + 1); ++pos; }
            if (f2) { sel[pos] = (unsigned char)(lane * 4 + 2); ++pos; }
            if (f3) { sel[pos] = (unsigned char)(lane * 4 + 3); ++pos; }
            n_act = __popcll(b0) + __popcll(b1) + __popcll(b2) + __popcll(b3);
        }
        wsync();
        u16* QL = (u16*)R;
        u16* PL = (u16*)R + 4096;
        {
            int t3 = t; asm volatile("" : "+v"(t3));
            const float* grow3 = GATES + ((size_t)b * S_ + t3) * 48 + g * 12;
#pragma unroll
            for (int h = 0; h < 4; ++h) {
                const float g0 = grow3[h * 3 + 0];
#pragma unroll
                for (int db = 0; db < 4; ++db) *(uint2*)(PL + (c16 * 4 + h) * 64 + db * 16 + q4 * 4) = pack4(Oc[h][db] * g0);
            }
#pragma unroll
            for (int i = 0; i < 8; ++i) {
                const int idx = i * 64 + lane, row = idx >> 3, ch = idx & 7;
                const uint4 v = *(const uint4*)(Q + ((size_t)b * S_ + t0 + (row >> 2)) * 1024 + g * 256 + (row & 3) * 64 + ch * 8);
                *(uint4*)(QL + row * 64 + ((ch ^ ((row >> 1) & 7)) << 3)) = v;
            }
        }
        wsync();
        for (int rep = 0; rep <= probe_rep; ++rep) {
            const int tg = c16 >> 2, hh = c16 & 3;
            f32x4 Os[4][4]; float m[4], l[4];
#pragma unroll
            for (int gq = 0; gq < 4; ++gq) {
                m[gq] = NEGBIG; l[gq] = 0.f;
#pragma unroll
                for (int db = 0; db < 4; ++db) Os[gq][db] = (f32x4){0.f, 0.f, 0.f, 0.f};
            }
            long qf8[4][2];
#pragma unroll
            for (int gq = 0; gq < 4; ++gq)
#pragma unroll
                for (int ks = 0; ks < 2; ++ks) {
                    const uint4 qv = *(const uint4*)(Q + ((size_t)b * S_ + t0 + gq * 4 + tg) * 1024 + g * 256 + hh * 64 + ks * 32 + q4 * 8);
                    const float f[8] = {__uint_as_float(qv.x << 16), __uint_as_float(qv.x & 0xffff0000u), __uint_as_float(qv.y << 16), __uint_as_float(qv.y & 0xffff0000u),
                                        __uint_as_float(qv.z << 16), __uint_as_float(qv.z & 0xffff0000u), __uint_as_float(qv.w << 16), __uint_as_float(qv.w & 0xffff0000u)};
                    qf8[gq][ks] = pk8_fp8(f);
                }
            const unsigned char* KS8 = (const unsigned char*)KS;
            const unsigned char* VS8 = (const unsigned char*)VST;
            auto ld = [&](int s, long (&K)[4], long (&V)[4]) __attribute__((always_inline)) {
                const int j = __builtin_amdgcn_readfirstlane((int)sel[s >> 1]);
                const int kb = j * 64 + (s & 1) * 32;
                const unsigned kof = (unsigned)(kb + kr) * 64u + (unsigned)q4 * 8u;
                K[0] = *(const long*)(KS8 + kof); K[1] = *(const long*)(KS8 + (kof + 32u)); K[2] = *(const long*)(KS8 + (kof + 256u)); K[3] = *(const long*)(KS8 + (kof + 288u));
                const unsigned vof = (unsigned)j * 4096u + (unsigned)c16 * 64u + (unsigned)(s & 1) * 32u + (unsigned)q4 * 8u;
#pragma unroll
                for (int db = 0; db < 4; ++db) V[db] = *(const long*)(VS8 + (vof + (unsigned)(db * 1024)));
            };
            auto cp = [&](int s, const long (&K)[4], const long (&V)[4]) __attribute__((always_inline)) {
                const int j = __builtin_amdgcn_readfirstlane((int)sel[s >> 1]);
                const unsigned mk = __builtin_amdgcn_readfirstlane(tm[j]);
                const int kpos = j * 64 + (s & 1) * 32 + q4 * 8;
#pragma unroll
                for (int gq = 0; gq < 4; ++gq) {
                    const unsigned gm = (mk >> (gq * 4)) & 0xFu;
                    if (gm == 0u) continue;
                    const float cmv = ((gm >> tg) & 1u) ? 0.f : NEGBIG;
                    f32x4 cm1 = {cmv, cmv, cmv, cmv}, cm2 = cm1;
                    if (j == cur) {
                        const int tc = t0 + gq * 4 + tg;
#pragma unroll
                        for (int i = 0; i < 4; ++i) { if (kpos + i > tc) cm1[i] = NEGBIG; if (kpos + 4 + i > tc) cm2[i] = NEGBIG; }
                    }
                    f32x4 s1 = mfma8(K[0], qf8[gq][0], cm1); s1 = mfma8(K[1], qf8[gq][1], s1);
                    f32x4 s2 = mfma8(K[2], qf8[gq][0], cm2); s2 = mfma8(K[3], qf8[gq][1], s2);
                    float mx = fmaxf(fmaxf(fmaxf(s1[0], s1[1]), fmaxf(s1[2], s1[3])), fmaxf(fmaxf(s2[0], s2[1]), fmaxf(s2[2], s2[3])));
                    mx = xmax32(xmax16(mx));
                    const float mn = fmaxf(m[gq], mx * SC);
                    if (__ballot(mn != m[gq])) {
                        const float alpha = fexp2(m[gq] - mn);
                        l[gq] *= alpha;
#pragma unroll
                        for (int db = 0; db < 4; ++db) Os[gq][db] = Os[gq][db] * alpha;
                    }
                    m[gq] = mn;
                    float pv[8]; float ps = 0.f;
#pragma unroll
                    for (int i = 0; i < 4; ++i) { pv[i] = fexp2(fmaf(s1[i], SC, 7.f - mn)); pv[4 + i] = fexp2(fmaf(s2[i], SC, 7.f - mn)); }
#pragma unroll
                    for (int i = 0; i < 8; ++i) ps += pv[i];
                    l[gq] += ps;
                    const long pf = pk8_fp8(pv);
#pragma unroll
                    for (int db = 0; db < 4; ++db) Os[gq][db] = mfma8(V[db], pf, Os[gq][db]);
                }
            };
            {
                long KA[4], VA[4], KB[4], VB[4];
                const int ns = 2 * n_act;
                ld(0, KA, VA);
                for (int s = 0; s < ns; s += 2) {
                    ld(s + 1, KB, VB);
                    cp(s, KA, VA);
                    if (s + 2 < ns) ld(s + 2, KA, VA);
                    cp(s + 1, KB, VB);
                }
            }
            const float repsc = (rep == 0) ? 1.f : 0.f;
#pragma unroll
            for (int gq = 0; gq < 4; ++gq) {
                float lt = l[gq]; lt += __shfl_xor(lt, 16); lt += __shfl_xor(lt, 32);
                const int tok = gq * 4 + tg;
                const float sc = repsc * GATES[((size_t)b * S_ + t0 + tok) * 48 + g * 12 + hh * 3 + 1] / lt;
#pragma unroll
                for (int db = 0; db < 4; ++db) {
                    u16* rp = PL + (tok * 4 + hh) * 64 + db * 16 + q4 * 4;
                    *(uint2*)rp = pack4(unpack4(*(const uint2*)rp) + Os[gq][db] * sc);
                }
            }
        }
        wsync();
        {
            f32x4 Ow[4][4]; float linv[4];
            int t2 = t; asm volatile("" : "+v"(t2));
            const u16* qrow2 = Q + ((size_t)b * S_ + t2) * 1024 + g * 256;
            const float* grow2 = GATES + ((size_t)b * S_ + t2) * 48 + g * 12;
            band_attn<false>(qrow2, KW, VWT, t0, 512, nullptr, Ow, linv, lane);
            u16* op = Ob + ((size_t)b * S_ + t2) * 1024 + g * 256;
#pragma unroll
            for (int h = 0; h < 4; ++h) {
                const float g2 = grow2[h * 3 + 2] * linv[h];
#pragma unroll
                for (int db = 0; db < 4; ++db) {
                    const f32x4 part = unpack4(*(const uint2*)(PL + (c16 * 4 + h) * 64 + db * 16 + q4 * 4));
                    *(uint2*)(op + h * 64 + db * 16 + q4 * 4) = pack4(part + Ow[h][db] * g2);
                }
            }
        }
        wsync();
    }
}


#define XB_TMO      128
#define XB_XCNT(j)  (256  + 64 * (j))
#define XB_XSUB(j)  (1280 + 64 * (j))
#define XB_XGEN(j)  (2304 + 64 * (j))
#define XB_TOP      3328
#define XB_TOPGEN   3392
#define XCD_BAR_WORDS 3456
#define XB_SPIN_CAP (1u << 22)
#define LAS __attribute__((address_space(3)))
__device__ __forceinline__ unsigned xb_ld(unsigned* p)              { return __hip_atomic_load(p, __ATOMIC_RELAXED, __HIP_MEMORY_SCOPE_AGENT); }
__device__ __forceinline__ unsigned xb_add(unsigned* p, unsigned v) { return __hip_atomic_fetch_add(p, v, __ATOMIC_RELAXED, __HIP_MEMORY_SCOPE_AGENT); }
__device__ __forceinline__ unsigned xb_xcc_id() { return (unsigned)__builtin_amdgcn_s_getreg((3 << 11) | 20) & 0xFu; }
#define XB_SPIN(cond, bar) do { unsigned _sp = 0; while (cond) { __builtin_amdgcn_s_sleep(1); \
    if ((++_sp & 255u) == 0u) { if (xb_ld(&(bar)[XB_TMO])) break; if (_sp > XB_SPIN_CAP) { atomicAdd(&(bar)[XB_TMO], 1u); break; } } } } while (0)
__device__ __forceinline__ void xcd_barrier_complete(unsigned* bar, unsigned x, unsigned& nloc, unsigned& nx) {
    const unsigned G = gridDim.x * gridDim.y * gridDim.z;
    unsigned sum, cnt, mine, sp = 0u;
    for (;;) {
        sum = 0u; cnt = 0u; mine = 0u;
#pragma unroll
        for (unsigned j = 0; j < 16; ++j) { const unsigned c = xb_ld(&bar[XB_XCNT(j)]); sum += c; cnt += (c > 0u) ? 1u : 0u; mine = (j == x) ? c : mine; }
        if (sum == G) break;
        __builtin_amdgcn_s_sleep(1);
        if ((++sp & 255u) == 0u) { if (xb_ld(&bar[XB_TMO])) break; if (sp > XB_SPIN_CAP) { atomicAdd(&bar[XB_TMO], 1u); break; } }
    }
    nloc = mine > 0u ? mine : 1u; nx = cnt > 0u ? cnt : 1u;
}
__device__ __forceinline__ void xcd_barrier(unsigned* bar, unsigned x, volatile LAS unsigned* st, int tid) {
    asm volatile("s_waitcnt vmcnt(0)" ::: "memory");
    __syncthreads();
    if (tid == 0) {
        __builtin_amdgcn_s_waitcnt(0);
        unsigned nloc = st[0], nx = st[1];
        if (nloc == 0u) { xcd_barrier_complete(bar, x, nloc, nx); st[0] = nloc; st[1] = nx; }
        const unsigned old = xb_add(&bar[XB_XSUB(x)], 1u);
        const unsigned gen = old / nloc;
        if (old + 1u == (gen + 1u) * nloc) {
            __builtin_amdgcn_fence(__ATOMIC_RELEASE, "agent");
            asm volatile("s_waitcnt vmcnt(0)" ::: "memory");
            const unsigned og = xb_add(&bar[XB_TOP], 1u);
            const unsigned tg = og / nx;
            if (og + 1u == (tg + 1u) * nx) xb_add(&bar[XB_TOPGEN], 1u);
            else XB_SPIN(xb_ld(&bar[XB_TOPGEN]) == tg, bar);
            __builtin_amdgcn_fence(__ATOMIC_ACQUIRE, "agent");
            xb_add(&bar[XB_XGEN(x)], 1u);
            asm volatile("s_waitcnt vmcnt(0)" ::: "memory");
        } else {
            XB_SPIN(xb_ld(&bar[XB_XGEN(x)]) == gen, bar);
            __builtin_amdgcn_fence(__ATOMIC_ACQUIRE, "agent");
            asm volatile("s_waitcnt vmcnt(0)" ::: "memory");
        }
    }
    __syncthreads();
}

enum { PT_PREP = 0, PT_NORM, PT_AIN, PT_CMP1, PT_CMP2, PT_NSA, PT_BKV, PT_BQ, PT_SWA, PT_AOUT, PT_FFNIN, PT_FIXUP, PT_FOUT, PT_FINAL };

__global__ void __launch_bounds__(NTHR, 2) mega(Params p) {
#if defined(__HIP_DEVICE_COMPILE__)
    extern __shared__ __attribute__((aligned(16))) unsigned char smem[];
    cg::grid_group grid = cg::this_grid();
    typedef const Params __attribute__((address_space(4)))* KP;
    const int ph_lo = p.ph_lo, ph_hi = p.ph_hi;
    const int wave_id = __builtin_amdgcn_readfirstlane((int)(threadIdx.x >> 6));
    unsigned* bar = (unsigned*)(p.ws + OFF_BAR);
    volatile LAS unsigned* xst = (volatile LAS unsigned*)(smem + LDS_USER);
    const unsigned xcc = __builtin_amdgcn_readfirstlane(xb_xcc_id());
    if (ph_hi - ph_lo > 1) {
        if (threadIdx.x == 0) { xst[0] = 0u; xst[1] = 0u; (void)xb_add(&bar[XB_XCNT(xcc)], 1u); }
        __syncthreads();
    }
    for (int ph = ph_lo; ph < ph_hi; ++ph) {
        int tid_, bid_ = blockIdx.x;
        asm volatile("v_mbcnt_lo_u32_b32 %0, -1, 0\n\tv_mbcnt_hi_u32_b32 %0, -1, %0" : "=v"(tid_));
        tid_ += wave_id * 64;
        asm volatile("" : "+s"(bid_));
        KP kp = (KP)__builtin_amdgcn_kernarg_segment_ptr();
        asm volatile("" : "+s"(kp));
        unsigned char* ws = kp->ws;
        u16* HN = (u16*)(ws + OFF_HN);
        const int d = kp->desc[ph], type = d & 255, sub = (d >> 8) & 255, L = d >> 16;
        const float* hsrc = (L == 0) ? kp->x : kp->out;
        EpiArgs e; e.resid = nullptr; e.out = kp->out; e.bias = nullptr; e.hid = nullptr; e.convw = nullptr; e.convb = nullptr; e.ws = ws;
        switch (type) {
        case PT_PREP: { const Params pl = *kp; prep_phase(pl, smem, tid_, bid_); } break;
        case PT_NORM: {
            const float* src = (sub == 1) ? kp->out : hsrc;
            const float* g = (sub == 0) ? kp->norm_attn + L * 1024 : (sub == 1) ? kp->norm_ffn + L * 1024 : kp->kv_norm;
            norm_phase<false>(src, g, HN, nullptr, tid_, bid_);
        } break;
        case PT_AIN: gemm_phase<AM_PLAIN, EPI_AIN>(HN, 1024, (const u16*)(ws + OFF_WT_AIN + L * SZ_WT_AIN), T_, 2688, 1024, 0, e, smem, tid_, bid_); break;
        case PT_CMP1:
            for (int kv = 0; kv < 2; ++kv) {
                e.bias = (const float*)(ws + OFF_CBIAS) + (L * 2 + kv) * 256; e.hid = (u16*)(ws + OFF_HID) + (size_t)kv * 8192 * 256;
                gemm_phase<AM_GATHER, EPI_CMP1>((const u16*)(ws + (kv == 0 ? OFF_KC : OFF_VC)), 0, (const u16*)(ws + OFF_WT_CW1 + (L * 2 + kv) * SZ_WT_CW1), 8184, 256, 2048,
                                                kv == 0 ? 0 : (int)(gridDim.x >> 1), e, smem, tid_, bid_);
            }
            break;
        case PT_CMP2: { const Params pl = *kp; cmp2_phase(pl, L, tid_, bid_); } break;
        case PT_NSA: { const Params pl = *kp; nsa_phase(pl, smem, tid_, bid_, sub); } break;
        case PT_BKV: gemm_phase<AM_PLAIN, EPI_BKV>(HN, 1024, (const u16*)(ws + OFF_WT_KV), T_, 256, 1024, 0, e, smem, tid_, bid_); break;
        case PT_BQ: gemm_phase<AM_PLAIN, EPI_BQ>(HN, 1024, (const u16*)(ws + OFF_WT_BQ + (L - 2) * SZ_WT_SQ), T_, 1024, 1024, 0, e, smem, tid_, bid_); break;
        case PT_SWA: { const Params pl = *kp; swa_phase(pl, L - 2, tid_, bid_); } break;
        case PT_AOUT:
        case PT_FOUT: {
            const bool ff = (type == PT_FOUT);
            e.resid = ff ? kp->out : hsrc;
            const u16* A = (const u16*)(ws + (ff ? OFF_ACT : OFF_O));
            const u16* Bt = (const u16*)(ws + (ff ? OFF_WT_FOUT + L * SZ_WT_FOUT : (L < 2 ? OFF_WT_AOUT + L * SZ_WT_SQ : OFF_WT_BOUT + (L - 2) * SZ_WT_SQ)));
            const int K = ff ? DFF : 1024;
            gemm_big<AM_PLAIN, EPI_RESID>(A, K, Bt, T_, 1024, K, 0, e, smem, tid_, bid_);
        } break;
        case PT_FFNIN:
            e.convw = kp->ffn_conv_w + (size_t)L * 3 * NFF2; e.convb = kp->ffn_conv_b + (size_t)L * NFF2;
            gemm_big<AM_PLAIN, EPI_FFNIN>(HN, 1024, (const u16*)(ws + OFF_WT_FIN + L * SZ_WT_FIN), T_, NFF2, 1024, 0, e, smem, tid_, bid_);
            break;
        case PT_FIXUP: { const Params pl = *kp; fixup_phase(pl, L, tid_, bid_); } break;
        case PT_FINAL: norm_phase<true>(kp->out, kp->final_norm, nullptr, kp->out, tid_, bid_); break;
        default: break;
        }
        if (ph + 1 < ph_hi) { if (ph == ph_lo) grid.sync(); else xcd_barrier(bar, xcc, xst, tid_); }
    }
#endif
}

static int build_program(int* desc) {
    int n = 0;
    auto add = [&](int type, int sub, int L) { desc[n++] = type | (sub << 8) | (L << 16); };
    add(PT_PREP, 0, 0);
    for (int L = 0; L < 4; ++L) {
        if (L < 2) {
            add(PT_NORM, 0, L); add(PT_AIN, 0, L); add(PT_CMP1, 0, L); add(PT_CMP2, 0, L); add(PT_NSA, NSA_PROBE_REP, L);
        } else {
            if (L == 2) { add(PT_NORM, 2, L); add(PT_BKV, 0, L); }
            add(PT_NORM, 0, L); add(PT_BQ, 0, L); add(PT_SWA, 0, L);
        }
        add(PT_AOUT, 0, L); add(PT_NORM, 1, L); add(PT_FFNIN, 0, L); add(PT_FIXUP, 0, L); add(PT_FOUT, 0, L);
    }
    add(PT_FINAL, 0, 0);
    return n;
}

extern "C" void kernel_launch(void* const* d_in, const int* in_sizes, int n_in, void* d_out, int out_size, void* d_ws, size_t ws_size, hipStream_t stream) {
    (void)in_sizes; (void)n_in; (void)out_size;
    static int grid_blocks = 0;
    if (!grid_blocks) {
        (void)hipFuncSetAttribute((const void*)mega, hipFuncAttributeMaxDynamicSharedMemorySize, LDS_BYTES);
        int dev = 0, cus = 0, per_cu = 0;
        (void)hipGetDevice(&dev);
        (void)hipDeviceGetAttribute(&cus, hipDeviceAttributeMultiprocessorCount, dev);
        (void)hipOccupancyMaxActiveBlocksPerMultiprocessor(&per_cu, mega, NTHR, LDS_BYTES);
        if (per_cu > 1) per_cu = 1;
        if (per_cu < 1) per_cu = 1;
        grid_blocks = (cus * per_cu) & ~7;
        if (grid_blocks < 8) grid_blocks = 8;
        if (ws_size < WS_NEED) fprintf(stderr, "workspace too small: %zu < %zu\n", ws_size, (size_t)WS_NEED);
    }
    Params p{};
    const float** pp = (const float**)&p;
    for (int i = 0; i < 18; ++i) pp[i] = (const float*)d_in[i];
    p.out = (float*)d_out;
    p.ws = (unsigned char*)d_ws;
    const int nph = build_program(p.desc);
#if MULTI_LAUNCH
    for (int ph = 0; ph < nph; ++ph) {
        p.ph_lo = ph; p.ph_hi = ph + 1;
        hipLaunchKernelGGL(mega, dim3(grid_blocks), dim3(NTHR), LDS_BYTES, stream, p);
    }
#else
    p.ph_lo = 0; p.ph_hi = nph;
    (void)hipMemsetAsync((unsigned char*)d_ws + OFF_BAR, 0, 16384, stream);
    void* args[] = {&p};
    hipError_t err = hipLaunchCooperativeKernel((const void*)mega, dim3(grid_blocks), dim3(NTHR), args, LDS_BYTES, stream);
    if (err != hipSuccess) fprintf(stderr, "cooperative launch failed: %s (grid %d)\n", hipGetErrorString(err), grid_blocks);
#endif
}
```

```cpp
#include <hip/hip_runtime.h>
#include <hip/hip_cooperative_groups.h>
#include <cstdio>
#include <cmath>
namespace cg = cooperative_groups;

typedef unsigned short u16;
typedef short bf16x8 __attribute__((ext_vector_type(8)));
typedef float f32x4 __attribute__((ext_vector_type(4)));

#ifndef NSA_PROBE_REP
#define NSA_PROBE_REP 0
#endif
#ifndef MULTI_LAUNCH
#define MULTI_LAUNCH 0
#endif

constexpr int S_ = 16384, T_ = 32768, D_ = 1024, DFF = 2816, NFF2 = 5632;
constexpr int NTHR = 512, NW = NTHR / 64;
constexpr int LDS_USER = NW * 16384 + NW * 1024 + NW * 256;
constexpr int LDS_BYTES = LDS_USER + 16;
constexpr float LOG2E = 1.4426950408889634f;
constexpr float NEGBIG = -1e30f;

constexpr size_t al256(size_t x) { return (x + 255) & ~(size_t)255; }
constexpr size_t SZ_WT_AIN = (size_t)2688 * 1024 * 2;
constexpr size_t SZ_WT_CW1 = (size_t)256 * 2048 * 2;
constexpr size_t SZ_WT_CW2 = (size_t)64 * 256 * 2;
constexpr size_t SZ_WT_SQ = (size_t)1024 * 1024 * 2;
constexpr size_t SZ_WT_KV = (size_t)256 * 1024 * 2;
constexpr size_t SZ_WT_FIN = (size_t)5632 * 1024 * 2;
constexpr size_t SZ_WT_FOUT = (size_t)1024 * 2816 * 2;
constexpr size_t OFF_WT_AIN = 0;
constexpr size_t OFF_WT_CW1 = OFF_WT_AIN + 2 * SZ_WT_AIN;
constexpr size_t OFF_WT_CW2 = OFF_WT_CW1 + 4 * SZ_WT_CW1;
constexpr size_t OFF_WT_AOUT = OFF_WT_CW2 + 4 * SZ_WT_CW2;
constexpr size_t OFF_WT_KV = OFF_WT_AOUT + 2 * SZ_WT_SQ;
constexpr size_t OFF_WT_BQ = OFF_WT_KV + SZ_WT_KV;
constexpr size_t OFF_WT_BOUT = OFF_WT_BQ + 2 * SZ_WT_SQ;
constexpr size_t OFF_WT_FIN = OFF_WT_BOUT + 2 * SZ_WT_SQ;
constexpr size_t OFF_WT_FOUT = OFF_WT_FIN + 4 * SZ_WT_FIN;
constexpr size_t OFF_COS = OFF_WT_FOUT + 4 * SZ_WT_FOUT;
constexpr size_t OFF_SIN = OFF_COS + (size_t)S_ * 32 * 4;
constexpr size_t OFF_CBIAS = OFF_SIN + (size_t)S_ * 32 * 4;
constexpr size_t OFF_HN = OFF_CBIAS + 4096;
constexpr size_t OFF_KSH = OFF_HN + (size_t)T_ * 1024 * 2;
constexpr size_t OFF_VSHT = OFF_KSH + (size_t)T_ * 128 * 2;
constexpr size_t OFF_HEAD = OFF_VSHT + (size_t)T_ * 128 * 2;
constexpr size_t OFF_HALO = OFF_HEAD + (size_t)256 * 2 * NFF2 * 4;
constexpr size_t OFF_R1 = OFF_HALO + (size_t)256 * 2 * NFF2 * 4;
constexpr size_t OFF_Q = OFF_R1;
constexpr size_t OFF_KC = OFF_Q + (size_t)T_ * 1024 * 2;
constexpr size_t OFF_VC = OFF_KC + (size_t)T_ * 256 * 2;
constexpr size_t OFF_KS = OFF_VC + (size_t)T_ * 256 * 2;
constexpr size_t OFF_VST = OFF_KS + (size_t)T_ * 256 * 2;
constexpr size_t OFF_KW = OFF_VST + (size_t)T_ * 256 * 2;
constexpr size_t OFF_VWT = OFF_KW + (size_t)T_ * 256 * 2;
constexpr size_t OFF_GATES = OFF_VWT + (size_t)T_ * 256 * 2;
constexpr size_t OFF_HID = OFF_GATES + (size_t)T_ * 48 * 4;
constexpr size_t OFF_KCC = OFF_HID + (size_t)2 * 8192 * 256 * 2;
constexpr size_t OFF_VCCT = OFF_KCC + (size_t)8 * 1024 * 64 * 2;
constexpr size_t OFF_O = OFF_VCCT + (size_t)8 * 1024 * 64 * 2;
constexpr size_t OFF_END = OFF_O + (size_t)T_ * 1024 * 2;
constexpr size_t OFF_BAR = OFF_END;
constexpr size_t WS_NEED = OFF_BAR + 16384;
constexpr size_t OFF_ACT = OFF_R1;
static_assert(OFF_ACT + (size_t)T_ * DFF * 2 <= OFF_END, "act alias");

struct Params {
    const float *x, *norm_attn, *norm_ffn, *a_w_in, *a_cmp_pos, *a_cmp_w1, *a_cmp_w2, *a_w_out, *kv_norm, *b_w_kv, *b_w_q, *b_sinks, *b_w_out,
        *ffn_w_in, *ffn_conv_w, *ffn_conv_b, *ffn_w_out, *final_norm;
    float* out;
    unsigned char* ws;
    int desc[48];
    int ph_lo, ph_hi;
};

__device__ __forceinline__ u16 f2bf(float f) {
    unsigned u = __float_as_uint(f);
    u += 0x7fffu + ((u >> 16) & 1u);
    return (u16)(u >> 16);
}
typedef __bf16 bf16x2_t __attribute__((ext_vector_type(2)));
typedef float f32x2_t __attribute__((ext_vector_type(2)));
__device__ __forceinline__ unsigned pack2(float lo, float hi) { f32x2_t v = {lo, hi}; bf16x2_t r = __builtin_convertvector(v, bf16x2_t); return __builtin_bit_cast(unsigned, r); }
typedef unsigned u32x4 __attribute__((ext_vector_type(4)));
__device__ __forceinline__ bf16x8 pack8(const float (&v)[8]) {
    u32x4 r;
    unsigned r0, r1, r2, r3;
    asm("v_cvt_pk_bf16_f32 %0, %4, %5\n\tv_cvt_pk_bf16_f32 %1, %6, %7\n\tv_cvt_pk_bf16_f32 %2, %8, %9\n\tv_cvt_pk_bf16_f32 %3, %10, %11\n\ts_nop 3"
        : "=&v"(r0), "=&v"(r1), "=&v"(r2), "=&v"(r3)
        : "v"(v[0]), "v"(v[1]), "v"(v[2]), "v"(v[3]), "v"(v[4]), "v"(v[5]), "v"(v[6]), "v"(v[7]));
    r[0] = r0; r[1] = r1; r[2] = r2; r[3] = r3;
    return __builtin_bit_cast(bf16x8, r);
}
__device__ __forceinline__ uint2 pack4(f32x4 v) { uint2 r; r.x = pack2(v[0], v[1]); r.y = pack2(v[2], v[3]); return r; }
__device__ __forceinline__ f32x4 unpack4(uint2 v) { return (f32x4){__uint_as_float(v.x << 16), __uint_as_float(v.x & 0xffff0000u), __uint_as_float(v.y << 16), __uint_as_float(v.y & 0xffff0000u)}; }
__device__ __forceinline__ unsigned pk4_fp8(float a, float b, float c, float d) { int r = __builtin_amdgcn_cvt_pk_fp8_f32(a, b, 0, false); r = __builtin_amdgcn_cvt_pk_fp8_f32(c, d, r, true); return (unsigned)r; }
__device__ __forceinline__ long pk8_fp8(const float (&v)[8]) { const unsigned lo = pk4_fp8(v[0], v[1], v[2], v[3]), hi = pk4_fp8(v[4], v[5], v[6], v[7]); return (long)(((unsigned long long)hi << 32) | lo); }
__device__ __forceinline__ f32x4 mfma8(long a, long b, f32x4 c) { return __builtin_amdgcn_mfma_f32_16x16x32_fp8_fp8(a, b, c, 0, 0, 0); }
__device__ __forceinline__ f32x4 mfma16(bf16x8 a, bf16x8 b, f32x4 c) { return __builtin_amdgcn_mfma_f32_16x16x32_bf16(a, b, c, 0, 0, 0); }
__device__ __forceinline__ float fexp2(float x) { return __builtin_amdgcn_exp2f(x); }
__device__ __forceinline__ void wsync() { __builtin_amdgcn_fence(__ATOMIC_ACQ_REL, "wavefront"); asm volatile("s_waitcnt lgkmcnt(0)" ::: "memory"); __builtin_amdgcn_wave_barrier(); }
typedef unsigned u32x2 __attribute__((ext_vector_type(2)));
__device__ __forceinline__ float xmax16(float x) { const unsigned u = __float_as_uint(x); const u32x2 r = __builtin_amdgcn_permlane16_swap(u, u, false, false); return fmaxf(__uint_as_float(r[0]), __uint_as_float(r[1])); }
__device__ __forceinline__ float xmax32(float x) { const unsigned u = __float_as_uint(x); const u32x2 r = __builtin_amdgcn_permlane32_swap(u, u, false, false); return fmaxf(__uint_as_float(r[0]), __uint_as_float(r[1])); }
template <int CTRL> __device__ __forceinline__ float dppf(float x) { return __int_as_float(__builtin_amdgcn_update_dpp(0, __float_as_int(x), CTRL, 0xf, 0xf, true)); }
__device__ __forceinline__ float wave_max(float x) {
    x = fmaxf(x, dppf<0xB1>(x)); x = fmaxf(x, dppf<0x4E>(x)); x = fmaxf(x, dppf<0x141>(x)); x = fmaxf(x, dppf<0x140>(x));
    return xmax32(xmax16(x));
}
__device__ __forceinline__ int kperm(int m) { return ((m >> 2) << 3) + (m & 3); }
__device__ __forceinline__ float sigmoidf_(float x) { return 1.f / (1.f + __expf(-x)); }
__device__ __forceinline__ float gelu_tanh(float x) {
    float u = 0.7978845608028654f * (x + 0.044715f * x * x * x);
    float e = __expf(2.f * u);
    float th = 1.f - 2.f / (e + 1.f);
    return 0.5f * x * (1.f + th);
}

__device__ __forceinline__ void cvt_transpose(const float* __restrict__ src, u16* __restrict__ dst, int K, int N, int Npad, int mode, unsigned char* smem, int tid_, int bid_) {
    const int half = tid_ >> 8, tid = tid_ & 255;
    float* ts = (float*)smem + half * (64 * 65);
    const int ntk = K >> 6, ntn = Npad >> 6, ntiles = ntk * ntn;
    for (int tile2 = bid_ * 2; tile2 < ntiles; tile2 += gridDim.x * 2) {
        const int tile = tile2 + half;
        const bool live = tile < ntiles;
        const int tk = live ? tile % ntk : 0, tn = live ? tile / ntk : 0;
        const int k0 = tk << 6, n0 = tn << 6;
        __syncthreads();
        if (live) {
#pragma unroll
            for (int i = 0; i < 4; ++i) {
                const int k = (tid >> 4) + 16 * i, n = (tid & 15) * 4;
                float4 v = make_float4(0.f, 0.f, 0.f, 0.f);
                if (n0 + n < N) v = *(const float4*)(src + (size_t)(k0 + k) * N + n0 + n);
                ts[k * 65 + n + 0] = v.x; ts[k * 65 + n + 1] = v.y; ts[k * 65 + n + 2] = v.z; ts[k * 65 + n + 3] = v.w;
            }
        }
        __syncthreads();
        if (!live) continue;
        const int n = tid >> 2, kq = (tid & 3) * 16;
        unsigned pk[8];
#pragma unroll
        for (int j = 0; j < 8; ++j) pk[j] = pack2(ts[(kq + 2 * j) * 65 + n], ts[(kq + 2 * j + 1) * 65 + n]);
        int drow;
        if (mode == 0) drow = n0 + n;
        else { const int nn = n0 + n; drow = (nn < DFF) ? ((nn >> 6) * 128 + (nn & 63)) : ((((nn - DFF) >> 6) * 128) + 64 + ((nn - DFF) & 63)); }
        uint4* dp = (uint4*)(dst + (size_t)drow * K + k0 + kq);
        dp[0] = make_uint4(pk[0], pk[1], pk[2], pk[3]);
        dp[1] = make_uint4(pk[4], pk[5], pk[6], pk[7]);
    }
}

__device__ __forceinline__ void prep_phase(const Params& p, unsigned char* smem, int tid_, int bid_) {
    unsigned char* ws = p.ws;
    for (int L = 0; L < 2; ++L) {
        cvt_transpose(p.a_w_in + (size_t)L * 1024 * 2608, (u16*)(ws + OFF_WT_AIN + L * SZ_WT_AIN), 1024, 2608, 2688, 0, smem, tid_, bid_);
        for (int kv = 0; kv < 2; ++kv) {
            cvt_transpose(p.a_cmp_w1 + (size_t)(L * 2 + kv) * 2048 * 256, (u16*)(ws + OFF_WT_CW1 + (L * 2 + kv) * SZ_WT_CW1), 2048, 256, 256, 0, smem, tid_, bid_);
            cvt_transpose(p.a_cmp_w2 + (size_t)(L * 2 + kv) * 256 * 64, (u16*)(ws + OFF_WT_CW2 + (L * 2 + kv) * SZ_WT_CW2), 256, 64, 64, 0, smem, tid_, bid_);
        }
        cvt_transpose(p.a_w_out + (size_t)L * 1024 * 1024, (u16*)(ws + OFF_WT_AOUT + L * SZ_WT_SQ), 1024, 1024, 1024, 0, smem, tid_, bid_);
        cvt_transpose(p.b_w_q + (size_t)L * 1024 * 1024, (u16*)(ws + OFF_WT_BQ + L * SZ_WT_SQ), 1024, 1024, 1024, 0, smem, tid_, bid_);
        cvt_transpose(p.b_w_out + (size_t)L * 1024 * 1024, (u16*)(ws + OFF_WT_BOUT + L * SZ_WT_SQ), 1024, 1024, 1024, 0, smem, tid_, bid_);
    }
    cvt_transpose(p.b_w_kv, (u16*)(ws + OFF_WT_KV), 1024, 256, 256, 0, smem, tid_, bid_);
    for (int L = 0; L < 4; ++L) {
        cvt_transpose(p.ffn_w_in + (size_t)L * 1024 * NFF2, (u16*)(ws + OFF_WT_FIN + L * SZ_WT_FIN), 1024, NFF2, NFF2, 1, smem, tid_, bid_);
        cvt_transpose(p.ffn_w_out + (size_t)L * DFF * 1024, (u16*)(ws + OFF_WT_FOUT + L * SZ_WT_FOUT), DFF, 1024, 1024, 0, smem, tid_, bid_);
    }
    {
        float* cosT = (float*)(ws + OFF_COS); float* sinT = (float*)(ws + OFF_SIN);
        const int gt = bid_ * NTHR + tid_, nt = gridDim.x * NTHR;
        for (int idx = gt; idx < S_ * 32; idx += nt) {
            const int pos = idx >> 5, i = idx & 31;
            const float ang = (float)pos * exp2f(-(float)i * (13.287712379549449f / 32.0f));
            double rev = (double)ang * 0.15915494309189535;
            rev -= rint(rev);
            const float fr = (float)rev;
            cosT[idx] = __builtin_amdgcn_cosf(fr);
            sinT[idx] = __builtin_amdgcn_sinf(fr);
        }
    }
    {
        float* cb = (float*)(ws + OFF_CBIAS);
        const int lane = tid_ & 63, w = tid_ >> 6;
        for (int task = bid_ * NW + w; task < 256; task += gridDim.x * NW) {
            const int lk = task >> 6, j4 = (task & 63) * 4;
            const float* pos = p.a_cmp_pos + (size_t)lk * 2048;
            const float* w1 = p.a_cmp_w1 + (size_t)lk * 2048 * 256;
            float4 a = make_float4(0.f, 0.f, 0.f, 0.f);
            for (int i = 0; i < 32; ++i) {
                const int k = lane + 64 * i;
                const float pv = pos[k];
                const float4 wv = *(const float4*)(w1 + (size_t)k * 256 + j4);
                a.x += pv * wv.x; a.y += pv * wv.y; a.z += pv * wv.z; a.w += pv * wv.w;
            }
#pragma unroll
            for (int off = 32; off >= 1; off >>= 1) {
                a.x += __shfl_xor(a.x, off); a.y += __shfl_xor(a.y, off); a.z += __shfl_xor(a.z, off); a.w += __shfl_xor(a.w, off);
            }
            if (lane == 0) *(float4*)(cb + lk * 256 + j4) = a;
        }
    }
}

template <bool OUT_F32>
__device__ __forceinline__ void norm_phase(const float* __restrict__ src, const float* __restrict__ g, u16* __restrict__ dst, float* __restrict__ dstf, int tid_, int bid_) {
    const int lane = tid_ & 63, w = tid_ >> 6;
    float4 gv[4];
#pragma unroll
    for (int i = 0; i < 4; ++i) gv[i] = *(const float4*)(g + lane * 4 + 256 * i);
    for (int row = bid_ * NW + w; row < T_; row += gridDim.x * NW) {
        const float* sp = src + (size_t)row * 1024;
        float4 v[4];
        float ss = 0.f;
#pragma unroll
        for (int i = 0; i < 4; ++i) { v[i] = *(const float4*)(sp + lane * 4 + 256 * i); ss += v[i].x * v[i].x + v[i].y * v[i].y + v[i].z * v[i].z + v[i].w * v[i].w; }
#pragma unroll
        for (int off = 32; off >= 1; off >>= 1) ss += __shfl_xor(ss, off);
        const float r = rsqrtf(ss * (1.f / 1024.f) + 1e-6f);
#pragma unroll
        for (int i = 0; i < 4; ++i) {
            f32x4 o = {v[i].x * r * gv[i].x, v[i].y * r * gv[i].y, v[i].z * r * gv[i].z, v[i].w * r * gv[i].w};
            if (OUT_F32) *(float4*)(dstf + (size_t)row * 1024 + lane * 4 + 256 * i) = make_float4(o[0], o[1], o[2], o[3]);
            else *(uint2*)(dst + (size_t)row * 1024 + lane * 4 + 256 * i) = pack4(o);
        }
    }
}

enum { AM_PLAIN = 0, AM_GATHER = 1 };
enum { EPI_AIN = 0, EPI_CMP1 = 1, EPI_RESID = 2, EPI_FFNIN = 3, EPI_BQ = 4, EPI_BKV = 5 };

struct EpiArgs {
    const float* resid; float* out;
    const float* bias; u16* hid;
    const float *convw, *convb;
    unsigned char* ws;
};

template <int NM>
__device__ __forceinline__ void rope_store(const f32x4 (&acc)[4][NM], int mi, u16* dstrow  , const float* cosT, const float* sinT, int pos, int q4) {
#pragma unroll
    for (int ni = 0; ni < 2; ++ni) {
        const int d = ni * 16 + q4 * 4;
        const float4 c = *(const float4*)(cosT + pos * 32 + d), s = *(const float4*)(sinT + pos * 32 + d);
        const f32x4 x1 = acc[ni][mi], x2 = acc[ni + 2][mi];
        f32x4 o1 = {x1[0] * c.x - x2[0] * s.x, x1[1] * c.y - x2[1] * s.y, x1[2] * c.z - x2[2] * s.z, x1[3] * c.w - x2[3] * s.w};
        f32x4 o2 = {x2[0] * c.x + x1[0] * s.x, x2[1] * c.y + x1[1] * s.y, x2[2] * c.z + x1[2] * s.z, x2[3] * c.w + x1[3] * s.w};
        *(uint2*)(dstrow + d) = pack4(o1);
        *(uint2*)(dstrow + d + 32) = pack4(o2);
    }
}

template <int AMODE, int EPI>
__device__ __forceinline__ void gemm_phase(const u16* __restrict__ A, int lda, const u16* __restrict__ Bt, int M, int Npad, int K, int vboff, const EpiArgs& e, unsigned char* smem, int tid_, int bid_) {
    const int tid = tid_, lane = tid & 63, w = tid >> 6, wm = w & 3, wn = w >> 2;
    const int c16 = lane & 15, q4 = lane >> 4;
    const int ntm = (M + 255) >> 8, ntn = Npad >> 7, nk = K >> 6;
    const int kstride = (AMODE == AM_GATHER) ? 256 : 64;
    const int ldc = tid & 7, ldr = tid >> 3;
    const unsigned wofs = ldr * 128 + ((ldc ^ ((ldr >> 1) & 7)) << 4);
    const int swz = (c16 >> 1) & 7;
    const float* cosT = (const float*)(e.ws + OFF_COS);
    const float* sinT = (const float*)(e.ws + OFF_SIN);
    int vb = bid_ + vboff; if (vb >= (int)gridDim.x) vb -= gridDim.x;
    const int xcd = vb & 7, loc = vb >> 3, nloc = gridDim.x >> 3;
    const int mpx = ntm >> 3, nfull = (ntn >> 3), bwl = ntn - (nfull << 3);
    const int tfull = nfull * mpx * 8, ttotal = mpx * ntn;
    for (int tl = loc; tl < ttotal; tl += nloc) {
        int mloc, nt;
        if (tl < tfull) { const int band = tl / (mpx * 8), r = tl - band * (mpx * 8); mloc = r >> 3; nt = band * 8 + (r & 7); }
        else { const int r = tl - tfull; mloc = r / bwl; nt = (nfull << 3) + (r - mloc * bwl); }
        const int mt = xcd * mpx + mloc;
        const int m0 = mt << 8, n0 = nt << 7;
        unsigned aoff[4];
#pragma unroll
        for (int i = 0; i < 4; ++i) {
            int m = m0 + ldr + 64 * i; if (m > M - 1) m = M - 1;
            if (AMODE == AM_GATHER) { const int g = m & 3, bn = m >> 2, b = bn / 1023, n = bn - b * 1023; aoff[i] = (unsigned)((b * S_ + n * 16) * 256 + g * 64 + ldc * 8); }
            else aoff[i] = (unsigned)m * (unsigned)lda + ldc * 8;
        }
        const u16* bp = Bt + (size_t)(n0 + ldr) * K + ldc * 8;
        u32x4 ra0[4], rb0[2], ra1[4], rb1[2];
        f32x4 acc[4][4];
#pragma unroll
        for (int a = 0; a < 4; ++a)
#pragma unroll
            for (int b = 0; b < 4; ++b) acc[a][b] = (f32x4){0.f, 0.f, 0.f, 0.f};
        auto g_load = [&](u32x4 (&RA)[4], u32x4 (&RB)[2], int KT) __attribute__((always_inline)) {
#pragma unroll
            for (int i = 0; i < 4; ++i) RA[i] = *(const u32x4*)(A + aoff[i] + KT * kstride);
#pragma unroll
            for (int i = 0; i < 2; ++i) RB[i] = *(const u32x4*)(bp + (size_t)i * 64 * K + KT * 64);
        };
        auto g_store = [&](const u32x4 (&RA)[4], const u32x4 (&RB)[2], int ST) __attribute__((always_inline)) {
            unsigned char* d_ = smem + ST * 49152;
#pragma unroll
            for (int i = 0; i < 4; ++i) *(u32x4*)(d_ + wofs + i * 8192) = RA[i];
#pragma unroll
            for (int i = 0; i < 2; ++i) *(u32x4*)(d_ + 32768 + wofs + i * 8192) = RB[i];
        };
        auto g_compute = [&](int ST) __attribute__((always_inline)) {
            const unsigned char* sA = smem + ST * 49152;
            const unsigned char* sB = sA + 32768;
#pragma unroll
            for (int ks = 0; ks < 2; ++ks) {
                bf16x8 wf[4], af[4];
                const int ch = ((ks * 4 + q4) ^ swz) << 4;
#pragma unroll
                for (int ni = 0; ni < 4; ++ni) wf[ni] = *(const bf16x8*)(sB + (wn * 64 + ni * 16 + c16) * 128 + ch);
#pragma unroll
                for (int mi = 0; mi < 4; ++mi) af[mi] = *(const bf16x8*)(sA + (wm * 64 + mi * 16 + c16) * 128 + ch);
#pragma unroll
                for (int ni = 0; ni < 4; ++ni)
#pragma unroll
                    for (int mi = 0; mi < 4; ++mi) acc[ni][mi] = mfma16(wf[ni], af[mi], acc[ni][mi]);
            }
        };
        g_load(ra0, rb0, 0);
        g_load(ra1, rb1, 1);
        g_store(ra0, rb0, 0);
        __syncthreads();
        for (int kt = 0; kt < nk; kt += 2) {
            if (kt + 2 < nk) g_load(ra0, rb0, kt + 2);
            g_compute(0);
            g_store(ra1, rb1, 1);
            __syncthreads();
            if (kt + 3 < nk) g_load(ra1, rb1, kt + 3);
            g_compute(1);
            if (kt + 2 < nk) g_store(ra0, rb0, 0);
            __syncthreads();
        }
        const int nb = n0 + wn * 64;
        if (EPI == EPI_RESID) {
#pragma unroll
            for (int mi = 0; mi < 4; ++mi) {
                const size_t tok = m0 + wm * 64 + mi * 16 + c16;
#pragma unroll
                for (int ni = 0; ni < 4; ++ni) {
                    const int n = nb + ni * 16 + q4 * 4;
                    float4 r = *(const float4*)(e.resid + tok * 1024 + n);
                    r.x += acc[ni][mi][0]; r.y += acc[ni][mi][1]; r.z += acc[ni][mi][2]; r.w += acc[ni][mi][3];
                    *(float4*)(e.out + tok * 1024 + n) = r;
                }
            }
        } else if (EPI == EPI_CMP1) {
#pragma unroll
            for (int mi = 0; mi < 4; ++mi) {
                const int m = m0 + wm * 64 + mi * 16 + c16;
                if (m < M) {
#pragma unroll
                    for (int ni = 0; ni < 4; ++ni) {
                        const int n = nb + ni * 16 + q4 * 4;
                        const float4 bv = *(const float4*)(e.bias + n);
                        f32x4 o = {gelu_tanh(acc[ni][mi][0] + bv.x), gelu_tanh(acc[ni][mi][1] + bv.y), gelu_tanh(acc[ni][mi][2] + bv.z), gelu_tanh(acc[ni][mi][3] + bv.w)};
                        *(uint2*)(e.hid + (size_t)m * 256 + n) = pack4(o);
                    }
                }
            }
        } else if (EPI == EPI_BQ) {
            u16* Q = (u16*)(e.ws + OFF_Q);
#pragma unroll
            for (int mi = 0; mi < 4; ++mi) {
                const int tok = m0 + wm * 64 + mi * 16 + c16;
                rope_store(acc, mi, Q + (size_t)tok * 1024 + nb, cosT, sinT, tok & (S_ - 1), q4);
            }
        } else if (EPI == EPI_BKV) {
            u16* KSH = (u16*)(e.ws + OFF_KSH); u16* VSHT = (u16*)(e.ws + OFF_VSHT);
#pragma unroll
            for (int mi = 0; mi < 4; ++mi) {
                const int tok = m0 + wm * 64 + mi * 16 + c16, b = tok >> 14, s = tok & (S_ - 1);
                if (nb < 128) {
                    const int g = nb >> 6;
                    rope_store(acc, mi, KSH + ((size_t)(b * 2 + g) * S_ + s) * 64, cosT, sinT, s, q4);
                } else {
                    const int g = (nb - 128) >> 6;
#pragma unroll
                    for (int ni = 0; ni < 4; ++ni)
#pragma unroll
                        for (int i = 0; i < 4; ++i) VSHT[((size_t)(b * 2 + g) * 64 + ni * 16 + q4 * 4 + i) * S_ + s] = f2bf(acc[ni][mi][i]);
                }
            }
        } else if (EPI == EPI_AIN) {
            unsigned char* ws = e.ws;
#pragma unroll
            for (int mi = 0; mi < 4; ++mi) {
                const int tok = m0 + wm * 64 + mi * 16 + c16, b = tok >> 14, s = tok & (S_ - 1);
                if (nb < 1024) {
                    rope_store(acc, mi, (u16*)(ws + OFF_Q) + (size_t)tok * 1024 + nb, cosT, sinT, s, q4);
                } else if (nb < 1536) {
                    u16* dst = (nb < 1280) ? ((u16*)(ws + OFF_KC) + (size_t)tok * 256 + (nb - 1024)) : ((u16*)(ws + OFF_VC) + (size_t)tok * 256 + (nb - 1280));
#pragma unroll
                    for (int ni = 0; ni < 4; ++ni) *(uint2*)(dst + ni * 16 + q4 * 4) = pack4(acc[ni][mi]);
                } else if (nb < 2560) {
                    const int r = (nb - 1536) >> 8;
                    const int g = ((nb - 1536) & 255) >> 6;
                    if (r == 0) {
                        unsigned char* kd = (unsigned char*)(ws + OFF_KS) + (size_t)(b * 4 + g) * S_ * 128 + (size_t)s * 64;
#pragma unroll
                        for (int ni = 0; ni < 2; ++ni) {
                            const int d = ni * 16 + q4 * 4;
                            const float4 c = *(const float4*)(cosT + s * 32 + d), sn = *(const float4*)(sinT + s * 32 + d);
                            const f32x4 x1 = acc[ni][mi], x2 = acc[ni + 2][mi];
                            *(unsigned*)(kd + d) = pk4_fp8(x1[0] * c.x - x2[0] * sn.x, x1[1] * c.y - x2[1] * sn.y, x1[2] * c.z - x2[2] * sn.z, x1[3] * c.w - x2[3] * sn.w);
                            *(unsigned*)(kd + d + 32) = pk4_fp8(x2[0] * c.x + x1[0] * sn.x, x2[1] * c.y + x1[1] * sn.y, x2[2] * c.z + x1[2] * sn.z, x2[3] * c.w + x1[3] * sn.w);
                        }
                    } else if (r == 2) {
                        u16* base = (u16*)(ws + OFF_KW);
                        rope_store(acc, mi, base + ((size_t)(b * 4 + g) * S_ + s) * 64, cosT, sinT, s, q4);
                    } else {
                        if (r == 1) {
                            unsigned char* base = (unsigned char*)(ws + OFF_VST) + (size_t)(b * 4 + g) * 128 * S_ + (size_t)(s >> 6) * 4096 + (s & 63);
#pragma unroll
                            for (int ni = 0; ni < 4; ++ni) {
                                const unsigned pk = pk4_fp8(acc[ni][mi][0], acc[ni][mi][1], acc[ni][mi][2], acc[ni][mi][3]);
#pragma unroll
                                for (int i = 0; i < 4; ++i) base[(ni * 16 + q4 * 4 + i) * 64] = (unsigned char)(pk >> (8 * i));
                            }
                        } else {
                            u16* base = (u16*)(ws + OFF_VWT);
#pragma unroll
                            for (int ni = 0; ni < 4; ++ni)
#pragma unroll
                                for (int i = 0; i < 4; ++i) base[((size_t)(b * 4 + g) * 64 + ni * 16 + q4 * 4 + i) * S_ + s] = f2bf(acc[ni][mi][i]);
                        }
                    }
                } else if (nb == 2560) {
                    float* G = (float*)(ws + OFF_GATES) + (size_t)tok * 48;
#pragma unroll
                    for (int ni = 0; ni < 3; ++ni) {
                        const int n = ni * 16 + q4 * 4;
                        *(float4*)(G + n) = make_float4(sigmoidf_(acc[ni][mi][0]), sigmoidf_(acc[ni][mi][1]), sigmoidf_(acc[ni][mi][2]), sigmoidf_(acc[ni][mi][3]));
                    }
                }
            }
        } else if (EPI == EPI_FFNIN) {
            float* U = (float*)smem;
#pragma unroll
            for (int mi = 0; mi < 4; ++mi) {
                const int row = wm * 64 + mi * 16 + c16;
#pragma unroll
                for (int ni = 0; ni < 4; ++ni) {
                    const int chunk = wn * 16 + ni * 4 + q4;
                    *(f32x4*)(U + row * 128 + ((chunk ^ (row & 31)) << 2)) = acc[ni][mi];
                }
            }
            __syncthreads();
            {
                const int ca = tid & 15, seg = tid >> 4;
                const int ncol = nt * 64 + ca * 4;
                const float4 w0a = *(const float4*)(e.convw + ncol), w1a = *(const float4*)(e.convw + NFF2 + ncol), w2a = *(const float4*)(e.convw + 2 * NFF2 + ncol);
                const float4 w0g = *(const float4*)(e.convw + DFF + ncol), w1g = *(const float4*)(e.convw + NFF2 + DFF + ncol), w2g = *(const float4*)(e.convw + 2 * NFF2 + DFF + ncol);
                const float4 ba = *(const float4*)(e.convb + ncol), bg = *(const float4*)(e.convb + DFF + ncol);
                float* head = (float*)(e.ws + OFF_HEAD); float* halo = (float*)(e.ws + OFF_HALO);
                u16* act = (u16*)(e.ws + OFF_ACT);
                const int r0 = seg * 8;
                float4 a2 = make_float4(0.f, 0.f, 0.f, 0.f), a1 = a2, g2 = a2, g1 = a2;
                if (seg > 0) {
                    const int rA = r0 - 2, rB = r0 - 1;
                    a2 = *(const float4*)(U + rA * 128 + ((ca ^ (rA & 31)) << 2)); g2 = *(const float4*)(U + rA * 128 + (((16 + ca) ^ (rA & 31)) << 2));
                    a1 = *(const float4*)(U + rB * 128 + ((ca ^ (rB & 31)) << 2)); g1 = *(const float4*)(U + rB * 128 + (((16 + ca) ^ (rB & 31)) << 2));
                }
#pragma unroll
                for (int r = 0; r < 8; ++r) {
                    const int row = r0 + r;
                    const float4 ua = *(const float4*)(U + row * 128 + ((ca ^ (row & 31)) << 2));
                    const float4 ug = *(const float4*)(U + row * 128 + (((16 + ca) ^ (row & 31)) << 2));
                    if (seg > 0 || r >= 2) {
                        float ca_[4], cg_[4];
                        ca_[0] = ba.x + w0a.x * a2.x + w1a.x * a1.x + w2a.x * ua.x; ca_[1] = ba.y + w0a.y * a2.y + w1a.y * a1.y + w2a.y * ua.y;
                        ca_[2] = ba.z + w0a.z * a2.z + w1a.z * a1.z + w2a.z * ua.z; ca_[3] = ba.w + w0a.w * a2.w + w1a.w * a1.w + w2a.w * ua.w;
                        cg_[0] = bg.x + w0g.x * g2.x + w1g.x * g1.x + w2g.x * ug.x; cg_[1] = bg.y + w0g.y * g2.y + w1g.y * g1.y + w2g.y * ug.y;
                        cg_[2] = bg.z + w0g.z * g2.z + w1g.z * g1.z + w2g.z * ug.z; cg_[3] = bg.w + w0g.w * g2.w + w1g.w * g1.w + w2g.w * ug.w;
                        f32x4 o = {ca_[0] * sigmoidf_(ca_[0]) * cg_[0], ca_[1] * sigmoidf_(ca_[1]) * cg_[1], ca_[2] * sigmoidf_(ca_[2]) * cg_[2], ca_[3] * sigmoidf_(ca_[3]) * cg_[3]};
                        *(uint2*)(act + (size_t)(m0 + row) * DFF + ncol) = pack4(o);
                    }
                    if (seg == 0 && r < 2) { *(float4*)(head + (size_t)(mt * 2 + r) * NFF2 + ncol) = ua; *(float4*)(head + (size_t)(mt * 2 + r) * NFF2 + DFF + ncol) = ug; }
                    if (seg == 31 && r >= 6) { *(float4*)(halo + (size_t)(mt * 2 + r - 6) * NFF2 + ncol) = ua; *(float4*)(halo + (size_t)(mt * 2 + r - 6) * NFF2 + DFF + ncol) = ug; }
                    a2 = a1; a1 = ua; g2 = g1; g1 = ug;
                }
            }
            __syncthreads();
        }
    }
}

template <int AMODE, int EPI>
__device__ __forceinline__ void gemm_big(const u16* __restrict__ A, int lda, const u16* __restrict__ Bt, int M, int Npad, int K, int vboff, const EpiArgs& e, unsigned char* smem, int tid_, int bid_) {
    const int tid = tid_, lane = tid & 63, w = tid >> 6, wm = w & 1, wn = w >> 1;
    const int c16 = lane & 15, q4 = lane >> 4;
    constexpr int MI = 8;
    const int ntm = (M + 255) >> 8, ntn = Npad >> 8, nk = K >> 5;
    const int kstride = (AMODE == AM_GATHER) ? 128 : 32;
    const float* cosT = (const float*)(e.ws + OFF_COS);
    const float* sinT = (const float*)(e.ws + OFF_SIN);
    int vb = bid_ + vboff; if (vb >= (int)gridDim.x) vb -= gridDim.x;
    const int xcd = vb & 7, loc = vb >> 3, nloc = gridDim.x >> 3;
    const int mpx = ntm >> 3, nfull = (ntn >> 3), bwl = ntn - (nfull << 3);
    const int tfull = nfull * mpx * 8, ttotal = mpx * ntn;
    for (int tl = loc; tl < ttotal; tl += nloc) {
        int mloc, nt;
        if (tl < tfull) { const int band = tl / (mpx * 8), r = tl - band * (mpx * 8); mloc = r >> 3; nt = band * 8 + (r & 7); }
        else { const int r = tl - tfull; mloc = r / bwl; nt = (nfull << 3) + (r - mloc * bwl); }
        const int mt = xcd * mpx + mloc;
        const int m0 = mt << 8, n0 = nt << 8;
        const int prow = ((w & 3) << 6) + (lane >> 3);
        const int pch = lane & 7;
        unsigned goff[8];
#pragma unroll
        for (int i = 0; i < 8; ++i) {
            const int row = prow + 8 * i;
            const int lc = pch ^ ((row >> 1) & 7);
            if (w < 4) {
                int m = m0 + row; if (m > M - 1) m = M - 1;
                if (AMODE == AM_GATHER) { const int gq = m & 3, bn = m >> 2, bb = bn / 1023, n = bn - bb * 1023; goff[i] = (unsigned)((bb * S_ + n * 16) * 256 + gq * 64 + lc * 8); }
                else goff[i] = (unsigned)m * (unsigned)lda + (unsigned)(lc * 8);
            } else goff[i] = (unsigned)(n0 + row) * (unsigned)K + (unsigned)(lc * 8);
        }
        const u16* gbase = (w < 4) ? A : Bt;
        const unsigned kst = (w < 4 && AMODE == AM_GATHER) ? 256u : 64u;
        typedef __attribute__((address_space(3))) unsigned* lds_u32p;
        const unsigned lbase = ((w < 4) ? 0u : 32768u) + (unsigned)(((w & 3) << 6) * 128) + (unsigned)lane * 16u;
        f32x4 acc[4][MI];
#pragma unroll
        for (int a2 = 0; a2 < 4; ++a2)
#pragma unroll
            for (int b2 = 0; b2 < MI; ++b2) acc[a2][b2] = (f32x4){0.f, 0.f, 0.f, 0.f};
        const int swz = (c16 >> 1) & 7;
        const int nk2 = nk >> 1;
#pragma unroll
        for (int i = 0; i < 8; ++i) __builtin_amdgcn_global_load_lds((const unsigned*)(gbase + goff[i]), (lds_u32p)(smem + lbase + i * 1024), 16, 0, 0);
        for (int kt = 0; kt < nk2; ++kt) {
            asm volatile("s_waitcnt vmcnt(0)" ::: "memory");
            __builtin_amdgcn_s_barrier();
            const unsigned char* sA = smem + (kt & 1) * 65536;
            const unsigned char* sB = sA + 32768;
            const bool more = kt + 1 < nk2;
            const unsigned ko = (unsigned)(kt + 1) * kst;
            unsigned char* sbn = smem + ((kt + 1) & 1) * 65536 + lbase;
#pragma unroll
            for (int ks = 0; ks < 2; ++ks) {
                bf16x8 wf[4], af[MI];
                const int ch = ((ks * 4 + q4) ^ swz) << 4;
#pragma unroll
                for (int ni = 0; ni < 4; ++ni) wf[ni] = *(const bf16x8*)(sB + (wn * 64 + ni * 16 + c16) * 128 + ch);
#pragma unroll
                for (int mi = 0; mi < MI; ++mi) af[mi] = *(const bf16x8*)(sA + (wm * 128 + mi * 16 + c16) * 128 + ch);
#pragma unroll
                for (int ni = 0; ni < 4; ++ni) {
                    if (more) __builtin_amdgcn_global_load_lds((const unsigned*)(gbase + (goff[ks * 4 + ni] + ko)), (lds_u32p)(sbn + (ks * 4 + ni) * 1024), 16, 0, 0);
#pragma unroll
                    for (int mi = 0; mi < MI; ++mi) acc[ni][mi] = mfma16(wf[ni], af[mi], acc[ni][mi]);
                }
            }
        }
        __syncthreads();
        const int nb = n0 + wn * 64;
        if (EPI == EPI_RESID) {
#pragma unroll
            for (int mi = 0; mi < MI; ++mi) { __builtin_amdgcn_sched_barrier(0);
                const size_t tok = m0 + wm * 128 + mi * 16 + c16;
#pragma unroll
                for (int ni = 0; ni < 4; ++ni) {
                    const int n = nb + ni * 16 + q4 * 4;
                    float4 r = *(const float4*)(e.resid + tok * 1024 + n);
                    r.x += acc[ni][mi][0]; r.y += acc[ni][mi][1]; r.z += acc[ni][mi][2]; r.w += acc[ni][mi][3];
                    *(float4*)(e.out + tok * 1024 + n) = r;
                }
            }
        } else if (EPI == EPI_CMP1) {
#pragma unroll
            for (int mi = 0; mi < MI; ++mi) { __builtin_amdgcn_sched_barrier(0);
                const int m = m0 + wm * 128 + mi * 16 + c16;
                if (m < M) {
#pragma unroll
                    for (int ni = 0; ni < 4; ++ni) {
                        const int n = nb + ni * 16 + q4 * 4;
                        const float4 bv = *(const float4*)(e.bias + n);
                        f32x4 o = {gelu_tanh(acc[ni][mi][0] + bv.x), gelu_tanh(acc[ni][mi][1] + bv.y), gelu_tanh(acc[ni][mi][2] + bv.z), gelu_tanh(acc[ni][mi][3] + bv.w)};
                        *(uint2*)(e.hid + (size_t)m * 256 + n) = pack4(o);
                    }
                }
            }
        } else if (EPI == EPI_BQ) {
            u16* Q = (u16*)(e.ws + OFF_Q);
#pragma unroll
            for (int mi = 0; mi < MI; ++mi) { __builtin_amdgcn_sched_barrier(0);
                const int tok = m0 + wm * 128 + mi * 16 + c16;
                rope_store(acc, mi, Q + (size_t)tok * 1024 + nb, cosT, sinT, tok & (S_ - 1), q4);
            }
        } else if (EPI == EPI_BKV) {
            u16* KSH = (u16*)(e.ws + OFF_KSH); u16* VSHT = (u16*)(e.ws + OFF_VSHT);
#pragma unroll
            for (int mi = 0; mi < MI; ++mi) { __builtin_amdgcn_sched_barrier(0);
                const int tok = m0 + wm * 128 + mi * 16 + c16, b = tok >> 14, s = tok & (S_ - 1);
                if (nb < 128) {
                    const int g = nb >> 6;
                    rope_store(acc, mi, KSH + ((size_t)(b * 2 + g) * S_ + s) * 64, cosT, sinT, s, q4);
                } else {
                    const int g = (nb - 128) >> 6;
#pragma unroll
                    for (int ni = 0; ni < 4; ++ni)
#pragma unroll
                        for (int i = 0; i < 4; ++i) VSHT[((size_t)(b * 2 + g) * 64 + ni * 16 + q4 * 4 + i) * S_ + s] = f2bf(acc[ni][mi][i]);
                }
            }
        } else if (EPI == EPI_AIN) {
            unsigned char* ws = e.ws;
#pragma unroll
            for (int mi = 0; mi < MI; ++mi) { __builtin_amdgcn_sched_barrier(0);
                const int tok = m0 + wm * 128 + mi * 16 + c16, b = tok >> 14, s = tok & (S_ - 1);
                if (nb < 1024) {
                    rope_store(acc, mi, (u16*)(ws + OFF_Q) + (size_t)tok * 1024 + nb, cosT, sinT, s, q4);
                } else if (nb < 1536) {
                    u16* dst = (nb < 1280) ? ((u16*)(ws + OFF_KC) + (size_t)tok * 256 + (nb - 1024)) : ((u16*)(ws + OFF_VC) + (size_t)tok * 256 + (nb - 1280));
#pragma unroll
                    for (int ni = 0; ni < 4; ++ni) *(uint2*)(dst + ni * 16 + q4 * 4) = pack4(acc[ni][mi]);
                } else if (nb < 2560) {
                    const int r = (nb - 1536) >> 8;
                    const int g = ((nb - 1536) & 255) >> 6;
                    if (r == 0) {
                        unsigned char* kd = (unsigned char*)(ws + OFF_KS) + (size_t)(b * 4 + g) * S_ * 128 + (size_t)s * 64;
#pragma unroll
                        for (int ni = 0; ni < 2; ++ni) {
                            const int d = ni * 16 + q4 * 4;
                            const float4 c = *(const float4*)(cosT + s * 32 + d), sn = *(const float4*)(sinT + s * 32 + d);
                            const f32x4 x1 = acc[ni][mi], x2 = acc[ni + 2][mi];
                            *(unsigned*)(kd + d) = pk4_fp8(x1[0] * c.x - x2[0] * sn.x, x1[1] * c.y - x2[1] * sn.y, x1[2] * c.z - x2[2] * sn.z, x1[3] * c.w - x2[3] * sn.w);
                            *(unsigned*)(kd + d + 32) = pk4_fp8(x2[0] * c.x + x1[0] * sn.x, x2[1] * c.y + x1[1] * sn.y, x2[2] * c.z + x1[2] * sn.z, x2[3] * c.w + x1[3] * sn.w);
                        }
                    } else if (r == 2) {
                        u16* base = (u16*)(ws + OFF_KW);
                        rope_store(acc, mi, base + ((size_t)(b * 4 + g) * S_ + s) * 64, cosT, sinT, s, q4);
                    } else {
                        if (r == 1) {
                            unsigned char* base = (unsigned char*)(ws + OFF_VST) + (size_t)(b * 4 + g) * 128 * S_ + (size_t)(s >> 6) * 4096 + (s & 63);
#pragma unroll
                            for (int ni = 0; ni < 4; ++ni) {
                                const unsigned pk = pk4_fp8(acc[ni][mi][0], acc[ni][mi][1], acc[ni][mi][2], acc[ni][mi][3]);
#pragma unroll
                                for (int i = 0; i < 4; ++i) base[(ni * 16 + q4 * 4 + i) * 64] = (unsigned char)(pk >> (8 * i));
                            }
                        } else {
                            u16* base = (u16*)(ws + OFF_VWT);
#pragma unroll
                            for (int ni = 0; ni < 4; ++ni)
#pragma unroll
                                for (int i = 0; i < 4; ++i) base[((size_t)(b * 4 + g) * 64 + ni * 16 + q4 * 4 + i) * S_ + s] = f2bf(acc[ni][mi][i]);
                        }
                    }
                } else if (nb == 2560) {
                    float* G = (float*)(ws + OFF_GATES) + (size_t)tok * 48;
#pragma unroll
                    for (int ni = 0; ni < 3; ++ni) {
                        const int n = ni * 16 + q4 * 4;
                        *(float4*)(G + n) = make_float4(sigmoidf_(acc[ni][mi][0]), sigmoidf_(acc[ni][mi][1]), sigmoidf_(acc[ni][mi][2]), sigmoidf_(acc[ni][mi][3]));
                    }
                }
            }
        } else if (EPI == EPI_FFNIN) {
            u16* U = (u16*)smem;
#pragma unroll
            for (int mi = 0; mi < MI; ++mi) {
                const int row = wm * 128 + mi * 16 + c16;
#pragma unroll
                for (int ni = 0; ni < 4; ++ni) {
                    const int cch = wn * 16 + ni * 4 + q4;
                    *(uint2*)(U + row * 256 + ((cch ^ (row & 15)) << 2)) = pack4(acc[ni][mi]);
                }
            }
            __syncthreads();
            {
                const int cc = tid & 31, gsel = cc >> 4, ca = cc & 15, seg = tid >> 5;
                const int ncol = (nt * 2 + gsel) * 64 + ca * 4;
                const int cha = gsel * 32 + ca, chg = cha + 16;
                const float4 w0a = *(const float4*)(e.convw + ncol), w1a = *(const float4*)(e.convw + NFF2 + ncol), w2a = *(const float4*)(e.convw + 2 * NFF2 + ncol);
                const float4 w0g = *(const float4*)(e.convw + DFF + ncol), w1g = *(const float4*)(e.convw + NFF2 + DFF + ncol), w2g = *(const float4*)(e.convw + 2 * NFF2 + DFF + ncol);
                const float4 ba = *(const float4*)(e.convb + ncol), bg = *(const float4*)(e.convb + DFF + ncol);
                float* head = (float*)(e.ws + OFF_HEAD); float* halo = (float*)(e.ws + OFF_HALO);
                u16* act = (u16*)(e.ws + OFF_ACT);
                auto ldu = [&](int row, int ch) __attribute__((always_inline)) -> float4 {
                    const uint2 v = *(const uint2*)(U + row * 256 + ((ch ^ (row & 15)) << 2));
                    return make_float4(__uint_as_float(v.x << 16), __uint_as_float(v.x & 0xffff0000u), __uint_as_float(v.y << 16), __uint_as_float(v.y & 0xffff0000u));
                };
                const int r0 = seg * 16;
                float4 a2 = make_float4(0.f, 0.f, 0.f, 0.f), a1 = a2, g2 = a2, g1 = a2;
                if (seg > 0) { a2 = ldu(r0 - 2, cha); g2 = ldu(r0 - 2, chg); a1 = ldu(r0 - 1, cha); g1 = ldu(r0 - 1, chg); }
#pragma unroll 2
                for (int r = 0; r < 16; ++r) {
                    const int row = r0 + r;
                    const float4 ua = ldu(row, cha), ug = ldu(row, chg);
                    if (seg > 0 || r >= 2) {
                        float ca_[4], cg_[4];
                        ca_[0] = ba.x + w0a.x * a2.x + w1a.x * a1.x + w2a.x * ua.x; ca_[1] = ba.y + w0a.y * a2.y + w1a.y * a1.y + w2a.y * ua.y;
                        ca_[2] = ba.z + w0a.z * a2.z + w1a.z * a1.z + w2a.z * ua.z; ca_[3] = ba.w + w0a.w * a2.w + w1a.w * a1.w + w2a.w * ua.w;
                        cg_[0] = bg.x + w0g.x * g2.x + w1g.x * g1.x + w2g.x * ug.x; cg_[1] = bg.y + w0g.y * g2.y + w1g.y * g1.y + w2g.y * ug.y;
                        cg_[2] = bg.z + w0g.z * g2.z + w1g.z * g1.z + w2g.z * ug.z; cg_[3] = bg.w + w0g.w * g2.w + w1g.w * g1.w + w2g.w * ug.w;
                        f32x4 o = {ca_[0] * sigmoidf_(ca_[0]) * cg_[0], ca_[1] * sigmoidf_(ca_[1]) * cg_[1], ca_[2] * sigmoidf_(ca_[2]) * cg_[2], ca_[3] * sigmoidf_(ca_[3]) * cg_[3]};
                        *(uint2*)(act + (size_t)(m0 + row) * DFF + ncol) = pack4(o);
                    }
                    if (seg == 0 && r < 2) { *(float4*)(head + (size_t)(mt * 2 + r) * NFF2 + ncol) = ua; *(float4*)(head + (size_t)(mt * 2 + r) * NFF2 + DFF + ncol) = ug; }
                    if (seg == 15 && r >= 14) { *(float4*)(halo + (size_t)(mt * 2 + r - 14) * NFF2 + ncol) = ua; *(float4*)(halo + (size_t)(mt * 2 + r - 14) * NFF2 + DFF + ncol) = ug; }
                    a2 = a1; a1 = ua; g2 = g1; g1 = ug;
                }
            }
            __syncthreads();
        }
    }
}

__device__ __forceinline__ void fixup_phase(const Params& p, int L, int tid_, int bid_) {
    const float* head = (const float*)(p.ws + OFF_HEAD); const float* halo = (const float*)(p.ws + OFF_HALO);
    u16* act = (u16*)(p.ws + OFF_ACT);
    const float* cw = p.ffn_conv_w + (size_t)L * 3 * NFF2; const float* cb = p.ffn_conv_b + (size_t)L * NFF2;
    const int gt = bid_ * NTHR + tid_, nthr = gridDim.x * NTHR;
    for (int idx = gt; idx < 128 * 704; idx += nthr) {
        const int i = idx / 704, n = (idx - i * 704) * 4;
        const int t0 = i * 256;
        const bool first = (t0 & (S_ - 1)) == 0;
        const float4 z = make_float4(0.f, 0.f, 0.f, 0.f);
        const float4 ha0 = *(const float4*)(head + (size_t)(i * 2) * NFF2 + n), ha1 = *(const float4*)(head + (size_t)(i * 2 + 1) * NFF2 + n);
        const float4 hg0 = *(const float4*)(head + (size_t)(i * 2) * NFF2 + DFF + n), hg1 = *(const float4*)(head + (size_t)(i * 2 + 1) * NFF2 + DFF + n);
        float4 pa0 = z, pa1 = z, pg0 = z, pg1 = z;
        if (!first) {
            pa0 = *(const float4*)(halo + (size_t)(i * 2 - 2) * NFF2 + n); pa1 = *(const float4*)(halo + (size_t)(i * 2 - 1) * NFF2 + n);
            pg0 = *(const float4*)(halo + (size_t)(i * 2 - 2) * NFF2 + DFF + n); pg1 = *(const float4*)(halo + (size_t)(i * 2 - 1) * NFF2 + DFF + n);
        }
        const float4 w0a = *(const float4*)(cw + n), w1a = *(const float4*)(cw + NFF2 + n), w2a = *(const float4*)(cw + 2 * NFF2 + n);
        const float4 w0g = *(const float4*)(cw + DFF + n), w1g = *(const float4*)(cw + NFF2 + DFF + n), w2g = *(const float4*)(cw + 2 * NFF2 + DFF + n);
        const float4 ba = *(const float4*)(cb + n), bg = *(const float4*)(cb + DFF + n);
#define CONV3(b_, w0_, w1_, w2_, x0_, x1_, x2_) make_float4(b_.x + w0_.x * x0_.x + w1_.x * x1_.x + w2_.x * x2_.x, b_.y + w0_.y * x0_.y + w1_.y * x1_.y + w2_.y * x2_.y, \
                                                             b_.z + w0_.z * x0_.z + w1_.z * x1_.z + w2_.z * x2_.z, b_.w + w0_.w * x0_.w + w1_.w * x1_.w + w2_.w * x2_.w)
        const float4 ca0 = CONV3(ba, w0a, w1a, w2a, pa0, pa1, ha0), cg0 = CONV3(bg, w0g, w1g, w2g, pg0, pg1, hg0);
        const float4 ca1 = CONV3(ba, w0a, w1a, w2a, pa1, ha0, ha1), cg1 = CONV3(bg, w0g, w1g, w2g, pg1, hg0, hg1);
        f32x4 o0 = {ca0.x * sigmoidf_(ca0.x) * cg0.x, ca0.y * sigmoidf_(ca0.y) * cg0.y, ca0.z * sigmoidf_(ca0.z) * cg0.z, ca0.w * sigmoidf_(ca0.w) * cg0.w};
        f32x4 o1 = {ca1.x * sigmoidf_(ca1.x) * cg1.x, ca1.y * sigmoidf_(ca1.y) * cg1.y, ca1.z * sigmoidf_(ca1.z) * cg1.z, ca1.w * sigmoidf_(ca1.w) * cg1.w};
        *(uint2*)(act + (size_t)t0 * DFF + n) = pack4(o0);
        *(uint2*)(act + (size_t)(t0 + 1) * DFF + n) = pack4(o1);
    }
}

__device__ __forceinline__ void cmp2_phase(const Params& p, int L, int tid_, int bid_) {
    const int lane = tid_ & 63, w = tid_ >> 6, c16 = lane & 15, q4 = lane >> 4;
    const float* cosT = (const float*)(p.ws + OFF_COS); const float* sinT = (const float*)(p.ws + OFF_SIN);
    u16* KCC = (u16*)(p.ws + OFF_KCC); u16* VCCT = (u16*)(p.ws + OFF_VCCT);
    for (int task = bid_ * NW + w; task < 1024; task += gridDim.x * NW) {
        const int kv = task >> 9, r0 = (task & 511) * 16;
        const u16* hid = (const u16*)(p.ws + OFF_HID) + (size_t)kv * 8192 * 256;
        const u16* w2t = (const u16*)(p.ws + OFF_WT_CW2 + (L * 2 + kv) * SZ_WT_CW2);
        const int row = r0 + c16, rowc = row < 8184 ? row : 8183;
        f32x4 acc[4][1];
        f32x4 accq[4][4];
#pragma unroll
        for (int a = 0; a < 4; ++a) accq[a][0] = (f32x4){0.f, 0.f, 0.f, 0.f};
#pragma unroll
        for (int kk = 0; kk < 8; ++kk) {
            const bf16x8 bfr = *(const bf16x8*)(hid + (size_t)rowc * 256 + kk * 32 + q4 * 8);
#pragma unroll
            for (int nbk = 0; nbk < 4; ++nbk) {
                const bf16x8 afr = *(const bf16x8*)(w2t + (nbk * 16 + c16) * 256 + kk * 32 + q4 * 8);
                accq[nbk][0] = mfma16(afr, bfr, accq[nbk][0]);
            }
        }
        (void)acc;
        if (row < 8184) {
            const int g = row & 3, bn = row >> 2, b = bn / 1023, n = bn - b * 1023, bg = b * 4 + g;
            if (kv == 0) {
                rope_store(accq, 0, KCC + ((size_t)bg * 1024 + n) * 64, cosT, sinT, n * 16 + 31, q4);
            } else {
#pragma unroll
                for (int nbk = 0; nbk < 4; ++nbk)
#pragma unroll
                    for (int i = 0; i < 4; ++i) VCCT[((size_t)bg * 64 + nbk * 16 + q4 * 4 + i) * 1024 + n] = f2bf(accq[nbk][0][i]);
            }
        }
    }
    const int gt = bid_ * NTHR + tid_;
    if (gt < 512) {
        const int bg = gt >> 6, d = gt & 63;
        KCC[((size_t)bg * 1024 + 1023) * 64 + d] = 0;
        VCCT[((size_t)bg * 64 + d) * 1024 + 1023] = 0;
    }
}

template <bool SINK>
__device__ __forceinline__ void band_attn(const u16* __restrict__ qrow, const u16* __restrict__ Kh, const u16* __restrict__ VT, int t0, int W, const float* sinks4,
                                          f32x4 (&O)[4][4], float (&linv)[4], int lane) {
    const int c16 = lane & 15, q4 = lane >> 4;
    const float SC = 0.125f * LOG2E;
    bf16x8 qf[4][2];
#pragma unroll
    for (int h = 0; h < 4; ++h)
#pragma unroll
        for (int ks = 0; ks < 2; ++ks) qf[h][ks] = *(const bf16x8*)(qrow + h * 64 + ks * 32 + q4 * 8);
    float m[4], l[4];
#pragma unroll
    for (int h = 0; h < 4; ++h) {
        if (SINK) { m[h] = sinks4[h] * LOG2E; l[h] = (q4 == 0) ? 1.f : 0.f; }
        else { m[h] = NEGBIG; l[h] = 0.f; }
#pragma unroll
        for (int db = 0; db < 4; ++db) O[h][db] = (f32x4){0.f, 0.f, 0.f, 0.f};
    }
    const int t = t0 + c16;
    int lo = t0 - W + 1; if (lo < 0) lo = 0;
    const int g0 = lo >> 5, g1 = (t0 + 15) >> 5;
    const int kr = kperm(c16);
    for (int grp = g0; grp <= g1; ++grp) {
        const int kb = grp << 5;
        const unsigned kof = (unsigned)(kb + kr) * 64u + (unsigned)q4 * 8u;
        const bf16x8 k1a = *(const bf16x8*)(Kh + kof), k1b = *(const bf16x8*)(Kh + (kof + 32u)), k2a = *(const bf16x8*)(Kh + (kof + 256u)), k2b = *(const bf16x8*)(Kh + (kof + 288u));
        bf16x8 vf[4];
        const unsigned vof = (unsigned)c16 * (unsigned)S_ + (unsigned)kb + (unsigned)q4 * 8u;
#pragma unroll
        for (int db = 0; db < 4; ++db) vf[db] = *(const bf16x8*)(VT + (size_t)(db * 16 * S_) + vof);
        const int kpos = kb + q4 * 8;
        f32x4 cm1 = {0.f, 0.f, 0.f, 0.f}, cm2 = cm1;
        if (!((kb + 31 <= t0) && (kb > t0 + 15 - W))) {
#pragma unroll
            for (int i = 0; i < 4; ++i) {
                const int d1 = t - (kpos + i), d2 = t - (kpos + 4 + i);
                if (!((d1 >= 0) && (d1 < W))) cm1[i] = NEGBIG;
                if (!((d2 >= 0) && (d2 < W))) cm2[i] = NEGBIG;
            }
        }
#pragma unroll
        for (int h = 0; h < 4; ++h) {
            f32x4 s1 = mfma16(k1a, qf[h][0], cm1); s1 = mfma16(k1b, qf[h][1], s1);
            f32x4 s2 = mfma16(k2a, qf[h][0], cm2); s2 = mfma16(k2b, qf[h][1], s2);
            float mx = fmaxf(fmaxf(fmaxf(s1[0], s1[1]), fmaxf(s1[2], s1[3])), fmaxf(fmaxf(s2[0], s2[1]), fmaxf(s2[2], s2[3])));
            mx = xmax32(xmax16(mx));
            const float mn = fmaxf(fmaxf(m[h], mx * SC), -1e20f);
            if (__ballot(mn != m[h])) {
                const float alpha = fexp2(m[h] - mn);
                l[h] *= alpha;
#pragma unroll
                for (int db = 0; db < 4; ++db) O[h][db] = O[h][db] * alpha;
            }
            m[h] = mn;
            float pv[8]; float ps = 0.f;
#pragma unroll
            for (int i = 0; i < 4; ++i) { pv[i] = fexp2(fmaf(s1[i], SC, -mn)); pv[4 + i] = fexp2(fmaf(s2[i], SC, -mn)); }
#pragma unroll
            for (int i = 0; i < 8; ++i) ps += pv[i];
            l[h] += ps;
            const bf16x8 pf = pack8(pv);
#pragma unroll
            for (int db = 0; db < 4; ++db) O[h][db] = mfma16(vf[db], pf, O[h][db]);
        }
    }
#pragma unroll
    for (int h = 0; h < 4; ++h) { float lt = l[h]; lt += __shfl_xor(lt, 16); lt += __shfl_xor(lt, 32); linv[h] = 1.f / lt; }
}

__device__ __forceinline__ void swa_phase(const Params& p, int j, int tid_, int bid_) {
    const int lane = tid_ & 63, w = tid_ >> 6, c16 = lane & 15, q4 = lane >> 4;
    const int x = bid_ & 7, b = x >> 2, kvh = (x >> 1) & 1, hq = x & 1;
    const int head0 = kvh * 8 + hq * 4;
    const u16* Q = (const u16*)(p.ws + OFF_Q); u16* Ob = (u16*)(p.ws + OFF_O);
    const u16* Kh = (const u16*)(p.ws + OFF_KSH) + (size_t)(b * 2 + kvh) * S_ * 64;
    const u16* VT = (const u16*)(p.ws + OFF_VSHT) + (size_t)(b * 2 + kvh) * 64 * S_;
    const float* sk = p.b_sinks + j * 16 + head0;
    const int nslots = (gridDim.x >> 3) * NW;
    for (int tile = (bid_ >> 3) * NW + w; tile < 1024; tile += nslots) {
        const int t0 = tile * 16;
        f32x4 O[4][4]; float linv[4];
        band_attn<true>(Q + ((size_t)b * S_ + t0 + c16) * 1024 + head0 * 64, Kh, VT, t0, 128, sk, O, linv, lane);
        u16* op = Ob + ((size_t)b * S_ + t0 + c16) * 1024 + head0 * 64;
#pragma unroll
        for (int h = 0; h < 4; ++h)
#pragma unroll
            for (int db = 0; db < 4; ++db) *(uint2*)(op + h * 64 + db * 16 + q4 * 4) = pack4(O[h][db] * linv[h]);
    }
}

__device__ __forceinline__ void nsa_phase(const Params& p, unsigned char* smem, int tid_, int bid_, int probe_rep) {
    const int lane0 = tid_ & 63, w = tid_ >> 6;
    float* R = (float*)(smem + w * 16384);
    unsigned* tm = (unsigned*)(smem + NW * 16384 + w * 1024);
    unsigned char* sel = smem + NW * 16384 + NW * 1024 + w * 256;
    const int bg = bid_ & 7, b = bg >> 2, g = bg & 3;
    const u16* Q = (const u16*)(p.ws + OFF_Q); u16* Ob = (u16*)(p.ws + OFF_O);
    const u16* KCC = (const u16*)(p.ws + OFF_KCC) + (size_t)bg * 1024 * 64;
    const u16* VCCT = (const u16*)(p.ws + OFF_VCCT) + (size_t)bg * 64 * 1024;
    const u16* KS = (const u16*)(p.ws + OFF_KS) + (size_t)bg * S_ * 64;
    const u16* VST = (const u16*)(p.ws + OFF_VST) + (size_t)bg * 64 * S_;
    const u16* KW = (const u16*)(p.ws + OFF_KW) + (size_t)bg * S_ * 64;
    const u16* VWT = (const u16*)(p.ws + OFF_VWT) + (size_t)bg * 64 * S_;
    const float* GATES = (const float*)(p.ws + OFF_GATES);
    const float SC = 0.125f * LOG2E;
    const int nslots = (gridDim.x >> 3) * NW;
    const int slot_ = (bid_ >> 3) * NW + w;
    for (int rnd = 0; rnd * nslots < 1024; ++rnd) {
        const int tile_ = rnd * nslots + ((rnd & 1) ? (nslots - 1 - slot_) : slot_);
        if (tile_ >= 1024) continue;
        const int tile = __builtin_amdgcn_readfirstlane(tile_);
        int lane = lane0; asm volatile("" : "+v"(lane));
        const int c16 = lane & 15, q4 = lane >> 4, kr = kperm(c16);
        const int t0 = tile * 16, cur = t0 >> 6, t = t0 + c16;
        const u16* qrow = Q + ((size_t)b * S_ + t) * 1024 + g * 256;
        const float* grow = GATES + ((size_t)b * S_ + t) * 48 + g * 12;
        const int nvl = (t >= 31) ? ((t - 31) >> 4) : -1;
        const int nvmax = (t0 + 15 >= 31) ? ((t0 + 15 - 31) >> 4) : -1;
        const int ng = (nvmax >= 0) ? ((nvmax >> 5) + 1) : 0;
        f32x4 Oc[4][4];
#pragma unroll
        for (int h = 0; h < 4; ++h)
#pragma unroll
            for (int db = 0; db < 4; ++db) Oc[h][db] = (f32x4){0.f, 0.f, 0.f, 0.f};
        {
            bf16x8 qf[4][2];
#pragma unroll
            for (int h = 0; h < 4; ++h)
#pragma unroll
                for (int ks = 0; ks < 2; ++ks) qf[h][ks] = *(const bf16x8*)(qrow + h * 64 + ks * 32 + q4 * 8);
            float m[4], l[4];
#pragma unroll
            for (int h = 0; h < 4; ++h) { m[h] = NEGBIG; l[h] = 0.f; }
            const int nvmin = (t0 >= 31) ? ((t0 - 31) >> 4) : -1;
            for (int grp = 0; grp < ng; ++grp) {
                const int kb = grp << 5;
                const unsigned kof = (unsigned)(kb + kr) * 64u + (unsigned)q4 * 8u;
                const bf16x8 k1a = *(const bf16x8*)(KCC + kof), k1b = *(const bf16x8*)(KCC + (kof + 32u)), k2a = *(const bf16x8*)(KCC + (kof + 256u)), k2b = *(const bf16x8*)(KCC + (kof + 288u));
                const int kpos = kb + q4 * 8;
                f32x4 cm1 = {0.f, 0.f, 0.f, 0.f}, cm2 = cm1;
                if (kb + 31 > nvmin) {
#pragma unroll
                    for (int i = 0; i < 4; ++i) { if (kpos + i > nvl) cm1[i] = NEGBIG; if (kpos + 4 + i > nvl) cm2[i] = NEGBIG; }
                }
#pragma unroll
                for (int h = 0; h < 4; ++h) {
                    f32x4 s1 = mfma16(k1a, qf[h][0], cm1); s1 = mfma16(k1b, qf[h][1], s1);
                    f32x4 s2 = mfma16(k2a, qf[h][0], cm2); s2 = mfma16(k2b, qf[h][1], s2);
                    float mx = fmaxf(fmaxf(fmaxf(s1[0], s1[1]), fmaxf(s1[2], s1[3])), fmaxf(fmaxf(s2[0], s2[1]), fmaxf(s2[2], s2[3])));
                    mx = xmax32(xmax16(mx));
                    const float mn = fmaxf(fmaxf(m[h], mx * SC), -1e20f);
                    if (__ballot(mn != m[h])) l[h] *= fexp2(m[h] - mn);
                    m[h] = mn;
                    float ps = 0.f;
#pragma unroll
                    for (int i = 0; i < 4; ++i) ps += fexp2(fmaf(s1[i], SC, -mn)) + fexp2(fmaf(s2[i], SC, -mn));
                    l[h] += ps;
                }
            }
            float linv[4];
#pragma unroll
            for (int h = 0; h < 4; ++h) { float lt = l[h]; lt += __shfl_xor(lt, 16); lt += __shfl_xor(lt, 32); linv[h] = lt > 0.f ? 1.f / lt : 0.f; }
            float carry = 0.f;
            for (int grp = 0; grp < ng; ++grp) {
                const int kb = grp << 5;
                const unsigned kof = (unsigned)(kb + kr) * 64u + (unsigned)q4 * 8u;
                const bf16x8 k1a = *(const bf16x8*)(KCC + kof), k1b = *(const bf16x8*)(KCC + (kof + 32u)), k2a = *(const bf16x8*)(KCC + (kof + 256u)), k2b = *(const bf16x8*)(KCC + (kof + 288u));
                bf16x8 vf[4];
#pragma unroll
                for (int db = 0; db < 4; ++db) vf[db] = *(const bf16x8*)(VCCT + (unsigned)(db * 16 * 1024) + ((unsigned)c16 * 1024u + (unsigned)kb + (unsigned)q4 * 8u));
                const int kpos = kb + q4 * 8;
                float psum[8];
#pragma unroll
                for (int i = 0; i < 8; ++i) psum[i] = 0.f;
                f32x4 cm1 = {0.f, 0.f, 0.f, 0.f}, cm2 = cm1;
                if (kb + 31 > nvmin) {
#pragma unroll
                    for (int i = 0; i < 4; ++i) { if (kpos + i > nvl) cm1[i] = NEGBIG; if (kpos + 4 + i > nvl) cm2[i] = NEGBIG; }
                }
#pragma unroll
                for (int h = 0; h < 4; ++h) {
                    f32x4 s1 = mfma16(k1a, qf[h][0], cm1); s1 = mfma16(k1b, qf[h][1], s1);
                    f32x4 s2 = mfma16(k2a, qf[h][0], cm2); s2 = mfma16(k2b, qf[h][1], s2);
                    float pv[8];
#pragma unroll
                    for (int i = 0; i < 4; ++i) {
                        pv[i] = fexp2(fmaf(s1[i], SC, -m[h])) * linv[h];
                        pv[4 + i] = fexp2(fmaf(s2[i], SC, -m[h])) * linv[h];
                    }
#pragma unroll
                    for (int i = 0; i < 8; ++i) psum[i] += pv[i];
                    const bf16x8 pf = pack8(pv);
#pragma unroll
                    for (int db = 0; db < 4; ++db) Oc[h][db] = mfma16(vf[db], pf, Oc[h][db]);
                }
                const float prev = __shfl(psum[7], (lane + 48) & 63);
                const float left = (q4 == 0) ? carry : prev;
                carry = prev;
                const float impA = left + 2.f * (psum[0] + psum[1] + psum[2]) + psum[3];
                const float impB = psum[3] + 2.f * (psum[4] + psum[5] + psum[6]) + psum[7];
                *(float2*)(R + c16 * 256 + (kb >> 2) + 2 * q4) = make_float2(impA, impB);
            }
        }
        wsync();
        const int ncand = cur - 2;
        const int npick = ncand < 0 ? 0 : (ncand < 13 ? ncand : 13);
        const int nforced = (cur < 2 ? cur : 2) + 1;
        const int nsel = npick + nforced;
        for (int tk = 0; tk < 8; ++tk) {
            float a0 = -1.f, a1 = -1.f, a2 = -1.f, a3 = -1.f, b0 = -1.f, b1 = -1.f, b2 = -1.f, b3 = -1.f;
            if (npick > 0) {
                const float4 va = *(const float4*)(R + tk * 256 + lane * 4), vb = *(const float4*)(R + (tk + 8) * 256 + lane * 4);
                const int j0 = lane * 4;
                const bool k0 = (j0 >= 1 && j0 <= ncand), k1 = (j0 + 1 <= ncand), k2 = (j0 + 2 <= ncand), k3 = (j0 + 3 <= ncand);
                a0 = k0 ? va.x : -1.f; a1 = k1 ? va.y : -1.f; a2 = k2 ? va.z : -1.f; a3 = k3 ? va.w : -1.f;
                b0 = k0 ? vb.x : -1.f; b1 = k1 ? vb.y : -1.f; b2 = k2 ? vb.z : -1.f; b3 = k3 ? vb.w : -1.f;
            }
            for (int it = 0; it < npick; ++it) {
                const float ma = wave_max(fmaxf(fmaxf(a0, a1), fmaxf(a2, a3)));
                const float mb = wave_max(fmaxf(fmaxf(b0, b1), fmaxf(b2, b3)));
                const unsigned long long bala = __ballot((a0 == ma) || (a1 == ma) || (a2 == ma) || (a3 == ma));
                const unsigned long long balb = __ballot((b0 == mb) || (b1 == mb) || (b2 == mb) || (b3 == mb));
                const int fa = __ffsll((long long)bala) - 1, fb = __ffsll((long long)balb) - 1;
                if (lane == fa) {
                    int sl;
                    if (a0 == ma) { sl = 0; a0 = -1.f; } else if (a1 == ma) { sl = 1; a1 = -1.f; } else if (a2 == ma) { sl = 2; a2 = -1.f; } else { sl = 3; a3 = -1.f; }
                    sel[tk * 16 + it] = (unsigned char)(lane * 4 + sl);
                }
                if (lane == fb) {
                    int sl;
                    if (b0 == mb) { sl = 0; b0 = -1.f; } else if (b1 == mb) { sl = 1; b1 = -1.f; } else if (b2 == mb) { sl = 2; b2 = -1.f; } else { sl = 3; b3 = -1.f; }
                    sel[(tk + 8) * 16 + it] = (unsigned char)(lane * 4 + sl);
                }
            }
            if (lane < 2) {
                const int tq = tk + lane * 8;
                sel[tq * 16 + npick] = 0;
                if (cur >= 1) sel[tq * 16 + npick + 1] = (unsigned char)cur;
                if (cur >= 2) sel[tq * 16 + npick + 2] = (unsigned char)(cur - 1);
            }
        }
        { unsigned zz = 0u; asm volatile("" : "+v"(zz)); *(uint4*)(tm + lane * 4) = make_uint4(zz, zz, zz, zz); }
        wsync();
        if (lane < 16) {
            for (int si = 0; si < nsel; ++si) atomicOr(&tm[sel[lane * 16 + si]], 1u << lane);
        }
        wsync();
        int n_act;
        {
            const uint4 mm = *(const uint4*)(tm + lane * 4);
            wsync();
            const bool f0 = mm.x != 0u, f1 = mm.y != 0u, f2 = mm.z != 0u, f3 = mm.w != 0u;
            const unsigned long long b0 = __ballot(f0), b1 = __ballot(f1), b2 = __ballot(f2), b3 = __ballot(f3);
            const unsigned long long below = (1ull << lane) - 1ull;
            int pos = __popcll(b0 & below) + __popcll(b1 & below) + __popcll(b2 & below) + __popcll(b3 & below);
            if (f0) { sel[pos] = (unsigned char)(lane * 4 + 0); ++pos; }
            if (f1) { sel[pos] = (unsigned char)(lane * 4 + 1); ++pos; }
            if (f2) { sel[pos] = (unsigned char)(lane * 4 + 2); ++pos; }
            if (f3) { sel[pos] = (unsigned char)(lane * 4 + 3); ++pos; }
            n_act = __popcll(b0) + __popcll(b1) + __popcll(b2) + __popcll(b3);
        }
        wsync();
        u16* QL = (u16*)R;
        u16* PL = (u16*)R + 4096;
        {
            int t3 = t; asm volatile("" : "+v"(t3));
            const float* grow3 = GATES + ((size_t)b * S_ + t3) * 48 + g * 12;
#pragma unroll
            for (int h = 0; h < 4; ++h) {
                const float g0 = grow3[h * 3 + 0];
#pragma unroll
                for (int db = 0; db < 4; ++db) *(uint2*)(PL + (c16 * 4 + h) * 64 + db * 16 + q4 * 4) = pack4(Oc[h][db] * g0);
            }
#pragma unroll
            for (int i = 0; i < 8; ++i) {
                const int idx = i * 64 + lane, row = idx >> 3, ch = idx & 7;
                const uint4 v = *(const uint4*)(Q + ((size_t)b * S_ + t0 + (row >> 2)) * 1024 + g * 256 + (row & 3) * 64 + ch * 8);
                *(uint4*)(QL + row * 64 + ((ch ^ ((row >> 1) & 7)) << 3)) = v;
            }
        }
        wsync();
        for (int rep = 0; rep <= probe_rep; ++rep) {
            const int tg = c16 >> 2, hh = c16 & 3;
            f32x4 Os[4][4], Ol[4]; float m[4];
#pragma unroll
            for (int gq = 0; gq < 4; ++gq) {
                m[gq] = NEGBIG; Ol[gq] = (f32x4){0.f, 0.f, 0.f, 0.f};
#pragma unroll
                for (int db = 0; db < 4; ++db) Os[gq][db] = (f32x4){0.f, 0.f, 0.f, 0.f};
            }
            const long ones8 = 0x3838383838383838L;
            long qf8[4][2];
#pragma unroll
            for (int gq = 0; gq < 4; ++gq)
#pragma unroll
                for (int ks = 0; ks < 2; ++ks) {
                    const uint4 qv = *(const uint4*)(Q + ((size_t)b * S_ + t0 + gq * 4 + tg) * 1024 + g * 256 + hh * 64 + ks * 32 + q4 * 8);
                    const float f[8] = {__uint_as_float(qv.x << 16), __uint_as_float(qv.x & 0xffff0000u), __uint_as_float(qv.y << 16), __uint_as_float(qv.y & 0xffff0000u),
                                        __uint_as_float(qv.z << 16), __uint_as_float(qv.z & 0xffff0000u), __uint_as_float(qv.w << 16), __uint_as_float(qv.w & 0xffff0000u)};
                    qf8[gq][ks] = pk8_fp8(f);
                }
            const unsigned char* KS8 = (const unsigned char*)KS;
            const unsigned char* VS8 = (const unsigned char*)VST;
            auto ld = [&](int s, long (&K)[4], long (&V)[4]) __attribute__((always_inline)) {
                const int j = __builtin_amdgcn_readfirstlane((int)sel[s >> 1]);
                const int kb = j * 64 + (s & 1) * 32;
                const unsigned kof = (unsigned)(kb + kr) * 64u + (unsigned)q4 * 8u;
                K[0] = *(const long*)(KS8 + kof); K[1] = *(const long*)(KS8 + (kof + 32u)); K[2] = *(const long*)(KS8 + (kof + 256u)); K[3] = *(const long*)(KS8 + (kof + 288u));
                const unsigned vof = (unsigned)j * 4096u + (unsigned)c16 * 64u + (unsigned)(s & 1) * 32u + (unsigned)q4 * 8u;
#pragma unroll
                for (int db = 0; db < 4; ++db) V[db] = *(const long*)(VS8 + (vof + (unsigned)(db * 1024)));
            };
            auto cp = [&](int s, const long (&K)[4], const long (&V)[4]) __attribute__((always_inline)) {
                const int j = __builtin_amdgcn_readfirstlane((int)sel[s >> 1]);
                const unsigned mk = __builtin_amdgcn_readfirstlane(tm[j]);
                const int kpos = j * 64 + (s & 1) * 32 + q4 * 8;
#pragma unroll
                for (int gq = 0; gq < 4; ++gq) {
                    const unsigned gm = (mk >> (gq * 4)) & 0xFu;
                    if (gm == 0u) continue;
                    const float cmv = ((gm >> tg) & 1u) ? 0.f : NEGBIG;
                    f32x4 cm1 = {cmv, cmv, cmv, cmv}, cm2 = cm1;
                    if (j == cur) {
                        const int tc = t0 + gq * 4 + tg;
#pragma unroll
                        for (int i = 0; i < 4; ++i) { if (kpos + i > tc) cm1[i] = NEGBIG; if (kpos + 4 + i > tc) cm2[i] = NEGBIG; }
                    }
                    f32x4 s1 = mfma8(K[0], qf8[gq][0], cm1); s1 = mfma8(K[1], qf8[gq][1], s1);
                    f32x4 s2 = mfma8(K[2], qf8[gq][0], cm2); s2 = mfma8(K[3], qf8[gq][1], s2);
                    float mx = fmaxf(fmaxf(fmaxf(s1[0], s1[1]), fmaxf(s1[2], s1[3])), fmaxf(fmaxf(s2[0], s2[1]), fmaxf(s2[2], s2[3])));
                    mx = xmax32(xmax16(mx));
                    const float mn = fmaxf(m[gq], mx * SC);
                    if (__ballot(mn != m[gq])) {
                        const float alpha = fexp2(m[gq] - mn);
                        Ol[gq] = Ol[gq] * alpha;
#pragma unroll
                        for (int db = 0; db < 4; ++db) Os[gq][db] = Os[gq][db] * alpha;
                    }
                    m[gq] = mn;
                    float pv[8];
#pragma unroll
                    for (int i = 0; i < 4; ++i) { pv[i] = fexp2(fmaf(s1[i], SC, 7.f - mn)); pv[4 + i] = fexp2(fmaf(s2[i], SC, 7.f - mn)); }
                    const long pf = pk8_fp8(pv);
#pragma unroll
                    for (int db = 0; db < 4; ++db) Os[gq][db] = mfma8(V[db], pf, Os[gq][db]);
                    Ol[gq] = mfma8(ones8, pf, Ol[gq]);
                }
            };
            {
                long KA[4], VA[4], KB[4], VB[4];
                const int ns = 2 * n_act;
                ld(0, KA, VA);
                for (int s = 0; s < ns; s += 2) {
                    ld(s + 1, KB, VB);
                    cp(s, KA, VA);
                    if (s + 2 < ns) ld(s + 2, KA, VA);
                    cp(s + 1, KB, VB);
                }
            }
            const float repsc = (rep == 0) ? 1.f : 0.f;
#pragma unroll
            for (int gq = 0; gq < 4; ++gq) {
                const float lt = Ol[gq][0];
                const int tok = gq * 4 + tg;
                const float sc = repsc * GATES[((size_t)b * S_ + t0 + tok) * 48 + g * 12 + hh * 3 + 1] / lt;
#pragma unroll
                for (int db = 0; db < 4; ++db) {
                    u16* rp = PL + (tok * 4 + hh) * 64 + db * 16 + q4 * 4;
                    *(uint2*)rp = pack4(unpack4(*(const uint2*)rp) + Os[gq][db] * sc);
                }
            }
        }
        wsync();
        {
            f32x4 Ow[4][4]; float linv[4];
            int t2 = t; asm volatile("" : "+v"(t2));
            const u16* qrow2 = Q + ((size_t)b * S_ + t2) * 1024 + g * 256;
            const float* grow2 = GATES + ((size_t)b * S_ + t2) * 48 + g * 12;
            band_attn<false>(qrow2, KW, VWT, t0, 512, nullptr, Ow, linv, lane);
            u16* op = Ob + ((size_t)b * S_ + t2) * 1024 + g * 256;
#pragma unroll
            for (int h = 0; h < 4; ++h) {
                const float g2 = grow2[h * 3 + 2] * linv[h];
#pragma unroll
                for (int db = 0; db < 4; ++db) {
                    const f32x4 part = unpack4(*(const uint2*)(PL + (c16 * 4 + h) * 64 + db * 16 + q4 * 4));
                    *(uint2*)(op + h * 64 + db * 16 + q4 * 4) = pack4(part + Ow[h][db] * g2);
                }
            }
        }
        wsync();
    }
}


#define XB_TMO      128
#define XB_XCNT(j)  (256  + 64 * (j))
#define XB_XSUB(j)  (1280 + 64 * (j))
#define XB_XGEN(j)  (2304 + 64 * (j))
#define XB_TOP      3328
#define XB_TOPGEN   3392
#define XCD_BAR_WORDS 3456
#define XB_SPIN_CAP (1u << 22)
#define LAS __attribute__((address_space(3)))
__device__ __forceinline__ unsigned xb_ld(unsigned* p)              { return __hip_atomic_load(p, __ATOMIC_RELAXED, __HIP_MEMORY_SCOPE_AGENT); }
__device__ __forceinline__ unsigned xb_add(unsigned* p, unsigned v) { return __hip_atomic_fetch_add(p, v, __ATOMIC_RELAXED, __HIP_MEMORY_SCOPE_AGENT); }
__device__ __forceinline__ unsigned xb_xcc_id() { return (unsigned)__builtin_amdgcn_s_getreg((3 << 11) | 20) & 0xFu; }
#define XB_SPIN(cond, bar) do { unsigned _sp = 0; while (cond) { __builtin_amdgcn_s_sleep(1); \
    if ((++_sp & 255u) == 0u) { if (xb_ld(&(bar)[XB_TMO])) break; if (_sp > XB_SPIN_CAP) { atomicAdd(&(bar)[XB_TMO], 1u); break; } } } } while (0)
__device__ __forceinline__ void xcd_barrier_complete(unsigned* bar, unsigned x, unsigned& nloc, unsigned& nx) {
    const unsigned G = gridDim.x * gridDim.y * gridDim.z;
    unsigned sum, cnt, mine, sp = 0u;
    for (;;) {
        sum = 0u; cnt = 0u; mine = 0u;
#pragma unroll
        for (unsigned j = 0; j < 16; ++j) { const unsigned c = xb_ld(&bar[XB_XCNT(j)]); sum += c; cnt += (c > 0u) ? 1u : 0u; mine = (j == x) ? c : mine; }
        if (sum == G) break;
        __builtin_amdgcn_s_sleep(1);
        if ((++sp & 255u) == 0u) { if (xb_ld(&bar[XB_TMO])) break; if (sp > XB_SPIN_CAP) { atomicAdd(&bar[XB_TMO], 1u); break; } }
    }
    nloc = mine > 0u ? mine : 1u; nx = cnt > 0u ? cnt : 1u;
}
__device__ __forceinline__ void xcd_barrier(unsigned* bar, unsigned x, volatile LAS unsigned* st, int tid) {
    asm volatile("s_waitcnt vmcnt(0)" ::: "memory");
    __syncthreads();
    if (tid == 0) {
        __builtin_amdgcn_s_waitcnt(0);
        unsigned nloc = st[0], nx = st[1];
        if (nloc == 0u) { xcd_barrier_complete(bar, x, nloc, nx); st[0] = nloc; st[1] = nx; }
        const unsigned old = xb_add(&bar[XB_XSUB(x)], 1u);
        const unsigned gen = old / nloc;
        if (old + 1u == (gen + 1u) * nloc) {
            __builtin_amdgcn_fence(__ATOMIC_RELEASE, "agent");
            asm volatile("s_waitcnt vmcnt(0)" ::: "memory");
            const unsigned og = xb_add(&bar[XB_TOP], 1u);
            const unsigned tg = og / nx;
            if (og + 1u == (tg + 1u) * nx) xb_add(&bar[XB_TOPGEN], 1u);
            else XB_SPIN(xb_ld(&bar[XB_TOPGEN]) == tg, bar);
            __builtin_amdgcn_fence(__ATOMIC_ACQUIRE, "agent");
            xb_add(&bar[XB_XGEN(x)], 1u);
            asm volatile("s_waitcnt vmcnt(0)" ::: "memory");
        } else {
            XB_SPIN(xb_ld(&bar[XB_XGEN(x)]) == gen, bar);
            __builtin_amdgcn_fence(__ATOMIC_ACQUIRE, "agent");
            asm volatile("s_waitcnt vmcnt(0)" ::: "memory");
        }
    }
    __syncthreads();
}

enum { PT_PREP = 0, PT_NORM, PT_AIN, PT_CMP1, PT_CMP2, PT_NSA, PT_BKV, PT_BQ, PT_SWA, PT_AOUT, PT_FFNIN, PT_FIXUP, PT_FOUT, PT_FINAL };

__global__ void __launch_bounds__(NTHR, 2) mega(Params p) {
#if defined(__HIP_DEVICE_COMPILE__)
    extern __shared__ __attribute__((aligned(16))) unsigned char smem[];
    cg::grid_group grid = cg::this_grid();
    typedef const Params __attribute__((address_space(4)))* KP;
    const int ph_lo = p.ph_lo, ph_hi = p.ph_hi;
    const int wave_id = __builtin_amdgcn_readfirstlane((int)(threadIdx.x >> 6));
    unsigned* bar = (unsigned*)(p.ws + OFF_BAR);
    volatile LAS unsigned* xst = (volatile LAS unsigned*)(smem + LDS_USER);
    const unsigned xcc = __builtin_amdgcn_readfirstlane(xb_xcc_id());
    if (ph_hi - ph_lo > 1) {
        if (threadIdx.x == 0) { xst[0] = 0u; xst[1] = 0u; (void)xb_add(&bar[XB_XCNT(xcc)], 1u); }
        __syncthreads();
    }
    for (int ph = ph_lo; ph < ph_hi; ++ph) {
        int tid_, bid_ = blockIdx.x;
        asm volatile("v_mbcnt_lo_u32_b32 %0, -1, 0\n\tv_mbcnt_hi_u32_b32 %0, -1, %0" : "=v"(tid_));
        tid_ += wave_id * 64;
        asm volatile("" : "+s"(bid_));
        KP kp = (KP)__builtin_amdgcn_kernarg_segment_ptr();
        asm volatile("" : "+s"(kp));
        unsigned char* ws = kp->ws;
        u16* HN = (u16*)(ws + OFF_HN);
        const int d = kp->desc[ph], type = d & 255, sub = (d >> 8) & 255, L = d >> 16;
        const float* hsrc = (L == 0) ? kp->x : kp->out;
        EpiArgs e; e.resid = nullptr; e.out = kp->out; e.bias = nullptr; e.hid = nullptr; e.convw = nullptr; e.convb = nullptr; e.ws = ws;
        switch (type) {
        case PT_PREP: { const Params pl = *kp; prep_phase(pl, smem, tid_, bid_); } break;
        case PT_NORM: {
            const float* src = (sub == 1) ? kp->out : hsrc;
            const float* g = (sub == 0) ? kp->norm_attn + L * 1024 : (sub == 1) ? kp->norm_ffn + L * 1024 : kp->kv_norm;
            norm_phase<false>(src, g, HN, nullptr, tid_, bid_);
        } break;
        case PT_AIN: gemm_phase<AM_PLAIN, EPI_AIN>(HN, 1024, (const u16*)(ws + OFF_WT_AIN + L * SZ_WT_AIN), T_, 2688, 1024, 0, e, smem, tid_, bid_); break;
        case PT_CMP1:
            for (int kv = 0; kv < 2; ++kv) {
                e.bias = (const float*)(ws + OFF_CBIAS) + (L * 2 + kv) * 256; e.hid = (u16*)(ws + OFF_HID) + (size_t)kv * 8192 * 256;
                gemm_phase<AM_GATHER, EPI_CMP1>((const u16*)(ws + (kv == 0 ? OFF_KC : OFF_VC)), 0, (const u16*)(ws + OFF_WT_CW1 + (L * 2 + kv) * SZ_WT_CW1), 8184, 256, 2048,
                                                kv == 0 ? 0 : (int)(gridDim.x >> 1), e, smem, tid_, bid_);
            }
            break;
        case PT_CMP2: { const Params pl = *kp; cmp2_phase(pl, L, tid_, bid_); } break;
        case PT_NSA: { const Params pl = *kp; nsa_phase(pl, smem, tid_, bid_, sub); } break;
        case PT_BKV: gemm_phase<AM_PLAIN, EPI_BKV>(HN, 1024, (const u16*)(ws + OFF_WT_KV), T_, 256, 1024, 0, e, smem, tid_, bid_); break;
        case PT_BQ: gemm_phase<AM_PLAIN, EPI_BQ>(HN, 1024, (const u16*)(ws + OFF_WT_BQ + (L - 2) * SZ_WT_SQ), T_, 1024, 1024, 0, e, smem, tid_, bid_); break;
        case PT_SWA: { const Params pl = *kp; swa_phase(pl, L - 2, tid_, bid_); } break;
        case PT_AOUT:
        case PT_FOUT: {
            const bool ff = (type == PT_FOUT);
            e.resid = ff ? kp->out : hsrc;
            const u16* A = (const u16*)(ws + (ff ? OFF_ACT : OFF_O));
            const u16* Bt = (const u16*)(ws + (ff ? OFF_WT_FOUT + L * SZ_WT_FOUT : (L < 2 ? OFF_WT_AOUT + L * SZ_WT_SQ : OFF_WT_BOUT + (L - 2) * SZ_WT_SQ)));
            const int K = ff ? DFF : 1024;
            gemm_big<AM_PLAIN, EPI_RESID>(A, K, Bt, T_, 1024, K, 0, e, smem, tid_, bid_);
        } break;
        case PT_FFNIN:
            e.convw = kp->ffn_conv_w + (size_t)L * 3 * NFF2; e.convb = kp->ffn_conv_b + (size_t)L * NFF2;
            gemm_big<AM_PLAIN, EPI_FFNIN>(HN, 1024, (const u16*)(ws + OFF_WT_FIN + L * SZ_WT_FIN), T_, NFF2, 1024, 0, e, smem, tid_, bid_);
            break;
        case PT_FIXUP: { const Params pl = *kp; fixup_phase(pl, L, tid_, bid_); } break;
        case PT_FINAL: norm_phase<true>(kp->out, kp->final_norm, nullptr, kp->out, tid_, bid_); break;
        default: break;
        }
        if (ph + 1 < ph_hi) { if (ph == ph_lo) grid.sync(); else xcd_barrier(bar, xcc, xst, tid_); }
    }
#endif
}

static int build_program(int* desc) {
    int n = 0;
    auto add = [&](int type, int sub, int L) { desc[n++] = type | (sub << 8) | (L << 16); };
    add(PT_PREP, 0, 0);
    for (int L = 0; L < 4; ++L) {
        if (L < 2) {
            add(PT_NORM, 0, L); add(PT_AIN, 0, L); add(PT_CMP1, 0, L); add(PT_CMP2, 0, L); add(PT_NSA, NSA_PROBE_REP, L);
        } else {
            if (L == 2) { add(PT_NORM, 2, L); add(PT_BKV, 0, L); }
            add(PT_NORM, 0, L); add(PT_BQ, 0, L); add(PT_SWA, 0, L);
        }
        add(PT_AOUT, 0, L); add(PT_NORM, 1, L); add(PT_FFNIN, 0, L); add(PT_FIXUP, 0, L); add(PT_FOUT, 0, L);
    }
    add(PT_FINAL, 0, 0);
    return n;
}

extern "C" void kernel_launch(void* const* d_in, const int* in_sizes, int n_in, void* d_out, int out_size, void* d_ws, size_t ws_size, hipStream_t stream) {
    (void)in_sizes; (void)n_in; (void)out_size;
    static int grid_blocks = 0;
    if (!grid_blocks) {
        (void)hipFuncSetAttribute((const void*)mega, hipFuncAttributeMaxDynamicSharedMemorySize, LDS_BYTES);
        int dev = 0, cus = 0, per_cu = 0;
        (void)hipGetDevice(&dev);
        (void)hipDeviceGetAttribute(&cus, hipDeviceAttributeMultiprocessorCount, dev);
        (void)hipOccupancyMaxActiveBlocksPerMultiprocessor(&per_cu, mega, NTHR, LDS_BYTES);
        if (per_cu > 1) per_cu = 1;
        if (per_cu < 1) per_cu = 1;
        grid_blocks = (cus * per_cu) & ~7;
        if (grid_blocks < 8) grid_blocks = 8;
        if (ws_size < WS_NEED) fprintf(stderr, "workspace too small: %zu < %zu\n", ws_size, (size_t)WS_NEED);
    }
    Params p{};
    const float** pp = (const float**)&p;
    for (int i = 0; i < 18; ++i) pp[i] = (const float*)d_in[i];
    p.out = (float*)d_out;
    p.ws = (unsigned char*)d_ws;
    const int nph = build_program(p.desc);
#if MULTI_LAUNCH
    for (int ph = 0; ph < nph; ++ph) {
        p.ph_lo = ph; p.ph_hi = ph + 1;
        hipLaunchKernelGGL(mega, dim3(grid_blocks), dim3(NTHR), LDS_BYTES, stream, p);
    }
#else
    p.ph_lo = 0; p.ph_hi = nph;
    (void)hipMemsetAsync((unsigned char*)d_ws + OFF_BAR, 0, 16384, stream);
    void* args[] = {&p};
    hipError_t err = hipLaunchCooperativeKernel((const void*)mega, dim3(grid_blocks), dim3(NTHR), args, LDS_BYTES, stream);
    if (err != hipSuccess) fprintf(stderr, "cooperative launch failed: %s (grid %d)\n", hipGetErrorString(err), grid_blocks);
#endif
}
```

```cpp
#include <hip/hip_runtime.h>
#include <hip/hip_cooperative_groups.h>
#include <cstdio>
#include <cmath>
namespace cg = cooperative_groups;

typedef unsigned short u16;
typedef short bf16x8 __attribute__((ext_vector_type(8)));
typedef float f32x4 __attribute__((ext_vector_type(4)));

#ifndef NSA_PROBE_REP
#define NSA_PROBE_REP 0
#endif
#ifndef MULTI_LAUNCH
#define MULTI_LAUNCH 0
#endif

constexpr int S_ = 16384, T_ = 32768, D_ = 1024, DFF = 2816, NFF2 = 5632;
constexpr int NTHR = 512, NW = NTHR / 64;
constexpr int LDS_USER = NW * 16384 + NW * 1024 + NW * 256;
constexpr int LDS_BYTES = LDS_USER + 16;
constexpr float LOG2E = 1.4426950408889634f;
constexpr float NEGBIG = -1e30f;

constexpr size_t al256(size_t x) { return (x + 255) & ~(size_t)255; }
constexpr size_t SZ_WT_AIN = (size_t)2688 * 1024 * 2;
constexpr size_t SZ_WT_CW1 = (size_t)256 * 2048 * 2;
constexpr size_t SZ_WT_CW2 = (size_t)64 * 256 * 2;
constexpr size_t SZ_WT_SQ = (size_t)1024 * 1024 * 2;
constexpr size_t SZ_WT_KV = (size_t)256 * 1024 * 2;
constexpr size_t SZ_WT_FIN = (size_t)5632 * 1024 * 2;
constexpr size_t SZ_WT_FOUT = (size_t)1024 * 2816 * 2;
constexpr size_t OFF_WT_AIN = 0;
constexpr size_t OFF_WT_CW1 = OFF_WT_AIN + 2 * SZ_WT_AIN;
constexpr size_t OFF_WT_CW2 = OFF_WT_CW1 + 4 * SZ_WT_CW1;
constexpr size_t OFF_WT_AOUT = OFF_WT_CW2 + 4 * SZ_WT_CW2;
constexpr size_t OFF_WT_KV = OFF_WT_AOUT + 2 * SZ_WT_SQ;
constexpr size_t OFF_WT_BQ = OFF_WT_KV + SZ_WT_KV;
constexpr size_t OFF_WT_BOUT = OFF_WT_BQ + 2 * SZ_WT_SQ;
constexpr size_t OFF_WT_FIN = OFF_WT_BOUT + 2 * SZ_WT_SQ;
constexpr size_t OFF_WT_FOUT = OFF_WT_FIN + 4 * SZ_WT_FIN;
constexpr size_t OFF_COS = OFF_WT_FOUT + 4 * SZ_WT_FOUT;
constexpr size_t OFF_SIN = OFF_COS + (size_t)S_ * 32 * 4;
constexpr size_t OFF_CBIAS = OFF_SIN + (size_t)S_ * 32 * 4;
constexpr size_t OFF_HN = OFF_CBIAS + 4096;
constexpr size_t OFF_KSH = OFF_HN + (size_t)T_ * 1024 * 2;
constexpr size_t OFF_VSHT = OFF_KSH + (size_t)T_ * 128 * 2;
constexpr size_t OFF_HEAD = OFF_VSHT + (size_t)T_ * 128 * 2;
constexpr size_t OFF_HALO = OFF_HEAD + (size_t)256 * 2 * NFF2 * 4;
constexpr size_t OFF_R1 = OFF_HALO + (size_t)256 * 2 * NFF2 * 4;
constexpr size_t OFF_Q = OFF_R1;
constexpr size_t OFF_KC = OFF_Q + (size_t)T_ * 1024 * 2;
constexpr size_t OFF_VC = OFF_KC + (size_t)T_ * 256 * 2;
constexpr size_t OFF_KS = OFF_VC + (size_t)T_ * 256 * 2;
constexpr size_t OFF_VST = OFF_KS + (size_t)T_ * 256 * 2;
constexpr size_t OFF_KW = OFF_VST + (size_t)T_ * 256 * 2;
constexpr size_t OFF_VWT = OFF_KW + (size_t)T_ * 256 * 2;
constexpr size_t OFF_GATES = OFF_VWT + (size_t)T_ * 256 * 2;
constexpr size_t OFF_HID = OFF_GATES + (size_t)T_ * 48 * 4;
constexpr size_t OFF_KCC = OFF_HID + (size_t)2 * 8192 * 256 * 2;
constexpr size_t OFF_VCCT = OFF_KCC + (size_t)8 * 1024 * 64 * 2;
constexpr size_t OFF_O = OFF_VCCT + (size_t)8 * 1024 * 64 * 2;
constexpr size_t OFF_END = OFF_O + (size_t)T_ * 1024 * 2;
constexpr size_t OFF_BAR = OFF_END;
constexpr size_t WS_NEED = OFF_BAR + 16384;
constexpr size_t OFF_ACT = OFF_R1;
static_assert(OFF_ACT + (size_t)T_ * DFF * 2 <= OFF_END, "act alias");

struct Params {
    const float *x, *norm_attn, *norm_ffn, *a_w_in, *a_cmp_pos, *a_cmp_w1, *a_cmp_w2, *a_w_out, *kv_norm, *b_w_kv, *b_w_q, *b_sinks, *b_w_out,
        *ffn_w_in, *ffn_conv_w, *ffn_conv_b, *ffn_w_out, *final_norm;
    float* out;
    unsigned char* ws;
    int desc[48];
    int ph_lo, ph_hi;
};

__device__ __forceinline__ u16 f2bf(float f) {
    unsigned u = __float_as_uint(f);
    u += 0x7fffu + ((u >> 16) & 1u);
    return (u16)(u >> 16);
}
typedef __bf16 bf16x2_t __attribute__((ext_vector_type(2)));
typedef float f32x2_t __attribute__((ext_vector_type(2)));
__device__ __forceinline__ unsigned pack2(float lo, float hi) { f32x2_t v = {lo, hi}; bf16x2_t r = __builtin_convertvector(v, bf16x2_t); return __builtin_bit_cast(unsigned, r); }
typedef unsigned u32x4 __attribute__((ext_vector_type(4)));
__device__ __forceinline__ bf16x8 pack8(const float (&v)[8]) {
    u32x4 r;
    unsigned r0, r1, r2, r3;
    asm("v_cvt_pk_bf16_f32 %0, %4, %5\n\tv_cvt_pk_bf16_f32 %1, %6, %7\n\tv_cvt_pk_bf16_f32 %2, %8, %9\n\tv_cvt_pk_bf16_f32 %3, %10, %11\n\ts_nop 3"
        : "=&v"(r0), "=&v"(r1), "=&v"(r2), "=&v"(r3)
        : "v"(v[0]), "v"(v[1]), "v"(v[2]), "v"(v[3]), "v"(v[4]), "v"(v[5]), "v"(v[6]), "v"(v[7]));
    r[0] = r0; r[1] = r1; r[2] = r2; r[3] = r3;
    return __builtin_bit_cast(bf16x8, r);
}
__device__ __forceinline__ uint2 pack4(f32x4 v) { uint2 r; r.x = pack2(v[0], v[1]); r.y = pack2(v[2], v[3]); return r; }
__device__ __forceinline__ f32x4 unpack4(uint2 v) { return (f32x4){__uint_as_float(v.x << 16), __uint_as_float(v.x & 0xffff0000u), __uint_as_float(v.y << 16), __uint_as_float(v.y & 0xffff0000u)}; }
__device__ __forceinline__ unsigned pk4_fp8(float a, float b, float c, float d) { int r = __builtin_amdgcn_cvt_pk_fp8_f32(a, b, 0, false); r = __builtin_amdgcn_cvt_pk_fp8_f32(c, d, r, true); return (unsigned)r; }
__device__ __forceinline__ long pk8_fp8(const float (&v)[8]) { const unsigned lo = pk4_fp8(v[0], v[1], v[2], v[3]), hi = pk4_fp8(v[4], v[5], v[6], v[7]); return (long)(((unsigned long long)hi << 32) | lo); }
__device__ __forceinline__ f32x4 mfma8(long a, long b, f32x4 c) { return __builtin_amdgcn_mfma_f32_16x16x32_fp8_fp8(a, b, c, 0, 0, 0); }
__device__ __forceinline__ f32x4 mfma16(bf16x8 a, bf16x8 b, f32x4 c) { return __builtin_amdgcn_mfma_f32_16x16x32_bf16(a, b, c, 0, 0, 0); }
__device__ __forceinline__ float fexp2(float x) { return __builtin_amdgcn_exp2f(x); }
__device__ __forceinline__ void wsync() { __builtin_amdgcn_fence(__ATOMIC_ACQ_REL, "wavefront"); asm volatile("s_waitcnt lgkmcnt(0)" ::: "memory"); __builtin_amdgcn_wave_barrier(); }
typedef unsigned u32x2 __attribute__((ext_vector_type(2)));
__device__ __forceinline__ float xmax16(float x) { const unsigned u = __float_as_uint(x); const u32x2 r = __builtin_amdgcn_permlane16_swap(u, u, false, false); return fmaxf(__uint_as_float(r[0]), __uint_as_float(r[1])); }
__device__ __forceinline__ float xmax32(float x) { const unsigned u = __float_as_uint(x); const u32x2 r = __builtin_amdgcn_permlane32_swap(u, u, false, false); return fmaxf(__uint_as_float(r[0]), __uint_as_float(r[1])); }
template <int CTRL> __device__ __forceinline__ float dppf(float x) { return __int_as_float(__builtin_amdgcn_update_dpp(0, __float_as_int(x), CTRL, 0xf, 0xf, true)); }
__device__ __forceinline__ float wave_max(float x) {
    x = fmaxf(x, dppf<0xB1>(x)); x = fmaxf(x, dppf<0x4E>(x)); x = fmaxf(x, dppf<0x141>(x)); x = fmaxf(x, dppf<0x140>(x));
    return xmax32(xmax16(x));
}
__device__ __forceinline__ int kperm(int m) { return ((m >> 2) << 3) + (m & 3); }
__device__ __forceinline__ float sigmoidf_(float x) { return 1.f / (1.f + __expf(-x)); }
__device__ __forceinline__ float gelu_tanh(float x) {
    float u = 0.7978845608028654f * (x + 0.044715f * x * x * x);
    float e = __expf(2.f * u);
    float th = 1.f - 2.f / (e + 1.f);
    return 0.5f * x * (1.f + th);
}

__device__ __forceinline__ void cvt_transpose(const float* __restrict__ src, u16* __restrict__ dst, int K, int N, int Npad, int mode, unsigned char* smem, int tid_, int bid_) {
    const int half = tid_ >> 8, tid = tid_ & 255;
    float* ts = (float*)smem + half * (64 * 65);
    const int ntk = K >> 6, ntn = Npad >> 6, ntiles = ntk * ntn;
    for (int tile2 = bid_ * 2; tile2 < ntiles; tile2 += gridDim.x * 2) {
        const int tile = tile2 + half;
        const bool live = tile < ntiles;
        const int tk = live ? tile % ntk : 0, tn = live ? tile / ntk : 0;
        const int k0 = tk << 6, n0 = tn << 6;
        __syncthreads();
        if (live) {
#pragma unroll
            for (int i = 0; i < 4; ++i) {
                const int k = (tid >> 4) + 16 * i, n = (tid & 15) * 4;
                float4 v = make_float4(0.f, 0.f, 0.f, 0.f);
                if (n0 + n < N) v = *(const float4*)(src + (size_t)(k0 + k) * N + n0 + n);
                ts[k * 65 + n + 0] = v.x; ts[k * 65 + n + 1] = v.y; ts[k * 65 + n + 2] = v.z; ts[k * 65 + n + 3] = v.w;
            }
        }
        __syncthreads();
        if (!live) continue;
        const int n = tid >> 2, kq = (tid & 3) * 16;
        unsigned pk[8];
#pragma unroll
        for (int j = 0; j < 8; ++j) pk[j] = pack2(ts[(kq + 2 * j) * 65 + n], ts[(kq + 2 * j + 1) * 65 + n]);
        int drow;
        if (mode == 0) drow = n0 + n;
        else { const int nn = n0 + n; drow = (nn < DFF) ? ((nn >> 6) * 128 + (nn & 63)) : ((((nn - DFF) >> 6) * 128) + 64 + ((nn - DFF) & 63)); }
        uint4* dp = (uint4*)(dst + (size_t)drow * K + k0 + kq);
        dp[0] = make_uint4(pk[0], pk[1], pk[2], pk[3]);
        dp[1] = make_uint4(pk[4], pk[5], pk[6], pk[7]);
    }
}

__device__ __forceinline__ void prep_phase(const Params& p, unsigned char* smem, int tid_, int bid_) {
    unsigned char* ws = p.ws;
    for (int L = 0; L < 2; ++L) {
        cvt_transpose(p.a_w_in + (size_t)L * 1024 * 2608, (u16*)(ws + OFF_WT_AIN + L * SZ_WT_AIN), 1024, 2608, 2688, 0, smem, tid_, bid_);
        for (int kv = 0; kv < 2; ++kv) {
            cvt_transpose(p.a_cmp_w1 + (size_t)(L * 2 + kv) * 2048 * 256, (u16*)(ws + OFF_WT_CW1 + (L * 2 + kv) * SZ_WT_CW1), 2048, 256, 256, 0, smem, tid_, bid_);
            cvt_transpose(p.a_cmp_w2 + (size_t)(L * 2 + kv) * 256 * 64, (u16*)(ws + OFF_WT_CW2 + (L * 2 + kv) * SZ_WT_CW2), 256, 64, 64, 0, smem, tid_, bid_);
        }
        cvt_transpose(p.a_w_out + (size_t)L * 1024 * 1024, (u16*)(ws + OFF_WT_AOUT + L * SZ_WT_SQ), 1024, 1024, 1024, 0, smem, tid_, bid_);
        cvt_transpose(p.b_w_q + (size_t)L * 1024 * 1024, (u16*)(ws + OFF_WT_BQ + L * SZ_WT_SQ), 1024, 1024, 1024, 0, smem, tid_, bid_);
        cvt_transpose(p.b_w_out + (size_t)L * 1024 * 1024, (u16*)(ws + OFF_WT_BOUT + L * SZ_WT_SQ), 1024, 1024, 1024, 0, smem, tid_, bid_);
    }
    cvt_transpose(p.b_w_kv, (u16*)(ws + OFF_WT_KV), 1024, 256, 256, 0, smem, tid_, bid_);
    for (int L = 0; L < 4; ++L) {
        cvt_transpose(p.ffn_w_in + (size_t)L * 1024 * NFF2, (u16*)(ws + OFF_WT_FIN + L * SZ_WT_FIN), 1024, NFF2, NFF2, 1, smem, tid_, bid_);
        cvt_transpose(p.ffn_w_out + (size_t)L * DFF * 1024, (u16*)(ws + OFF_WT_FOUT + L * SZ_WT_FOUT), DFF, 1024, 1024, 0, smem, tid_, bid_);
    }
    {
        float* cosT = (float*)(ws + OFF_COS); float* sinT = (float*)(ws + OFF_SIN);
        const int gt = bid_ * NTHR + tid_, nt = gridDim.x * NTHR;
        for (int idx = gt; idx < S_ * 32; idx += nt) {
            const int pos = idx >> 5, i = idx & 31;
            const float ang = (float)pos * exp2f(-(float)i * (13.287712379549449f / 32.0f));
            double rev = (double)ang * 0.15915494309189535;
            rev -= rint(rev);
            const float fr = (float)rev;
            cosT[idx] = __builtin_amdgcn_cosf(fr);
            sinT[idx] = __builtin_amdgcn_sinf(fr);
        }
    }
    {
        float* cb = (float*)(ws + OFF_CBIAS);
        const int lane = tid_ & 63, w = tid_ >> 6;
        for (int task = bid_ * NW + w; task < 256; task += gridDim.x * NW) {
            const int lk = task >> 6, j4 = (task & 63) * 4;
            const float* pos = p.a_cmp_pos + (size_t)lk * 2048;
            const float* w1 = p.a_cmp_w1 + (size_t)lk * 2048 * 256;
            float4 a = make_float4(0.f, 0.f, 0.f, 0.f);
            for (int i = 0; i < 32; ++i) {
                const int k = lane + 64 * i;
                const float pv = pos[k];
                const float4 wv = *(const float4*)(w1 + (size_t)k * 256 + j4);
                a.x += pv * wv.x; a.y += pv * wv.y; a.z += pv * wv.z; a.w += pv * wv.w;
            }
#pragma unroll
            for (int off = 32; off >= 1; off >>= 1) {
                a.x += __shfl_xor(a.x, off); a.y += __shfl_xor(a.y, off); a.z += __shfl_xor(a.z, off); a.w += __shfl_xor(a.w, off);
            }
            if (lane == 0) *(float4*)(cb + lk * 256 + j4) = a;
        }
    }
}

template <bool OUT_F32>
__device__ __forceinline__ void norm_phase(const float* __restrict__ src, const float* __restrict__ g, u16* __restrict__ dst, float* __restrict__ dstf, int tid_, int bid_) {
    const int lane = tid_ & 63, w = tid_ >> 6;
    float4 gv[4];
#pragma unroll
    for (int i = 0; i < 4; ++i) gv[i] = *(const float4*)(g + lane * 4 + 256 * i);
    for (int row = bid_ * NW + w; row < T_; row += gridDim.x * NW) {
        const float* sp = src + (size_t)row * 1024;
        float4 v[4];
        float ss = 0.f;
#pragma unroll
        for (int i = 0; i < 4; ++i) { v[i] = *(const float4*)(sp + lane * 4 + 256 * i); ss += v[i].x * v[i].x + v[i].y * v[i].y + v[i].z * v[i].z + v[i].w * v[i].w; }
#pragma unroll
        for (int off = 32; off >= 1; off >>= 1) ss += __shfl_xor(ss, off);
        const float r = rsqrtf(ss * (1.f / 1024.f) + 1e-6f);
#pragma unroll
        for (int i = 0; i < 4; ++i) {
            f32x4 o = {v[i].x * r * gv[i].x, v[i].y * r * gv[i].y, v[i].z * r * gv[i].z, v[i].w * r * gv[i].w};
            if (OUT_F32) *(float4*)(dstf + (size_t)row * 1024 + lane * 4 + 256 * i) = make_float4(o[0], o[1], o[2], o[3]);
            else *(uint2*)(dst + (size_t)row * 1024 + lane * 4 + 256 * i) = pack4(o);
        }
    }
}

enum { AM_PLAIN = 0, AM_GATHER = 1 };
enum { EPI_AIN = 0, EPI_CMP1 = 1, EPI_RESID = 2, EPI_FFNIN = 3, EPI_BQ = 4, EPI_BKV = 5 };

struct EpiArgs {
    const float* resid; float* out;
    const float* bias; u16* hid;
    const float *convw, *convb;
    unsigned char* ws;
};

template <int NM>
__device__ __forceinline__ void rope_store(const f32x4 (&acc)[4][NM], int mi, u16* dstrow  , const float* cosT, const float* sinT, int pos, int q4) {
#pragma unroll
    for (int ni = 0; ni < 2; ++ni) {
        const int d = ni * 16 + q4 * 4;
        const float4 c = *(const float4*)(cosT + pos * 32 + d), s = *(const float4*)(sinT + pos * 32 + d);
        const f32x4 x1 = acc[ni][mi], x2 = acc[ni + 2][mi];
        f32x4 o1 = {x1[0] * c.x - x2[0] * s.x, x1[1] * c.y - x2[1] * s.y, x1[2] * c.z - x2[2] * s.z, x1[3] * c.w - x2[3] * s.w};
        f32x4 o2 = {x2[0] * c.x + x1[0] * s.x, x2[1] * c.y + x1[1] * s.y, x2[2] * c.z + x1[2] * s.z, x2[3] * c.w + x1[3] * s.w};
        *(uint2*)(dstrow + d) = pack4(o1);
        *(uint2*)(dstrow + d + 32) = pack4(o2);
    }
}

template <int AMODE, int EPI>
__device__ __forceinline__ void gemm_phase(const u16* __restrict__ A, int lda, const u16* __restrict__ Bt, int M, int Npad, int K, int vboff, const EpiArgs& e, unsigned char* smem, int tid_, int bid_) {
    const int tid = tid_, lane = tid & 63, w = tid >> 6, wm = w & 3, wn = w >> 2;
    const int c16 = lane & 15, q4 = lane >> 4;
    const int ntm = (M + 255) >> 8, ntn = Npad >> 7, nk = K >> 6;
    const int kstride = (AMODE == AM_GATHER) ? 256 : 64;
    const int ldc = tid & 7, ldr = tid >> 3;
    const unsigned wofs = ldr * 128 + ((ldc ^ ((ldr >> 1) & 7)) << 4);
    const int swz = (c16 >> 1) & 7;
    const float* cosT = (const float*)(e.ws + OFF_COS);
    const float* sinT = (const float*)(e.ws + OFF_SIN);
    int vb = bid_ + vboff; if (vb >= (int)gridDim.x) vb -= gridDim.x;
    const int xcd = vb & 7, loc = vb >> 3, nloc = gridDim.x >> 3;
    const int mpx = ntm >> 3, nfull = (ntn >> 3), bwl = ntn - (nfull << 3);
    const int tfull = nfull * mpx * 8, ttotal = mpx * ntn;
    for (int tl = loc; tl < ttotal; tl += nloc) {
        int mloc, nt;
        if (tl < tfull) { const int band = tl / (mpx * 8), r = tl - band * (mpx * 8); mloc = r >> 3; nt = band * 8 + (r & 7); }
        else { const int r = tl - tfull; mloc = r / bwl; nt = (nfull << 3) + (r - mloc * bwl); }
        const int mt = xcd * mpx + mloc;
        const int m0 = mt << 8, n0 = nt << 7;
        unsigned aoff[4];
#pragma unroll
        for (int i = 0; i < 4; ++i) {
            int m = m0 + ldr + 64 * i; if (m > M - 1) m = M - 1;
            if (AMODE == AM_GATHER) { const int g = m & 3, bn = m >> 2, b = bn / 1023, n = bn - b * 1023; aoff[i] = (unsigned)((b * S_ + n * 16) * 256 + g * 64 + ldc * 8); }
            else aoff[i] = (unsigned)m * (unsigned)lda + ldc * 8;
        }
        const u16* bp = Bt + (size_t)(n0 + ldr) * K + ldc * 8;
        u32x4 ra0[4], rb0[2], ra1[4], rb1[2];
        f32x4 acc[4][4];
#pragma unroll
        for (int a = 0; a < 4; ++a)
#pragma unroll
            for (int b = 0; b < 4; ++b) acc[a][b] = (f32x4){0.f, 0.f, 0.f, 0.f};
        auto g_load = [&](u32x4 (&RA)[4], u32x4 (&RB)[2], int KT) __attribute__((always_inline)) {
#pragma unroll
            for (int i = 0; i < 4; ++i) RA[i] = *(const u32x4*)(A + aoff[i] + KT * kstride);
#pragma unroll
            for (int i = 0; i < 2; ++i) RB[i] = *(const u32x4*)(bp + (size_t)i * 64 * K + KT * 64);
        };
        auto g_store = [&](const u32x4 (&RA)[4], const u32x4 (&RB)[2], int ST) __attribute__((always_inline)) {
            unsigned char* d_ = smem + ST * 49152;
#pragma unroll
            for (int i = 0; i < 4; ++i) *(u32x4*)(d_ + wofs + i * 8192) = RA[i];
#pragma unroll
            for (int i = 0; i < 2; ++i) *(u32x4*)(d_ + 32768 + wofs + i * 8192) = RB[i];
        };
        auto g_compute = [&](int ST) __attribute__((always_inline)) {
            const unsigned char* sA = smem + ST * 49152;
            const unsigned char* sB = sA + 32768;
#pragma unroll
            for (int ks = 0; ks < 2; ++ks) {
                bf16x8 wf[4], af[4];
                const int ch = ((ks * 4 + q4) ^ swz) << 4;
#pragma unroll
                for (int ni = 0; ni < 4; ++ni) wf[ni] = *(const bf16x8*)(sB + (wn * 64 + ni * 16 + c16) * 128 + ch);
#pragma unroll
                for (int mi = 0; mi < 4; ++mi) af[mi] = *(const bf16x8*)(sA + (wm * 64 + mi * 16 + c16) * 128 + ch);
#pragma unroll
                for (int ni = 0; ni < 4; ++ni)
#pragma unroll
                    for (int mi = 0; mi < 4; ++mi) acc[ni][mi] = mfma16(wf[ni], af[mi], acc[ni][mi]);
            }
        };
        g_load(ra0, rb0, 0);
        g_load(ra1, rb1, 1);
        g_store(ra0, rb0, 0);
        __syncthreads();
        for (int kt = 0; kt < nk; kt += 2) {
            if (kt + 2 < nk) g_load(ra0, rb0, kt + 2);
            g_compute(0);
            g_store(ra1, rb1, 1);
            __syncthreads();
            if (kt + 3 < nk) g_load(ra1, rb1, kt + 3);
            g_compute(1);
            if (kt + 2 < nk) g_store(ra0, rb0, 0);
            __syncthreads();
        }
        const int nb = n0 + wn * 64;
        if (EPI == EPI_RESID) {
#pragma unroll
            for (int mi = 0; mi < 4; ++mi) {
                const size_t tok = m0 + wm * 64 + mi * 16 + c16;
#pragma unroll
                for (int ni = 0; ni < 4; ++ni) {
                    const int n = nb + ni * 16 + q4 * 4;
                    float4 r = *(const float4*)(e.resid + tok * 1024 + n);
                    r.x += acc[ni][mi][0]; r.y += acc[ni][mi][1]; r.z += acc[ni][mi][2]; r.w += acc[ni][mi][3];
                    *(float4*)(e.out + tok * 1024 + n) = r;
                }
            }
        } else if (EPI == EPI_CMP1) {
#pragma unroll
            for (int mi = 0; mi < 4; ++mi) {
                const int m = m0 + wm * 64 + mi * 16 + c16;
                if (m < M) {
#pragma unroll
                    for (int ni = 0; ni < 4; ++ni) {
                        const int n = nb + ni * 16 + q4 * 4;
                        const float4 bv = *(const float4*)(e.bias + n);
                        f32x4 o = {gelu_tanh(acc[ni][mi][0] + bv.x), gelu_tanh(acc[ni][mi][1] + bv.y), gelu_tanh(acc[ni][mi][2] + bv.z), gelu_tanh(acc[ni][mi][3] + bv.w)};
                        *(uint2*)(e.hid + (size_t)m * 256 + n) = pack4(o);
                    }
                }
            }
        } else if (EPI == EPI_BQ) {
            u16* Q = (u16*)(e.ws + OFF_Q);
#pragma unroll
            for (int mi = 0; mi < 4; ++mi) {
                const int tok = m0 + wm * 64 + mi * 16 + c16;
                rope_store(acc, mi, Q + (size_t)tok * 1024 + nb, cosT, sinT, tok & (S_ - 1), q4);
            }
        } else if (EPI == EPI_BKV) {
            u16* KSH = (u16*)(e.ws + OFF_KSH); u16* VSHT = (u16*)(e.ws + OFF_VSHT);
#pragma unroll
            for (int mi = 0; mi < 4; ++mi) {
                const int tok = m0 + wm * 64 + mi * 16 + c16, b = tok >> 14, s = tok & (S_ - 1);
                if (nb < 128) {
                    const int g = nb >> 6;
                    rope_store(acc, mi, KSH + ((size_t)(b * 2 + g) * S_ + s) * 64, cosT, sinT, s, q4);
                } else {
                    const int g = (nb - 128) >> 6;
#pragma unroll
                    for (int ni = 0; ni < 4; ++ni)
#pragma unroll
                        for (int i = 0; i < 4; ++i) VSHT[((size_t)(b * 2 + g) * 64 + ni * 16 + q4 * 4 + i) * S_ + s] = f2bf(acc[ni][mi][i]);
                }
            }
        } else if (EPI == EPI_AIN) {
            unsigned char* ws = e.ws;
#pragma unroll
            for (int mi = 0; mi < 4; ++mi) {
                const int tok = m0 + wm * 64 + mi * 16 + c16, b = tok >> 14, s = tok & (S_ - 1);
                if (nb < 1024) {
                    rope_store(acc, mi, (u16*)(ws + OFF_Q) + (size_t)tok * 1024 + nb, cosT, sinT, s, q4);
                } else if (nb < 1536) {
                    u16* dst = (nb < 1280) ? ((u16*)(ws + OFF_KC) + (size_t)tok * 256 + (nb - 1024)) : ((u16*)(ws + OFF_VC) + (size_t)tok * 256 + (nb - 1280));
#pragma unroll
                    for (int ni = 0; ni < 4; ++ni) *(uint2*)(dst + ni * 16 + q4 * 4) = pack4(acc[ni][mi]);
                } else if (nb < 2560) {
                    const int r = (nb - 1536) >> 8;
                    const int g = ((nb - 1536) & 255) >> 6;
                    if (r == 0) {
                        unsigned char* kd = (unsigned char*)(ws + OFF_KS) + (size_t)(b * 4 + g) * S_ * 128 + (size_t)s * 64;
#pragma unroll
                        for (int ni = 0; ni < 2; ++ni) {
                            const int d = ni * 16 + q4 * 4;
                            const float4 c = *(const float4*)(cosT + s * 32 + d), sn = *(const float4*)(sinT + s * 32 + d);
                            const f32x4 x1 = acc[ni][mi], x2 = acc[ni + 2][mi];
                            *(unsigned*)(kd + d) = pk4_fp8(x1[0] * c.x - x2[0] * sn.x, x1[1] * c.y - x2[1] * sn.y, x1[2] * c.z - x2[2] * sn.z, x1[3] * c.w - x2[3] * sn.w);
                            *(unsigned*)(kd + d + 32) = pk4_fp8(x2[0] * c.x + x1[0] * sn.x, x2[1] * c.y + x1[1] * sn.y, x2[2] * c.z + x1[2] * sn.z, x2[3] * c.w + x1[3] * sn.w);
                        }
                    } else if (r == 2) {
                        u16* base = (u16*)(ws + OFF_KW);
                        rope_store(acc, mi, base + ((size_t)(b * 4 + g) * S_ + s) * 64, cosT, sinT, s, q4);
                    } else {
                        if (r == 1) {
                            unsigned char* base = (unsigned char*)(ws + OFF_VST) + (size_t)(b * 4 + g) * 128 * S_ + (size_t)(s >> 6) * 4096 + (s & 63);
#pragma unroll
                            for (int ni = 0; ni < 4; ++ni) {
                                const unsigned pk = pk4_fp8(acc[ni][mi][0], acc[ni][mi][1], acc[ni][mi][2], acc[ni][mi][3]);
#pragma unroll
                                for (int i = 0; i < 4; ++i) base[(ni * 16 + q4 * 4 + i) * 64] = (unsigned char)(pk >> (8 * i));
                            }
                        } else {
                            u16* base = (u16*)(ws + OFF_VWT);
#pragma unroll
                            for (int ni = 0; ni < 4; ++ni)
#pragma unroll
                                for (int i = 0; i < 4; ++i) base[((size_t)(b * 4 + g) * 64 + ni * 16 + q4 * 4 + i) * S_ + s] = f2bf(acc[ni][mi][i]);
                        }
                    }
                } else if (nb == 2560) {
                    float* G = (float*)(ws + OFF_GATES) + (size_t)tok * 48;
#pragma unroll
                    for (int ni = 0; ni < 3; ++ni) {
                        const int n = ni * 16 + q4 * 4;
                        *(float4*)(G + n) = make_float4(sigmoidf_(acc[ni][mi][0]), sigmoidf_(acc[ni][mi][1]), sigmoidf_(acc[ni][mi][2]), sigmoidf_(acc[ni][mi][3]));
                    }
                }
            }
        } else if (EPI == EPI_FFNIN) {
            float* U = (float*)smem;
#pragma unroll
            for (int mi = 0; mi < 4; ++mi) {
                const int row = wm * 64 + mi * 16 + c16;
#pragma unroll
                for (int ni = 0; ni < 4; ++ni) {
                    const int chunk = wn * 16 + ni * 4 + q4;
                    *(f32x4*)(U + row * 128 + ((chunk ^ (row & 31)) << 2)) = acc[ni][mi];
                }
            }
            __syncthreads();
            {
                const int ca = tid & 15, seg = tid >> 4;
                const int ncol = nt * 64 + ca * 4;
                const float4 w0a = *(const float4*)(e.convw + ncol), w1a = *(const float4*)(e.convw + NFF2 + ncol), w2a = *(const float4*)(e.convw + 2 * NFF2 + ncol);
                const float4 w0g = *(const float4*)(e.convw + DFF + ncol), w1g = *(const float4*)(e.convw + NFF2 + DFF + ncol), w2g = *(const float4*)(e.convw + 2 * NFF2 + DFF + ncol);
                const float4 ba = *(const float4*)(e.convb + ncol), bg = *(const float4*)(e.convb + DFF + ncol);
                float* head = (float*)(e.ws + OFF_HEAD); float* halo = (float*)(e.ws + OFF_HALO);
                u16* act = (u16*)(e.ws + OFF_ACT);
                const int r0 = seg * 8;
                float4 a2 = make_float4(0.f, 0.f, 0.f, 0.f), a1 = a2, g2 = a2, g1 = a2;
                if (seg > 0) {
                    const int rA = r0 - 2, rB = r0 - 1;
                    a2 = *(const float4*)(U + rA * 128 + ((ca ^ (rA & 31)) << 2)); g2 = *(const float4*)(U + rA * 128 + (((16 + ca) ^ (rA & 31)) << 2));
                    a1 = *(const float4*)(U + rB * 128 + ((ca ^ (rB & 31)) << 2)); g1 = *(const float4*)(U + rB * 128 + (((16 + ca) ^ (rB & 31)) << 2));
                }
#pragma unroll
                for (int r = 0; r < 8; ++r) {
                    const int row = r0 + r;
                    const float4 ua = *(const float4*)(U + row * 128 + ((ca ^ (row & 31)) << 2));
                    const float4 ug = *(const float4*)(U + row * 128 + (((16 + ca) ^ (row & 31)) << 2));
                    if (seg > 0 || r >= 2) {
                        float ca_[4], cg_[4];
                        ca_[0] = ba.x + w0a.x * a2.x + w1a.x * a1.x + w2a.x * ua.x; ca_[1] = ba.y + w0a.y * a2.y + w1a.y * a1.y + w2a.y * ua.y;
                        ca_[2] = ba.z + w0a.z * a2.z + w1a.z * a1.z + w2a.z * ua.z; ca_[3] = ba.w + w0a.w * a2.w + w1a.w * a1.w + w2a.w * ua.w;
                        cg_[0] = bg.x + w0g.x * g2.x + w1g.x * g1.x + w2g.x * ug.x; cg_[1] = bg.y + w0g.y * g2.y + w1g.y * g1.y + w2g.y * ug.y;
                        cg_[2] = bg.z + w0g.z * g2.z + w1g.z * g1.z + w2g.z * ug.z; cg_[3] = bg.w + w0g.w * g2.w + w1g.w * g1.w + w2g.w * ug.w;
                        f32x4 o = {ca_[0] * sigmoidf_(ca_[0]) * cg_[0], ca_[1] * sigmoidf_(ca_[1]) * cg_[1], ca_[2] * sigmoidf_(ca_[2]) * cg_[2], ca_[3] * sigmoidf_(ca_[3]) * cg_[3]};
                        *(uint2*)(act + (size_t)(m0 + row) * DFF + ncol) = pack4(o);
                    }
                    if (seg == 0 && r < 2) { *(float4*)(head + (size_t)(mt * 2 + r) * NFF2 + ncol) = ua; *(float4*)(head + (size_t)(mt * 2 + r) * NFF2 + DFF + ncol) = ug; }
                    if (seg == 31 && r >= 6) { *(float4*)(halo + (size_t)(mt * 2 + r - 6) * NFF2 + ncol) = ua; *(float4*)(halo + (size_t)(mt * 2 + r - 6) * NFF2 + DFF + ncol) = ug; }
                    a2 = a1; a1 = ua; g2 = g1; g1 = ug;
                }
            }
            __syncthreads();
        }
    }
}

template <int AMODE, int EPI>
__device__ __forceinline__ void gemm_big(const u16* __restrict__ A, int lda, const u16* __restrict__ Bt, int M, int Npad, int K, int vboff, const EpiArgs& e, unsigned char* smem, int tid_, int bid_) {
    const int tid = tid_, lane = tid & 63, w = tid >> 6, wm = w & 1, wn = w >> 1;
    const int c16 = lane & 15, q4 = lane >> 4;
    constexpr int MI = 8;
    const int ntm = (M + 255) >> 8, ntn = Npad >> 8, nk = K >> 5;
    const int kstride = (AMODE == AM_GATHER) ? 128 : 32;
    const float* cosT = (const float*)(e.ws + OFF_COS);
    const float* sinT = (const float*)(e.ws + OFF_SIN);
    int vb = bid_ + vboff; if (vb >= (int)gridDim.x) vb -= gridDim.x;
    const int xcd = vb & 7, loc = vb >> 3, nloc = gridDim.x >> 3;
    const int mpx = ntm >> 3, nfull = (ntn >> 3), bwl = ntn - (nfull << 3);
    const int tfull = nfull * mpx * 8, ttotal = mpx * ntn;
    for (int tl = loc; tl < ttotal; tl += nloc) {
        int mloc, nt;
        if (tl < tfull) { const int band = tl / (mpx * 8), r = tl - band * (mpx * 8); mloc = r >> 3; nt = band * 8 + (r & 7); }
        else { const int r = tl - tfull; mloc = r / bwl; nt = (nfull << 3) + (r - mloc * bwl); }
        const int mt = xcd * mpx + mloc;
        const int m0 = mt << 8, n0 = nt << 8;
        const int prow = ((w & 3) << 6) + (lane >> 3);
        const int pch = lane & 7;
        unsigned goff[8];
#pragma unroll
        for (int i = 0; i < 8; ++i) {
            const int row = prow + 8 * i;
            const int lc = pch ^ ((row >> 1) & 7);
            if (w < 4) {
                int m = m0 + row; if (m > M - 1) m = M - 1;
                if (AMODE == AM_GATHER) { const int gq = m & 3, bn = m >> 2, bb = bn / 1023, n = bn - bb * 1023; goff[i] = (unsigned)((bb * S_ + n * 16) * 256 + gq * 64 + lc * 8); }
                else goff[i] = (unsigned)m * (unsigned)lda + (unsigned)(lc * 8);
            } else goff[i] = (unsigned)(n0 + row) * (unsigned)K + (unsigned)(lc * 8);
        }
        const u16* gbase = (w < 4) ? A : Bt;
        const unsigned kst = (w < 4 && AMODE == AM_GATHER) ? 256u : 64u;
        typedef __attribute__((address_space(3))) unsigned* lds_u32p;
        const unsigned lbase = ((w < 4) ? 0u : 32768u) + (unsigned)(((w & 3) << 6) * 128) + (unsigned)lane * 16u;
        f32x4 acc[4][MI];
#pragma unroll
        for (int a2 = 0; a2 < 4; ++a2)
#pragma unroll
            for (int b2 = 0; b2 < MI; ++b2) acc[a2][b2] = (f32x4){0.f, 0.f, 0.f, 0.f};
        const int swz = (c16 >> 1) & 7;
        const int nk2 = nk >> 1;
#pragma unroll
        for (int i = 0; i < 8; ++i) __builtin_amdgcn_global_load_lds((const unsigned*)(gbase + goff[i]), (lds_u32p)(smem + lbase + i * 1024), 16, 0, 0);
        for (int kt = 0; kt < nk2; ++kt) {
            asm volatile("s_waitcnt vmcnt(0)" ::: "memory");
            __builtin_amdgcn_s_barrier();
            const unsigned char* sA = smem + (kt & 1) * 65536;
            const unsigned char* sB = sA + 32768;
            const bool more = kt + 1 < nk2;
            const unsigned ko = (unsigned)(kt + 1) * kst;
            unsigned char* sbn = smem + ((kt + 1) & 1) * 65536 + lbase;
#pragma unroll
            for (int ks = 0; ks < 2; ++ks) {
                bf16x8 wf[4], af[MI];
                const int ch = ((ks * 4 + q4) ^ swz) << 4;
#pragma unroll
                for (int ni = 0; ni < 4; ++ni) wf[ni] = *(const bf16x8*)(sB + (wn * 64 + ni * 16 + c16) * 128 + ch);
#pragma unroll
                for (int mi = 0; mi < MI; ++mi) af[mi] = *(const bf16x8*)(sA + (wm * 128 + mi * 16 + c16) * 128 + ch);
#pragma unroll
                for (int ni = 0; ni < 4; ++ni) {
                    if (more) __builtin_amdgcn_global_load_lds((const unsigned*)(gbase + (goff[ks * 4 + ni] + ko)), (lds_u32p)(sbn + (ks * 4 + ni) * 1024), 16, 0, 0);
#pragma unroll
                    for (int mi = 0; mi < MI; ++mi) acc[ni][mi] = mfma16(wf[ni], af[mi], acc[ni][mi]);
                }
            }
        }
        __syncthreads();
        const int nb = n0 + wn * 64;
        if (EPI == EPI_RESID) {
#pragma unroll
            for (int mi = 0; mi < MI; ++mi) { __builtin_amdgcn_sched_barrier(0);
                const size_t tok = m0 + wm * 128 + mi * 16 + c16;
#pragma unroll
                for (int ni = 0; ni < 4; ++ni) {
                    const int n = nb + ni * 16 + q4 * 4;
                    float4 r = *(const float4*)(e.resid + tok * 1024 + n);
                    r.x += acc[ni][mi][0]; r.y += acc[ni][mi][1]; r.z += acc[ni][mi][2]; r.w += acc[ni][mi][3];
                    *(float4*)(e.out + tok * 1024 + n) = r;
                }
            }
        } else if (EPI == EPI_CMP1) {
#pragma unroll
            for (int mi = 0; mi < MI; ++mi) { __builtin_amdgcn_sched_barrier(0);
                const int m = m0 + wm * 128 + mi * 16 + c16;
                if (m < M) {
#pragma unroll
                    for (int ni = 0; ni < 4; ++ni) {
                        const int n = nb + ni * 16 + q4 * 4;
                        const float4 bv = *(const float4*)(e.bias + n);
                        f32x4 o = {gelu_tanh(acc[ni][mi][0] + bv.x), gelu_tanh(acc[ni][mi][1] + bv.y), gelu_tanh(acc[ni][mi][2] + bv.z), gelu_tanh(acc[ni][mi][3] + bv.w)};
                        *(uint2*)(e.hid + (size_t)m * 256 + n) = pack4(o);
                    }
                }
            }
        } else if (EPI == EPI_BQ) {
            u16* Q = (u16*)(e.ws + OFF_Q);
#pragma unroll
            for (int mi = 0; mi < MI; ++mi) { __builtin_amdgcn_sched_barrier(0);
                const int tok = m0 + wm * 128 + mi * 16 + c16;
                rope_store(acc, mi, Q + (size_t)tok * 1024 + nb, cosT, sinT, tok & (S_ - 1), q4);
            }
        } else if (EPI == EPI_BKV) {
            u16* KSH = (u16*)(e.ws + OFF_KSH); u16* VSHT = (u16*)(e.ws + OFF_VSHT);
#pragma unroll
            for (int mi = 0; mi < MI; ++mi) { __builtin_amdgcn_sched_barrier(0);
                const int tok = m0 + wm * 128 + mi * 16 + c16, b = tok >> 14, s = tok & (S_ - 1);
                if (nb < 128) {
                    const int g = nb >> 6;
                    rope_store(acc, mi, KSH + ((size_t)(b * 2 + g) * S_ + s) * 64, cosT, sinT, s, q4);
                } else {
                    const int g = (nb - 128) >> 6;
#pragma unroll
                    for (int ni = 0; ni < 4; ++ni)
#pragma unroll
                        for (int i = 0; i < 4; ++i) VSHT[((size_t)(b * 2 + g) * 64 + ni * 16 + q4 * 4 + i) * S_ + s] = f2bf(acc[ni][mi][i]);
                }
            }
        } else if (EPI == EPI_AIN) {
            unsigned char* ws = e.ws;
#pragma unroll
            for (int mi = 0; mi < MI; ++mi) { __builtin_amdgcn_sched_barrier(0);
                const int tok = m0 + wm * 128 + mi * 16 + c16, b = tok >> 14, s = tok & (S_ - 1);
                if (nb < 1024) {
                    rope_store(acc, mi, (u16*)(ws + OFF_Q) + (size_t)tok * 1024 + nb, cosT, sinT, s, q4);
                } else if (nb < 1536) {
                    u16* dst = (nb < 1280) ? ((u16*)(ws + OFF_KC) + (size_t)tok * 256 + (nb - 1024)) : ((u16*)(ws + OFF_VC) + (size_t)tok * 256 + (nb - 1280));
#pragma unroll
                    for (int ni = 0; ni < 4; ++ni) *(uint2*)(dst + ni * 16 + q4 * 4) = pack4(acc[ni][mi]);
                } else if (nb < 2560) {
                    const int r = (nb - 1536) >> 8;
                    const int g = ((nb - 1536) & 255) >> 6;
                    if (r == 0) {
                        unsigned char* kd = (unsigned char*)(ws + OFF_KS) + (size_t)(b * 4 + g) * S_ * 128 + (size_t)s * 64;
#pragma unroll
                        for (int ni = 0; ni < 2; ++ni) {
                            const int d = ni * 16 + q4 * 4;
                            const float4 c = *(const float4*)(cosT + s * 32 + d), sn = *(const float4*)(sinT + s * 32 + d);
                            const f32x4 x1 = acc[ni][mi], x2 = acc[ni + 2][mi];
                            *(unsigned*)(kd + d) = pk4_fp8(x1[0] * c.x - x2[0] * sn.x, x1[1] * c.y - x2[1] * sn.y, x1[2] * c.z - x2[2] * sn.z, x1[3] * c.w - x2[3] * sn.w);
                            *(unsigned*)(kd + d + 32) = pk4_fp8(x2[0] * c.x + x1[0] * sn.x, x2[1] * c.y + x1[1] * sn.y, x2[2] * c.z + x1[2] * sn.z, x2[3] * c.w + x1[3] * sn.w);
                        }
                    } else if (r == 2) {
                        u16* base = (u16*)(ws + OFF_KW);
                        rope_store(acc, mi, base + ((size_t)(b * 4 + g) * S_ + s) * 64, cosT, sinT, s, q4);
                    } else {
                        if (r == 1) {
                            unsigned char* base = (unsigned char*)(ws + OFF_VST) + (size_t)(b * 4 + g) * 128 * S_ + (size_t)(s >> 6) * 4096 + (s & 63);
#pragma unroll
                            for (int ni = 0; ni < 4; ++ni) {
                                const unsigned pk = pk4_fp8(acc[ni][mi][0], acc[ni][mi][1], acc[ni][mi][2], acc[ni][mi][3]);
#pragma unroll
                                for (int i = 0; i < 4; ++i) base[(ni * 16 + q4 * 4 + i) * 64] = (unsigned char)(pk >> (8 * i));
                            }
                        } else {
                            u16* base = (u16*)(ws + OFF_VWT);
#pragma unroll
                            for (int ni = 0; ni < 4; ++ni)
#pragma unroll
                                for (int i = 0; i < 4; ++i) base[((size_t)(b * 4 + g) * 64 + ni * 16 + q4 * 4 + i) * S_ + s] = f2bf(acc[ni][mi][i]);
                        }
                    }
                } else if (nb == 2560) {
                    float* G = (float*)(ws + OFF_GATES) + (size_t)tok * 48;
#pragma unroll
                    for (int ni = 0; ni < 3; ++ni) {
                        const int n = ni * 16 + q4 * 4;
                        *(float4*)(G + n) = make_float4(sigmoidf_(acc[ni][mi][0]), sigmoidf_(acc[ni][mi][1]), sigmoidf_(acc[ni][mi][2]), sigmoidf_(acc[ni][mi][3]));
                    }
                }
            }
        } else if (EPI == EPI_FFNIN) {
            u16* U = (u16*)smem;
#pragma unroll
            for (int mi = 0; mi < MI; ++mi) {
                const int row = wm * 128 + mi * 16 + c16;
#pragma unroll
                for (int ni = 0; ni < 4; ++ni) {
                    const int cch = wn * 16 + ni * 4 + q4;
                    *(uint2*)(U + row * 256 + ((cch ^ (row & 15)) << 2)) = pack4(acc[ni][mi]);
                }
            }
            __syncthreads();
            {
                const int cc = tid & 31, gsel = cc >> 4, ca = cc & 15, seg = tid >> 5;
                const int ncol = (nt * 2 + gsel) * 64 + ca * 4;
                const int cha = gsel * 32 + ca, chg = cha + 16;
                const float4 w0a = *(const float4*)(e.convw + ncol), w1a = *(const float4*)(e.convw + NFF2 + ncol), w2a = *(const float4*)(e.convw + 2 * NFF2 + ncol);
                const float4 w0g = *(const float4*)(e.convw + DFF + ncol), w1g = *(const float4*)(e.convw + NFF2 + DFF + ncol), w2g = *(const float4*)(e.convw + 2 * NFF2 + DFF + ncol);
                const float4 ba = *(const float4*)(e.convb + ncol), bg = *(const float4*)(e.convb + DFF + ncol);
                float* head = (float*)(e.ws + OFF_HEAD); float* halo = (float*)(e.ws + OFF_HALO);
                u16* act = (u16*)(e.ws + OFF_ACT);
                auto ldu = [&](int row, int ch) __attribute__((always_inline)) -> float4 {
                    const uint2 v = *(const uint2*)(U + row * 256 + ((ch ^ (row & 15)) << 2));
                    return make_float4(__uint_as_float(v.x << 16), __uint_as_float(v.x & 0xffff0000u), __uint_as_float(v.y << 16), __uint_as_float(v.y & 0xffff0000u));
                };
                const int r0 = seg * 16;
                float4 a2 = make_float4(0.f, 0.f, 0.f, 0.f), a1 = a2, g2 = a2, g1 = a2;
                if (seg > 0) { a2 = ldu(r0 - 2, cha); g2 = ldu(r0 - 2, chg); a1 = ldu(r0 - 1, cha); g1 = ldu(r0 - 1, chg); }
#pragma unroll 2
                for (int r = 0; r < 16; ++r) {
                    const int row = r0 + r;
                    const float4 ua = ldu(row, cha), ug = ldu(row, chg);
                    if (seg > 0 || r >= 2) {
                        float ca_[4], cg_[4];
                        ca_[0] = ba.x + w0a.x * a2.x + w1a.x * a1.x + w2a.x * ua.x; ca_[1] = ba.y + w0a.y * a2.y + w1a.y * a1.y + w2a.y * ua.y;
                        ca_[2] = ba.z + w0a.z * a2.z + w1a.z * a1.z + w2a.z * ua.z; ca_[3] = ba.w + w0a.w * a2.w + w1a.w * a1.w + w2a.w * ua.w;
                        cg_[0] = bg.x + w0g.x * g2.x + w1g.x * g1.x + w2g.x * ug.x; cg_[1] = bg.y + w0g.y * g2.y + w1g.y * g1.y + w2g.y * ug.y;
                        cg_[2] = bg.z + w0g.z * g2.z + w1g.z * g1.z + w2g.z * ug.z; cg_[3] = bg.w + w0g.w * g2.w + w1g.w * g1.w + w2g.w * ug.w;
                        f32x4 o = {ca_[0] * sigmoidf_(ca_[0]) * cg_[0], ca_[1] * sigmoidf_(ca_[1]) * cg_[1], ca_[2] * sigmoidf_(ca_[2]) * cg_[2], ca_[3] * sigmoidf_(ca_[3]) * cg_[3]};
                        *(uint2*)(act + (size_t)(m0 + row) * DFF + ncol) = pack4(o);
                    }
                    if (seg == 0 && r < 2) { *(float4*)(head + (size_t)(mt * 2 + r) * NFF2 + ncol) = ua; *(float4*)(head + (size_t)(mt * 2 + r) * NFF2 + DFF + ncol) = ug; }
                    if (seg == 15 && r >= 14) { *(float4*)(halo + (size_t)(mt * 2 + r - 14) * NFF2 + ncol) = ua; *(float4*)(halo + (size_t)(mt * 2 + r - 14) * NFF2 + DFF + ncol) = ug; }
                    a2 = a1; a1 = ua; g2 = g1; g1 = ug;
                }
            }
            __syncthreads();
        }
    }
}

__device__ __forceinline__ void fixup_phase(const Params& p, int L, int tid_, int bid_) {
    const float* head = (const float*)(p.ws + OFF_HEAD); const float* halo = (const float*)(p.ws + OFF_HALO);
    u16* act = (u16*)(p.ws + OFF_ACT);
    const float* cw = p.ffn_conv_w + (size_t)L * 3 * NFF2; const float* cb = p.ffn_conv_b + (size_t)L * NFF2;
    const int gt = bid_ * NTHR + tid_, nthr = gridDim.x * NTHR;
    for (int idx = gt; idx < 128 * 704; idx += nthr) {
        const int i = idx / 704, n = (idx - i * 704) * 4;
        const int t0 = i * 256;
        const bool first = (t0 & (S_ - 1)) == 0;
        const float4 z = make_float4(0.f, 0.f, 0.f, 0.f);
        const float4 ha0 = *(const float4*)(head + (size_t)(i * 2) * NFF2 + n), ha1 = *(const float4*)(head + (size_t)(i * 2 + 1) * NFF2 + n);
        const float4 hg0 = *(const float4*)(head + (size_t)(i * 2) * NFF2 + DFF + n), hg1 = *(const float4*)(head + (size_t)(i * 2 + 1) * NFF2 + DFF + n);
        float4 pa0 = z, pa1 = z, pg0 = z, pg1 = z;
        if (!first) {
            pa0 = *(const float4*)(halo + (size_t)(i * 2 - 2) * NFF2 + n); pa1 = *(const float4*)(halo + (size_t)(i * 2 - 1) * NFF2 + n);
            pg0 = *(const float4*)(halo + (size_t)(i * 2 - 2) * NFF2 + DFF + n); pg1 = *(const float4*)(halo + (size_t)(i * 2 - 1) * NFF2 + DFF + n);
        }
        const float4 w0a = *(const float4*)(cw + n), w1a = *(const float4*)(cw + NFF2 + n), w2a = *(const float4*)(cw + 2 * NFF2 + n);
        const float4 w0g = *(const float4*)(cw + DFF + n), w1g = *(const float4*)(cw + NFF2 + DFF + n), w2g = *(const float4*)(cw + 2 * NFF2 + DFF + n);
        const float4 ba = *(const float4*)(cb + n), bg = *(const float4*)(cb + DFF + n);
#define CONV3(b_, w0_, w1_, w2_, x0_, x1_, x2_) make_float4(b_.x + w0_.x * x0_.x + w1_.x * x1_.x + w2_.x * x2_.x, b_.y + w0_.y * x0_.y + w1_.y * x1_.y + w2_.y * x2_.y, \
                                                             b_.z + w0_.z * x0_.z + w1_.z * x1_.z + w2_.z * x2_.z, b_.w + w0_.w * x0_.w + w1_.w * x1_.w + w2_.w * x2_.w)
        const float4 ca0 = CONV3(ba, w0a, w1a, w2a, pa0, pa1, ha0), cg0 = CONV3(bg, w0g, w1g, w2g, pg0, pg1, hg0);
        const float4 ca1 = CONV3(ba, w0a, w1a, w2a, pa1, ha0, ha1), cg1 = CONV3(bg, w0g, w1g, w2g, pg1, hg0, hg1);
        f32x4 o0 = {ca0.x * sigmoidf_(ca0.x) * cg0.x, ca0.y * sigmoidf_(ca0.y) * cg0.y, ca0.z * sigmoidf_(ca0.z) * cg0.z, ca0.w * sigmoidf_(ca0.w) * cg0.w};
        f32x4 o1 = {ca1.x * sigmoidf_(ca1.x) * cg1.x, ca1.y * sigmoidf_(ca1.y) * cg1.y, ca1.z * sigmoidf_(ca1.z) * cg1.z, ca1.w * sigmoidf_(ca1.w) * cg1.w};
        *(uint2*)(act + (size_t)t0 * DFF + n) = pack4(o0);
        *(uint2*)(act + (size_t)(t0 + 1) * DFF + n) = pack4(o1);
    }
}

__device__ __forceinline__ void cmp2_phase(const Params& p, int L, int tid_, int bid_) {
    const int lane = tid_ & 63, w = tid_ >> 6, c16 = lane & 15, q4 = lane >> 4;
    const float* cosT = (const float*)(p.ws + OFF_COS); const float* sinT = (const float*)(p.ws + OFF_SIN);
    u16* KCC = (u16*)(p.ws + OFF_KCC); u16* VCCT = (u16*)(p.ws + OFF_VCCT);
    for (int task = bid_ * NW + w; task < 1024; task += gridDim.x * NW) {
        const int kv = task >> 9, r0 = (task & 511) * 16;
        const u16* hid = (const u16*)(p.ws + OFF_HID) + (size_t)kv * 8192 * 256;
        const u16* w2t = (const u16*)(p.ws + OFF_WT_CW2 + (L * 2 + kv) * SZ_WT_CW2);
        const int row = r0 + c16, rowc = row < 8184 ? row : 8183;
        f32x4 acc[4][1];
        f32x4 accq[4][4];
#pragma unroll
        for (int a = 0; a < 4; ++a) accq[a][0] = (f32x4){0.f, 0.f, 0.f, 0.f};
#pragma unroll
        for (int kk = 0; kk < 8; ++kk) {
            const bf16x8 bfr = *(const bf16x8*)(hid + (size_t)rowc * 256 + kk * 32 + q4 * 8);
#pragma unroll
            for (int nbk = 0; nbk < 4; ++nbk) {
                const bf16x8 afr = *(const bf16x8*)(w2t + (nbk * 16 + c16) * 256 + kk * 32 + q4 * 8);
                accq[nbk][0] = mfma16(afr, bfr, accq[nbk][0]);
            }
        }
        (void)acc;
        if (row < 8184) {
            const int g = row & 3, bn = row >> 2, b = bn / 1023, n = bn - b * 1023, bg = b * 4 + g;
            if (kv == 0) {
                rope_store(accq, 0, KCC + ((size_t)bg * 1024 + n) * 64, cosT, sinT, n * 16 + 31, q4);
            } else {
#pragma unroll
                for (int nbk = 0; nbk < 4; ++nbk)
#pragma unroll
                    for (int i = 0; i < 4; ++i) VCCT[((size_t)bg * 64 + nbk * 16 + q4 * 4 + i) * 1024 + n] = f2bf(accq[nbk][0][i]);
            }
        }
    }
    const int gt = bid_ * NTHR + tid_;
    if (gt < 512) {
        const int bg = gt >> 6, d = gt & 63;
        KCC[((size_t)bg * 1024 + 1023) * 64 + d] = 0;
        VCCT[((size_t)bg * 64 + d) * 1024 + 1023] = 0;
    }
}

template <bool SINK>
__device__ __forceinline__ void band_attn(const u16* __restrict__ qrow, const u16* __restrict__ Kh, const u16* __restrict__ VT, int t0, int W, const float* sinks4,
                                          f32x4 (&O)[4][4], float (&linv)[4], int lane) {
    const int c16 = lane & 15, q4 = lane >> 4;
    const float SC = 0.125f * LOG2E;
    bf16x8 qf[4][2];
#pragma unroll
    for (int h = 0; h < 4; ++h)
#pragma unroll
        for (int ks = 0; ks < 2; ++ks) qf[h][ks] = *(const bf16x8*)(qrow + h * 64 + ks * 32 + q4 * 8);
    float m[4], l[4];
#pragma unroll
    for (int h = 0; h < 4; ++h) {
        if (SINK) { m[h] = sinks4[h] * LOG2E; l[h] = (q4 == 0) ? 1.f : 0.f; }
        else { m[h] = NEGBIG; l[h] = 0.f; }
#pragma unroll
        for (int db = 0; db < 4; ++db) O[h][db] = (f32x4){0.f, 0.f, 0.f, 0.f};
    }
    const int t = t0 + c16;
    int lo = t0 - W + 1; if (lo < 0) lo = 0;
    const int g0 = lo >> 5, g1 = (t0 + 15) >> 5;
    const int kr = kperm(c16);
    for (int grp = g0; grp <= g1; ++grp) {
        const int kb = grp << 5;
        const unsigned kof = (unsigned)(kb + kr) * 64u + (unsigned)q4 * 8u;
        const bf16x8 k1a = *(const bf16x8*)(Kh + kof), k1b = *(const bf16x8*)(Kh + (kof + 32u)), k2a = *(const bf16x8*)(Kh + (kof + 256u)), k2b = *(const bf16x8*)(Kh + (kof + 288u));
        bf16x8 vf[4];
        const unsigned vof = (unsigned)c16 * (unsigned)S_ + (unsigned)kb + (unsigned)q4 * 8u;
#pragma unroll
        for (int db = 0; db < 4; ++db) vf[db] = *(const bf16x8*)(VT + (size_t)(db * 16 * S_) + vof);
        const int kpos = kb + q4 * 8;
        f32x4 cm1 = {0.f, 0.f, 0.f, 0.f}, cm2 = cm1;
        if (!((kb + 31 <= t0) && (kb > t0 + 15 - W))) {
#pragma unroll
            for (int i = 0; i < 4; ++i) {
                const int d1 = t - (kpos + i), d2 = t - (kpos + 4 + i);
                if (!((d1 >= 0) && (d1 < W))) cm1[i] = NEGBIG;
                if (!((d2 >= 0) && (d2 < W))) cm2[i] = NEGBIG;
            }
        }
#pragma unroll
        for (int h = 0; h < 4; ++h) {
            f32x4 s1 = mfma16(k1a, qf[h][0], cm1); s1 = mfma16(k1b, qf[h][1], s1);
            f32x4 s2 = mfma16(k2a, qf[h][0], cm2); s2 = mfma16(k2b, qf[h][1], s2);
            float mx = fmaxf(fmaxf(fmaxf(s1[0], s1[1]), fmaxf(s1[2], s1[3])), fmaxf(fmaxf(s2[0], s2[1]), fmaxf(s2[2], s2[3])));
            mx = xmax32(xmax16(mx));
            const float mn = fmaxf(fmaxf(m[h], mx * SC), -1e20f);
            if (__ballot(mn != m[h])) {
                const float alpha = fexp2(m[h] - mn);
                l[h] *= alpha;
#pragma unroll
                for (int db = 0; db < 4; ++db) O[h][db] = O[h][db] * alpha;
            }
            m[h] = mn;
            float pv[8]; float ps = 0.f;
#pragma unroll
            for (int i = 0; i < 4; ++i) { pv[i] = fexp2(fmaf(s1[i], SC, -mn)); pv[4 + i] = fexp2(fmaf(s2[i], SC, -mn)); }
#pragma unroll
            for (int i = 0; i < 8; ++i) ps += pv[i];
            l[h] += ps;
            const bf16x8 pf = pack8(pv);
#pragma unroll
            for (int db = 0; db < 4; ++db) O[h][db] = mfma16(vf[db], pf, O[h][db]);
        }
    }
#pragma unroll
    for (int h = 0; h < 4; ++h) { float lt = l[h]; lt += __shfl_xor(lt, 16); lt += __shfl_xor(lt, 32); linv[h] = 1.f / lt; }
}

__device__ __forceinline__ void swa_phase(const Params& p, int j, int tid_, int bid_) {
    const int lane = tid_ & 63, w = tid_ >> 6, c16 = lane & 15, q4 = lane >> 4;
    const int x = bid_ & 7, b = x >> 2, kvh = (x >> 1) & 1, hq = x & 1;
    const int head0 = kvh * 8 + hq * 4;
    const u16* Q = (const u16*)(p.ws + OFF_Q); u16* Ob = (u16*)(p.ws + OFF_O);
    const u16* Kh = (const u16*)(p.ws + OFF_KSH) + (size_t)(b * 2 + kvh) * S_ * 64;
    const u16* VT = (const u16*)(p.ws + OFF_VSHT) + (size_t)(b * 2 + kvh) * 64 * S_;
    const float* sk = p.b_sinks + j * 16 + head0;
    const int nslots = (gridDim.x >> 3) * NW;
    for (int tile = (bid_ >> 3) * NW + w; tile < 1024; tile += nslots) {
        const int t0 = tile * 16;
        f32x4 O[4][4]; float linv[4];
        band_attn<true>(Q + ((size_t)b * S_ + t0 + c16) * 1024 + head0 * 64, Kh, VT, t0, 128, sk, O, linv, lane);
        u16* op = Ob + ((size_t)b * S_ + t0 + c16) * 1024 + head0 * 64;
#pragma unroll
        for (int h = 0; h < 4; ++h)
#pragma unroll
            for (int db = 0; db < 4; ++db) *(uint2*)(op + h * 64 + db * 16 + q4 * 4) = pack4(O[h][db] * linv[h]);
    }
}

__device__ __forceinline__ void nsa_phase(const Params& p, unsigned char* smem, int tid_, int bid_, int probe_rep) {
    const int lane0 = tid_ & 63, w = tid_ >> 6;
    float* R = (float*)(smem + w * 16384);
    unsigned* tm = (unsigned*)(smem + NW * 16384 + w * 1024);
    unsigned char* sel = smem + NW * 16384 + NW * 1024 + w * 256;
    const int bg = bid_ & 7, b = bg >> 2, g = bg & 3;
    const u16* Q = (const u16*)(p.ws + OFF_Q); u16* Ob = (u16*)(p.ws + OFF_O);
    const u16* KCC = (const u16*)(p.ws + OFF_KCC) + (size_t)bg * 1024 * 64;
    const u16* VCCT = (const u16*)(p.ws + OFF_VCCT) + (size_t)bg * 64 * 1024;
    const u16* KS = (const u16*)(p.ws + OFF_KS) + (size_t)bg * S_ * 64;
    const u16* VST = (const u16*)(p.ws + OFF_VST) + (size_t)bg * 64 * S_;
    const u16* KW = (const u16*)(p.ws + OFF_KW) + (size_t)bg * S_ * 64;
    const u16* VWT = (const u16*)(p.ws + OFF_VWT) + (size_t)bg * 64 * S_;
    const float* GATES = (const float*)(p.ws + OFF_GATES);
    const float SC = 0.125f * LOG2E;
    const int nslots = (gridDim.x >> 3) * NW;
    const int slot_ = (bid_ >> 3) * NW + w;
    for (int rnd = 0; rnd * nslots < 1024; ++rnd) {
        const int tile_ = rnd * nslots + ((rnd & 1) ? (nslots - 1 - slot_) : slot_);
        if (tile_ >= 1024) continue;
        const int tile = __builtin_amdgcn_readfirstlane(tile_);
        int lane = lane0; asm volatile("" : "+v"(lane));
        const int c16 = lane & 15, q4 = lane >> 4, kr = kperm(c16);
        const int t0 = tile * 16, cur = t0 >> 6, t = t0 + c16;
        const u16* qrow = Q + ((size_t)b * S_ + t) * 1024 + g * 256;
        const float* grow = GATES + ((size_t)b * S_ + t) * 48 + g * 12;
        const int nvl = (t >= 31) ? ((t - 31) >> 4) : -1;
        const int nvmax = (t0 + 15 >= 31) ? ((t0 + 15 - 31) >> 4) : -1;
        const int ng = (nvmax >= 0) ? ((nvmax >> 5) + 1) : 0;
        f32x4 Oc[4][4];
#pragma unroll
        for (int h = 0; h < 4; ++h)
#pragma unroll
            for (int db = 0; db < 4; ++db) Oc[h][db] = (f32x4){0.f, 0.f, 0.f, 0.f};
        {
            bf16x8 qf[4][2];
#pragma unroll
            for (int h = 0; h < 4; ++h)
#pragma unroll
                for (int ks = 0; ks < 2; ++ks) qf[h][ks] = *(const bf16x8*)(qrow + h * 64 + ks * 32 + q4 * 8);
            float m[4], l[4];
#pragma unroll
            for (int h = 0; h < 4; ++h) { m[h] = NEGBIG; l[h] = 0.f; }
            const int nvmin = (t0 >= 31) ? ((t0 - 31) >> 4) : -1;
            for (int grp = 0; grp < ng; ++grp) {
                const int kb = grp << 5;
                const unsigned kof = (unsigned)(kb + kr) * 64u + (unsigned)q4 * 8u;
                const bf16x8 k1a = *(const bf16x8*)(KCC + kof), k1b = *(const bf16x8*)(KCC + (kof + 32u)), k2a = *(const bf16x8*)(KCC + (kof + 256u)), k2b = *(const bf16x8*)(KCC + (kof + 288u));
                const int kpos = kb + q4 * 8;
                f32x4 cm1 = {0.f, 0.f, 0.f, 0.f}, cm2 = cm1;
                if (kb + 31 > nvmin) {
#pragma unroll
                    for (int i = 0; i < 4; ++i) { if (kpos + i > nvl) cm1[i] = NEGBIG; if (kpos + 4 + i > nvl) cm2[i] = NEGBIG; }
                }
#pragma unroll
                for (int h = 0; h < 4; ++h) {
                    f32x4 s1 = mfma16(k1a, qf[h][0], cm1); s1 = mfma16(k1b, qf[h][1], s1);
                    f32x4 s2 = mfma16(k2a, qf[h][0], cm2); s2 = mfma16(k2b, qf[h][1], s2);
                    float mx = fmaxf(fmaxf(fmaxf(s1[0], s1[1]), fmaxf(s1[2], s1[3])), fmaxf(fmaxf(s2[0], s2[1]), fmaxf(s2[2], s2[3])));
                    mx = xmax32(xmax16(mx));
                    const float mn = fmaxf(fmaxf(m[h], mx * SC), -1e20f);
                    if (__ballot(mn != m[h])) l[h] *= fexp2(m[h] - mn);
                    m[h] = mn;
                    float ps = 0.f;
#pragma unroll
                    for (int i = 0; i < 4; ++i) ps += fexp2(fmaf(s1[i], SC, -mn)) + fexp2(fmaf(s2[i], SC, -mn));
                    l[h] += ps;
                }
            }
            float linv[4];
#pragma unroll
            for (int h = 0; h < 4; ++h) { float lt = l[h]; lt += __shfl_xor(lt, 16); lt += __shfl_xor(lt, 32); linv[h] = lt > 0.f ? 1.f / lt : 0.f; }
            float carry = 0.f;
            for (int grp = 0; grp < ng; ++grp) {
                const int kb = grp << 5;
                const unsigned kof = (unsigned)(kb + kr) * 64u + (unsigned)q4 * 8u;
                const bf16x8 k1a = *(const bf16x8*)(KCC + kof), k1b = *(const bf16x8*)(KCC + (kof + 32u)), k2a = *(const bf16x8*)(KCC + (kof + 256u)), k2b = *(const bf16x8*)(KCC + (kof + 288u));
                bf16x8 vf[4];
#pragma unroll
                for (int db = 0; db < 4; ++db) vf[db] = *(const bf16x8*)(VCCT + (unsigned)(db * 16 * 1024) + ((unsigned)c16 * 1024u + (unsigned)kb + (unsigned)q4 * 8u));
                const int kpos = kb + q4 * 8;
                float psum[8];
#pragma unroll
                for (int i = 0; i < 8; ++i) psum[i] = 0.f;
                f32x4 cm1 = {0.f, 0.f, 0.f, 0.f}, cm2 = cm1;
                if (kb + 31 > nvmin) {
#pragma unroll
                    for (int i = 0; i < 4; ++i) { if (kpos + i > nvl) cm1[i] = NEGBIG; if (kpos + 4 + i > nvl) cm2[i] = NEGBIG; }
                }
#pragma unroll
                for (int h = 0; h < 4; ++h) {
                    f32x4 s1 = mfma16(k1a, qf[h][0], cm1); s1 = mfma16(k1b, qf[h][1], s1);
                    f32x4 s2 = mfma16(k2a, qf[h][0], cm2); s2 = mfma16(k2b, qf[h][1], s2);
                    float pv[8];
#pragma unroll
                    for (int i = 0; i < 4; ++i) {
                        pv[i] = fexp2(fmaf(s1[i], SC, -m[h])) * linv[h];
                        pv[4 + i] = fexp2(fmaf(s2[i], SC, -m[h])) * linv[h];
                    }
#pragma unroll
                    for (int i = 0; i < 8; ++i) psum[i] += pv[i];
                    const bf16x8 pf = pack8(pv);
#pragma unroll
                    for (int db = 0; db < 4; ++db) Oc[h][db] = mfma16(vf[db], pf, Oc[h][db]);
                }
                const float prev = __shfl(psum[7], (lane + 48) & 63);
                const float left = (q4 == 0) ? carry : prev;
                carry = prev;
                const float impA = left + 2.f * (psum[0] + psum[1] + psum[2]) + psum[3];
                const float impB = psum[3] + 2.f * (psum[4] + psum[5] + psum[6]) + psum[7];
                *(float2*)(R + c16 * 256 + (kb >> 2) + 2 * q4) = make_float2(impA, impB);
            }
        }
        wsync();
        const int ncand = cur - 2;
        const int npick = ncand < 0 ? 0 : (ncand < 13 ? ncand : 13);
        const int nforced = (cur < 2 ? cur : 2) + 1;
        const int nsel = npick + nforced;
        for (int tk = 0; tk < 8; ++tk) {
            float a0 = -1.f, a1 = -1.f, a2 = -1.f, a3 = -1.f, b0 = -1.f, b1 = -1.f, b2 = -1.f, b3 = -1.f;
            if (npick > 0) {
                const float4 va = *(const float4*)(R + tk * 256 + lane * 4), vb = *(const float4*)(R + (tk + 8) * 256 + lane * 4);
                const int j0 = lane * 4;
                const bool k0 = (j0 >= 1 && j0 <= ncand), k1 = (j0 + 1 <= ncand), k2 = (j0 + 2 <= ncand), k3 = (j0 + 3 <= ncand);
                a0 = k0 ? va.x : -1.f; a1 = k1 ? va.y : -1.f; a2 = k2 ? va.z : -1.f; a3 = k3 ? va.w : -1.f;
                b0 = k0 ? vb.x : -1.f; b1 = k1 ? vb.y : -1.f; b2 = k2 ? vb.z : -1.f; b3 = k3 ? vb.w : -1.f;
            }
            for (int it = 0; it < npick; ++it) {
                const float ma = wave_max(fmaxf(fmaxf(a0, a1), fmaxf(a2, a3)));
                const float mb = wave_max(fmaxf(fmaxf(b0, b1), fmaxf(b2, b3)));
                const unsigned long long bala = __ballot((a0 == ma) || (a1 == ma) || (a2 == ma) || (a3 == ma));
                const unsigned long long balb = __ballot((b0 == mb) || (b1 == mb) || (b2 == mb) || (b3 == mb));
                const int fa = __ffsll((long long)bala) - 1, fb = __ffsll((long long)balb) - 1;
                if (lane == fa) {
                    int sl;
                    if (a0 == ma) { sl = 0; a0 = -1.f; } else if (a1 == ma) { sl = 1; a1 = -1.f; } else if (a2 == ma) { sl = 2; a2 = -1.f; } else { sl = 3; a3 = -1.f; }
                    sel[tk * 16 + it] = (unsigned char)(lane * 4 + sl);
                }
                if (lane == fb) {
                    int sl;
                    if (b0 == mb) { sl = 0; b0 = -1.f; } else if (b1 == mb) { sl = 1; b1 = -1.f; } else if (b2 == mb) { sl = 2; b2 = -1.f; } else { sl = 3; b3 = -1.f; }
                    sel[(tk + 8) * 16 + it] = (unsigned char)(lane * 4 + sl);
                }
            }
            if (lane < 2) {
                const int tq = tk + lane * 8;
                sel[tq * 16 + npick] = 0;
                if (cur >= 1) sel[tq * 16 + npick + 1] = (unsigned char)cur;
                if (cur >= 2) sel[tq * 16 + npick + 2] = (unsigned char)(cur - 1);
            }
        }
        { unsigned zz = 0u; asm volatile("" : "+v"(zz)); *(uint4*)(tm + lane * 4) = make_uint4(zz, zz, zz, zz); }
        wsync();
        if (lane < 16) {
            for (int si = 0; si < nsel; ++si) atomicOr(&tm[sel[lane * 16 + si]], 1u << lane);
        }
        wsync();
        int n_act;
        {
            const uint4 mm = *(const uint4*)(tm + lane * 4);
            wsync();
            const bool f0 = mm.x != 0u, f1 = mm.y != 0u, f2 = mm.z != 0u, f3 = mm.w != 0u;
            const unsigned long long b0 = __ballot(f0), b1 = __ballot(f1), b2 = __ballot(f2), b3 = __ballot(f3);
            const unsigned long long below = (1ull << lane) - 1ull;
            int pos = __popcll(b0 & below) + __popcll(b1 & below) + __popcll(b2 & below) + __popcll(b3 & below);
            if (f0) { sel[pos] = (unsigned char)(lane * 4 + 0); ++pos; }
            if (f1) { sel[pos] = (unsigned char)(lane * 4 + 1); ++pos; }
            if (f2) { sel[pos] = (unsigned char)(lane * 4 + 2); ++pos; }
            if (f3) { sel[pos] = (unsigned char)(lane * 4 + 3); ++pos; }
            n_act = __popcll(b0) + __popcll(b1) + __popcll(b2) + __popcll(b3);
        }
        wsync();
        u16* PL = (u16*)R + 4096;
        {
            int t3 = t; asm volatile("" : "+v"(t3));
            const float* grow3 = GATES + ((size_t)b * S_ + t3) * 48 + g * 12;
#pragma unroll
            for (int h = 0; h < 4; ++h) {
                const float g0 = grow3[h * 3 + 0];
#pragma unroll
                for (int db = 0; db < 4; ++db) *(uint2*)(PL + (c16 * 4 + h) * 64 + db * 16 + q4 * 4) = pack4(Oc[h][db] * g0);
            }
        }
        wsync();
        for (int rep = 0; rep <= probe_rep; ++rep) {
            const int tg = c16 >> 2, hh = c16 & 3;
            f32x4 Os[4][4], Ol[4]; float m[4];
#pragma unroll
            for (int gq = 0; gq < 4; ++gq) {
                m[gq] = NEGBIG; Ol[gq] = (f32x4){0.f, 0.f, 0.f, 0.f};
#pragma unroll
                for (int db = 0; db < 4; ++db) Os[gq][db] = (f32x4){0.f, 0.f, 0.f, 0.f};
            }
            const long ones8 = 0x3838383838383838L;
            long qf8[4][2];
#pragma unroll
            for (int gq = 0; gq < 4; ++gq)
#pragma unroll
                for (int ks = 0; ks < 2; ++ks) {
                    const uint4 qv = *(const uint4*)(Q + ((size_t)b * S_ + t0 + gq * 4 + tg) * 1024 + g * 256 + hh * 64 + ks * 32 + q4 * 8);
                    const float f[8] = {__uint_as_float(qv.x << 16), __uint_as_float(qv.x & 0xffff0000u), __uint_as_float(qv.y << 16), __uint_as_float(qv.y & 0xffff0000u),
                                        __uint_as_float(qv.z << 16), __uint_as_float(qv.z & 0xffff0000u), __uint_as_float(qv.w << 16), __uint_as_float(qv.w & 0xffff0000u)};
                    qf8[gq][ks] = pk8_fp8(f);
                }
            const unsigned char* KS8 = (const unsigned char*)KS;
            const unsigned char* VS8 = (const unsigned char*)VST;
            auto ld = [&](int s, long (&K)[4], long (&V)[4]) __attribute__((always_inline)) {
                const int j = __builtin_amdgcn_readfirstlane((int)sel[s >> 1]);
                const int kb = j * 64 + (s & 1) * 32;
                const unsigned kof = (unsigned)(kb + kr) * 64u + (unsigned)q4 * 8u;
                K[0] = *(const long*)(KS8 + kof); K[1] = *(const long*)(KS8 + (kof + 32u)); K[2] = *(const long*)(KS8 + (kof + 256u)); K[3] = *(const long*)(KS8 + (kof + 288u));
                const unsigned vof = (unsigned)j * 4096u + (unsigned)c16 * 64u + (unsigned)(s & 1) * 32u + (unsigned)q4 * 8u;
#pragma unroll
                for (int db = 0; db < 4; ++db) V[db] = *(const long*)(VS8 + (vof + (unsigned)(db * 1024)));
            };
            auto cp = [&](int s, const long (&K)[4], const long (&V)[4]) __attribute__((always_inline)) {
                const int j = __builtin_amdgcn_readfirstlane((int)sel[s >> 1]);
                const unsigned mk = __builtin_amdgcn_readfirstlane(tm[j]);
                const int kpos = j * 64 + (s & 1) * 32 + q4 * 8;
#pragma unroll
                for (int gq = 0; gq < 4; ++gq) {
                    const unsigned gm = (mk >> (gq * 4)) & 0xFu;
                    if (gm == 0u) continue;
                    const float cmv = ((gm >> tg) & 1u) ? 0.f : NEGBIG;
                    f32x4 cm1 = {cmv, cmv, cmv, cmv}, cm2 = cm1;
                    if (j == cur) {
                        const int tc = t0 + gq * 4 + tg;
#pragma unroll
                        for (int i = 0; i < 4; ++i) { if (kpos + i > tc) cm1[i] = NEGBIG; if (kpos + 4 + i > tc) cm2[i] = NEGBIG; }
                    }
                    f32x4 s1 = mfma8(K[0], qf8[gq][0], cm1); s1 = mfma8(K[1], qf8[gq][1], s1);
                    f32x4 s2 = mfma8(K[2], qf8[gq][0], cm2); s2 = mfma8(K[3], qf8[gq][1], s2);
                    float mx = fmaxf(fmaxf(fmaxf(s1[0], s1[1]), fmaxf(s1[2], s1[3])), fmaxf(fmaxf(s2[0], s2[1]), fmaxf(s2[2], s2[3])));
                    mx = xmax32(xmax16(mx));
                    const float mn = fmaxf(m[gq], mx * SC);
                    if (__ballot(mn != m[gq])) {
                        const float alpha = fexp2(m[gq] - mn);
                        Ol[gq] = Ol[gq] * alpha;
#pragma unroll
                        for (int db = 0; db < 4; ++db) Os[gq][db] = Os[gq][db] * alpha;
                    }
                    m[gq] = mn;
                    float pv[8];
#pragma unroll
                    for (int i = 0; i < 4; ++i) { pv[i] = fexp2(fmaf(s1[i], SC, 7.f - mn)); pv[4 + i] = fexp2(fmaf(s2[i], SC, 7.f - mn)); }
                    const long pf = pk8_fp8(pv);
#pragma unroll
                    for (int db = 0; db < 4; ++db) Os[gq][db] = mfma8(V[db], pf, Os[gq][db]);
                    Ol[gq] = mfma8(ones8, pf, Ol[gq]);
                }
            };
            {
                long KA[4], VA[4], KB[4], VB[4];
                const int ns = 2 * n_act;
                ld(0, KA, VA);
                for (int s = 0; s < ns; s += 2) {
                    ld(s + 1, KB, VB);
                    cp(s, KA, VA);
                    if (s + 2 < ns) ld(s + 2, KA, VA);
                    cp(s + 1, KB, VB);
                }
            }
            const float repsc = (rep == 0) ? 1.f : 0.f;
#pragma unroll
            for (int gq = 0; gq < 4; ++gq) {
                const float lt = Ol[gq][0];
                const int tok = gq * 4 + tg;
                const float sc = repsc * GATES[((size_t)b * S_ + t0 + tok) * 48 + g * 12 + hh * 3 + 1] / lt;
#pragma unroll
                for (int db = 0; db < 4; ++db) {
                    u16* rp = PL + (tok * 4 + hh) * 64 + db * 16 + q4 * 4;
                    *(uint2*)rp = pack4(unpack4(*(const uint2*)rp) + Os[gq][db] * sc);
                }
            }
        }
        wsync();
        {
            f32x4 Ow[4][4]; float linv[4];
            int t2 = t; asm volatile("" : "+v"(t2));
            const u16* qrow2 = Q + ((size_t)b * S_ + t2) * 1024 + g * 256;
            const float* grow2 = GATES + ((size_t)b * S_ + t2) * 48 + g * 12;
            band_attn<false>(qrow2, KW, VWT, t0, 512, nullptr, Ow, linv, lane);
            u16* op = Ob + ((size_t)b * S_ + t2) * 1024 + g * 256;
#pragma unroll
            for (int h = 0; h < 4; ++h) {
                const float g2 = grow2[h * 3 + 2] * linv[h];
#pragma unroll
                for (int db = 0; db < 4; ++db) {
                    const f32x4 part = unpack4(*(const uint2*)(PL + (c16 * 4 + h) * 64 + db * 16 + q4 * 4));
                    *(uint2*)(op + h * 64 + db * 16 + q4 * 4) = pack4(part + Ow[h][db] * g2);
                }
            }
        }
        wsync();
    }
}


#define XB_TMO      128
#define XB_XCNT(j)  (256  + 64 * (j))
#define XB_XSUB(j)  (1280 + 64 * (j))
#define XB_XGEN(j)  (2304 + 64 * (j))
#define XB_TOP      3328
#define XB_TOPGEN   3392
#define XCD_BAR_WORDS 3456
#define XB_SPIN_CAP (1u << 22)
#define LAS __attribute__((address_space(3)))
__device__ __forceinline__ unsigned xb_ld(unsigned* p)              { return __hip_atomic_load(p, __ATOMIC_RELAXED, __HIP_MEMORY_SCOPE_AGENT); }
__device__ __forceinline__ unsigned xb_add(unsigned* p, unsigned v) { return __hip_atomic_fetch_add(p, v, __ATOMIC_RELAXED, __HIP_MEMORY_SCOPE_AGENT); }
__device__ __forceinline__ unsigned xb_xcc_id() { return (unsigned)__builtin_amdgcn_s_getreg((3 << 11) | 20) & 0xFu; }
#define XB_SPIN(cond, bar) do { unsigned _sp = 0; while (cond) { __builtin_amdgcn_s_sleep(1); \
    if ((++_sp & 255u) == 0u) { if (xb_ld(&(bar)[XB_TMO])) break; if (_sp > XB_SPIN_CAP) { atomicAdd(&(bar)[XB_TMO], 1u); break; } } } } while (0)
__device__ __forceinline__ void xcd_barrier_complete(unsigned* bar, unsigned x, unsigned& nloc, unsigned& nx) {
    const unsigned G = gridDim.x * gridDim.y * gridDim.z;
    unsigned sum, cnt, mine, sp = 0u;
    for (;;) {
        sum = 0u; cnt = 0u; mine = 0u;
#pragma unroll
        for (unsigned j = 0; j < 16; ++j) { const unsigned c = xb_ld(&bar[XB_XCNT(j)]); sum += c; cnt += (c > 0u) ? 1u : 0u; mine = (j == x) ? c : mine; }
        if (sum == G) break;
        __builtin_amdgcn_s_sleep(1);
        if ((++sp & 255u) == 0u) { if (xb_ld(&bar[XB_TMO])) break; if (sp > XB_SPIN_CAP) { atomicAdd(&bar[XB_TMO], 1u); break; } }
    }
    nloc = mine > 0u ? mine : 1u; nx = cnt > 0u ? cnt : 1u;
}
__device__ __forceinline__ void xcd_barrier(unsigned* bar, unsigned x, volatile LAS unsigned* st, int tid) {
    asm volatile("s_waitcnt vmcnt(0)" ::: "memory");
    __syncthreads();
    if (tid == 0) {
        __builtin_amdgcn_s_waitcnt(0);
        unsigned nloc = st[0], nx = st[1];
        if (nloc == 0u) { xcd_barrier_complete(bar, x, nloc, nx); st[0] = nloc; st[1] = nx; }
        const unsigned old = xb_add(&bar[XB_XSUB(x)], 1u);
        const unsigned gen = old / nloc;
        if (old + 1u == (gen + 1u) * nloc) {
            __builtin_amdgcn_fence(__ATOMIC_RELEASE, "agent");
            asm volatile("s_waitcnt vmcnt(0)" ::: "memory");
            const unsigned og = xb_add(&bar[XB_TOP], 1u);
            const unsigned tg = og / nx;
            if (og + 1u == (tg + 1u) * nx) xb_add(&bar[XB_TOPGEN], 1u);
            else XB_SPIN(xb_ld(&bar[XB_TOPGEN]) == tg, bar);
            __builtin_amdgcn_fence(__ATOMIC_ACQUIRE, "agent");
            xb_add(&bar[XB_XGEN(x)], 1u);
            asm volatile("s_waitcnt vmcnt(0)" ::: "memory");
        } else {
            XB_SPIN(xb_ld(&bar[XB_XGEN(x)]) == gen, bar);
            __builtin_amdgcn_fence(__ATOMIC_ACQUIRE, "agent");
            asm volatile("s_waitcnt vmcnt(0)" ::: "memory");
        }
    }
    __syncthreads();
}

enum { PT_PREP = 0, PT_NORM, PT_AIN, PT_CMP1, PT_CMP2, PT_NSA, PT_BKV, PT_BQ, PT_SWA, PT_AOUT, PT_FFNIN, PT_FIXUP, PT_FOUT, PT_FINAL };

__global__ void __launch_bounds__(NTHR, 2) mega(Params p) {
#if defined(__HIP_DEVICE_COMPILE__)
    extern __shared__ __attribute__((aligned(16))) unsigned char smem[];
    cg::grid_group grid = cg::this_grid();
    typedef const Params __attribute__((address_space(4)))* KP;
    const int ph_lo = p.ph_lo, ph_hi = p.ph_hi;
    const int wave_id = __builtin_amdgcn_readfirstlane((int)(threadIdx.x >> 6));
    unsigned* bar = (unsigned*)(p.ws + OFF_BAR);
    volatile LAS unsigned* xst = (volatile LAS unsigned*)(smem + LDS_USER);
    const unsigned xcc = __builtin_amdgcn_readfirstlane(xb_xcc_id());
    if (ph_hi - ph_lo > 1) {
        if (threadIdx.x == 0) { xst[0] = 0u; xst[1] = 0u; (void)xb_add(&bar[XB_XCNT(xcc)], 1u); }
        __syncthreads();
    }
    for (int ph = ph_lo; ph < ph_hi; ++ph) {
        int tid_, bid_ = blockIdx.x;
        asm volatile("v_mbcnt_lo_u32_b32 %0, -1, 0\n\tv_mbcnt_hi_u32_b32 %0, -1, %0" : "=v"(tid_));
        tid_ += wave_id * 64;
        asm volatile("" : "+s"(bid_));
        KP kp = (KP)__builtin_amdgcn_kernarg_segment_ptr();
        asm volatile("" : "+s"(kp));
        unsigned char* ws = kp->ws;
        u16* HN = (u16*)(ws + OFF_HN);
        const int d = kp->desc[ph], type = d & 255, sub = (d >> 8) & 255, L = d >> 16;
        const float* hsrc = (L == 0) ? kp->x : kp->out;
        EpiArgs e; e.resid = nullptr; e.out = kp->out; e.bias = nullptr; e.hid = nullptr; e.convw = nullptr; e.convb = nullptr; e.ws = ws;
        switch (type) {
        case PT_PREP: { const Params pl = *kp; prep_phase(pl, smem, tid_, bid_); } break;
        case PT_NORM: {
            const float* src = (sub == 1) ? kp->out : hsrc;
            const float* g = (sub == 0) ? kp->norm_attn + L * 1024 : (sub == 1) ? kp->norm_ffn + L * 1024 : kp->kv_norm;
            norm_phase<false>(src, g, HN, nullptr, tid_, bid_);
        } break;
        case PT_AIN: gemm_phase<AM_PLAIN, EPI_AIN>(HN, 1024, (const u16*)(ws + OFF_WT_AIN + L * SZ_WT_AIN), T_, 2688, 1024, 0, e, smem, tid_, bid_); break;
        case PT_CMP1:
            for (int kv = 0; kv < 2; ++kv) {
                e.bias = (const float*)(ws + OFF_CBIAS) + (L * 2 + kv) * 256; e.hid = (u16*)(ws + OFF_HID) + (size_t)kv * 8192 * 256;
                gemm_phase<AM_GATHER, EPI_CMP1>((const u16*)(ws + (kv == 0 ? OFF_KC : OFF_VC)), 0, (const u16*)(ws + OFF_WT_CW1 + (L * 2 + kv) * SZ_WT_CW1), 8184, 256, 2048,
                                                kv == 0 ? 0 : (int)(gridDim.x >> 1), e, smem, tid_, bid_);
            }
            break;
        case PT_CMP2: { const Params pl = *kp; cmp2_phase(pl, L, tid_, bid_); } break;
        case PT_NSA: { const Params pl = *kp; nsa_phase(pl, smem, tid_, bid_, sub); } break;
        case PT_BKV: gemm_phase<AM_PLAIN, EPI_BKV>(HN, 1024, (const u16*)(ws + OFF_WT_KV), T_, 256, 1024, 0, e, smem, tid_, bid_); break;
        case PT_BQ: gemm_phase<AM_PLAIN, EPI_BQ>(HN, 1024, (const u16*)(ws + OFF_WT_BQ + (L - 2) * SZ_WT_SQ), T_, 1024, 1024, 0, e, smem, tid_, bid_); break;
        case PT_SWA: { const Params pl = *kp; swa_phase(pl, L - 2, tid_, bid_); } break;
        case PT_AOUT:
        case PT_FOUT: {
            const bool ff = (type == PT_FOUT);
            e.resid = ff ? kp->out : hsrc;
            const u16* A = (const u16*)(ws + (ff ? OFF_ACT : OFF_O));
            const u16* Bt = (const u16*)(ws + (ff ? OFF_WT_FOUT + L * SZ_WT_FOUT : (L < 2 ? OFF_WT_AOUT + L * SZ_WT_SQ : OFF_WT_BOUT + (L - 2) * SZ_WT_SQ)));
            const int K = ff ? DFF : 1024;
            gemm_big<AM_PLAIN, EPI_RESID>(A, K, Bt, T_, 1024, K, 0, e, smem, tid_, bid_);
        } break;
        case PT_FFNIN:
            e.convw = kp->ffn_conv_w + (size_t)L * 3 * NFF2; e.convb = kp->ffn_conv_b + (size_t)L * NFF2;
            gemm_big<AM_PLAIN, EPI_FFNIN>(HN, 1024, (const u16*)(ws + OFF_WT_FIN + L * SZ_WT_FIN), T_, NFF2, 1024, 0, e, smem, tid_, bid_);
            break;
        case PT_FIXUP: { const Params pl = *kp; fixup_phase(pl, L, tid_, bid_); } break;
        case PT_FINAL: norm_phase<true>(kp->out, kp->final_norm, nullptr, kp->out, tid_, bid_); break;
        default: break;
        }
        if (ph + 1 < ph_hi) { if (ph == ph_lo) grid.sync(); else xcd_barrier(bar, xcc, xst, tid_); }
    }
#endif
}

static int build_program(int* desc) {
    int n = 0;
    auto add = [&](int type, int sub, int L) { desc[n++] = type | (sub << 8) | (L << 16); };
    add(PT_PREP, 0, 0);
    for (int L = 0; L < 4; ++L) {
        if (L < 2) {
            add(PT_NORM, 0, L); add(PT_AIN, 0, L); add(PT_CMP1, 0, L); add(PT_CMP2, 0, L); add(PT_NSA, NSA_PROBE_REP, L);
        } else {
            if (L == 2) { add(PT_NORM, 2, L); add(PT_BKV, 0, L); }
            add(PT_NORM, 0, L); add(PT_BQ, 0, L); add(PT_SWA, 0, L);
        }
        add(PT_AOUT, 0, L); add(PT_NORM, 1, L); add(PT_FFNIN, 0, L); add(PT_FIXUP, 0, L); add(PT_FOUT, 0, L);
    }
    add(PT_FINAL, 0, 0);
    return n;
}

extern "C" void kernel_launch(void* const* d_in, const int* in_sizes, int n_in, void* d_out, int out_size, void* d_ws, size_t ws_size, hipStream_t stream) {
    (void)in_sizes; (void)n_in; (void)out_size;
    static int grid_blocks = 0;
    if (!grid_blocks) {
        (void)hipFuncSetAttribute((const void*)mega, hipFuncAttributeMaxDynamicSharedMemorySize, LDS_BYTES);
        int dev = 0, cus = 0, per_cu = 0;
        (void)hipGetDevice(&dev);
        (void)hipDeviceGetAttribute(&cus, hipDeviceAttributeMultiprocessorCount, dev);
        (void)hipOccupancyMaxActiveBlocksPerMultiprocessor(&per_cu, mega, NTHR, LDS_BYTES);
        if (per_cu > 1) per_cu = 1;
        if (per_cu < 1) per_cu = 1;
        grid_blocks = (cus * per_cu) & ~7;
        if (grid_blocks < 8) grid_blocks = 8;
        if (ws_size < WS_NEED) fprintf(stderr, "workspace too small: %zu < %zu\n", ws_size, (size_t)WS_NEED);
    }
    Params p{};
    const float** pp = (const float**)&p;
    for (int i = 0; i < 18; ++i) pp[i] = (const float*)d_in[i];
    p.out = (float*)d_out;
    p.ws = (unsigned char*)d_ws;
    const int nph = build_program(p.desc);
#if MULTI_LAUNCH
    for (int ph = 0; ph < nph; ++ph) {
        p.ph_lo = ph; p.ph_hi = ph + 1;
        hipLaunchKernelGGL(mega, dim3(grid_blocks), dim3(NTHR), LDS_BYTES, stream, p);
    }
#else
    p.ph_lo = 0; p.ph_hi = nph;
    (void)hipMemsetAsync((unsigned char*)d_ws + OFF_BAR, 0, 16384, stream);
    void* args[] = {&p};
    hipError_t err = hipLaunchCooperativeKernel((const void*)mega, dim3(grid_blocks), dim3(NTHR), args, LDS_BYTES, stream);
    if (err != hipSuccess) fprintf(stderr, "cooperative launch failed: %s (grid %d)\n", hipGetErrorString(err), grid_blocks);
#endif
}
```

```cpp
#include <hip/hip_runtime.h>
#include <hip/hip_cooperative_groups.h>
#include <cstdio>
#include <cmath>
namespace cg = cooperative_groups;

typedef unsigned short u16;
typedef short bf16x8 __attribute__((ext_vector_type(8)));
typedef float f32x4 __attribute__((ext_vector_type(4)));

#ifndef NSA_PROBE_REP
#define NSA_PROBE_REP 0
#endif
#ifndef MULTI_LAUNCH
#define MULTI_LAUNCH 0
#endif

constexpr int S_ = 16384, T_ = 32768, D_ = 1024, DFF = 2816, NFF2 = 5632;
constexpr int NTHR = 512, NW = NTHR / 64;
constexpr int LDS_USER = NW * 16384 + NW * 1024 + NW * 256;
constexpr int LDS_BYTES = LDS_USER + 16;
constexpr float LOG2E = 1.4426950408889634f;
constexpr float NEGBIG = -1e30f;

constexpr size_t al256(size_t x) { return (x + 255) & ~(size_t)255; }
constexpr size_t SZ_WT_AIN = (size_t)2688 * 1024 * 2;
constexpr size_t SZ_WT_CW1 = (size_t)256 * 2048 * 2;
constexpr size_t SZ_WT_CW2 = (size_t)64 * 256 * 2;
constexpr size_t SZ_WT_SQ = (size_t)1024 * 1024 * 2;
constexpr size_t SZ_WT_KV = (size_t)256 * 1024 * 2;
constexpr size_t SZ_WT_FIN = (size_t)5632 * 1024 * 2;
constexpr size_t SZ_WT_FOUT = (size_t)1024 * 2816 * 2;
constexpr size_t OFF_WT_AIN = 0;
constexpr size_t OFF_WT_CW1 = OFF_WT_AIN + 2 * SZ_WT_AIN;
constexpr size_t OFF_WT_CW2 = OFF_WT_CW1 + 4 * SZ_WT_CW1;
constexpr size_t OFF_WT_AOUT = OFF_WT_CW2 + 4 * SZ_WT_CW2;
constexpr size_t OFF_WT_KV = OFF_WT_AOUT + 2 * SZ_WT_SQ;
constexpr size_t OFF_WT_BQ = OFF_WT_KV + SZ_WT_KV;
constexpr size_t OFF_WT_BOUT = OFF_WT_BQ + 2 * SZ_WT_SQ;
constexpr size_t OFF_WT_FIN = OFF_WT_BOUT + 2 * SZ_WT_SQ;
constexpr size_t OFF_WT_FOUT = OFF_WT_FIN + 4 * SZ_WT_FIN;
constexpr size_t OFF_COS = OFF_WT_FOUT + 4 * SZ_WT_FOUT;
constexpr size_t OFF_SIN = OFF_COS + (size_t)S_ * 32 * 4;
constexpr size_t OFF_CBIAS = OFF_SIN + (size_t)S_ * 32 * 4;
constexpr size_t OFF_HN = OFF_CBIAS + 4096;
constexpr size_t OFF_KSH = OFF_HN + (size_t)T_ * 1024 * 2;
constexpr size_t OFF_VSHT = OFF_KSH + (size_t)T_ * 128 * 2;
constexpr size_t OFF_HEAD = OFF_VSHT + (size_t)T_ * 128 * 2;
constexpr size_t OFF_HALO = OFF_HEAD + (size_t)256 * 2 * NFF2 * 4;
constexpr size_t OFF_R1 = OFF_HALO + (size_t)256 * 2 * NFF2 * 4;
constexpr size_t OFF_Q = OFF_R1;
constexpr size_t OFF_KC = OFF_Q + (size_t)T_ * 1024 * 2;
constexpr size_t OFF_VC = OFF_KC + (size_t)T_ * 256 * 2;
constexpr size_t OFF_KS = OFF_VC + (size_t)T_ * 256 * 2;
constexpr size_t OFF_VST = OFF_KS + (size_t)T_ * 256 * 2;
constexpr size_t OFF_KW = OFF_VST + (size_t)T_ * 256 * 2;
constexpr size_t OFF_VWT = OFF_KW + (size_t)T_ * 256 * 2;
constexpr size_t OFF_GATES = OFF_VWT + (size_t)T_ * 256 * 2;
constexpr size_t OFF_HID = OFF_GATES + (size_t)T_ * 48 * 4;
constexpr size_t OFF_KCC = OFF_HID + (size_t)2 * 8192 * 256 * 2;
constexpr size_t OFF_VCCT = OFF_KCC + (size_t)8 * 1024 * 64 * 2;
constexpr size_t OFF_O = OFF_VCCT + (size_t)8 * 1024 * 64 * 2;
constexpr size_t OFF_END = OFF_O + (size_t)T_ * 1024 * 2;
constexpr size_t OFF_BAR = OFF_END;
constexpr size_t WS_NEED = OFF_BAR + 32768;
constexpr size_t OFF_ACT = OFF_R1;
static_assert(OFF_ACT + (size_t)T_ * DFF * 2 <= OFF_END, "act alias");

struct Params {
    const float *x, *norm_attn, *norm_ffn, *a_w_in, *a_cmp_pos, *a_cmp_w1, *a_cmp_w2, *a_w_out, *kv_norm, *b_w_kv, *b_w_q, *b_sinks, *b_w_out,
        *ffn_w_in, *ffn_conv_w, *ffn_conv_b, *ffn_w_out, *final_norm;
    float* out;
    unsigned char* ws;
    int desc[48];
    int ph_lo, ph_hi;
};

__device__ __forceinline__ u16 f2bf(float f) {
    unsigned u = __float_as_uint(f);
    u += 0x7fffu + ((u >> 16) & 1u);
    return (u16)(u >> 16);
}
typedef __bf16 bf16x2_t __attribute__((ext_vector_type(2)));
typedef float f32x2_t __attribute__((ext_vector_type(2)));
__device__ __forceinline__ unsigned pack2(float lo, float hi) { f32x2_t v = {lo, hi}; bf16x2_t r = __builtin_convertvector(v, bf16x2_t); return __builtin_bit_cast(unsigned, r); }
typedef unsigned u32x4 __attribute__((ext_vector_type(4)));
__device__ __forceinline__ bf16x8 pack8(const float (&v)[8]) {
    u32x4 r;
    unsigned r0, r1, r2, r3;
    asm("v_cvt_pk_bf16_f32 %0, %4, %5\n\tv_cvt_pk_bf16_f32 %1, %6, %7\n\tv_cvt_pk_bf16_f32 %2, %8, %9\n\tv_cvt_pk_bf16_f32 %3, %10, %11\n\ts_nop 3"
        : "=&v"(r0), "=&v"(r1), "=&v"(r2), "=&v"(r3)
        : "v"(v[0]), "v"(v[1]), "v"(v[2]), "v"(v[3]), "v"(v[4]), "v"(v[5]), "v"(v[6]), "v"(v[7]));
    r[0] = r0; r[1] = r1; r[2] = r2; r[3] = r3;
    return __builtin_bit_cast(bf16x8, r);
}
__device__ __forceinline__ uint2 pack4(f32x4 v) { uint2 r; r.x = pack2(v[0], v[1]); r.y = pack2(v[2], v[3]); return r; }
__device__ __forceinline__ f32x4 unpack4(uint2 v) { return (f32x4){__uint_as_float(v.x << 16), __uint_as_float(v.x & 0xffff0000u), __uint_as_float(v.y << 16), __uint_as_float(v.y & 0xffff0000u)}; }
__device__ __forceinline__ unsigned pk4_fp8(float a, float b, float c, float d) { int r = __builtin_amdgcn_cvt_pk_fp8_f32(a, b, 0, false); r = __builtin_amdgcn_cvt_pk_fp8_f32(c, d, r, true); return (unsigned)r; }
__device__ __forceinline__ long pk8_fp8(const float (&v)[8]) { const unsigned lo = pk4_fp8(v[0], v[1], v[2], v[3]), hi = pk4_fp8(v[4], v[5], v[6], v[7]); return (long)(((unsigned long long)hi << 32) | lo); }
__device__ __forceinline__ f32x4 mfma8(long a, long b, f32x4 c) { return __builtin_amdgcn_mfma_f32_16x16x32_fp8_fp8(a, b, c, 0, 0, 0); }
__device__ __forceinline__ f32x4 mfma16(bf16x8 a, bf16x8 b, f32x4 c) { return __builtin_amdgcn_mfma_f32_16x16x32_bf16(a, b, c, 0, 0, 0); }
__device__ __forceinline__ float fexp2(float x) { return __builtin_amdgcn_exp2f(x); }
__device__ __forceinline__ void wsync() { __builtin_amdgcn_fence(__ATOMIC_ACQ_REL, "wavefront"); asm volatile("s_waitcnt lgkmcnt(0)" ::: "memory"); __builtin_amdgcn_wave_barrier(); }
typedef unsigned u32x2 __attribute__((ext_vector_type(2)));
__device__ __forceinline__ float xmax16(float x) { const unsigned u = __float_as_uint(x); const u32x2 r = __builtin_amdgcn_permlane16_swap(u, u, false, false); return fmaxf(__uint_as_float(r[0]), __uint_as_float(r[1])); }
__device__ __forceinline__ float xmax32(float x) { const unsigned u = __float_as_uint(x); const u32x2 r = __builtin_amdgcn_permlane32_swap(u, u, false, false); return fmaxf(__uint_as_float(r[0]), __uint_as_float(r[1])); }
template <int CTRL> __device__ __forceinline__ float dppf(float x) { return __int_as_float(__builtin_amdgcn_update_dpp(0, __float_as_int(x), CTRL, 0xf, 0xf, true)); }
__device__ __forceinline__ float wave_max(float x) {
    x = fmaxf(x, dppf<0xB1>(x)); x = fmaxf(x, dppf<0x4E>(x)); x = fmaxf(x, dppf<0x141>(x)); x = fmaxf(x, dppf<0x140>(x));
    return xmax32(xmax16(x));
}
__device__ __forceinline__ int kperm(int m) { return ((m >> 2) << 3) + (m & 3); }
__device__ __forceinline__ float sigmoidf_(float x) { return 1.f / (1.f + __expf(-x)); }
__device__ __forceinline__ float gelu_tanh(float x) {
    float u = 0.7978845608028654f * (x + 0.044715f * x * x * x);
    float e = __expf(2.f * u);
    float th = 1.f - 2.f / (e + 1.f);
    return 0.5f * x * (1.f + th);
}

__device__ __forceinline__ void cvt_transpose(const float* __restrict__ src, u16* __restrict__ dst, int K, int N, int Npad, int mode, unsigned char* smem, int tid_, int bid_) {
    const int half = tid_ >> 8, tid = tid_ & 255;
    float* ts = (float*)smem + half * (64 * 65);
    const int ntk = K >> 6, ntn = Npad >> 6, ntiles = ntk * ntn;
    for (int tile2 = bid_ * 2; tile2 < ntiles; tile2 += gridDim.x * 2) {
        const int tile = tile2 + half;
        const bool live = tile < ntiles;
        const int tk = live ? tile % ntk : 0, tn = live ? tile / ntk : 0;
        const int k0 = tk << 6, n0 = tn << 6;
        __syncthreads();
        if (live) {
#pragma unroll
            for (int i = 0; i < 4; ++i) {
                const int k = (tid >> 4) + 16 * i, n = (tid & 15) * 4;
                float4 v = make_float4(0.f, 0.f, 0.f, 0.f);
                if (n0 + n < N) v = *(const float4*)(src + (size_t)(k0 + k) * N + n0 + n);
                ts[k * 65 + n + 0] = v.x; ts[k * 65 + n + 1] = v.y; ts[k * 65 + n + 2] = v.z; ts[k * 65 + n + 3] = v.w;
            }
        }
        __syncthreads();
        if (!live) continue;
        const int n = tid >> 2, kq = (tid & 3) * 16;
        unsigned pk[8];
#pragma unroll
        for (int j = 0; j < 8; ++j) pk[j] = pack2(ts[(kq + 2 * j) * 65 + n], ts[(kq + 2 * j + 1) * 65 + n]);
        int drow;
        if (mode == 0) drow = n0 + n;
        else { const int nn = n0 + n; drow = (nn < DFF) ? ((nn >> 6) * 128 + (nn & 63)) : ((((nn - DFF) >> 6) * 128) + 64 + ((nn - DFF) & 63)); }
        uint4* dp = (uint4*)(dst + (size_t)drow * K + k0 + kq);
        dp[0] = make_uint4(pk[0], pk[1], pk[2], pk[3]);
        dp[1] = make_uint4(pk[4], pk[5], pk[6], pk[7]);
    }
}

__device__ __forceinline__ void prep_phase(const Params& p, unsigned char* smem, int tid_, int bid_) {
    unsigned char* ws = p.ws;
    for (int L = 0; L < 2; ++L) {
        cvt_transpose(p.a_w_in + (size_t)L * 1024 * 2608, (u16*)(ws + OFF_WT_AIN + L * SZ_WT_AIN), 1024, 2608, 2688, 0, smem, tid_, bid_);
        for (int kv = 0; kv < 2; ++kv) {
            cvt_transpose(p.a_cmp_w1 + (size_t)(L * 2 + kv) * 2048 * 256, (u16*)(ws + OFF_WT_CW1 + (L * 2 + kv) * SZ_WT_CW1), 2048, 256, 256, 0, smem, tid_, bid_);
            cvt_transpose(p.a_cmp_w2 + (size_t)(L * 2 + kv) * 256 * 64, (u16*)(ws + OFF_WT_CW2 + (L * 2 + kv) * SZ_WT_CW2), 256, 64, 64, 0, smem, tid_, bid_);
        }
        cvt_transpose(p.a_w_out + (size_t)L * 1024 * 1024, (u16*)(ws + OFF_WT_AOUT + L * SZ_WT_SQ), 1024, 1024, 1024, 0, smem, tid_, bid_);
        cvt_transpose(p.b_w_q + (size_t)L * 1024 * 1024, (u16*)(ws + OFF_WT_BQ + L * SZ_WT_SQ), 1024, 1024, 1024, 0, smem, tid_, bid_);
        cvt_transpose(p.b_w_out + (size_t)L * 1024 * 1024, (u16*)(ws + OFF_WT_BOUT + L * SZ_WT_SQ), 1024, 1024, 1024, 0, smem, tid_, bid_);
    }
    cvt_transpose(p.b_w_kv, (u16*)(ws + OFF_WT_KV), 1024, 256, 256, 0, smem, tid_, bid_);
    for (int L = 0; L < 4; ++L) {
        cvt_transpose(p.ffn_w_in + (size_t)L * 1024 * NFF2, (u16*)(ws + OFF_WT_FIN + L * SZ_WT_FIN), 1024, NFF2, NFF2, 1, smem, tid_, bid_);
        cvt_transpose(p.ffn_w_out + (size_t)L * DFF * 1024, (u16*)(ws + OFF_WT_FOUT + L * SZ_WT_FOUT), DFF, 1024, 1024, 0, smem, tid_, bid_);
    }
    {
        float* cosT = (float*)(ws + OFF_COS); float* sinT = (float*)(ws + OFF_SIN);
        const int gt = bid_ * NTHR + tid_, nt = gridDim.x * NTHR;
        for (int idx = gt; idx < S_ * 32; idx += nt) {
            const int pos = idx >> 5, i = idx & 31;
            const float ang = (float)pos * exp2f(-(float)i * (13.287712379549449f / 32.0f));
            double rev = (double)ang * 0.15915494309189535;
            rev -= rint(rev);
            const float fr = (float)rev;
            cosT[idx] = __builtin_amdgcn_cosf(fr);
            sinT[idx] = __builtin_amdgcn_sinf(fr);
        }
    }
    {
        float* cb = (float*)(ws + OFF_CBIAS);
        const int lane = tid_ & 63, w = tid_ >> 6;
        for (int task = bid_ * NW + w; task < 256; task += gridDim.x * NW) {
            const int lk = task >> 6, j4 = (task & 63) * 4;
            const float* pos = p.a_cmp_pos + (size_t)lk * 2048;
            const float* w1 = p.a_cmp_w1 + (size_t)lk * 2048 * 256;
            float4 a = make_float4(0.f, 0.f, 0.f, 0.f);
            for (int i = 0; i < 32; ++i) {
                const int k = lane + 64 * i;
                const float pv = pos[k];
                const float4 wv = *(const float4*)(w1 + (size_t)k * 256 + j4);
                a.x += pv * wv.x; a.y += pv * wv.y; a.z += pv * wv.z; a.w += pv * wv.w;
            }
#pragma unroll
            for (int off = 32; off >= 1; off >>= 1) {
                a.x += __shfl_xor(a.x, off); a.y += __shfl_xor(a.y, off); a.z += __shfl_xor(a.z, off); a.w += __shfl_xor(a.w, off);
            }
            if (lane == 0) *(float4*)(cb + lk * 256 + j4) = a;
        }
    }
}

template <bool OUT_F32>
__device__ __forceinline__ void norm_phase(const float* __restrict__ src, const float* __restrict__ g, u16* __restrict__ dst, float* __restrict__ dstf, int tid_, int bid_) {
    const int lane = tid_ & 63, w = tid_ >> 6;
    float4 gv[4];
#pragma unroll
    for (int i = 0; i < 4; ++i) gv[i] = *(const float4*)(g + lane * 4 + 256 * i);
    for (int row = bid_ * NW + w; row < T_; row += gridDim.x * NW) {
        const float* sp = src + (size_t)row * 1024;
        float4 v[4];
        float ss = 0.f;
#pragma unroll
        for (int i = 0; i < 4; ++i) { v[i] = *(const float4*)(sp + lane * 4 + 256 * i); ss += v[i].x * v[i].x + v[i].y * v[i].y + v[i].z * v[i].z + v[i].w * v[i].w; }
#pragma unroll
        for (int off = 32; off >= 1; off >>= 1) ss += __shfl_xor(ss, off);
        const float r = rsqrtf(ss * (1.f / 1024.f) + 1e-6f);
#pragma unroll
        for (int i = 0; i < 4; ++i) {
            f32x4 o = {v[i].x * r * gv[i].x, v[i].y * r * gv[i].y, v[i].z * r * gv[i].z, v[i].w * r * gv[i].w};
            if (OUT_F32) *(float4*)(dstf + (size_t)row * 1024 + lane * 4 + 256 * i) = make_float4(o[0], o[1], o[2], o[3]);
            else *(uint2*)(dst + (size_t)row * 1024 + lane * 4 + 256 * i) = pack4(o);
        }
    }
}

enum { AM_PLAIN = 0, AM_GATHER = 1 };
enum { EPI_AIN = 0, EPI_CMP1 = 1, EPI_RESID = 2, EPI_FFNIN = 3, EPI_BQ = 4, EPI_BKV = 5 };

struct EpiArgs {
    const float* resid; float* out;
    const float* bias; u16* hid;
    const float *convw, *convb;
    unsigned char* ws;
};

template <int NM>
__device__ __forceinline__ void rope_store(const f32x4 (&acc)[4][NM], int mi, u16* dstrow  , const float* cosT, const float* sinT, int pos, int q4) {
#pragma unroll
    for (int ni = 0; ni < 2; ++ni) {
        const int d = ni * 16 + q4 * 4;
        const float4 c = *(const float4*)(cosT + pos * 32 + d), s = *(const float4*)(sinT + pos * 32 + d);
        const f32x4 x1 = acc[ni][mi], x2 = acc[ni + 2][mi];
        f32x4 o1 = {x1[0] * c.x - x2[0] * s.x, x1[1] * c.y - x2[1] * s.y, x1[2] * c.z - x2[2] * s.z, x1[3] * c.w - x2[3] * s.w};
        f32x4 o2 = {x2[0] * c.x + x1[0] * s.x, x2[1] * c.y + x1[1] * s.y, x2[2] * c.z + x1[2] * s.z, x2[3] * c.w + x1[3] * s.w};
        *(uint2*)(dstrow + d) = pack4(o1);
        *(uint2*)(dstrow + d + 32) = pack4(o2);
    }
}

template <int AMODE, int EPI>
__device__ __forceinline__ void gemm_phase(const u16* __restrict__ A, int lda, const u16* __restrict__ Bt, int M, int Npad, int K, int vboff, const EpiArgs& e, unsigned char* smem, int tid_, int bid_) {
    const int tid = tid_, lane = tid & 63, w = tid >> 6, wm = w & 3, wn = w >> 2;
    const int c16 = lane & 15, q4 = lane >> 4;
    const int ntm = (M + 255) >> 8, ntn = Npad >> 7, nk = K >> 6;
    const int kstride = (AMODE == AM_GATHER) ? 256 : 64;
    const int ldc = tid & 7, ldr = tid >> 3;
    const unsigned wofs = ldr * 128 + ((ldc ^ ((ldr >> 1) & 7)) << 4);
    const int swz = (c16 >> 1) & 7;
    const float* cosT = (const float*)(e.ws + OFF_COS);
    const float* sinT = (const float*)(e.ws + OFF_SIN);
    int vb = bid_ + vboff; if (vb >= (int)gridDim.x) vb -= gridDim.x;
    const int xcd = vb & 7, loc = vb >> 3, nloc = gridDim.x >> 3;
    const int mpx = ntm >> 3, nfull = (ntn >> 3), bwl = ntn - (nfull << 3);
    const int tfull = nfull * mpx * 8, ttotal = mpx * ntn;
    for (int tl = loc; tl < ttotal; tl += nloc) {
        int mloc, nt;
        if (tl < tfull) { const int band = tl / (mpx * 8), r = tl - band * (mpx * 8); mloc = r >> 3; nt = band * 8 + (r & 7); }
        else { const int r = tl - tfull; mloc = r / bwl; nt = (nfull << 3) + (r - mloc * bwl); }
        const int mt = xcd * mpx + mloc;
        const int m0 = mt << 8, n0 = nt << 7;
        unsigned aoff[4];
#pragma unroll
        for (int i = 0; i < 4; ++i) {
            int m = m0 + ldr + 64 * i; if (m > M - 1) m = M - 1;
            if (AMODE == AM_GATHER) { const int g = m & 3, bn = m >> 2, b = bn / 1023, n = bn - b * 1023; aoff[i] = (unsigned)((b * S_ + n * 16) * 256 + g * 64 + ldc * 8); }
            else aoff[i] = (unsigned)m * (unsigned)lda + ldc * 8;
        }
        const u16* bp = Bt + (size_t)(n0 + ldr) * K + ldc * 8;
        u32x4 ra0[4], rb0[2], ra1[4], rb1[2];
        f32x4 acc[4][4];
#pragma unroll
        for (int a = 0; a < 4; ++a)
#pragma unroll
            for (int b = 0; b < 4; ++b) acc[a][b] = (f32x4){0.f, 0.f, 0.f, 0.f};
        auto g_load = [&](u32x4 (&RA)[4], u32x4 (&RB)[2], int KT) __attribute__((always_inline)) {
#pragma unroll
            for (int i = 0; i < 4; ++i) RA[i] = *(const u32x4*)(A + aoff[i] + KT * kstride);
#pragma unroll
            for (int i = 0; i < 2; ++i) RB[i] = *(const u32x4*)(bp + (size_t)i * 64 * K + KT * 64);
        };
        auto g_store = [&](const u32x4 (&RA)[4], const u32x4 (&RB)[2], int ST) __attribute__((always_inline)) {
            unsigned char* d_ = smem + ST * 49152;
#pragma unroll
            for (int i = 0; i < 4; ++i) *(u32x4*)(d_ + wofs + i * 8192) = RA[i];
#pragma unroll
            for (int i = 0; i < 2; ++i) *(u32x4*)(d_ + 32768 + wofs + i * 8192) = RB[i];
        };
        auto g_compute = [&](int ST) __attribute__((always_inline)) {
            const unsigned char* sA = smem + ST * 49152;
            const unsigned char* sB = sA + 32768;
#pragma unroll
            for (int ks = 0; ks < 2; ++ks) {
                bf16x8 wf[4], af[4];
                const int ch = ((ks * 4 + q4) ^ swz) << 4;
#pragma unroll
                for (int ni = 0; ni < 4; ++ni) wf[ni] = *(const bf16x8*)(sB + (wn * 64 + ni * 16 + c16) * 128 + ch);
#pragma unroll
                for (int mi = 0; mi < 4; ++mi) af[mi] = *(const bf16x8*)(sA + (wm * 64 + mi * 16 + c16) * 128 + ch);
#pragma unroll
                for (int ni = 0; ni < 4; ++ni)
#pragma unroll
                    for (int mi = 0; mi < 4; ++mi) acc[ni][mi] = mfma16(wf[ni], af[mi], acc[ni][mi]);
            }
        };
        g_load(ra0, rb0, 0);
        g_load(ra1, rb1, 1);
        g_store(ra0, rb0, 0);
        __syncthreads();
        for (int kt = 0; kt < nk; kt += 2) {
            if (kt + 2 < nk) g_load(ra0, rb0, kt + 2);
            g_compute(0);
            g_store(ra1, rb1, 1);
            __syncthreads();
            if (kt + 3 < nk) g_load(ra1, rb1, kt + 3);
            g_compute(1);
            if (kt + 2 < nk) g_store(ra0, rb0, 0);
            __syncthreads();
        }
        const int nb = n0 + wn * 64;
        if (EPI == EPI_RESID) {
#pragma unroll
            for (int mi = 0; mi < 4; ++mi) {
                const size_t tok = m0 + wm * 64 + mi * 16 + c16;
#pragma unroll
                for (int ni = 0; ni < 4; ++ni) {
                    const int n = nb + ni * 16 + q4 * 4;
                    float4 r = *(const float4*)(e.resid + tok * 1024 + n);
                    r.x += acc[ni][mi][0]; r.y += acc[ni][mi][1]; r.z += acc[ni][mi][2]; r.w += acc[ni][mi][3];
                    *(float4*)(e.out + tok * 1024 + n) = r;
                }
            }
        } else if (EPI == EPI_CMP1) {
#pragma unroll
            for (int mi = 0; mi < 4; ++mi) {
                const int m = m0 + wm * 64 + mi * 16 + c16;
                if (m < M) {
#pragma unroll
                    for (int ni = 0; ni < 4; ++ni) {
                        const int n = nb + ni * 16 + q4 * 4;
                        const float4 bv = *(const float4*)(e.bias + n);
                        f32x4 o = {gelu_tanh(acc[ni][mi][0] + bv.x), gelu_tanh(acc[ni][mi][1] + bv.y), gelu_tanh(acc[ni][mi][2] + bv.z), gelu_tanh(acc[ni][mi][3] + bv.w)};
                        *(uint2*)(e.hid + (size_t)m * 256 + n) = pack4(o);
                    }
                }
            }
        } else if (EPI == EPI_BQ) {
            u16* Q = (u16*)(e.ws + OFF_Q);
#pragma unroll
            for (int mi = 0; mi < 4; ++mi) {
                const int tok = m0 + wm * 64 + mi * 16 + c16;
                rope_store(acc, mi, Q + (size_t)tok * 1024 + nb, cosT, sinT, tok & (S_ - 1), q4);
            }
        } else if (EPI == EPI_BKV) {
            u16* KSH = (u16*)(e.ws + OFF_KSH); u16* VSHT = (u16*)(e.ws + OFF_VSHT);
#pragma unroll
            for (int mi = 0; mi < 4; ++mi) {
                const int tok = m0 + wm * 64 + mi * 16 + c16, b = tok >> 14, s = tok & (S_ - 1);
                if (nb < 128) {
                    const int g = nb >> 6;
                    rope_store(acc, mi, KSH + ((size_t)(b * 2 + g) * S_ + s) * 64, cosT, sinT, s, q4);
                } else {
                    const int g = (nb - 128) >> 6;
#pragma unroll
                    for (int ni = 0; ni < 4; ++ni)
#pragma unroll
                        for (int i = 0; i < 4; ++i) VSHT[((size_t)(b * 2 + g) * 64 + ni * 16 + q4 * 4 + i) * S_ + s] = f2bf(acc[ni][mi][i]);
                }
            }
        } else if (EPI == EPI_AIN) {
            unsigned char* ws = e.ws;
#pragma unroll
            for (int mi = 0; mi < 4; ++mi) {
                const int tok = m0 + wm * 64 + mi * 16 + c16, b = tok >> 14, s = tok & (S_ - 1);
                if (nb < 1024) {
                    rope_store(acc, mi, (u16*)(ws + OFF_Q) + (size_t)tok * 1024 + nb, cosT, sinT, s, q4);
                } else if (nb < 1536) {
                    u16* dst = (nb < 1280) ? ((u16*)(ws + OFF_KC) + (size_t)tok * 256 + (nb - 1024)) : ((u16*)(ws + OFF_VC) + (size_t)tok * 256 + (nb - 1280));
#pragma unroll
                    for (int ni = 0; ni < 4; ++ni) *(uint2*)(dst + ni * 16 + q4 * 4) = pack4(acc[ni][mi]);
                } else if (nb < 2560) {
                    const int r = (nb - 1536) >> 8;
                    const int g = ((nb - 1536) & 255) >> 6;
                    if (r == 0) {
                        unsigned char* kd = (unsigned char*)(ws + OFF_KS) + (size_t)(b * 4 + g) * S_ * 128 + (size_t)s * 64;
#pragma unroll
                        for (int ni = 0; ni < 2; ++ni) {
                            const int d = ni * 16 + q4 * 4;
                            const float4 c = *(const float4*)(cosT + s * 32 + d), sn = *(const float4*)(sinT + s * 32 + d);
                            const f32x4 x1 = acc[ni][mi], x2 = acc[ni + 2][mi];
                            *(unsigned*)(kd + d) = pk4_fp8(x1[0] * c.x - x2[0] * sn.x, x1[1] * c.y - x2[1] * sn.y, x1[2] * c.z - x2[2] * sn.z, x1[3] * c.w - x2[3] * sn.w);
                            *(unsigned*)(kd + d + 32) = pk4_fp8(x2[0] * c.x + x1[0] * sn.x, x2[1] * c.y + x1[1] * sn.y, x2[2] * c.z + x1[2] * sn.z, x2[3] * c.w + x1[3] * sn.w);
                        }
                    } else if (r == 2) {
                        u16* base = (u16*)(ws + OFF_KW);
                        rope_store(acc, mi, base + ((size_t)(b * 4 + g) * S_ + s) * 64, cosT, sinT, s, q4);
                    } else {
                        if (r == 1) {
                            unsigned char* base = (unsigned char*)(ws + OFF_VST) + (size_t)(b * 4 + g) * 128 * S_ + (size_t)(s >> 6) * 4096 + (s & 63);
#pragma unroll
                            for (int ni = 0; ni < 4; ++ni) {
                                const unsigned pk = pk4_fp8(acc[ni][mi][0], acc[ni][mi][1], acc[ni][mi][2], acc[ni][mi][3]);
#pragma unroll
                                for (int i = 0; i < 4; ++i) base[(ni * 16 + q4 * 4 + i) * 64] = (unsigned char)(pk >> (8 * i));
                            }
                        } else {
                            u16* base = (u16*)(ws + OFF_VWT);
#pragma unroll
                            for (int ni = 0; ni < 4; ++ni)
#pragma unroll
                                for (int i = 0; i < 4; ++i) base[((size_t)(b * 4 + g) * 64 + ni * 16 + q4 * 4 + i) * S_ + s] = f2bf(acc[ni][mi][i]);
                        }
                    }
                } else if (nb == 2560) {
                    float* G = (float*)(ws + OFF_GATES) + (size_t)tok * 48;
#pragma unroll
                    for (int ni = 0; ni < 3; ++ni) {
                        const int n = ni * 16 + q4 * 4;
                        *(float4*)(G + n) = make_float4(sigmoidf_(acc[ni][mi][0]), sigmoidf_(acc[ni][mi][1]), sigmoidf_(acc[ni][mi][2]), sigmoidf_(acc[ni][mi][3]));
                    }
                }
            }
        } else if (EPI == EPI_FFNIN) {
            float* U = (float*)smem;
#pragma unroll
            for (int mi = 0; mi < 4; ++mi) {
                const int row = wm * 64 + mi * 16 + c16;
#pragma unroll
                for (int ni = 0; ni < 4; ++ni) {
                    const int chunk = wn * 16 + ni * 4 + q4;
                    *(f32x4*)(U + row * 128 + ((chunk ^ (row & 31)) << 2)) = acc[ni][mi];
                }
            }
            __syncthreads();
            {
                const int ca = tid & 15, seg = tid >> 4;
                const int ncol = nt * 64 + ca * 4;
                const float4 w0a = *(const float4*)(e.convw + ncol), w1a = *(const float4*)(e.convw + NFF2 + ncol), w2a = *(const float4*)(e.convw + 2 * NFF2 + ncol);
                const float4 w0g = *(const float4*)(e.convw + DFF + ncol), w1g = *(const float4*)(e.convw + NFF2 + DFF + ncol), w2g = *(const float4*)(e.convw + 2 * NFF2 + DFF + ncol);
                const float4 ba = *(const float4*)(e.convb + ncol), bg = *(const float4*)(e.convb + DFF + ncol);
                float* head = (float*)(e.ws + OFF_HEAD); float* halo = (float*)(e.ws + OFF_HALO);
                u16* act = (u16*)(e.ws + OFF_ACT);
                const int r0 = seg * 8;
                float4 a2 = make_float4(0.f, 0.f, 0.f, 0.f), a1 = a2, g2 = a2, g1 = a2;
                if (seg > 0) {
                    const int rA = r0 - 2, rB = r0 - 1;
                    a2 = *(const float4*)(U + rA * 128 + ((ca ^ (rA & 31)) << 2)); g2 = *(const float4*)(U + rA * 128 + (((16 + ca) ^ (rA & 31)) << 2));
                    a1 = *(const float4*)(U + rB * 128 + ((ca ^ (rB & 31)) << 2)); g1 = *(const float4*)(U + rB * 128 + (((16 + ca) ^ (rB & 31)) << 2));
                }
#pragma unroll
                for (int r = 0; r < 8; ++r) {
                    const int row = r0 + r;
                    const float4 ua = *(const float4*)(U + row * 128 + ((ca ^ (row & 31)) << 2));
                    const float4 ug = *(const float4*)(U + row * 128 + (((16 + ca) ^ (row & 31)) << 2));
                    if (seg > 0 || r >= 2) {
                        float ca_[4], cg_[4];
                        ca_[0] = ba.x + w0a.x * a2.x + w1a.x * a1.x + w2a.x * ua.x; ca_[1] = ba.y + w0a.y * a2.y + w1a.y * a1.y + w2a.y * ua.y;
                        ca_[2] = ba.z + w0a.z * a2.z + w1a.z * a1.z + w2a.z * ua.z; ca_[3] = ba.w + w0a.w * a2.w + w1a.w * a1.w + w2a.w * ua.w;
                        cg_[0] = bg.x + w0g.x * g2.x + w1g.x * g1.x + w2g.x * ug.x; cg_[1] = bg.y + w0g.y * g2.y + w1g.y * g1.y + w2g.y * ug.y;
                        cg_[2] = bg.z + w0g.z * g2.z + w1g.z * g1.z + w2g.z * ug.z; cg_[3] = bg.w + w0g.w * g2.w + w1g.w * g1.w + w2g.w * ug.w;
                        f32x4 o = {ca_[0] * sigmoidf_(ca_[0]) * cg_[0], ca_[1] * sigmoidf_(ca_[1]) * cg_[1], ca_[2] * sigmoidf_(ca_[2]) * cg_[2], ca_[3] * sigmoidf_(ca_[3]) * cg_[3]};
                        *(uint2*)(act + (size_t)(m0 + row) * DFF + ncol) = pack4(o);
                    }
                    if (seg == 0 && r < 2) { *(float4*)(head + (size_t)(mt * 2 + r) * NFF2 + ncol) = ua; *(float4*)(head + (size_t)(mt * 2 + r) * NFF2 + DFF + ncol) = ug; }
                    if (seg == 31 && r >= 6) { *(float4*)(halo + (size_t)(mt * 2 + r - 6) * NFF2 + ncol) = ua; *(float4*)(halo + (size_t)(mt * 2 + r - 6) * NFF2 + DFF + ncol) = ug; }
                    a2 = a1; a1 = ua; g2 = g1; g1 = ug;
                }
            }
            __syncthreads();
        }
    }
}

template <int AMODE, int EPI>
__device__ __forceinline__ void gemm_big(const u16* __restrict__ A, int lda, const u16* __restrict__ Bt, int M, int Npad, int K, int vboff, const EpiArgs& e, unsigned char* smem, int tid_, int bid_) {
    const int tid = tid_, lane = tid & 63, w = tid >> 6, wm = w & 1, wn = w >> 1;
    const int c16 = lane & 15, q4 = lane >> 4;
    constexpr int MI = 8;
    const int ntm = (M + 255) >> 8, ntn = Npad >> 8, nk = K >> 5;
    const int kstride = (AMODE == AM_GATHER) ? 128 : 32;
    const float* cosT = (const float*)(e.ws + OFF_COS);
    const float* sinT = (const float*)(e.ws + OFF_SIN);
    int vb = bid_ + vboff; if (vb >= (int)gridDim.x) vb -= gridDim.x;
    const int xcd = vb & 7, loc = vb >> 3, nloc = gridDim.x >> 3;
    const int mpx = ntm >> 3, nfull = (ntn >> 3), bwl = ntn - (nfull << 3);
    const int tfull = nfull * mpx * 8, ttotal = mpx * ntn;
    for (int tl = loc; tl < ttotal; tl += nloc) {
        int mloc, nt;
        if (tl < tfull) { const int band = tl / (mpx * 8), r = tl - band * (mpx * 8); mloc = r >> 3; nt = band * 8 + (r & 7); }
        else { const int r = tl - tfull; mloc = r / bwl; nt = (nfull << 3) + (r - mloc * bwl); }
        const int mt = xcd * mpx + mloc;
        const int m0 = mt << 8, n0 = nt << 8;
        const int prow = ((w & 3) << 6) + (lane >> 3);
        const int pch = lane & 7;
        unsigned goff[8];
#pragma unroll
        for (int i = 0; i < 8; ++i) {
            const int row = prow + 8 * i;
            const int lc = pch ^ ((row >> 1) & 7);
            if (w < 4) {
                int m = m0 + row; if (m > M - 1) m = M - 1;
                if (AMODE == AM_GATHER) { const int gq = m & 3, bn = m >> 2, bb = bn / 1023, n = bn - bb * 1023; goff[i] = (unsigned)((bb * S_ + n * 16) * 256 + gq * 64 + lc * 8); }
                else goff[i] = (unsigned)m * (unsigned)lda + (unsigned)(lc * 8);
            } else goff[i] = (unsigned)(n0 + row) * (unsigned)K + (unsigned)(lc * 8);
        }
        const u16* gbase = (w < 4) ? A : Bt;
        const unsigned kst = (w < 4 && AMODE == AM_GATHER) ? 256u : 64u;
        typedef __attribute__((address_space(3))) unsigned* lds_u32p;
        const unsigned lbase = ((w < 4) ? 0u : 32768u) + (unsigned)(((w & 3) << 6) * 128) + (unsigned)lane * 16u;
        f32x4 acc[4][MI];
#pragma unroll
        for (int a2 = 0; a2 < 4; ++a2)
#pragma unroll
            for (int b2 = 0; b2 < MI; ++b2) acc[a2][b2] = (f32x4){0.f, 0.f, 0.f, 0.f};
        const int swz = (c16 >> 1) & 7;
        const int nk2 = nk >> 1;
#pragma unroll
        for (int i = 0; i < 8; ++i) __builtin_amdgcn_global_load_lds((const unsigned*)(gbase + goff[i]), (lds_u32p)(smem + lbase + i * 1024), 16, 0, 0);
        for (int kt = 0; kt < nk2; ++kt) {
            asm volatile("s_waitcnt vmcnt(0)" ::: "memory");
            __builtin_amdgcn_s_barrier();
            const unsigned char* sA = smem + (kt & 1) * 65536;
            const unsigned char* sB = sA + 32768;
            const bool more = kt + 1 < nk2;
            const unsigned ko = (unsigned)(kt + 1) * kst;
            unsigned char* sbn = smem + ((kt + 1) & 1) * 65536 + lbase;
#pragma unroll
            for (int ks = 0; ks < 2; ++ks) {
                bf16x8 wf[4], af[MI];
                const int ch = ((ks * 4 + q4) ^ swz) << 4;
#pragma unroll
                for (int ni = 0; ni < 4; ++ni) wf[ni] = *(const bf16x8*)(sB + (wn * 64 + ni * 16 + c16) * 128 + ch);
#pragma unroll
                for (int mi = 0; mi < MI; ++mi) af[mi] = *(const bf16x8*)(sA + (wm * 128 + mi * 16 + c16) * 128 + ch);
#pragma unroll
                for (int ni = 0; ni < 4; ++ni) {
                    if (more) __builtin_amdgcn_global_load_lds((const unsigned*)(gbase + (goff[ks * 4 + ni] + ko)), (lds_u32p)(sbn + (ks * 4 + ni) * 1024), 16, 0, 0);
#pragma unroll
                    for (int mi = 0; mi < MI; ++mi) acc[ni][mi] = mfma16(wf[ni], af[mi], acc[ni][mi]);
                }
            }
        }
        __syncthreads();
        const int nb = n0 + wn * 64;
        if (EPI == EPI_RESID) {
#pragma unroll
            for (int mi = 0; mi < MI; ++mi) { __builtin_amdgcn_sched_barrier(0);
                const size_t tok = m0 + wm * 128 + mi * 16 + c16;
#pragma unroll
                for (int ni = 0; ni < 4; ++ni) {
                    const int n = nb + ni * 16 + q4 * 4;
                    float4 r = *(const float4*)(e.resid + tok * 1024 + n);
                    r.x += acc[ni][mi][0]; r.y += acc[ni][mi][1]; r.z += acc[ni][mi][2]; r.w += acc[ni][mi][3];
                    *(float4*)(e.out + tok * 1024 + n) = r;
                }
            }
        } else if (EPI == EPI_CMP1) {
#pragma unroll
            for (int mi = 0; mi < MI; ++mi) { __builtin_amdgcn_sched_barrier(0);
                const int m = m0 + wm * 128 + mi * 16 + c16;
                if (m < M) {
#pragma unroll
                    for (int ni = 0; ni < 4; ++ni) {
                        const int n = nb + ni * 16 + q4 * 4;
                        const float4 bv = *(const float4*)(e.bias + n);
                        f32x4 o = {gelu_tanh(acc[ni][mi][0] + bv.x), gelu_tanh(acc[ni][mi][1] + bv.y), gelu_tanh(acc[ni][mi][2] + bv.z), gelu_tanh(acc[ni][mi][3] + bv.w)};
                        *(uint2*)(e.hid + (size_t)m * 256 + n) = pack4(o);
                    }
                }
            }
        } else if (EPI == EPI_BQ) {
            u16* Q = (u16*)(e.ws + OFF_Q);
#pragma unroll
            for (int mi = 0; mi < MI; ++mi) { __builtin_amdgcn_sched_barrier(0);
                const int tok = m0 + wm * 128 + mi * 16 + c16;
                rope_store(acc, mi, Q + (size_t)tok * 1024 + nb, cosT, sinT, tok & (S_ - 1), q4);
            }
        } else if (EPI == EPI_BKV) {
            u16* KSH = (u16*)(e.ws + OFF_KSH); u16* VSHT = (u16*)(e.ws + OFF_VSHT);
#pragma unroll
            for (int mi = 0; mi < MI; ++mi) { __builtin_amdgcn_sched_barrier(0);
                const int tok = m0 + wm * 128 + mi * 16 + c16, b = tok >> 14, s = tok & (S_ - 1);
                if (nb < 128) {
                    const int g = nb >> 6;
                    rope_store(acc, mi, KSH + ((size_t)(b * 2 + g) * S_ + s) * 64, cosT, sinT, s, q4);
                } else {
                    const int g = (nb - 128) >> 6;
#pragma unroll
                    for (int ni = 0; ni < 4; ++ni)
#pragma unroll
                        for (int i = 0; i < 4; ++i) VSHT[((size_t)(b * 2 + g) * 64 + ni * 16 + q4 * 4 + i) * S_ + s] = f2bf(acc[ni][mi][i]);
                }
            }
        } else if (EPI == EPI_AIN) {
            unsigned char* ws = e.ws;
#pragma unroll
            for (int mi = 0; mi < MI; ++mi) { __builtin_amdgcn_sched_barrier(0);
                const int tok = m0 + wm * 128 + mi * 16 + c16, b = tok >> 14, s = tok & (S_ - 1);
                if (nb < 1024) {
                    rope_store(acc, mi, (u16*)(ws + OFF_Q) + (size_t)tok * 1024 + nb, cosT, sinT, s, q4);
                } else if (nb < 1536) {
                    u16* dst = (nb < 1280) ? ((u16*)(ws + OFF_KC) + (size_t)tok * 256 + (nb - 1024)) : ((u16*)(ws + OFF_VC) + (size_t)tok * 256 + (nb - 1280));
#pragma unroll
                    for (int ni = 0; ni < 4; ++ni) *(uint2*)(dst + ni * 16 + q4 * 4) = pack4(acc[ni][mi]);
                } else if (nb < 2560) {
                    const int r = (nb - 1536) >> 8;
                    const int g = ((nb - 1536) & 255) >> 6;
                    if (r == 0) {
                        unsigned char* kd = (unsigned char*)(ws + OFF_KS) + (size_t)(b * 4 + g) * S_ * 128 + (size_t)s * 64;
#pragma unroll
                        for (int ni = 0; ni < 2; ++ni) {
                            const int d = ni * 16 + q4 * 4;
                            const float4 c = *(const float4*)(cosT + s * 32 + d), sn = *(const float4*)(sinT + s * 32 + d);
                            const f32x4 x1 = acc[ni][mi], x2 = acc[ni + 2][mi];
                            *(unsigned*)(kd + d) = pk4_fp8(x1[0] * c.x - x2[0] * sn.x, x1[1] * c.y - x2[1] * sn.y, x1[2] * c.z - x2[2] * sn.z, x1[3] * c.w - x2[3] * sn.w);
                            *(unsigned*)(kd + d + 32) = pk4_fp8(x2[0] * c.x + x1[0] * sn.x, x2[1] * c.y + x1[1] * sn.y, x2[2] * c.z + x1[2] * sn.z, x2[3] * c.w + x1[3] * sn.w);
                        }
                    } else if (r == 2) {
                        u16* base = (u16*)(ws + OFF_KW);
                        rope_store(acc, mi, base + ((size_t)(b * 4 + g) * S_ + s) * 64, cosT, sinT, s, q4);
                    } else {
                        if (r == 1) {
                            unsigned char* base = (unsigned char*)(ws + OFF_VST) + (size_t)(b * 4 + g) * 128 * S_ + (size_t)(s >> 6) * 4096 + (s & 63);
#pragma unroll
                            for (int ni = 0; ni < 4; ++ni) {
                                const unsigned pk = pk4_fp8(acc[ni][mi][0], acc[ni][mi][1], acc[ni][mi][2], acc[ni][mi][3]);
#pragma unroll
                                for (int i = 0; i < 4; ++i) base[(ni * 16 + q4 * 4 + i) * 64] = (unsigned char)(pk >> (8 * i));
                            }
                        } else {
                            u16* base = (u16*)(ws + OFF_VWT);
#pragma unroll
                            for (int ni = 0; ni < 4; ++ni)
#pragma unroll
                                for (int i = 0; i < 4; ++i) base[((size_t)(b * 4 + g) * 64 + ni * 16 + q4 * 4 + i) * S_ + s] = f2bf(acc[ni][mi][i]);
                        }
                    }
                } else if (nb == 2560) {
                    float* G = (float*)(ws + OFF_GATES) + (size_t)tok * 48;
#pragma unroll
                    for (int ni = 0; ni < 3; ++ni) {
                        const int n = ni * 16 + q4 * 4;
                        *(float4*)(G + n) = make_float4(sigmoidf_(acc[ni][mi][0]), sigmoidf_(acc[ni][mi][1]), sigmoidf_(acc[ni][mi][2]), sigmoidf_(acc[ni][mi][3]));
                    }
                }
            }
        } else if (EPI == EPI_FFNIN) {
            u16* U = (u16*)smem;
#pragma unroll
            for (int mi = 0; mi < MI; ++mi) {
                const int row = wm * 128 + mi * 16 + c16;
#pragma unroll
                for (int ni = 0; ni < 4; ++ni) {
                    const int cch = wn * 16 + ni * 4 + q4;
                    *(uint2*)(U + row * 256 + ((cch ^ (row & 15)) << 2)) = pack4(acc[ni][mi]);
                }
            }
            __syncthreads();
            {
                const int cc = tid & 31, gsel = cc >> 4, ca = cc & 15, seg = tid >> 5;
                const int ncol = (nt * 2 + gsel) * 64 + ca * 4;
                const int cha = gsel * 32 + ca, chg = cha + 16;
                const float4 w0a = *(const float4*)(e.convw + ncol), w1a = *(const float4*)(e.convw + NFF2 + ncol), w2a = *(const float4*)(e.convw + 2 * NFF2 + ncol);
                const float4 w0g = *(const float4*)(e.convw + DFF + ncol), w1g = *(const float4*)(e.convw + NFF2 + DFF + ncol), w2g = *(const float4*)(e.convw + 2 * NFF2 + DFF + ncol);
                const float4 ba = *(const float4*)(e.convb + ncol), bg = *(const float4*)(e.convb + DFF + ncol);
                float* head = (float*)(e.ws + OFF_HEAD); float* halo = (float*)(e.ws + OFF_HALO);
                u16* act = (u16*)(e.ws + OFF_ACT);
                auto ldu = [&](int row, int ch) __attribute__((always_inline)) -> float4 {
                    const uint2 v = *(const uint2*)(U + row * 256 + ((ch ^ (row & 15)) << 2));
                    return make_float4(__uint_as_float(v.x << 16), __uint_as_float(v.x & 0xffff0000u), __uint_as_float(v.y << 16), __uint_as_float(v.y & 0xffff0000u));
                };
                const int r0 = seg * 16;
                float4 a2 = make_float4(0.f, 0.f, 0.f, 0.f), a1 = a2, g2 = a2, g1 = a2;
                if (seg > 0) { a2 = ldu(r0 - 2, cha); g2 = ldu(r0 - 2, chg); a1 = ldu(r0 - 1, cha); g1 = ldu(r0 - 1, chg); }
#pragma unroll 2
                for (int r = 0; r < 16; ++r) {
                    const int row = r0 + r;
                    const float4 ua = ldu(row, cha), ug = ldu(row, chg);
                    if (seg > 0 || r >= 2) {
                        float ca_[4], cg_[4];
                        ca_[0] = ba.x + w0a.x * a2.x + w1a.x * a1.x + w2a.x * ua.x; ca_[1] = ba.y + w0a.y * a2.y + w1a.y * a1.y + w2a.y * ua.y;
                        ca_[2] = ba.z + w0a.z * a2.z + w1a.z * a1.z + w2a.z * ua.z; ca_[3] = ba.w + w0a.w * a2.w + w1a.w * a1.w + w2a.w * ua.w;
                        cg_[0] = bg.x + w0g.x * g2.x + w1g.x * g1.x + w2g.x * ug.x; cg_[1] = bg.y + w0g.y * g2.y + w1g.y * g1.y + w2g.y * ug.y;
                        cg_[2] = bg.z + w0g.z * g2.z + w1g.z * g1.z + w2g.z * ug.z; cg_[3] = bg.w + w0g.w * g2.w + w1g.w * g1.w + w2g.w * ug.w;
                        f32x4 o = {ca_[0] * sigmoidf_(ca_[0]) * cg_[0], ca_[1] * sigmoidf_(ca_[1]) * cg_[1], ca_[2] * sigmoidf_(ca_[2]) * cg_[2], ca_[3] * sigmoidf_(ca_[3]) * cg_[3]};
                        *(uint2*)(act + (size_t)(m0 + row) * DFF + ncol) = pack4(o);
                    }
                    if (seg == 0 && r < 2) { *(float4*)(head + (size_t)(mt * 2 + r) * NFF2 + ncol) = ua; *(float4*)(head + (size_t)(mt * 2 + r) * NFF2 + DFF + ncol) = ug; }
                    if (seg == 15 && r >= 14) { *(float4*)(halo + (size_t)(mt * 2 + r - 14) * NFF2 + ncol) = ua; *(float4*)(halo + (size_t)(mt * 2 + r - 14) * NFF2 + DFF + ncol) = ug; }
                    a2 = a1; a1 = ua; g2 = g1; g1 = ug;
                }
            }
            __syncthreads();
        }
    }
}

__device__ __forceinline__ void fixup_phase(const Params& p, int L, int tid_, int bid_) {
    const float* head = (const float*)(p.ws + OFF_HEAD); const float* halo = (const float*)(p.ws + OFF_HALO);
    u16* act = (u16*)(p.ws + OFF_ACT);
    const float* cw = p.ffn_conv_w + (size_t)L * 3 * NFF2; const float* cb = p.ffn_conv_b + (size_t)L * NFF2;
    const int gt = bid_ * NTHR + tid_, nthr = gridDim.x * NTHR;
    for (int idx = gt; idx < 128 * 704; idx += nthr) {
        const int i = idx / 704, n = (idx - i * 704) * 4;
        const int t0 = i * 256;
        const bool first = (t0 & (S_ - 1)) == 0;
        const float4 z = make_float4(0.f, 0.f, 0.f, 0.f);
        const float4 ha0 = *(const float4*)(head + (size_t)(i * 2) * NFF2 + n), ha1 = *(const float4*)(head + (size_t)(i * 2 + 1) * NFF2 + n);
        const float4 hg0 = *(const float4*)(head + (size_t)(i * 2) * NFF2 + DFF + n), hg1 = *(const float4*)(head + (size_t)(i * 2 + 1) * NFF2 + DFF + n);
        float4 pa0 = z, pa1 = z, pg0 = z, pg1 = z;
        if (!first) {
            pa0 = *(const float4*)(halo + (size_t)(i * 2 - 2) * NFF2 + n); pa1 = *(const float4*)(halo + (size_t)(i * 2 - 1) * NFF2 + n);
            pg0 = *(const float4*)(halo + (size_t)(i * 2 - 2) * NFF2 + DFF + n); pg1 = *(const float4*)(halo + (size_t)(i * 2 - 1) * NFF2 + DFF + n);
        }
        const float4 w0a = *(const float4*)(cw + n), w1a = *(const float4*)(cw + NFF2 + n), w2a = *(const float4*)(cw + 2 * NFF2 + n);
        const float4 w0g = *(const float4*)(cw + DFF + n), w1g = *(const float4*)(cw + NFF2 + DFF + n), w2g = *(const float4*)(cw + 2 * NFF2 + DFF + n);
        const float4 ba = *(const float4*)(cb + n), bg = *(const float4*)(cb + DFF + n);
#define CONV3(b_, w0_, w1_, w2_, x0_, x1_, x2_) make_float4(b_.x + w0_.x * x0_.x + w1_.x * x1_.x + w2_.x * x2_.x, b_.y + w0_.y * x0_.y + w1_.y * x1_.y + w2_.y * x2_.y, \
                                                             b_.z + w0_.z * x0_.z + w1_.z * x1_.z + w2_.z * x2_.z, b_.w + w0_.w * x0_.w + w1_.w * x1_.w + w2_.w * x2_.w)
        const float4 ca0 = CONV3(ba, w0a, w1a, w2a, pa0, pa1, ha0), cg0 = CONV3(bg, w0g, w1g, w2g, pg0, pg1, hg0);
        const float4 ca1 = CONV3(ba, w0a, w1a, w2a, pa1, ha0, ha1), cg1 = CONV3(bg, w0g, w1g, w2g, pg1, hg0, hg1);
        f32x4 o0 = {ca0.x * sigmoidf_(ca0.x) * cg0.x, ca0.y * sigmoidf_(ca0.y) * cg0.y, ca0.z * sigmoidf_(ca0.z) * cg0.z, ca0.w * sigmoidf_(ca0.w) * cg0.w};
        f32x4 o1 = {ca1.x * sigmoidf_(ca1.x) * cg1.x, ca1.y * sigmoidf_(ca1.y) * cg1.y, ca1.z * sigmoidf_(ca1.z) * cg1.z, ca1.w * sigmoidf_(ca1.w) * cg1.w};
        *(uint2*)(act + (size_t)t0 * DFF + n) = pack4(o0);
        *(uint2*)(act + (size_t)(t0 + 1) * DFF + n) = pack4(o1);
    }
}

__device__ __forceinline__ void cmp2_phase(const Params& p, int L, int tid_, int bid_) {
    const int lane = tid_ & 63, w = tid_ >> 6, c16 = lane & 15, q4 = lane >> 4;
    const float* cosT = (const float*)(p.ws + OFF_COS); const float* sinT = (const float*)(p.ws + OFF_SIN);
    u16* KCC = (u16*)(p.ws + OFF_KCC); u16* VCCT = (u16*)(p.ws + OFF_VCCT);
    for (int task = bid_ * NW + w; task < 1024; task += gridDim.x * NW) {
        const int kv = task >> 9, r0 = (task & 511) * 16;
        const u16* hid = (const u16*)(p.ws + OFF_HID) + (size_t)kv * 8192 * 256;
        const u16* w2t = (const u16*)(p.ws + OFF_WT_CW2 + (L * 2 + kv) * SZ_WT_CW2);
        const int row = r0 + c16, rowc = row < 8184 ? row : 8183;
        f32x4 acc[4][1];
        f32x4 accq[4][4];
#pragma unroll
        for (int a = 0; a < 4; ++a) accq[a][0] = (f32x4){0.f, 0.f, 0.f, 0.f};
#pragma unroll
        for (int kk = 0; kk < 8; ++kk) {
            const bf16x8 bfr = *(const bf16x8*)(hid + (size_t)rowc * 256 + kk * 32 + q4 * 8);
#pragma unroll
            for (int nbk = 0; nbk < 4; ++nbk) {
                const bf16x8 afr = *(const bf16x8*)(w2t + (nbk * 16 + c16) * 256 + kk * 32 + q4 * 8);
                accq[nbk][0] = mfma16(afr, bfr, accq[nbk][0]);
            }
        }
        (void)acc;
        if (row < 8184) {
            const int g = row & 3, bn = row >> 2, b = bn / 1023, n = bn - b * 1023, bg = b * 4 + g;
            if (kv == 0) {
                rope_store(accq, 0, KCC + ((size_t)bg * 1024 + n) * 64, cosT, sinT, n * 16 + 31, q4);
            } else {
#pragma unroll
                for (int nbk = 0; nbk < 4; ++nbk)
#pragma unroll
                    for (int i = 0; i < 4; ++i) VCCT[((size_t)bg * 64 + nbk * 16 + q4 * 4 + i) * 1024 + n] = f2bf(accq[nbk][0][i]);
            }
        }
    }
    const int gt = bid_ * NTHR + tid_;
    if (gt < 512) {
        const int bg = gt >> 6, d = gt & 63;
        KCC[((size_t)bg * 1024 + 1023) * 64 + d] = 0;
        VCCT[((size_t)bg * 64 + d) * 1024 + 1023] = 0;
    }
}

template <bool SINK>
__device__ __forceinline__ void band_attn(const u16* __restrict__ qrow, const u16* __restrict__ Kh, const u16* __restrict__ VT, int t0, int W, const float* sinks4,
                                          f32x4 (&O)[4][4], float (&linv)[4], int lane) {
    const int c16 = lane & 15, q4 = lane >> 4;
    const float SC = 0.125f * LOG2E;
    bf16x8 qf[4][2];
#pragma unroll
    for (int h = 0; h < 4; ++h)
#pragma unroll
        for (int ks = 0; ks < 2; ++ks) qf[h][ks] = *(const bf16x8*)(qrow + h * 64 + ks * 32 + q4 * 8);
    float m[4], l[4];
#pragma unroll
    for (int h = 0; h < 4; ++h) {
        if (SINK) { m[h] = sinks4[h] * LOG2E; l[h] = (q4 == 0) ? 1.f : 0.f; }
        else { m[h] = NEGBIG; l[h] = 0.f; }
#pragma unroll
        for (int db = 0; db < 4; ++db) O[h][db] = (f32x4){0.f, 0.f, 0.f, 0.f};
    }
    const int t = t0 + c16;
    int lo = t0 - W + 1; if (lo < 0) lo = 0;
    const int g0 = lo >> 5, g1 = (t0 + 15) >> 5;
    const int kr = kperm(c16);
    for (int grp = g0; grp <= g1; ++grp) {
        const int kb = grp << 5;
        const unsigned kof = (unsigned)(kb + kr) * 64u + (unsigned)q4 * 8u;
        const bf16x8 k1a = *(const bf16x8*)(Kh + kof), k1b = *(const bf16x8*)(Kh + (kof + 32u)), k2a = *(const bf16x8*)(Kh + (kof + 256u)), k2b = *(const bf16x8*)(Kh + (kof + 288u));
        bf16x8 vf[4];
        const unsigned vof = (unsigned)c16 * (unsigned)S_ + (unsigned)kb + (unsigned)q4 * 8u;
#pragma unroll
        for (int db = 0; db < 4; ++db) vf[db] = *(const bf16x8*)(VT + (size_t)(db * 16 * S_) + vof);
        const int kpos = kb + q4 * 8;
        f32x4 cm1 = {0.f, 0.f, 0.f, 0.f}, cm2 = cm1;
        if (!((kb + 31 <= t0) && (kb > t0 + 15 - W))) {
#pragma unroll
            for (int i = 0; i < 4; ++i) {
                const int d1 = t - (kpos + i), d2 = t - (kpos + 4 + i);
                if (!((d1 >= 0) && (d1 < W))) cm1[i] = NEGBIG;
                if (!((d2 >= 0) && (d2 < W))) cm2[i] = NEGBIG;
            }
        }
#pragma unroll
        for (int h = 0; h < 4; ++h) {
            f32x4 s1 = mfma16(k1a, qf[h][0], cm1); s1 = mfma16(k1b, qf[h][1], s1);
            f32x4 s2 = mfma16(k2a, qf[h][0], cm2); s2 = mfma16(k2b, qf[h][1], s2);
            float mx = fmaxf(fmaxf(fmaxf(s1[0], s1[1]), fmaxf(s1[2], s1[3])), fmaxf(fmaxf(s2[0], s2[1]), fmaxf(s2[2], s2[3])));
            mx = xmax32(xmax16(mx));
            const float mn = fmaxf(fmaxf(m[h], mx * SC), -1e20f);
            if (__ballot(mn != m[h])) {
                const float alpha = fexp2(m[h] - mn);
                l[h] *= alpha;
#pragma unroll
                for (int db = 0; db < 4; ++db) O[h][db] = O[h][db] * alpha;
            }
            m[h] = mn;
            float pv[8]; float ps = 0.f;
#pragma unroll
            for (int i = 0; i < 4; ++i) { pv[i] = fexp2(fmaf(s1[i], SC, -mn)); pv[4 + i] = fexp2(fmaf(s2[i], SC, -mn)); }
#pragma unroll
            for (int i = 0; i < 8; ++i) ps += pv[i];
            l[h] += ps;
            const bf16x8 pf = pack8(pv);
#pragma unroll
            for (int db = 0; db < 4; ++db) O[h][db] = mfma16(vf[db], pf, O[h][db]);
        }
    }
#pragma unroll
    for (int h = 0; h < 4; ++h) { float lt = l[h]; lt += __shfl_xor(lt, 16); lt += __shfl_xor(lt, 32); linv[h] = 1.f / lt; }
}

__device__ __forceinline__ void swa_phase(const Params& p, int j, int tid_, int bid_) {
    const int lane = tid_ & 63, w = tid_ >> 6, c16 = lane & 15, q4 = lane >> 4;
    const int x = bid_ & 7, b = x >> 2, kvh = (x >> 1) & 1, hq = x & 1;
    const int head0 = kvh * 8 + hq * 4;
    const u16* Q = (const u16*)(p.ws + OFF_Q); u16* Ob = (u16*)(p.ws + OFF_O);
    const u16* Kh = (const u16*)(p.ws + OFF_KSH) + (size_t)(b * 2 + kvh) * S_ * 64;
    const u16* VT = (const u16*)(p.ws + OFF_VSHT) + (size_t)(b * 2 + kvh) * 64 * S_;
    const float* sk = p.b_sinks + j * 16 + head0;
    const int nslots = (gridDim.x >> 3) * NW;
    for (int tile = (bid_ >> 3) * NW + w; tile < 1024; tile += nslots) {
        const int t0 = tile * 16;
        f32x4 O[4][4]; float linv[4];
        band_attn<true>(Q + ((size_t)b * S_ + t0 + c16) * 1024 + head0 * 64, Kh, VT, t0, 128, sk, O, linv, lane);
        u16* op = Ob + ((size_t)b * S_ + t0 + c16) * 1024 + head0 * 64;
#pragma unroll
        for (int h = 0; h < 4; ++h)
#pragma unroll
            for (int db = 0; db < 4; ++db) *(uint2*)(op + h * 64 + db * 16 + q4 * 4) = pack4(O[h][db] * linv[h]);
    }
}

__device__ __forceinline__ void nsa_phase(const Params& p, unsigned char* smem, int tid_, int bid_, int probe_rep, int layer) {
    const int lane0 = tid_ & 63, w = tid_ >> 6;
    float* R = (float*)(smem + w * 16384);
    unsigned* tm = (unsigned*)(smem + NW * 16384 + w * 1024);
    unsigned char* sel = smem + NW * 16384 + NW * 1024 + w * 256;
    const int bg = bid_ & 7, b = bg >> 2, g = bg & 3;
    const u16* Q = (const u16*)(p.ws + OFF_Q); u16* Ob = (u16*)(p.ws + OFF_O);
    const u16* KCC = (const u16*)(p.ws + OFF_KCC) + (size_t)bg * 1024 * 64;
    const u16* VCCT = (const u16*)(p.ws + OFF_VCCT) + (size_t)bg * 64 * 1024;
    const u16* KS = (const u16*)(p.ws + OFF_KS) + (size_t)bg * S_ * 64;
    const u16* VST = (const u16*)(p.ws + OFF_VST) + (size_t)bg * 64 * S_;
    const u16* KW = (const u16*)(p.ws + OFF_KW) + (size_t)bg * S_ * 64;
    const u16* VWT = (const u16*)(p.ws + OFF_VWT) + (size_t)bg * 64 * S_;
    const float* GATES = (const float*)(p.ws + OFF_GATES);
    const float SC = 0.125f * LOG2E;
    const int nslots = (gridDim.x >> 3) * NW;
    unsigned* qhead = (unsigned*)(p.ws + OFF_BAR) + 4096 + (layer * 8 + bg) * 64;
    for (;;) {
        int tile_ = 0;
        if (lane0 == 0) tile_ = (int)__hip_atomic_fetch_add(qhead, 1u, __ATOMIC_RELAXED, __HIP_MEMORY_SCOPE_AGENT);
        tile_ = 1023 - __builtin_amdgcn_readfirstlane(tile_);
        if (tile_ < 0) break;
        const int tile = __builtin_amdgcn_readfirstlane(tile_);
        int lane = lane0; asm volatile("" : "+v"(lane));
        const int c16 = lane & 15, q4 = lane >> 4, kr = kperm(c16);
        const int t0 = tile * 16, cur = t0 >> 6, t = t0 + c16;
        const u16* qrow = Q + ((size_t)b * S_ + t) * 1024 + g * 256;
        const float* grow = GATES + ((size_t)b * S_ + t) * 48 + g * 12;
        const int nvl = (t >= 31) ? ((t - 31) >> 4) : -1;
        const int nvmax = (t0 + 15 >= 31) ? ((t0 + 15 - 31) >> 4) : -1;
        const int ng = (nvmax >= 0) ? ((nvmax >> 5) + 1) : 0;
        f32x4 Oc[4][4];
#pragma unroll
        for (int h = 0; h < 4; ++h)
#pragma unroll
            for (int db = 0; db < 4; ++db) Oc[h][db] = (f32x4){0.f, 0.f, 0.f, 0.f};
        {
            bf16x8 qf[4][2];
#pragma unroll
            for (int h = 0; h < 4; ++h)
#pragma unroll
                for (int ks = 0; ks < 2; ++ks) qf[h][ks] = *(const bf16x8*)(qrow + h * 64 + ks * 32 + q4 * 8);
            float m[4], l[4];
#pragma unroll
            for (int h = 0; h < 4; ++h) { m[h] = NEGBIG; l[h] = 0.f; }
            const int nvmin = (t0 >= 31) ? ((t0 - 31) >> 4) : -1;
            for (int grp = 0; grp < ng; ++grp) {
                const int kb = grp << 5;
                const unsigned kof = (unsigned)(kb + kr) * 64u + (unsigned)q4 * 8u;
                const bf16x8 k1a = *(const bf16x8*)(KCC + kof), k1b = *(const bf16x8*)(KCC + (kof + 32u)), k2a = *(const bf16x8*)(KCC + (kof + 256u)), k2b = *(const bf16x8*)(KCC + (kof + 288u));
                const int kpos = kb + q4 * 8;
                f32x4 cm1 = {0.f, 0.f, 0.f, 0.f}, cm2 = cm1;
                if (kb + 31 > nvmin) {
#pragma unroll
                    for (int i = 0; i < 4; ++i) { if (kpos + i > nvl) cm1[i] = NEGBIG; if (kpos + 4 + i > nvl) cm2[i] = NEGBIG; }
                }
#pragma unroll
                for (int h = 0; h < 4; ++h) {
                    f32x4 s1 = mfma16(k1a, qf[h][0], cm1); s1 = mfma16(k1b, qf[h][1], s1);
                    f32x4 s2 = mfma16(k2a, qf[h][0], cm2); s2 = mfma16(k2b, qf[h][1], s2);
                    float mx = fmaxf(fmaxf(fmaxf(s1[0], s1[1]), fmaxf(s1[2], s1[3])), fmaxf(fmaxf(s2[0], s2[1]), fmaxf(s2[2], s2[3])));
                    mx = xmax32(xmax16(mx));
                    const float mn = fmaxf(fmaxf(m[h], mx * SC), -1e20f);
                    if (__ballot(mn != m[h])) l[h] *= fexp2(m[h] - mn);
                    m[h] = mn;
                    float ps = 0.f;
#pragma unroll
                    for (int i = 0; i < 4; ++i) ps += fexp2(fmaf(s1[i], SC, -mn)) + fexp2(fmaf(s2[i], SC, -mn));
                    l[h] += ps;
                }
            }
            float linv[4];
#pragma unroll
            for (int h = 0; h < 4; ++h) { float lt = l[h]; lt += __shfl_xor(lt, 16); lt += __shfl_xor(lt, 32); linv[h] = lt > 0.f ? 1.f / lt : 0.f; }
            float carry = 0.f;
            for (int grp = 0; grp < ng; ++grp) {
                const int kb = grp << 5;
                const unsigned kof = (unsigned)(kb + kr) * 64u + (unsigned)q4 * 8u;
                const bf16x8 k1a = *(const bf16x8*)(KCC + kof), k1b = *(const bf16x8*)(KCC + (kof + 32u)), k2a = *(const bf16x8*)(KCC + (kof + 256u)), k2b = *(const bf16x8*)(KCC + (kof + 288u));
                bf16x8 vf[4];
#pragma unroll
                for (int db = 0; db < 4; ++db) vf[db] = *(const bf16x8*)(VCCT + (unsigned)(db * 16 * 1024) + ((unsigned)c16 * 1024u + (unsigned)kb + (unsigned)q4 * 8u));
                const int kpos = kb + q4 * 8;
                float psum[8];
#pragma unroll
                for (int i = 0; i < 8; ++i) psum[i] = 0.f;
                f32x4 cm1 = {0.f, 0.f, 0.f, 0.f}, cm2 = cm1;
                if (kb + 31 > nvmin) {
#pragma unroll
                    for (int i = 0; i < 4; ++i) { if (kpos + i > nvl) cm1[i] = NEGBIG; if (kpos + 4 + i > nvl) cm2[i] = NEGBIG; }
                }
#pragma unroll
                for (int h = 0; h < 4; ++h) {
                    f32x4 s1 = mfma16(k1a, qf[h][0], cm1); s1 = mfma16(k1b, qf[h][1], s1);
                    f32x4 s2 = mfma16(k2a, qf[h][0], cm2); s2 = mfma16(k2b, qf[h][1], s2);
                    float pv[8];
#pragma unroll
                    for (int i = 0; i < 4; ++i) {
                        pv[i] = fexp2(fmaf(s1[i], SC, -m[h])) * linv[h];
                        pv[4 + i] = fexp2(fmaf(s2[i], SC, -m[h])) * linv[h];
                    }
#pragma unroll
                    for (int i = 0; i < 8; ++i) psum[i] += pv[i];
                    const bf16x8 pf = pack8(pv);
#pragma unroll
                    for (int db = 0; db < 4; ++db) Oc[h][db] = mfma16(vf[db], pf, Oc[h][db]);
                }
                const float prev = __shfl(psum[7], (lane + 48) & 63);
                const float left = (q4 == 0) ? carry : prev;
                carry = prev;
                const float impA = left + 2.f * (psum[0] + psum[1] + psum[2]) + psum[3];
                const float impB = psum[3] + 2.f * (psum[4] + psum[5] + psum[6]) + psum[7];
                *(float2*)(R + c16 * 256 + (kb >> 2) + 2 * q4) = make_float2(impA, impB);
            }
        }
        wsync();
        const int ncand = cur - 2;
        const int npick = ncand < 0 ? 0 : (ncand < 13 ? ncand : 13);
        const int nforced = (cur < 2 ? cur : 2) + 1;
        const int nsel = npick + nforced;
        for (int tk = 0; tk < 8; ++tk) {
            float a0 = -1.f, a1 = -1.f, a2 = -1.f, a3 = -1.f, b0 = -1.f, b1 = -1.f, b2 = -1.f, b3 = -1.f;
            if (npick > 0) {
                const float4 va = *(const float4*)(R + tk * 256 + lane * 4), vb = *(const float4*)(R + (tk + 8) * 256 + lane * 4);
                const int j0 = lane * 4;
                const bool k0 = (j0 >= 1 && j0 <= ncand), k1 = (j0 + 1 <= ncand), k2 = (j0 + 2 <= ncand), k3 = (j0 + 3 <= ncand);
                a0 = k0 ? va.x : -1.f; a1 = k1 ? va.y : -1.f; a2 = k2 ? va.z : -1.f; a3 = k3 ? va.w : -1.f;
                b0 = k0 ? vb.x : -1.f; b1 = k1 ? vb.y : -1.f; b2 = k2 ? vb.z : -1.f; b3 = k3 ? vb.w : -1.f;
            }
            for (int it = 0; it < npick; ++it) {
                const float ma = wave_max(fmaxf(fmaxf(a0, a1), fmaxf(a2, a3)));
                const float mb = wave_max(fmaxf(fmaxf(b0, b1), fmaxf(b2, b3)));
                const unsigned long long bala = __ballot((a0 == ma) || (a1 == ma) || (a2 == ma) || (a3 == ma));
                const unsigned long long balb = __ballot((b0 == mb) || (b1 == mb) || (b2 == mb) || (b3 == mb));
                const int fa = __ffsll((long long)bala) - 1, fb = __ffsll((long long)balb) - 1;
                if (lane == fa) {
                    int sl;
                    if (a0 == ma) { sl = 0; a0 = -1.f; } else if (a1 == ma) { sl = 1; a1 = -1.f; } else if (a2 == ma) { sl = 2; a2 = -1.f; } else { sl = 3; a3 = -1.f; }
                    sel[tk * 16 + it] = (unsigned char)(lane * 4 + sl);
                }
                if (lane == fb) {
                    int sl;
                    if (b0 == mb) { sl = 0; b0 = -1.f; } else if (b1 == mb) { sl = 1; b1 = -1.f; } else if (b2 == mb) { sl = 2; b2 = -1.f; } else { sl = 3; b3 = -1.f; }
                    sel[(tk + 8) * 16 + it] = (unsigned char)(lane * 4 + sl);
                }
            }
            if (lane < 2) {
                const int tq = tk + lane * 8;
                sel[tq * 16 + npick] = 0;
                if (cur >= 1) sel[tq * 16 + npick + 1] = (unsigned char)cur;
                if (cur >= 2) sel[tq * 16 + npick + 2] = (unsigned char)(cur - 1);
            }
        }
        { unsigned zz = 0u; asm volatile("" : "+v"(zz)); *(uint4*)(tm + lane * 4) = make_uint4(zz, zz, zz, zz); }
        wsync();
        if (lane < 16) {
            for (int si = 0; si < nsel; ++si) atomicOr(&tm[sel[lane * 16 + si]], 1u << lane);
        }
        wsync();
        int n_act;
        {
            const uint4 mm = *(const uint4*)(tm + lane * 4);
            wsync();
            const bool f0 = mm.x != 0u, f1 = mm.y != 0u, f2 = mm.z != 0u, f3 = mm.w != 0u;
            const unsigned long long b0 = __ballot(f0), b1 = __ballot(f1), b2 = __ballot(f2), b3 = __ballot(f3);
            const unsigned long long below = (1ull << lane) - 1ull;
            int pos = __popcll(b0 & below) + __popcll(b1 & below) + __popcll(b2 & below) + __popcll(b3 & below);
            if (f0) { sel[pos] = (unsigned char)(lane * 4 + 0); ++pos; }
            if (f1) { sel[pos] = (unsigned char)(lane * 4 + 1); ++pos; }
            if (f2) { sel[pos] = (unsigned char)(lane * 4 + 2); ++pos; }
            if (f3) { sel[pos] = (unsigned char)(lane * 4 + 3); ++pos; }
            n_act = __popcll(b0) + __popcll(b1) + __popcll(b2) + __popcll(b3);
        }
        wsync();
        u16* PL = (u16*)R + 4096;
        {
            int t3 = t; asm volatile("" : "+v"(t3));
            const float* grow3 = GATES + ((size_t)b * S_ + t3) * 48 + g * 12;
#pragma unroll
            for (int h = 0; h < 4; ++h) {
                const float g0 = grow3[h * 3 + 0];
#pragma unroll
                for (int db = 0; db < 4; ++db) *(uint2*)(PL + (c16 * 4 + h) * 64 + db * 16 + q4 * 4) = pack4(Oc[h][db] * g0);
            }
        }
        wsync();
        for (int rep = 0; rep <= probe_rep; ++rep) {
            const int tg = c16 >> 2, hh = c16 & 3;
            f32x4 Os[4][4], Ol[4]; float m[4];
#pragma unroll
            for (int gq = 0; gq < 4; ++gq) {
                m[gq] = NEGBIG; Ol[gq] = (f32x4){0.f, 0.f, 0.f, 0.f};
#pragma unroll
                for (int db = 0; db < 4; ++db) Os[gq][db] = (f32x4){0.f, 0.f, 0.f, 0.f};
            }
            const long ones8 = 0x3838383838383838L;
            long qf8[4][2];
#pragma unroll
            for (int gq = 0; gq < 4; ++gq)
#pragma unroll
                for (int ks = 0; ks < 2; ++ks) {
                    const uint4 qv = *(const uint4*)(Q + ((size_t)b * S_ + t0 + gq * 4 + tg) * 1024 + g * 256 + hh * 64 + ks * 32 + q4 * 8);
                    const float f[8] = {__uint_as_float(qv.x << 16), __uint_as_float(qv.x & 0xffff0000u), __uint_as_float(qv.y << 16), __uint_as_float(qv.y & 0xffff0000u),
                                        __uint_as_float(qv.z << 16), __uint_as_float(qv.z & 0xffff0000u), __uint_as_float(qv.w << 16), __uint_as_float(qv.w & 0xffff0000u)};
                    qf8[gq][ks] = pk8_fp8(f);
                }
            const unsigned char* KS8 = (const unsigned char*)KS;
            const unsigned char* VS8 = (const unsigned char*)VST;
            auto ld = [&](int s, long (&K)[4], long (&V)[4]) __attribute__((always_inline)) {
                const int j = __builtin_amdgcn_readfirstlane((int)sel[s >> 1]);
                const int kb = j * 64 + (s & 1) * 32;
                const unsigned kof = (unsigned)(kb + kr) * 64u + (unsigned)q4 * 8u;
                K[0] = *(const long*)(KS8 + kof); K[1] = *(const long*)(KS8 + (kof + 32u)); K[2] = *(const long*)(KS8 + (kof + 256u)); K[3] = *(const long*)(KS8 + (kof + 288u));
                const unsigned vof = (unsigned)j * 4096u + (unsigned)c16 * 64u + (unsigned)(s & 1) * 32u + (unsigned)q4 * 8u;
#pragma unroll
                for (int db = 0; db < 4; ++db) V[db] = *(const long*)(VS8 + (vof + (unsigned)(db * 1024)));
            };
            auto cp = [&](int s, const long (&K)[4], const long (&V)[4]) __attribute__((always_inline)) {
                const int j = __builtin_amdgcn_readfirstlane((int)sel[s >> 1]);
                const unsigned mk = __builtin_amdgcn_readfirstlane(tm[j]);
                const int kpos = j * 64 + (s & 1) * 32 + q4 * 8;
#pragma unroll
                for (int gq = 0; gq < 4; ++gq) {
                    const unsigned gm = (mk >> (gq * 4)) & 0xFu;
                    if (gm == 0u) continue;
                    const float cmv = ((gm >> tg) & 1u) ? 0.f : NEGBIG;
                    f32x4 cm1 = {cmv, cmv, cmv, cmv}, cm2 = cm1;
                    if (j == cur) {
                        const int tc = t0 + gq * 4 + tg;
#pragma unroll
                        for (int i = 0; i < 4; ++i) { if (kpos + i > tc) cm1[i] = NEGBIG; if (kpos + 4 + i > tc) cm2[i] = NEGBIG; }
                    }
                    f32x4 s1 = mfma8(K[0], qf8[gq][0], cm1); s1 = mfma8(K[1], qf8[gq][1], s1);
                    f32x4 s2 = mfma8(K[2], qf8[gq][0], cm2); s2 = mfma8(K[3], qf8[gq][1], s2);
                    float mx = fmaxf(fmaxf(fmaxf(s1[0], s1[1]), fmaxf(s1[2], s1[3])), fmaxf(fmaxf(s2[0], s2[1]), fmaxf(s2[2], s2[3])));
                    mx = xmax32(xmax16(mx));
                    const float mn = fmaxf(m[gq], mx * SC);
                    if (__ballot(mn != m[gq])) {
                        const float alpha = fexp2(m[gq] - mn);
                        Ol[gq] = Ol[gq] * alpha;
#pragma unroll
                        for (int db = 0; db < 4; ++db) Os[gq][db] = Os[gq][db] * alpha;
                    }
                    m[gq] = mn;
                    float pv[8];
#pragma unroll
                    for (int i = 0; i < 4; ++i) { pv[i] = fexp2(fmaf(s1[i], SC, 7.f - mn)); pv[4 + i] = fexp2(fmaf(s2[i], SC, 7.f - mn)); }
                    const long pf = pk8_fp8(pv);
#pragma unroll
                    for (int db = 0; db < 4; ++db) Os[gq][db] = mfma8(V[db], pf, Os[gq][db]);
                    Ol[gq] = mfma8(ones8, pf, Ol[gq]);
                }
            };
            {
                long KA[4], VA[4], KB[4], VB[4];
                const int ns = 2 * n_act;
                ld(0, KA, VA);
                for (int s = 0; s < ns; s += 2) {
                    ld(s + 1, KB, VB);
                    cp(s, KA, VA);
                    if (s + 2 < ns) ld(s + 2, KA, VA);
                    cp(s + 1, KB, VB);
                }
            }
            const float repsc = (rep == 0) ? 1.f : 0.f;
#pragma unroll
            for (int gq = 0; gq < 4; ++gq) {
                const float lt = Ol[gq][0];
                const int tok = gq * 4 + tg;
                const float sc = repsc * GATES[((size_t)b * S_ + t0 + tok) * 48 + g * 12 + hh * 3 + 1] / lt;
#pragma unroll
                for (int db = 0; db < 4; ++db) {
                    u16* rp = PL + (tok * 4 + hh) * 64 + db * 16 + q4 * 4;
                    *(uint2*)rp = pack4(unpack4(*(const uint2*)rp) + Os[gq][db] * sc);
                }
            }
        }
        wsync();
        {
            f32x4 Ow[4][4]; float linv[4];
            int t2 = t; asm volatile("" : "+v"(t2));
            const u16* qrow2 = Q + ((size_t)b * S_ + t2) * 1024 + g * 256;
            const float* grow2 = GATES + ((size_t)b * S_ + t2) * 48 + g * 12;
            band_attn<false>(qrow2, KW, VWT, t0, 512, nullptr, Ow, linv, lane);
            u16* op = Ob + ((size_t)b * S_ + t2) * 1024 + g * 256;
#pragma unroll
            for (int h = 0; h < 4; ++h) {
                const float g2 = grow2[h * 3 + 2] * linv[h];
#pragma unroll
                for (int db = 0; db < 4; ++db) {
                    const f32x4 part = unpack4(*(const uint2*)(PL + (c16 * 4 + h) * 64 + db * 16 + q4 * 4));
                    *(uint2*)(op + h * 64 + db * 16 + q4 * 4) = pack4(part + Ow[h][db] * g2);
                }
            }
        }
        wsync();
    }
}


#define XB_TMO      128
#define XB_XCNT(j)  (256  + 64 * (j))
#define XB_XSUB(j)  (1280 + 64 * (j))
#define XB_XGEN(j)  (2304 + 64 * (j))
#define XB_TOP      3328
#define XB_TOPGEN   3392
#define XCD_BAR_WORDS 3456
#define XB_SPIN_CAP (1u << 22)
#define LAS __attribute__((address_space(3)))
__device__ __forceinline__ unsigned xb_ld(unsigned* p)              { return __hip_atomic_load(p, __ATOMIC_RELAXED, __HIP_MEMORY_SCOPE_AGENT); }
__device__ __forceinline__ unsigned xb_add(unsigned* p, unsigned v) { return __hip_atomic_fetch_add(p, v, __ATOMIC_RELAXED, __HIP_MEMORY_SCOPE_AGENT); }
__device__ __forceinline__ unsigned xb_xcc_id() { return (unsigned)__builtin_amdgcn_s_getreg((3 << 11) | 20) & 0xFu; }
#define XB_SPIN(cond, bar) do { unsigned _sp = 0; while (cond) { __builtin_amdgcn_s_sleep(1); \
    if ((++_sp & 255u) == 0u) { if (xb_ld(&(bar)[XB_TMO])) break; if (_sp > XB_SPIN_CAP) { atomicAdd(&(bar)[XB_TMO], 1u); break; } } } } while (0)
__device__ __forceinline__ void xcd_barrier_complete(unsigned* bar, unsigned x, unsigned& nloc, unsigned& nx) {
    const unsigned G = gridDim.x * gridDim.y * gridDim.z;
    unsigned sum, cnt, mine, sp = 0u;
    for (;;) {
        sum = 0u; cnt = 0u; mine = 0u;
#pragma unroll
        for (unsigned j = 0; j < 16; ++j) { const unsigned c = xb_ld(&bar[XB_XCNT(j)]); sum += c; cnt += (c > 0u) ? 1u : 0u; mine = (j == x) ? c : mine; }
        if (sum == G) break;
        __builtin_amdgcn_s_sleep(1);
        if ((++sp & 255u) == 0u) { if (xb_ld(&bar[XB_TMO])) break; if (sp > XB_SPIN_CAP) { atomicAdd(&bar[XB_TMO], 1u); break; } }
    }
    nloc = mine > 0u ? mine : 1u; nx = cnt > 0u ? cnt : 1u;
}
__device__ __forceinline__ void xcd_barrier(unsigned* bar, unsigned x, volatile LAS unsigned* st, int tid) {
    asm volatile("s_waitcnt vmcnt(0)" ::: "memory");
    __syncthreads();
    if (tid == 0) {
        __builtin_amdgcn_s_waitcnt(0);
        unsigned nloc = st[0], nx = st[1];
        if (nloc == 0u) { xcd_barrier_complete(bar, x, nloc, nx); st[0] = nloc; st[1] = nx; }
        const unsigned old = xb_add(&bar[XB_XSUB(x)], 1u);
        const unsigned gen = old / nloc;
        if (old + 1u == (gen + 1u) * nloc) {
            __builtin_amdgcn_fence(__ATOMIC_RELEASE, "agent");
            asm volatile("s_waitcnt vmcnt(0)" ::: "memory");
            const unsigned og = xb_add(&bar[XB_TOP], 1u);
            const unsigned tg = og / nx;
            if (og + 1u == (tg + 1u) * nx) xb_add(&bar[XB_TOPGEN], 1u);
            else XB_SPIN(xb_ld(&bar[XB_TOPGEN]) == tg, bar);
            __builtin_amdgcn_fence(__ATOMIC_ACQUIRE, "agent");
            xb_add(&bar[XB_XGEN(x)], 1u);
            asm volatile("s_waitcnt vmcnt(0)" ::: "memory");
        } else {
            XB_SPIN(xb_ld(&bar[XB_XGEN(x)]) == gen, bar);
            __builtin_amdgcn_fence(__ATOMIC_ACQUIRE, "agent");
            asm volatile("s_waitcnt vmcnt(0)" ::: "memory");
        }
    }
    __syncthreads();
}

enum { PT_PREP = 0, PT_NORM, PT_AIN, PT_CMP1, PT_CMP2, PT_NSA, PT_BKV, PT_BQ, PT_SWA, PT_AOUT, PT_FFNIN, PT_FIXUP, PT_FOUT, PT_FINAL };

__global__ void __launch_bounds__(NTHR, 2) mega(Params p) {
#if defined(__HIP_DEVICE_COMPILE__)
    extern __shared__ __attribute__((aligned(16))) unsigned char smem[];
    cg::grid_group grid = cg::this_grid();
    typedef const Params __attribute__((address_space(4)))* KP;
    const int ph_lo = p.ph_lo, ph_hi = p.ph_hi;
    const int wave_id = __builtin_amdgcn_readfirstlane((int)(threadIdx.x >> 6));
    unsigned* bar = (unsigned*)(p.ws + OFF_BAR);
    volatile LAS unsigned* xst = (volatile LAS unsigned*)(smem + LDS_USER);
    const unsigned xcc = __builtin_amdgcn_readfirstlane(xb_xcc_id());
    if (ph_hi - ph_lo > 1) {
        if (threadIdx.x == 0) { xst[0] = 0u; xst[1] = 0u; (void)xb_add(&bar[XB_XCNT(xcc)], 1u); }
        __syncthreads();
    }
    for (int ph = ph_lo; ph < ph_hi; ++ph) {
        int tid_, bid_ = blockIdx.x;
        asm volatile("v_mbcnt_lo_u32_b32 %0, -1, 0\n\tv_mbcnt_hi_u32_b32 %0, -1, %0" : "=v"(tid_));
        tid_ += wave_id * 64;
        asm volatile("" : "+s"(bid_));
        KP kp = (KP)__builtin_amdgcn_kernarg_segment_ptr();
        asm volatile("" : "+s"(kp));
        unsigned char* ws = kp->ws;
        u16* HN = (u16*)(ws + OFF_HN);
        const int d = kp->desc[ph], type = d & 255, sub = (d >> 8) & 255, L = d >> 16;
        const float* hsrc = (L == 0) ? kp->x : kp->out;
        EpiArgs e; e.resid = nullptr; e.out = kp->out; e.bias = nullptr; e.hid = nullptr; e.convw = nullptr; e.convb = nullptr; e.ws = ws;
        switch (type) {
        case PT_PREP: { const Params pl = *kp; prep_phase(pl, smem, tid_, bid_); } break;
        case PT_NORM: {
            const float* src = (sub == 1) ? kp->out : hsrc;
            const float* g = (sub == 0) ? kp->norm_attn + L * 1024 : (sub == 1) ? kp->norm_ffn + L * 1024 : kp->kv_norm;
            norm_phase<false>(src, g, HN, nullptr, tid_, bid_);
        } break;
        case PT_AIN: gemm_phase<AM_PLAIN, EPI_AIN>(HN, 1024, (const u16*)(ws + OFF_WT_AIN + L * SZ_WT_AIN), T_, 2688, 1024, 0, e, smem, tid_, bid_); break;
        case PT_CMP1:
            for (int kv = 0; kv < 2; ++kv) {
                e.bias = (const float*)(ws + OFF_CBIAS) + (L * 2 + kv) * 256; e.hid = (u16*)(ws + OFF_HID) + (size_t)kv * 8192 * 256;
                gemm_phase<AM_GATHER, EPI_CMP1>((const u16*)(ws + (kv == 0 ? OFF_KC : OFF_VC)), 0, (const u16*)(ws + OFF_WT_CW1 + (L * 2 + kv) * SZ_WT_CW1), 8184, 256, 2048,
                                                kv == 0 ? 0 : (int)(gridDim.x >> 1), e, smem, tid_, bid_);
            }
            break;
        case PT_CMP2: { const Params pl = *kp; cmp2_phase(pl, L, tid_, bid_); } break;
        case PT_NSA: { const Params pl = *kp; nsa_phase(pl, smem, tid_, bid_, sub, L); } break;
        case PT_BKV: gemm_phase<AM_PLAIN, EPI_BKV>(HN, 1024, (const u16*)(ws + OFF_WT_KV), T_, 256, 1024, 0, e, smem, tid_, bid_); break;
        case PT_BQ: gemm_phase<AM_PLAIN, EPI_BQ>(HN, 1024, (const u16*)(ws + OFF_WT_BQ + (L - 2) * SZ_WT_SQ), T_, 1024, 1024, 0, e, smem, tid_, bid_); break;
        case PT_SWA: { const Params pl = *kp; swa_phase(pl, L - 2, tid_, bid_); } break;
        case PT_AOUT:
        case PT_FOUT: {
            const bool ff = (type == PT_FOUT);
            e.resid = ff ? kp->out : hsrc;
            const u16* A = (const u16*)(ws + (ff ? OFF_ACT : OFF_O));
            const u16* Bt = (const u16*)(ws + (ff ? OFF_WT_FOUT + L * SZ_WT_FOUT : (L < 2 ? OFF_WT_AOUT + L * SZ_WT_SQ : OFF_WT_BOUT + (L - 2) * SZ_WT_SQ)));
            const int K = ff ? DFF : 1024;
            gemm_big<AM_PLAIN, EPI_RESID>(A, K, Bt, T_, 1024, K, 0, e, smem, tid_, bid_);
        } break;
        case PT_FFNIN:
            e.convw = kp->ffn_conv_w + (size_t)L * 3 * NFF2; e.convb = kp->ffn_conv_b + (size_t)L * NFF2;
            gemm_big<AM_PLAIN, EPI_FFNIN>(HN, 1024, (const u16*)(ws + OFF_WT_FIN + L * SZ_WT_FIN), T_, NFF2, 1024, 0, e, smem, tid_, bid_);
            break;
        case PT_FIXUP: { const Params pl = *kp; fixup_phase(pl, L, tid_, bid_); } break;
        case PT_FINAL: norm_phase<true>(kp->out, kp->final_norm, nullptr, kp->out, tid_, bid_); break;
        default: break;
        }
        if (ph + 1 < ph_hi) { if (ph == ph_lo) grid.sync(); else xcd_barrier(bar, xcc, xst, tid_); }
    }
#endif
}

static int build_program(int* desc) {
    int n = 0;
    auto add = [&](int type, int sub, int L) { desc[n++] = type | (sub << 8) | (L << 16); };
    add(PT_PREP, 0, 0);
    for (int L = 0; L < 4; ++L) {
        if (L < 2) {
            add(PT_NORM, 0, L); add(PT_AIN, 0, L); add(PT_CMP1, 0, L); add(PT_CMP2, 0, L); add(PT_NSA, NSA_PROBE_REP, L);
        } else {
            if (L == 2) { add(PT_NORM, 2, L); add(PT_BKV, 0, L); }
            add(PT_NORM, 0, L); add(PT_BQ, 0, L); add(PT_SWA, 0, L);
        }
        add(PT_AOUT, 0, L); add(PT_NORM, 1, L); add(PT_FFNIN, 0, L); add(PT_FIXUP, 0, L); add(PT_FOUT, 0, L);
    }
    add(PT_FINAL, 0, 0);
    return n;
}

extern "C" void kernel_launch(void* const* d_in, const int* in_sizes, int n_in, void* d_out, int out_size, void* d_ws, size_t ws_size, hipStream_t stream) {
    (void)in_sizes; (void)n_in; (void)out_size;
    static int grid_blocks = 0;
    if (!grid_blocks) {
        (void)hipFuncSetAttribute((const void*)mega, hipFuncAttributeMaxDynamicSharedMemorySize, LDS_BYTES);
        int dev = 0, cus = 0, per_cu = 0;
        (void)hipGetDevice(&dev);
        (void)hipDeviceGetAttribute(&cus, hipDeviceAttributeMultiprocessorCount, dev);
        (void)hipOccupancyMaxActiveBlocksPerMultiprocessor(&per_cu, mega, NTHR, LDS_BYTES);
        if (per_cu > 1) per_cu = 1;
        if (per_cu < 1) per_cu = 1;
        grid_blocks = (cus * per_cu) & ~7;
        if (grid_blocks < 8) grid_blocks = 8;
        if (ws_size < WS_NEED) fprintf(stderr, "workspace too small: %zu < %zu\n", ws_size, (size_t)WS_NEED);
    }
    Params p{};
    const float** pp = (const float**)&p;
    for (int i = 0; i < 18; ++i) pp[i] = (const float*)d_in[i];
    p.out = (float*)d_out;
    p.ws = (unsigned char*)d_ws;
    const int nph = build_program(p.desc);
#if MULTI_LAUNCH
    for (int ph = 0; ph < nph; ++ph) {
        p.ph_lo = ph; p.ph_hi = ph + 1;
        hipLaunchKernelGGL(mega, dim3(grid_blocks), dim3(NTHR), LDS_BYTES, stream, p);
    }
#else
    p.ph_lo = 0; p.ph_hi = nph;
    (void)hipMemsetAsync((unsigned char*)d_ws + OFF_BAR, 0, 32768, stream);
    void* args[] = {&p};
    hipError_t err = hipLaunchCooperativeKernel((const void*)mega, dim3(grid_blocks), dim3(NTHR), args, LDS_BYTES, stream);
    if (err != hipSuccess) fprintf(stderr, "cooperative launch failed: %s (grid %d)\n", hipGetErrorString(err), grid_blocks);
#endif
}
```

```cpp
#include <hip/hip_runtime.h>
#include <hip/hip_cooperative_groups.h>
#include <cstdio>
#include <cmath>
namespace cg = cooperative_groups;

typedef unsigned short u16;
typedef short bf16x8 __attribute__((ext_vector_type(8)));
typedef float f32x4 __attribute__((ext_vector_type(4)));

#ifndef NSA_PROBE_REP
#define NSA_PROBE_REP 0
#endif
#ifndef MULTI_LAUNCH
#define MULTI_LAUNCH 0
#endif

constexpr int S_ = 16384, T_ = 32768, D_ = 1024, DFF = 2816, NFF2 = 5632;
constexpr int NTHR = 512, NW = NTHR / 64;
constexpr int LDS_USER = NW * 16384 + NW * 1024 + NW * 256;
constexpr int LDS_BYTES = LDS_USER + 16;
constexpr float LOG2E = 1.4426950408889634f;
constexpr float NEGBIG = -1e30f;

constexpr size_t al256(size_t x) { return (x + 255) & ~(size_t)255; }
constexpr size_t SZ_WT_AIN = (size_t)2688 * 1024 * 2;
constexpr size_t SZ_WT_CW1 = (size_t)256 * 2048 * 2;
constexpr size_t SZ_WT_CW2 = (size_t)64 * 256 * 2;
constexpr size_t SZ_WT_SQ = (size_t)1024 * 1024 * 2;
constexpr size_t SZ_WT_KV = (size_t)256 * 1024 * 2;
constexpr size_t SZ_WT_FIN = (size_t)5632 * 1024 * 2;
constexpr size_t SZ_WT_FOUT = (size_t)1024 * 2816 * 2;
constexpr size_t OFF_WT_AIN = 0;
constexpr size_t OFF_WT_CW1 = OFF_WT_AIN + 2 * SZ_WT_AIN;
constexpr size_t OFF_WT_CW2 = OFF_WT_CW1 + 4 * SZ_WT_CW1;
constexpr size_t OFF_WT_AOUT = OFF_WT_CW2 + 4 * SZ_WT_CW2;
constexpr size_t OFF_WT_KV = OFF_WT_AOUT + 2 * SZ_WT_SQ;
constexpr size_t OFF_WT_BQ = OFF_WT_KV + SZ_WT_KV;
constexpr size_t OFF_WT_BOUT = OFF_WT_BQ + 2 * SZ_WT_SQ;
constexpr size_t OFF_WT_FIN = OFF_WT_BOUT + 2 * SZ_WT_SQ;
constexpr size_t OFF_WT_FOUT = OFF_WT_FIN + 4 * SZ_WT_FIN;
constexpr size_t OFF_COS = OFF_WT_FOUT + 4 * SZ_WT_FOUT;
constexpr size_t OFF_SIN = OFF_COS + (size_t)S_ * 32 * 4;
constexpr size_t OFF_CBIAS = OFF_SIN + (size_t)S_ * 32 * 4;
constexpr size_t OFF_HN = OFF_CBIAS + 4096;
constexpr size_t OFF_KSH = OFF_HN + (size_t)T_ * 1024 * 2;
constexpr size_t OFF_VSHT = OFF_KSH + (size_t)T_ * 128 * 2;
constexpr size_t OFF_HEAD = OFF_VSHT + (size_t)T_ * 128 * 2;
constexpr size_t OFF_HALO = OFF_HEAD + (size_t)256 * 2 * NFF2 * 4;
constexpr size_t OFF_R1 = OFF_HALO + (size_t)256 * 2 * NFF2 * 4;
constexpr size_t OFF_Q = OFF_R1;
constexpr size_t OFF_KC = OFF_Q + (size_t)T_ * 1024 * 2;
constexpr size_t OFF_VC = OFF_KC + (size_t)T_ * 256 * 2;
constexpr size_t OFF_KS = OFF_VC + (size_t)T_ * 256 * 2;
constexpr size_t OFF_VST = OFF_KS + (size_t)T_ * 256 * 2;
constexpr size_t OFF_KW = OFF_VST + (size_t)T_ * 256 * 2;
constexpr size_t OFF_VWT = OFF_KW + (size_t)T_ * 256 * 2;
constexpr size_t OFF_GATES = OFF_VWT + (size_t)T_ * 256 * 2;
constexpr size_t OFF_HID = OFF_GATES + (size_t)T_ * 48 * 4;
constexpr size_t OFF_KCC = OFF_HID + (size_t)2 * 8192 * 256 * 2;
constexpr size_t OFF_VCCT = OFF_KCC + (size_t)8 * 1024 * 64 * 2;
constexpr size_t OFF_O = OFF_VCCT + (size_t)8 * 1024 * 64 * 2;
constexpr size_t OFF_END = OFF_O + (size_t)T_ * 1024 * 2;
constexpr size_t OFF_BAR = OFF_END;
constexpr size_t WS_NEED = OFF_BAR + 32768;
constexpr size_t OFF_ACT = OFF_R1;
static_assert(OFF_ACT + (size_t)T_ * DFF * 2 <= OFF_END, "act alias");

struct Params {
    const float *x, *norm_attn, *norm_ffn, *a_w_in, *a_cmp_pos, *a_cmp_w1, *a_cmp_w2, *a_w_out, *kv_norm, *b_w_kv, *b_w_q, *b_sinks, *b_w_out,
        *ffn_w_in, *ffn_conv_w, *ffn_conv_b, *ffn_w_out, *final_norm;
    float* out;
    unsigned char* ws;
    int desc[48];
    int ph_lo, ph_hi;
};

__device__ __forceinline__ u16 f2bf(float f) {
    unsigned u = __float_as_uint(f);
    u += 0x7fffu + ((u >> 16) & 1u);
    return (u16)(u >> 16);
}
typedef __bf16 bf16x2_t __attribute__((ext_vector_type(2)));
typedef float f32x2_t __attribute__((ext_vector_type(2)));
__device__ __forceinline__ unsigned pack2(float lo, float hi) { f32x2_t v = {lo, hi}; bf16x2_t r = __builtin_convertvector(v, bf16x2_t); return __builtin_bit_cast(unsigned, r); }
typedef unsigned u32x4 __attribute__((ext_vector_type(4)));
__device__ __forceinline__ bf16x8 pack8(const float (&v)[8]) {
    u32x4 r;
    unsigned r0, r1, r2, r3;
    asm("v_cvt_pk_bf16_f32 %0, %4, %5\n\tv_cvt_pk_bf16_f32 %1, %6, %7\n\tv_cvt_pk_bf16_f32 %2, %8, %9\n\tv_cvt_pk_bf16_f32 %3, %10, %11\n\ts_nop 3"
        : "=&v"(r0), "=&v"(r1), "=&v"(r2), "=&v"(r3)
        : "v"(v[0]), "v"(v[1]), "v"(v[2]), "v"(v[3]), "v"(v[4]), "v"(v[5]), "v"(v[6]), "v"(v[7]));
    r[0] = r0; r[1] = r1; r[2] = r2; r[3] = r3;
    return __builtin_bit_cast(bf16x8, r);
}
__device__ __forceinline__ uint2 pack4(f32x4 v) { uint2 r; r.x = pack2(v[0], v[1]); r.y = pack2(v[2], v[3]); return r; }
__device__ __forceinline__ f32x4 unpack4(uint2 v) { return (f32x4){__uint_as_float(v.x << 16), __uint_as_float(v.x & 0xffff0000u), __uint_as_float(v.y << 16), __uint_as_float(v.y & 0xffff0000u)}; }
__device__ __forceinline__ unsigned pk4_fp8(float a, float b, float c, float d) { int r = __builtin_amdgcn_cvt_pk_fp8_f32(a, b, 0, false); r = __builtin_amdgcn_cvt_pk_fp8_f32(c, d, r, true); return (unsigned)r; }
__device__ __forceinline__ long pk8_fp8(const float (&v)[8]) { const unsigned lo = pk4_fp8(v[0], v[1], v[2], v[3]), hi = pk4_fp8(v[4], v[5], v[6], v[7]); return (long)(((unsigned long long)hi << 32) | lo); }
__device__ __forceinline__ f32x4 mfma8(long a, long b, f32x4 c) { return __builtin_amdgcn_mfma_f32_16x16x32_fp8_fp8(a, b, c, 0, 0, 0); }
__device__ __forceinline__ f32x4 mfma16(bf16x8 a, bf16x8 b, f32x4 c) { return __builtin_amdgcn_mfma_f32_16x16x32_bf16(a, b, c, 0, 0, 0); }
__device__ __forceinline__ float fexp2(float x) { return __builtin_amdgcn_exp2f(x); }
__device__ __forceinline__ void wsync() { __builtin_amdgcn_fence(__ATOMIC_ACQ_REL, "wavefront"); asm volatile("s_waitcnt lgkmcnt(0)" ::: "memory"); __builtin_amdgcn_wave_barrier(); }
typedef unsigned u32x2 __attribute__((ext_vector_type(2)));
__device__ __forceinline__ float xmax16(float x) { const unsigned u = __float_as_uint(x); const u32x2 r = __builtin_amdgcn_permlane16_swap(u, u, false, false); return fmaxf(__uint_as_float(r[0]), __uint_as_float(r[1])); }
__device__ __forceinline__ float xmax32(float x) { const unsigned u = __float_as_uint(x); const u32x2 r = __builtin_amdgcn_permlane32_swap(u, u, false, false); return fmaxf(__uint_as_float(r[0]), __uint_as_float(r[1])); }
template <int CTRL> __device__ __forceinline__ float dppf(float x) { return __int_as_float(__builtin_amdgcn_update_dpp(0, __float_as_int(x), CTRL, 0xf, 0xf, true)); }
__device__ __forceinline__ float wave_max(float x) {
    x = fmaxf(x, dppf<0xB1>(x)); x = fmaxf(x, dppf<0x4E>(x)); x = fmaxf(x, dppf<0x141>(x)); x = fmaxf(x, dppf<0x140>(x));
    return xmax32(xmax16(x));
}
__device__ __forceinline__ int kperm(int m) { return ((m >> 2) << 3) + (m & 3); }
__device__ __forceinline__ float sigmoidf_(float x) { return 1.f / (1.f + __expf(-x)); }
__device__ __forceinline__ float gelu_tanh(float x) {
    float u = 0.7978845608028654f * (x + 0.044715f * x * x * x);
    float e = __expf(2.f * u);
    float th = 1.f - 2.f / (e + 1.f);
    return 0.5f * x * (1.f + th);
}

__device__ __forceinline__ void cvt_transpose(const float* __restrict__ src, u16* __restrict__ dst, int K, int N, int Npad, int mode, unsigned char* smem, int tid_, int bid_) {
    const int half = tid_ >> 8, tid = tid_ & 255;
    float* ts = (float*)smem + half * (64 * 65);
    const int ntk = K >> 6, ntn = Npad >> 6, ntiles = ntk * ntn;
    for (int tile2 = bid_ * 2; tile2 < ntiles; tile2 += gridDim.x * 2) {
        const int tile = tile2 + half;
        const bool live = tile < ntiles;
        const int tk = live ? tile % ntk : 0, tn = live ? tile / ntk : 0;
        const int k0 = tk << 6, n0 = tn << 6;
        __syncthreads();
        if (live) {
#pragma unroll
            for (int i = 0; i < 4; ++i) {
                const int k = (tid >> 4) + 16 * i, n = (tid & 15) * 4;
                float4 v = make_float4(0.f, 0.f, 0.f, 0.f);
                if (n0 + n < N) v = *(const float4*)(src + (size_t)(k0 + k) * N + n0 + n);
                ts[k * 65 + n + 0] = v.x; ts[k * 65 + n + 1] = v.y; ts[k * 65 + n + 2] = v.z; ts[k * 65 + n + 3] = v.w;
            }
        }
        __syncthreads();
        if (!live) continue;
        const int n = tid >> 2, kq = (tid & 3) * 16;
        unsigned pk[8];
#pragma unroll
        for (int j = 0; j < 8; ++j) pk[j] = pack2(ts[(kq + 2 * j) * 65 + n], ts[(kq + 2 * j + 1) * 65 + n]);
        int drow;
        if (mode == 0) drow = n0 + n;
        else { const int nn = n0 + n; drow = (nn < DFF) ? ((nn >> 6) * 128 + (nn & 63)) : ((((nn - DFF) >> 6) * 128) + 64 + ((nn - DFF) & 63)); }
        uint4* dp = (uint4*)(dst + (size_t)drow * K + k0 + kq);
        dp[0] = make_uint4(pk[0], pk[1], pk[2], pk[3]);
        dp[1] = make_uint4(pk[4], pk[5], pk[6], pk[7]);
    }
}

__device__ __forceinline__ void prep_phase(const Params& p, unsigned char* smem, int tid_, int bid_) {
    unsigned char* ws = p.ws;
    for (int L = 0; L < 2; ++L) {
        cvt_transpose(p.a_w_in + (size_t)L * 1024 * 2608, (u16*)(ws + OFF_WT_AIN + L * SZ_WT_AIN), 1024, 2608, 2688, 0, smem, tid_, bid_);
        for (int kv = 0; kv < 2; ++kv) {
            cvt_transpose(p.a_cmp_w1 + (size_t)(L * 2 + kv) * 2048 * 256, (u16*)(ws + OFF_WT_CW1 + (L * 2 + kv) * SZ_WT_CW1), 2048, 256, 256, 0, smem, tid_, bid_);
            cvt_transpose(p.a_cmp_w2 + (size_t)(L * 2 + kv) * 256 * 64, (u16*)(ws + OFF_WT_CW2 + (L * 2 + kv) * SZ_WT_CW2), 256, 64, 64, 0, smem, tid_, bid_);
        }
        cvt_transpose(p.a_w_out + (size_t)L * 1024 * 1024, (u16*)(ws + OFF_WT_AOUT + L * SZ_WT_SQ), 1024, 1024, 1024, 0, smem, tid_, bid_);
        cvt_transpose(p.b_w_q + (size_t)L * 1024 * 1024, (u16*)(ws + OFF_WT_BQ + L * SZ_WT_SQ), 1024, 1024, 1024, 0, smem, tid_, bid_);
        cvt_transpose(p.b_w_out + (size_t)L * 1024 * 1024, (u16*)(ws + OFF_WT_BOUT + L * SZ_WT_SQ), 1024, 1024, 1024, 0, smem, tid_, bid_);
    }
    cvt_transpose(p.b_w_kv, (u16*)(ws + OFF_WT_KV), 1024, 256, 256, 0, smem, tid_, bid_);
    for (int L = 0; L < 4; ++L) {
        cvt_transpose(p.ffn_w_in + (size_t)L * 1024 * NFF2, (u16*)(ws + OFF_WT_FIN + L * SZ_WT_FIN), 1024, NFF2, NFF2, 1, smem, tid_, bid_);
        cvt_transpose(p.ffn_w_out + (size_t)L * DFF * 1024, (u16*)(ws + OFF_WT_FOUT + L * SZ_WT_FOUT), DFF, 1024, 1024, 0, smem, tid_, bid_);
    }
    {
        float* cosT = (float*)(ws + OFF_COS); float* sinT = (float*)(ws + OFF_SIN);
        const int gt = bid_ * NTHR + tid_, nt = gridDim.x * NTHR;
        for (int idx = gt; idx < S_ * 32; idx += nt) {
            const int pos = idx >> 5, i = idx & 31;
            const float ang = (float)pos * exp2f(-(float)i * (13.287712379549449f / 32.0f));
            double rev = (double)ang * 0.15915494309189535;
            rev -= rint(rev);
            const float fr = (float)rev;
            cosT[idx] = __builtin_amdgcn_cosf(fr);
            sinT[idx] = __builtin_amdgcn_sinf(fr);
        }
    }
    {
        float* cb = (float*)(ws + OFF_CBIAS);
        const int lane = tid_ & 63, w = tid_ >> 6;
        for (int task = bid_ * NW + w; task < 256; task += gridDim.x * NW) {
            const int lk = task >> 6, j4 = (task & 63) * 4;
            const float* pos = p.a_cmp_pos + (size_t)lk * 2048;
            const float* w1 = p.a_cmp_w1 + (size_t)lk * 2048 * 256;
            float4 a = make_float4(0.f, 0.f, 0.f, 0.f);
            for (int i = 0; i < 32; ++i) {
                const int k = lane + 64 * i;
                const float pv = pos[k];
                const float4 wv = *(const float4*)(w1 + (size_t)k * 256 + j4);
                a.x += pv * wv.x; a.y += pv * wv.y; a.z += pv * wv.z; a.w += pv * wv.w;
            }
#pragma unroll
            for (int off = 32; off >= 1; off >>= 1) {
                a.x += __shfl_xor(a.x, off); a.y += __shfl_xor(a.y, off); a.z += __shfl_xor(a.z, off); a.w += __shfl_xor(a.w, off);
            }
            if (lane == 0) *(float4*)(cb + lk * 256 + j4) = a;
        }
    }
}

template <bool OUT_F32>
__device__ __forceinline__ void norm_phase(const float* __restrict__ src, const float* __restrict__ g, u16* __restrict__ dst, float* __restrict__ dstf, int tid_, int bid_) {
    const int lane = tid_ & 63, w = tid_ >> 6;
    float4 gv[4];
#pragma unroll
    for (int i = 0; i < 4; ++i) gv[i] = *(const float4*)(g + lane * 4 + 256 * i);
    for (int row = bid_ * NW + w; row < T_; row += gridDim.x * NW) {
        const float* sp = src + (size_t)row * 1024;
        float4 v[4];
        float ss = 0.f;
#pragma unroll
        for (int i = 0; i < 4; ++i) { v[i] = *(const float4*)(sp + lane * 4 + 256 * i); ss += v[i].x * v[i].x + v[i].y * v[i].y + v[i].z * v[i].z + v[i].w * v[i].w; }
#pragma unroll
        for (int off = 32; off >= 1; off >>= 1) ss += __shfl_xor(ss, off);
        const float r = rsqrtf(ss * (1.f / 1024.f) + 1e-6f);
#pragma unroll
        for (int i = 0; i < 4; ++i) {
            f32x4 o = {v[i].x * r * gv[i].x, v[i].y * r * gv[i].y, v[i].z * r * gv[i].z, v[i].w * r * gv[i].w};
            if (OUT_F32) *(float4*)(dstf + (size_t)row * 1024 + lane * 4 + 256 * i) = make_float4(o[0], o[1], o[2], o[3]);
            else *(uint2*)(dst + (size_t)row * 1024 + lane * 4 + 256 * i) = pack4(o);
        }
    }
}

enum { AM_PLAIN = 0, AM_GATHER = 1 };
enum { EPI_AIN = 0, EPI_CMP1 = 1, EPI_RESID = 2, EPI_FFNIN = 3, EPI_BQ = 4, EPI_BKV = 5 };

struct EpiArgs {
    const float* resid; float* out;
    const float* bias; u16* hid;
    const float *convw, *convb;
    unsigned char* ws;
};

template <int NM>
__device__ __forceinline__ void rope_store(const f32x4 (&acc)[4][NM], int mi, u16* dstrow  , const float* cosT, const float* sinT, int pos, int q4) {
#pragma unroll
    for (int ni = 0; ni < 2; ++ni) {
        const int d = ni * 16 + q4 * 4;
        const float4 c = *(const float4*)(cosT + pos * 32 + d), s = *(const float4*)(sinT + pos * 32 + d);
        const f32x4 x1 = acc[ni][mi], x2 = acc[ni + 2][mi];
        f32x4 o1 = {x1[0] * c.x - x2[0] * s.x, x1[1] * c.y - x2[1] * s.y, x1[2] * c.z - x2[2] * s.z, x1[3] * c.w - x2[3] * s.w};
        f32x4 o2 = {x2[0] * c.x + x1[0] * s.x, x2[1] * c.y + x1[1] * s.y, x2[2] * c.z + x1[2] * s.z, x2[3] * c.w + x1[3] * s.w};
        *(uint2*)(dstrow + d) = pack4(o1);
        *(uint2*)(dstrow + d + 32) = pack4(o2);
    }
}

__device__ __forceinline__ void rope_ivr(float (&ivr)[8], int q4) {
#pragma unroll
    for (int k = 0; k < 8; ++k) { const int d = (k >> 2) * 16 + q4 * 4 + (k & 3); ivr[k] = exp2f(-(float)d * (13.287712379549449f / 32.0f)) * 0.15915494309189535f; }
}
__device__ __forceinline__ void rope_cs(const float (&ivr)[8], int ni, int pos, float (&c)[4], float (&s)[4]) {
#pragma unroll
    for (int i = 0; i < 4; ++i) { float rev = (float)pos * ivr[ni * 4 + i]; rev = rev - floorf(rev); c[i] = __builtin_amdgcn_cosf(rev); s[i] = __builtin_amdgcn_sinf(rev); }
}
template <int NM>
__device__ __forceinline__ void rope_store_fly(const f32x4 (&acc)[4][NM], int mi, u16* dstrow, const float (&ivr)[8], int pos, int q4) {
#pragma unroll
    for (int ni = 0; ni < 2; ++ni) {
        const int d = ni * 16 + q4 * 4;
        float c[4], s[4];
        rope_cs(ivr, ni, pos, c, s);
        const f32x4 x1 = acc[ni][mi], x2 = acc[ni + 2][mi];
        f32x4 o1 = {x1[0] * c[0] - x2[0] * s[0], x1[1] * c[1] - x2[1] * s[1], x1[2] * c[2] - x2[2] * s[2], x1[3] * c[3] - x2[3] * s[3]};
        f32x4 o2 = {x2[0] * c[0] + x1[0] * s[0], x2[1] * c[1] + x1[1] * s[1], x2[2] * c[2] + x1[2] * s[2], x2[3] * c[3] + x1[3] * s[3]};
        *(uint2*)(dstrow + d) = pack4(o1);
        *(uint2*)(dstrow + d + 32) = pack4(o2);
    }
}

template <int AMODE, int EPI>
__device__ __forceinline__ void gemm_phase(const u16* __restrict__ A, int lda, const u16* __restrict__ Bt, int M, int Npad, int K, int vboff, const EpiArgs& e, unsigned char* smem, int tid_, int bid_) {
    const int tid = tid_, lane = tid & 63, w = tid >> 6, wm = w & 3, wn = w >> 2;
    const int c16 = lane & 15, q4 = lane >> 4;
    const int ntm = (M + 255) >> 8, ntn = Npad >> 7, nk = K >> 6;
    const int kstride = (AMODE == AM_GATHER) ? 256 : 64;
    const int ldc = tid & 7, ldr = tid >> 3;
    const unsigned wofs = ldr * 128 + ((ldc ^ ((ldr >> 1) & 7)) << 4);
    const int swz = (c16 >> 1) & 7;
    const float* cosT = (const float*)(e.ws + OFF_COS);
    const float* sinT = (const float*)(e.ws + OFF_SIN);
    int vb = bid_ + vboff; if (vb >= (int)gridDim.x) vb -= gridDim.x;
    const int xcd = vb & 7, loc = vb >> 3, nloc = gridDim.x >> 3;
    const int mpx = ntm >> 3, nfull = (ntn >> 3), bwl = ntn - (nfull << 3);
    const int tfull = nfull * mpx * 8, ttotal = mpx * ntn;
    for (int tl = loc; tl < ttotal; tl += nloc) {
        int mloc, nt;
        if (tl < tfull) { const int band = tl / (mpx * 8), r = tl - band * (mpx * 8); mloc = r >> 3; nt = band * 8 + (r & 7); }
        else { const int r = tl - tfull; mloc = r / bwl; nt = (nfull << 3) + (r - mloc * bwl); }
        const int mt = xcd * mpx + mloc;
        const int m0 = mt << 8, n0 = nt << 7;
        unsigned aoff[4];
#pragma unroll
        for (int i = 0; i < 4; ++i) {
            int m = m0 + ldr + 64 * i; if (m > M - 1) m = M - 1;
            if (AMODE == AM_GATHER) { const int g = m & 3, bn = m >> 2, b = bn / 1023, n = bn - b * 1023; aoff[i] = (unsigned)((b * S_ + n * 16) * 256 + g * 64 + ldc * 8); }
            else aoff[i] = (unsigned)m * (unsigned)lda + ldc * 8;
        }
        const u16* bp = Bt + (size_t)(n0 + ldr) * K + ldc * 8;
        u32x4 ra0[4], rb0[2], ra1[4], rb1[2];
        f32x4 acc[4][4];
#pragma unroll
        for (int a = 0; a < 4; ++a)
#pragma unroll
            for (int b = 0; b < 4; ++b) acc[a][b] = (f32x4){0.f, 0.f, 0.f, 0.f};
        auto g_load = [&](u32x4 (&RA)[4], u32x4 (&RB)[2], int KT) __attribute__((always_inline)) {
#pragma unroll
            for (int i = 0; i < 4; ++i) RA[i] = *(const u32x4*)(A + aoff[i] + KT * kstride);
#pragma unroll
            for (int i = 0; i < 2; ++i) RB[i] = *(const u32x4*)(bp + (size_t)i * 64 * K + KT * 64);
        };
        auto g_store = [&](const u32x4 (&RA)[4], const u32x4 (&RB)[2], int ST) __attribute__((always_inline)) {
            unsigned char* d_ = smem + ST * 49152;
#pragma unroll
            for (int i = 0; i < 4; ++i) *(u32x4*)(d_ + wofs + i * 8192) = RA[i];
#pragma unroll
            for (int i = 0; i < 2; ++i) *(u32x4*)(d_ + 32768 + wofs + i * 8192) = RB[i];
        };
        auto g_compute = [&](int ST) __attribute__((always_inline)) {
            const unsigned char* sA = smem + ST * 49152;
            const unsigned char* sB = sA + 32768;
#pragma unroll
            for (int ks = 0; ks < 2; ++ks) {
                bf16x8 wf[4], af[4];
                const int ch = ((ks * 4 + q4) ^ swz) << 4;
#pragma unroll
                for (int ni = 0; ni < 4; ++ni) wf[ni] = *(const bf16x8*)(sB + (wn * 64 + ni * 16 + c16) * 128 + ch);
#pragma unroll
                for (int mi = 0; mi < 4; ++mi) af[mi] = *(const bf16x8*)(sA + (wm * 64 + mi * 16 + c16) * 128 + ch);
#pragma unroll
                for (int ni = 0; ni < 4; ++ni)
#pragma unroll
                    for (int mi = 0; mi < 4; ++mi) acc[ni][mi] = mfma16(wf[ni], af[mi], acc[ni][mi]);
            }
        };
        g_load(ra0, rb0, 0);
        g_load(ra1, rb1, 1);
        g_store(ra0, rb0, 0);
        __syncthreads();
        for (int kt = 0; kt < nk; kt += 2) {
            if (kt + 2 < nk) g_load(ra0, rb0, kt + 2);
            g_compute(0);
            g_store(ra1, rb1, 1);
            __syncthreads();
            if (kt + 3 < nk) g_load(ra1, rb1, kt + 3);
            g_compute(1);
            if (kt + 2 < nk) g_store(ra0, rb0, 0);
            __syncthreads();
        }
        float ivr[8];
        if (EPI == EPI_AIN || EPI == EPI_BQ || EPI == EPI_BKV) rope_ivr(ivr, q4);
        const int nb = n0 + wn * 64;
        if (EPI == EPI_RESID) {
#pragma unroll
            for (int mi = 0; mi < 4; ++mi) {
                const size_t tok = m0 + wm * 64 + mi * 16 + c16;
#pragma unroll
                for (int ni = 0; ni < 4; ++ni) {
                    const int n = nb + ni * 16 + q4 * 4;
                    float4 r = *(const float4*)(e.resid + tok * 1024 + n);
                    r.x += acc[ni][mi][0]; r.y += acc[ni][mi][1]; r.z += acc[ni][mi][2]; r.w += acc[ni][mi][3];
                    *(float4*)(e.out + tok * 1024 + n) = r;
                }
            }
        } else if (EPI == EPI_CMP1) {
#pragma unroll
            for (int mi = 0; mi < 4; ++mi) {
                const int m = m0 + wm * 64 + mi * 16 + c16;
                if (m < M) {
#pragma unroll
                    for (int ni = 0; ni < 4; ++ni) {
                        const int n = nb + ni * 16 + q4 * 4;
                        const float4 bv = *(const float4*)(e.bias + n);
                        f32x4 o = {gelu_tanh(acc[ni][mi][0] + bv.x), gelu_tanh(acc[ni][mi][1] + bv.y), gelu_tanh(acc[ni][mi][2] + bv.z), gelu_tanh(acc[ni][mi][3] + bv.w)};
                        *(uint2*)(e.hid + (size_t)m * 256 + n) = pack4(o);
                    }
                }
            }
        } else if (EPI == EPI_BQ) {
            u16* Q = (u16*)(e.ws + OFF_Q);
#pragma unroll
            for (int mi = 0; mi < 4; ++mi) {
                const int tok = m0 + wm * 64 + mi * 16 + c16;
                rope_store_fly(acc, mi, Q + (size_t)tok * 1024 + nb, ivr, tok & (S_ - 1), q4);
            }
        } else if (EPI == EPI_BKV) {
            u16* KSH = (u16*)(e.ws + OFF_KSH); u16* VSHT = (u16*)(e.ws + OFF_VSHT);
#pragma unroll
            for (int mi = 0; mi < 4; ++mi) {
                const int tok = m0 + wm * 64 + mi * 16 + c16, b = tok >> 14, s = tok & (S_ - 1);
                if (nb < 128) {
                    const int g = nb >> 6;
                    rope_store_fly(acc, mi, KSH + ((size_t)(b * 2 + g) * S_ + s) * 64, ivr, s, q4);
                } else {
                    const int g = (nb - 128) >> 6;
#pragma unroll
                    for (int ni = 0; ni < 4; ++ni)
#pragma unroll
                        for (int i = 0; i < 4; ++i) VSHT[((size_t)(b * 2 + g) * 64 + ni * 16 + q4 * 4 + i) * S_ + s] = f2bf(acc[ni][mi][i]);
                }
            }
        } else if (EPI == EPI_AIN) {
            unsigned char* ws = e.ws;
#pragma unroll
            for (int mi = 0; mi < 4; ++mi) {
                const int tok = m0 + wm * 64 + mi * 16 + c16, b = tok >> 14, s = tok & (S_ - 1);
                if (nb < 1024) {
                    rope_store_fly(acc, mi, (u16*)(ws + OFF_Q) + (size_t)tok * 1024 + nb, ivr, s, q4);
                } else if (nb < 1536) {
                    u16* dst = (nb < 1280) ? ((u16*)(ws + OFF_KC) + (size_t)tok * 256 + (nb - 1024)) : ((u16*)(ws + OFF_VC) + (size_t)tok * 256 + (nb - 1280));
#pragma unroll
                    for (int ni = 0; ni < 4; ++ni) *(uint2*)(dst + ni * 16 + q4 * 4) = pack4(acc[ni][mi]);
                } else if (nb < 2560) {
                    const int r = (nb - 1536) >> 8;
                    const int g = ((nb - 1536) & 255) >> 6;
                    if (r == 0) {
                        unsigned char* kd = (unsigned char*)(ws + OFF_KS) + (size_t)(b * 4 + g) * S_ * 128 + (size_t)s * 64;
#pragma unroll
                        for (int ni = 0; ni < 2; ++ni) {
                            const int d = ni * 16 + q4 * 4;
                            float c[4], sn[4];
                            rope_cs(ivr, ni, s, c, sn);
                            const f32x4 x1 = acc[ni][mi], x2 = acc[ni + 2][mi];
                            *(unsigned*)(kd + d) = pk4_fp8(x1[0] * c[0] - x2[0] * sn[0], x1[1] * c[1] - x2[1] * sn[1], x1[2] * c[2] - x2[2] * sn[2], x1[3] * c[3] - x2[3] * sn[3]);
                            *(unsigned*)(kd + d + 32) = pk4_fp8(x2[0] * c[0] + x1[0] * sn[0], x2[1] * c[1] + x1[1] * sn[1], x2[2] * c[2] + x1[2] * sn[2], x2[3] * c[3] + x1[3] * sn[3]);
                        }
                    } else if (r == 2) {
                        u16* base = (u16*)(ws + OFF_KW);
                        rope_store_fly(acc, mi, base + ((size_t)(b * 4 + g) * S_ + s) * 64, ivr, s, q4);
                    } else {
                        if (r == 1) {
                            unsigned char* base = (unsigned char*)(ws + OFF_VST) + (size_t)(b * 4 + g) * 128 * S_ + (size_t)(s >> 6) * 4096 + (s & 63);
#pragma unroll
                            for (int ni = 0; ni < 4; ++ni) {
                                const unsigned pk = pk4_fp8(acc[ni][mi][0], acc[ni][mi][1], acc[ni][mi][2], acc[ni][mi][3]);
#pragma unroll
                                for (int i = 0; i < 4; ++i) base[(ni * 16 + q4 * 4 + i) * 64] = (unsigned char)(pk >> (8 * i));
                            }
                        } else {
                            u16* base = (u16*)(ws + OFF_VWT);
#pragma unroll
                            for (int ni = 0; ni < 4; ++ni)
#pragma unroll
                                for (int i = 0; i < 4; ++i) base[((size_t)(b * 4 + g) * 64 + ni * 16 + q4 * 4 + i) * S_ + s] = f2bf(acc[ni][mi][i]);
                        }
                    }
                } else if (nb == 2560) {
                    float* G = (float*)(ws + OFF_GATES) + (size_t)tok * 48;
#pragma unroll
                    for (int ni = 0; ni < 3; ++ni) {
                        const int n = ni * 16 + q4 * 4;
                        *(float4*)(G + n) = make_float4(sigmoidf_(acc[ni][mi][0]), sigmoidf_(acc[ni][mi][1]), sigmoidf_(acc[ni][mi][2]), sigmoidf_(acc[ni][mi][3]));
                    }
                }
            }
        } else if (EPI == EPI_FFNIN) {
            float* U = (float*)smem;
#pragma unroll
            for (int mi = 0; mi < 4; ++mi) {
                const int row = wm * 64 + mi * 16 + c16;
#pragma unroll
                for (int ni = 0; ni < 4; ++ni) {
                    const int chunk = wn * 16 + ni * 4 + q4;
                    *(f32x4*)(U + row * 128 + ((chunk ^ (row & 31)) << 2)) = acc[ni][mi];
                }
            }
            __syncthreads();
            {
                const int ca = tid & 15, seg = tid >> 4;
                const int ncol = nt * 64 + ca * 4;
                const float4 w0a = *(const float4*)(e.convw + ncol), w1a = *(const float4*)(e.convw + NFF2 + ncol), w2a = *(const float4*)(e.convw + 2 * NFF2 + ncol);
                const float4 w0g = *(const float4*)(e.convw + DFF + ncol), w1g = *(const float4*)(e.convw + NFF2 + DFF + ncol), w2g = *(const float4*)(e.convw + 2 * NFF2 + DFF + ncol);
                const float4 ba = *(const float4*)(e.convb + ncol), bg = *(const float4*)(e.convb + DFF + ncol);
                float* head = (float*)(e.ws + OFF_HEAD); float* halo = (float*)(e.ws + OFF_HALO);
                u16* act = (u16*)(e.ws + OFF_ACT);
                const int r0 = seg * 8;
                float4 a2 = make_float4(0.f, 0.f, 0.f, 0.f), a1 = a2, g2 = a2, g1 = a2;
                if (seg > 0) {
                    const int rA = r0 - 2, rB = r0 - 1;
                    a2 = *(const float4*)(U + rA * 128 + ((ca ^ (rA & 31)) << 2)); g2 = *(const float4*)(U + rA * 128 + (((16 + ca) ^ (rA & 31)) << 2));
                    a1 = *(const float4*)(U + rB * 128 + ((ca ^ (rB & 31)) << 2)); g1 = *(const float4*)(U + rB * 128 + (((16 + ca) ^ (rB & 31)) << 2));
                }
#pragma unroll
                for (int r = 0; r < 8; ++r) {
                    const int row = r0 + r;
                    const float4 ua = *(const float4*)(U + row * 128 + ((ca ^ (row & 31)) << 2));
                    const float4 ug = *(const float4*)(U + row * 128 + (((16 + ca) ^ (row & 31)) << 2));
                    if (seg > 0 || r >= 2) {
                        float ca_[4], cg_[4];
                        ca_[0] = ba.x + w0a.x * a2.x + w1a.x * a1.x + w2a.x * ua.x; ca_[1] = ba.y + w0a.y * a2.y + w1a.y * a1.y + w2a.y * ua.y;
                        ca_[2] = ba.z + w0a.z * a2.z + w1a.z * a1.z + w2a.z * ua.z; ca_[3] = ba.w + w0a.w * a2.w + w1a.w * a1.w + w2a.w * ua.w;
                        cg_[0] = bg.x + w0g.x * g2.x + w1g.x * g1.x + w2g.x * ug.x; cg_[1] = bg.y + w0g.y * g2.y + w1g.y * g1.y + w2g.y * ug.y;
                        cg_[2] = bg.z + w0g.z * g2.z + w1g.z * g1.z + w2g.z * ug.z; cg_[3] = bg.w + w0g.w * g2.w + w1g.w * g1.w + w2g.w * ug.w;
                        f32x4 o = {ca_[0] * sigmoidf_(ca_[0]) * cg_[0], ca_[1] * sigmoidf_(ca_[1]) * cg_[1], ca_[2] * sigmoidf_(ca_[2]) * cg_[2], ca_[3] * sigmoidf_(ca_[3]) * cg_[3]};
                        *(uint2*)(act + (size_t)(m0 + row) * DFF + ncol) = pack4(o);
                    }
                    if (seg == 0 && r < 2) { *(float4*)(head + (size_t)(mt * 2 + r) * NFF2 + ncol) = ua; *(float4*)(head + (size_t)(mt * 2 + r) * NFF2 + DFF + ncol) = ug; }
                    if (seg == 31 && r >= 6) { *(float4*)(halo + (size_t)(mt * 2 + r - 6) * NFF2 + ncol) = ua; *(float4*)(halo + (size_t)(mt * 2 + r - 6) * NFF2 + DFF + ncol) = ug; }
                    a2 = a1; a1 = ua; g2 = g1; g1 = ug;
                }
            }
            __syncthreads();
        }
    }
}

template <int AMODE, int EPI>
__device__ __forceinline__ void gemm_big(const u16* __restrict__ A, int lda, const u16* __restrict__ Bt, int M, int Npad, int K, int vboff, const EpiArgs& e, unsigned char* smem, int tid_, int bid_) {
    const int tid = tid_, lane = tid & 63, w = tid >> 6, wm = w & 1, wn = w >> 1;
    const int c16 = lane & 15, q4 = lane >> 4;
    constexpr int MI = 8;
    const int ntm = (M + 255) >> 8, ntn = Npad >> 8, nk = K >> 5;
    const int kstride = (AMODE == AM_GATHER) ? 128 : 32;
    const float* cosT = (const float*)(e.ws + OFF_COS);
    const float* sinT = (const float*)(e.ws + OFF_SIN);
    int vb = bid_ + vboff; if (vb >= (int)gridDim.x) vb -= gridDim.x;
    const int xcd = vb & 7, loc = vb >> 3, nloc = gridDim.x >> 3;
    const int mpx = ntm >> 3, nfull = (ntn >> 3), bwl = ntn - (nfull << 3);
    const int tfull = nfull * mpx * 8, ttotal = mpx * ntn;
    for (int tl = loc; tl < ttotal; tl += nloc) {
        int mloc, nt;
        if (tl < tfull) { const int band = tl / (mpx * 8), r = tl - band * (mpx * 8); mloc = r >> 3; nt = band * 8 + (r & 7); }
        else { const int r = tl - tfull; mloc = r / bwl; nt = (nfull << 3) + (r - mloc * bwl); }
        const int mt = xcd * mpx + mloc;
        const int m0 = mt << 8, n0 = nt << 8;
        const int prow = ((w & 3) << 6) + (lane >> 3);
        const int pch = lane & 7;
        unsigned goff[8];
#pragma unroll
        for (int i = 0; i < 8; ++i) {
            const int row = prow + 8 * i;
            const int lc = pch ^ ((row >> 1) & 7);
            if (w < 4) {
                int m = m0 + row; if (m > M - 1) m = M - 1;
                if (AMODE == AM_GATHER) { const int gq = m & 3, bn = m >> 2, bb = bn / 1023, n = bn - bb * 1023; goff[i] = (unsigned)((bb * S_ + n * 16) * 256 + gq * 64 + lc * 8); }
                else goff[i] = (unsigned)m * (unsigned)lda + (unsigned)(lc * 8);
            } else goff[i] = (unsigned)(n0 + row) * (unsigned)K + (unsigned)(lc * 8);
        }
        const u16* gbase = (w < 4) ? A : Bt;
        const unsigned kst = (w < 4 && AMODE == AM_GATHER) ? 256u : 64u;
        typedef __attribute__((address_space(3))) unsigned* lds_u32p;
        const unsigned lbase = ((w < 4) ? 0u : 32768u) + (unsigned)(((w & 3) << 6) * 128) + (unsigned)lane * 16u;
        f32x4 acc[4][MI];
#pragma unroll
        for (int a2 = 0; a2 < 4; ++a2)
#pragma unroll
            for (int b2 = 0; b2 < MI; ++b2) acc[a2][b2] = (f32x4){0.f, 0.f, 0.f, 0.f};
        const int swz = (c16 >> 1) & 7;
        const int nk2 = nk >> 1;
#pragma unroll
        for (int i = 0; i < 8; ++i) __builtin_amdgcn_global_load_lds((const unsigned*)(gbase + goff[i]), (lds_u32p)(smem + lbase + i * 1024), 16, 0, 0);
        for (int kt = 0; kt < nk2; ++kt) {
            asm volatile("s_waitcnt vmcnt(0)" ::: "memory");
            __builtin_amdgcn_s_barrier();
            const unsigned char* sA = smem + (kt & 1) * 65536;
            const unsigned char* sB = sA + 32768;
            const bool more = kt + 1 < nk2;
            const unsigned ko = (unsigned)(kt + 1) * kst;
            unsigned char* sbn = smem + ((kt + 1) & 1) * 65536 + lbase;
#pragma unroll
            for (int ks = 0; ks < 2; ++ks) {
                bf16x8 wf[4], af[MI];
                const int ch = ((ks * 4 + q4) ^ swz) << 4;
#pragma unroll
                for (int ni = 0; ni < 4; ++ni) wf[ni] = *(const bf16x8*)(sB + (wn * 64 + ni * 16 + c16) * 128 + ch);
#pragma unroll
                for (int mi = 0; mi < MI; ++mi) af[mi] = *(const bf16x8*)(sA + (wm * 128 + mi * 16 + c16) * 128 + ch);
#pragma unroll
                for (int ni = 0; ni < 4; ++ni) {
                    if (more) __builtin_amdgcn_global_load_lds((const unsigned*)(gbase + (goff[ks * 4 + ni] + ko)), (lds_u32p)(sbn + (ks * 4 + ni) * 1024), 16, 0, 0);
#pragma unroll
                    for (int mi = 0; mi < MI; ++mi) acc[ni][mi] = mfma16(wf[ni], af[mi], acc[ni][mi]);
                }
            }
        }
        __syncthreads();
        const int nb = n0 + wn * 64;
        if (EPI == EPI_RESID) {
#pragma unroll
            for (int mi = 0; mi < MI; ++mi) { __builtin_amdgcn_sched_barrier(0);
                const size_t tok = m0 + wm * 128 + mi * 16 + c16;
#pragma unroll
                for (int ni = 0; ni < 4; ++ni) {
                    const int n = nb + ni * 16 + q4 * 4;
                    float4 r = *(const float4*)(e.resid + tok * 1024 + n);
                    r.x += acc[ni][mi][0]; r.y += acc[ni][mi][1]; r.z += acc[ni][mi][2]; r.w += acc[ni][mi][3];
                    *(float4*)(e.out + tok * 1024 + n) = r;
                }
            }
        } else if (EPI == EPI_CMP1) {
#pragma unroll
            for (int mi = 0; mi < MI; ++mi) { __builtin_amdgcn_sched_barrier(0);
                const int m = m0 + wm * 128 + mi * 16 + c16;
                if (m < M) {
#pragma unroll
                    for (int ni = 0; ni < 4; ++ni) {
                        const int n = nb + ni * 16 + q4 * 4;
                        const float4 bv = *(const float4*)(e.bias + n);
                        f32x4 o = {gelu_tanh(acc[ni][mi][0] + bv.x), gelu_tanh(acc[ni][mi][1] + bv.y), gelu_tanh(acc[ni][mi][2] + bv.z), gelu_tanh(acc[ni][mi][3] + bv.w)};
                        *(uint2*)(e.hid + (size_t)m * 256 + n) = pack4(o);
                    }
                }
            }
        } else if (EPI == EPI_BQ) {
            u16* Q = (u16*)(e.ws + OFF_Q);
#pragma unroll
            for (int mi = 0; mi < MI; ++mi) { __builtin_amdgcn_sched_barrier(0);
                const int tok = m0 + wm * 128 + mi * 16 + c16;
                rope_store(acc, mi, Q + (size_t)tok * 1024 + nb, cosT, sinT, tok & (S_ - 1), q4);
            }
        } else if (EPI == EPI_BKV) {
            u16* KSH = (u16*)(e.ws + OFF_KSH); u16* VSHT = (u16*)(e.ws + OFF_VSHT);
#pragma unroll
            for (int mi = 0; mi < MI; ++mi) { __builtin_amdgcn_sched_barrier(0);
                const int tok = m0 + wm * 128 + mi * 16 + c16, b = tok >> 14, s = tok & (S_ - 1);
                if (nb < 128) {
                    const int g = nb >> 6;
                    rope_store(acc, mi, KSH + ((size_t)(b * 2 + g) * S_ + s) * 64, cosT, sinT, s, q4);
                } else {
                    const int g = (nb - 128) >> 6;
#pragma unroll
                    for (int ni = 0; ni < 4; ++ni)
#pragma unroll
                        for (int i = 0; i < 4; ++i) VSHT[((size_t)(b * 2 + g) * 64 + ni * 16 + q4 * 4 + i) * S_ + s] = f2bf(acc[ni][mi][i]);
                }
            }
        } else if (EPI == EPI_AIN) {
            unsigned char* ws = e.ws;
#pragma unroll
            for (int mi = 0; mi < MI; ++mi) { __builtin_amdgcn_sched_barrier(0);
                const int tok = m0 + wm * 128 + mi * 16 + c16, b = tok >> 14, s = tok & (S_ - 1);
                if (nb < 1024) {
                    rope_store(acc, mi, (u16*)(ws + OFF_Q) + (size_t)tok * 1024 + nb, cosT, sinT, s, q4);
                } else if (nb < 1536) {
                    u16* dst = (nb < 1280) ? ((u16*)(ws + OFF_KC) + (size_t)tok * 256 + (nb - 1024)) : ((u16*)(ws + OFF_VC) + (size_t)tok * 256 + (nb - 1280));
#pragma unroll
                    for (int ni = 0; ni < 4; ++ni) *(uint2*)(dst + ni * 16 + q4 * 4) = pack4(acc[ni][mi]);
                } else if (nb < 2560) {
                    const int r = (nb - 1536) >> 8;
                    const int g = ((nb - 1536) & 255) >> 6;
                    if (r == 0) {
                        unsigned char* kd = (unsigned char*)(ws + OFF_KS) + (size_t)(b * 4 + g) * S_ * 128 + (size_t)s * 64;
#pragma unroll
                        for (int ni = 0; ni < 2; ++ni) {
                            const int d = ni * 16 + q4 * 4;
                            const float4 c = *(const float4*)(cosT + s * 32 + d), sn = *(const float4*)(sinT + s * 32 + d);
                            const f32x4 x1 = acc[ni][mi], x2 = acc[ni + 2][mi];
                            *(unsigned*)(kd + d) = pk4_fp8(x1[0] * c.x - x2[0] * sn.x, x1[1] * c.y - x2[1] * sn.y, x1[2] * c.z - x2[2] * sn.z, x1[3] * c.w - x2[3] * sn.w);
                            *(unsigned*)(kd + d + 32) = pk4_fp8(x2[0] * c.x + x1[0] * sn.x, x2[1] * c.y + x1[1] * sn.y, x2[2] * c.z + x1[2] * sn.z, x2[3] * c.w + x1[3] * sn.w);
                        }
                    } else if (r == 2) {
                        u16* base = (u16*)(ws + OFF_KW);
                        rope_store(acc, mi, base + ((size_t)(b * 4 + g) * S_ + s) * 64, cosT, sinT, s, q4);
                    } else {
                        if (r == 1) {
                            unsigned char* base = (unsigned char*)(ws + OFF_VST) + (size_t)(b * 4 + g) * 128 * S_ + (size_t)(s >> 6) * 4096 + (s & 63);
#pragma unroll
                            for (int ni = 0; ni < 4; ++ni) {
                                const unsigned pk = pk4_fp8(acc[ni][mi][0], acc[ni][mi][1], acc[ni][mi][2], acc[ni][mi][3]);
#pragma unroll
                                for (int i = 0; i < 4; ++i) base[(ni * 16 + q4 * 4 + i) * 64] = (unsigned char)(pk >> (8 * i));
                            }
                        } else {
                            u16* base = (u16*)(ws + OFF_VWT);
#pragma unroll
                            for (int ni = 0; ni < 4; ++ni)
#pragma unroll
                                for (int i = 0; i < 4; ++i) base[((size_t)(b * 4 + g) * 64 + ni * 16 + q4 * 4 + i) * S_ + s] = f2bf(acc[ni][mi][i]);
                        }
                    }
                } else if (nb == 2560) {
                    float* G = (float*)(ws + OFF_GATES) + (size_t)tok * 48;
#pragma unroll
                    for (int ni = 0; ni < 3; ++ni) {
                        const int n = ni * 16 + q4 * 4;
                        *(float4*)(G + n) = make_float4(sigmoidf_(acc[ni][mi][0]), sigmoidf_(acc[ni][mi][1]), sigmoidf_(acc[ni][mi][2]), sigmoidf_(acc[ni][mi][3]));
                    }
                }
            }
        } else if (EPI == EPI_FFNIN) {
            u16* U = (u16*)smem;
#pragma unroll
            for (int mi = 0; mi < MI; ++mi) {
                const int row = wm * 128 + mi * 16 + c16;
#pragma unroll
                for (int ni = 0; ni < 4; ++ni) {
                    const int cch = wn * 16 + ni * 4 + q4;
                    *(uint2*)(U + row * 256 + ((cch ^ (row & 15)) << 2)) = pack4(acc[ni][mi]);
                }
            }
            __syncthreads();
            {
                const int cc = tid & 31, gsel = cc >> 4, ca = cc & 15, seg = tid >> 5;
                const int ncol = (nt * 2 + gsel) * 64 + ca * 4;
                const int cha = gsel * 32 + ca, chg = cha + 16;
                const float4 w0a = *(const float4*)(e.convw + ncol), w1a = *(const float4*)(e.convw + NFF2 + ncol), w2a = *(const float4*)(e.convw + 2 * NFF2 + ncol);
                const float4 w0g = *(const float4*)(e.convw + DFF + ncol), w1g = *(const float4*)(e.convw + NFF2 + DFF + ncol), w2g = *(const float4*)(e.convw + 2 * NFF2 + DFF + ncol);
                const float4 ba = *(const float4*)(e.convb + ncol), bg = *(const float4*)(e.convb + DFF + ncol);
                float* head = (float*)(e.ws + OFF_HEAD); float* halo = (float*)(e.ws + OFF_HALO);
                u16* act = (u16*)(e.ws + OFF_ACT);
                auto ldu = [&](int row, int ch) __attribute__((always_inline)) -> float4 {
                    const uint2 v = *(const uint2*)(U + row * 256 + ((ch ^ (row & 15)) << 2));
                    return make_float4(__uint_as_float(v.x << 16), __uint_as_float(v.x & 0xffff0000u), __uint_as_float(v.y << 16), __uint_as_float(v.y & 0xffff0000u));
                };
                const int r0 = seg * 16;
                float4 a2 = make_float4(0.f, 0.f, 0.f, 0.f), a1 = a2, g2 = a2, g1 = a2;
                if (seg > 0) { a2 = ldu(r0 - 2, cha); g2 = ldu(r0 - 2, chg); a1 = ldu(r0 - 1, cha); g1 = ldu(r0 - 1, chg); }
#pragma unroll 2
                for (int r = 0; r < 16; ++r) {
                    const int row = r0 + r;
                    const float4 ua = ldu(row, cha), ug = ldu(row, chg);
                    if (seg > 0 || r >= 2) {
                        float ca_[4], cg_[4];
                        ca_[0] = ba.x + w0a.x * a2.x + w1a.x * a1.x + w2a.x * ua.x; ca_[1] = ba.y + w0a.y * a2.y + w1a.y * a1.y + w2a.y * ua.y;
                        ca_[2] = ba.z + w0a.z * a2.z + w1a.z * a1.z + w2a.z * ua.z; ca_[3] = ba.w + w0a.w * a2.w + w1a.w * a1.w + w2a.w * ua.w;
                        cg_[0] = bg.x + w0g.x * g2.x + w1g.x * g1.x + w2g.x * ug.x; cg_[1] = bg.y + w0g.y * g2.y + w1g.y * g1.y + w2g.y * ug.y;
                        cg_[2] = bg.z + w0g.z * g2.z + w1g.z * g1.z + w2g.z * ug.z; cg_[3] = bg.w + w0g.w * g2.w + w1g.w * g1.w + w2g.w * ug.w;
                        f32x4 o = {ca_[0] * sigmoidf_(ca_[0]) * cg_[0], ca_[1] * sigmoidf_(ca_[1]) * cg_[1], ca_[2] * sigmoidf_(ca_[2]) * cg_[2], ca_[3] * sigmoidf_(ca_[3]) * cg_[3]};
                        *(uint2*)(act + (size_t)(m0 + row) * DFF + ncol) = pack4(o);
                    }
                    if (seg == 0 && r < 2) { *(float4*)(head + (size_t)(mt * 2 + r) * NFF2 + ncol) = ua; *(float4*)(head + (size_t)(mt * 2 + r) * NFF2 + DFF + ncol) = ug; }
                    if (seg == 15 && r >= 14) { *(float4*)(halo + (size_t)(mt * 2 + r - 14) * NFF2 + ncol) = ua; *(float4*)(halo + (size_t)(mt * 2 + r - 14) * NFF2 + DFF + ncol) = ug; }
                    a2 = a1; a1 = ua; g2 = g1; g1 = ug;
                }
            }
            __syncthreads();
        }
    }
}

__device__ __forceinline__ void fixup_phase(const Params& p, int L, int tid_, int bid_) {
    const float* head = (const float*)(p.ws + OFF_HEAD); const float* halo = (const float*)(p.ws + OFF_HALO);
    u16* act = (u16*)(p.ws + OFF_ACT);
    const float* cw = p.ffn_conv_w + (size_t)L * 3 * NFF2; const float* cb = p.ffn_conv_b + (size_t)L * NFF2;
    const int gt = bid_ * NTHR + tid_, nthr = gridDim.x * NTHR;
    for (int idx = gt; idx < 128 * 704; idx += nthr) {
        const int i = idx / 704, n = (idx - i * 704) * 4;
        const int t0 = i * 256;
        const bool first = (t0 & (S_ - 1)) == 0;
        const float4 z = make_float4(0.f, 0.f, 0.f, 0.f);
        const float4 ha0 = *(const float4*)(head + (size_t)(i * 2) * NFF2 + n), ha1 = *(const float4*)(head + (size_t)(i * 2 + 1) * NFF2 + n);
        const float4 hg0 = *(const float4*)(head + (size_t)(i * 2) * NFF2 + DFF + n), hg1 = *(const float4*)(head + (size_t)(i * 2 + 1) * NFF2 + DFF + n);
        float4 pa0 = z, pa1 = z, pg0 = z, pg1 = z;
        if (!first) {
            pa0 = *(const float4*)(halo + (size_t)(i * 2 - 2) * NFF2 + n); pa1 = *(const float4*)(halo + (size_t)(i * 2 - 1) * NFF2 + n);
            pg0 = *(const float4*)(halo + (size_t)(i * 2 - 2) * NFF2 + DFF + n); pg1 = *(const float4*)(halo + (size_t)(i * 2 - 1) * NFF2 + DFF + n);
        }
        const float4 w0a = *(const float4*)(cw + n), w1a = *(const float4*)(cw + NFF2 + n), w2a = *(const float4*)(cw + 2 * NFF2 + n);
        const float4 w0g = *(const float4*)(cw + DFF + n), w1g = *(const float4*)(cw + NFF2 + DFF + n), w2g = *(const float4*)(cw + 2 * NFF2 + DFF + n);
        const float4 ba = *(const float4*)(cb + n), bg = *(const float4*)(cb + DFF + n);
#define CONV3(b_, w0_, w1_, w2_, x0_, x1_, x2_) make_float4(b_.x + w0_.x * x0_.x + w1_.x * x1_.x + w2_.x * x2_.x, b_.y + w0_.y * x0_.y + w1_.y * x1_.y + w2_.y * x2_.y, \
                                                             b_.z + w0_.z * x0_.z + w1_.z * x1_.z + w2_.z * x2_.z, b_.w + w0_.w * x0_.w + w1_.w * x1_.w + w2_.w * x2_.w)
        const float4 ca0 = CONV3(ba, w0a, w1a, w2a, pa0, pa1, ha0), cg0 = CONV3(bg, w0g, w1g, w2g, pg0, pg1, hg0);
        const float4 ca1 = CONV3(ba, w0a, w1a, w2a, pa1, ha0, ha1), cg1 = CONV3(bg, w0g, w1g, w2g, pg1, hg0, hg1);
        f32x4 o0 = {ca0.x * sigmoidf_(ca0.x) * cg0.x, ca0.y * sigmoidf_(ca0.y) * cg0.y, ca0.z * sigmoidf_(ca0.z) * cg0.z, ca0.w * sigmoidf_(ca0.w) * cg0.w};
        f32x4 o1 = {ca1.x * sigmoidf_(ca1.x) * cg1.x, ca1.y * sigmoidf_(ca1.y) * cg1.y, ca1.z * sigmoidf_(ca1.z) * cg1.z, ca1.w * sigmoidf_(ca1.w) * cg1.w};
        *(uint2*)(act + (size_t)t0 * DFF + n) = pack4(o0);
        *(uint2*)(act + (size_t)(t0 + 1) * DFF + n) = pack4(o1);
    }
}

__device__ __forceinline__ void cmp2_phase(const Params& p, int L, int tid_, int bid_) {
    const int lane = tid_ & 63, w = tid_ >> 6, c16 = lane & 15, q4 = lane >> 4;
    const float* cosT = (const float*)(p.ws + OFF_COS); const float* sinT = (const float*)(p.ws + OFF_SIN);
    u16* KCC = (u16*)(p.ws + OFF_KCC); u16* VCCT = (u16*)(p.ws + OFF_VCCT);
    for (int task = bid_ * NW + w; task < 1024; task += gridDim.x * NW) {
        const int kv = task >> 9, r0 = (task & 511) * 16;
        const u16* hid = (const u16*)(p.ws + OFF_HID) + (size_t)kv * 8192 * 256;
        const u16* w2t = (const u16*)(p.ws + OFF_WT_CW2 + (L * 2 + kv) * SZ_WT_CW2);
        const int row = r0 + c16, rowc = row < 8184 ? row : 8183;
        f32x4 acc[4][1];
        f32x4 accq[4][4];
#pragma unroll
        for (int a = 0; a < 4; ++a) accq[a][0] = (f32x4){0.f, 0.f, 0.f, 0.f};
#pragma unroll
        for (int kk = 0; kk < 8; ++kk) {
            const bf16x8 bfr = *(const bf16x8*)(hid + (size_t)rowc * 256 + kk * 32 + q4 * 8);
#pragma unroll
            for (int nbk = 0; nbk < 4; ++nbk) {
                const bf16x8 afr = *(const bf16x8*)(w2t + (nbk * 16 + c16) * 256 + kk * 32 + q4 * 8);
                accq[nbk][0] = mfma16(afr, bfr, accq[nbk][0]);
            }
        }
        (void)acc;
        if (row < 8184) {
            const int g = row & 3, bn = row >> 2, b = bn / 1023, n = bn - b * 1023, bg = b * 4 + g;
            if (kv == 0) {
                rope_store(accq, 0, KCC + ((size_t)bg * 1024 + n) * 64, cosT, sinT, n * 16 + 31, q4);
            } else {
#pragma unroll
                for (int nbk = 0; nbk < 4; ++nbk)
#pragma unroll
                    for (int i = 0; i < 4; ++i) VCCT[((size_t)bg * 64 + nbk * 16 + q4 * 4 + i) * 1024 + n] = f2bf(accq[nbk][0][i]);
            }
        }
    }
    const int gt = bid_ * NTHR + tid_;
    if (gt < 512) {
        const int bg = gt >> 6, d = gt & 63;
        KCC[((size_t)bg * 1024 + 1023) * 64 + d] = 0;
        VCCT[((size_t)bg * 64 + d) * 1024 + 1023] = 0;
    }
}

template <bool SINK>
__device__ __forceinline__ void band_attn(const u16* __restrict__ qrow, const u16* __restrict__ Kh, const u16* __restrict__ VT, int t0, int W, const float* sinks4,
                                          f32x4 (&O)[4][4], float (&linv)[4], int lane) {
    const int c16 = lane & 15, q4 = lane >> 4;
    const float SC = 0.125f * LOG2E;
    bf16x8 qf[4][2];
#pragma unroll
    for (int h = 0; h < 4; ++h)
#pragma unroll
        for (int ks = 0; ks < 2; ++ks) qf[h][ks] = *(const bf16x8*)(qrow + h * 64 + ks * 32 + q4 * 8);
    float m[4], l[4];
#pragma unroll
    for (int h = 0; h < 4; ++h) {
        if (SINK) { m[h] = sinks4[h] * LOG2E; l[h] = (q4 == 0) ? 1.f : 0.f; }
        else { m[h] = NEGBIG; l[h] = 0.f; }
#pragma unroll
        for (int db = 0; db < 4; ++db) O[h][db] = (f32x4){0.f, 0.f, 0.f, 0.f};
    }
    const int t = t0 + c16;
    int lo = t0 - W + 1; if (lo < 0) lo = 0;
    const int g0 = lo >> 5, g1 = (t0 + 15) >> 5;
    const int kr = kperm(c16);
    for (int grp = g0; grp <= g1; ++grp) {
        const int kb = grp << 5;
        const unsigned kof = (unsigned)(kb + kr) * 64u + (unsigned)q4 * 8u;
        const bf16x8 k1a = *(const bf16x8*)(Kh + kof), k1b = *(const bf16x8*)(Kh + (kof + 32u)), k2a = *(const bf16x8*)(Kh + (kof + 256u)), k2b = *(const bf16x8*)(Kh + (kof + 288u));
        bf16x8 vf[4];
        const unsigned vof = (unsigned)c16 * (unsigned)S_ + (unsigned)kb + (unsigned)q4 * 8u;
#pragma unroll
        for (int db = 0; db < 4; ++db) vf[db] = *(const bf16x8*)(VT + (size_t)(db * 16 * S_) + vof);
        const int kpos = kb + q4 * 8;
        f32x4 cm1 = {0.f, 0.f, 0.f, 0.f}, cm2 = cm1;
        if (!((kb + 31 <= t0) && (kb > t0 + 15 - W))) {
#pragma unroll
            for (int i = 0; i < 4; ++i) {
                const int d1 = t - (kpos + i), d2 = t - (kpos + 4 + i);
                if (!((d1 >= 0) && (d1 < W))) cm1[i] = NEGBIG;
                if (!((d2 >= 0) && (d2 < W))) cm2[i] = NEGBIG;
            }
        }
#pragma unroll
        for (int h = 0; h < 4; ++h) {
            f32x4 s1 = mfma16(k1a, qf[h][0], cm1); s1 = mfma16(k1b, qf[h][1], s1);
            f32x4 s2 = mfma16(k2a, qf[h][0], cm2); s2 = mfma16(k2b, qf[h][1], s2);
            float mx = fmaxf(fmaxf(fmaxf(s1[0], s1[1]), fmaxf(s1[2], s1[3])), fmaxf(fmaxf(s2[0], s2[1]), fmaxf(s2[2], s2[3])));
            mx = xmax32(xmax16(mx));
            const float mn = fmaxf(fmaxf(m[h], mx * SC), -1e20f);
            if (__ballot(mn != m[h])) {
                const float alpha = fexp2(m[h] - mn);
                l[h] *= alpha;
#pragma unroll
                for (int db = 0; db < 4; ++db) O[h][db] = O[h][db] * alpha;
            }
            m[h] = mn;
            float pv[8]; float ps = 0.f;
#pragma unroll
            for (int i = 0; i < 4; ++i) { pv[i] = fexp2(fmaf(s1[i], SC, -mn)); pv[4 + i] = fexp2(fmaf(s2[i], SC, -mn)); }
#pragma unroll
            for (int i = 0; i < 8; ++i) ps += pv[i];
            l[h] += ps;
            const bf16x8 pf = pack8(pv);
#pragma unroll
            for (int db = 0; db < 4; ++db) O[h][db] = mfma16(vf[db], pf, O[h][db]);
        }
    }
#pragma unroll
    for (int h = 0; h < 4; ++h) { float lt = l[h]; lt += __shfl_xor(lt, 16); lt += __shfl_xor(lt, 32); linv[h] = 1.f / lt; }
}

__device__ __forceinline__ void swa_phase(const Params& p, int j, int tid_, int bid_) {
    const int lane = tid_ & 63, w = tid_ >> 6, c16 = lane & 15, q4 = lane >> 4;
    const int x = bid_ & 7, b = x >> 2, kvh = (x >> 1) & 1, hq = x & 1;
    const int head0 = kvh * 8 + hq * 4;
    const u16* Q = (const u16*)(p.ws + OFF_Q); u16* Ob = (u16*)(p.ws + OFF_O);
    const u16* Kh = (const u16*)(p.ws + OFF_KSH) + (size_t)(b * 2 + kvh) * S_ * 64;
    const u16* VT = (const u16*)(p.ws + OFF_VSHT) + (size_t)(b * 2 + kvh) * 64 * S_;
    const float* sk = p.b_sinks + j * 16 + head0;
    const int nslots = (gridDim.x >> 3) * NW;
    for (int tile = (bid_ >> 3) * NW + w; tile < 1024; tile += nslots) {
        const int t0 = tile * 16;
        f32x4 O[4][4]; float linv[4];
        band_attn<true>(Q + ((size_t)b * S_ + t0 + c16) * 1024 + head0 * 64, Kh, VT, t0, 128, sk, O, linv, lane);
        u16* op = Ob + ((size_t)b * S_ + t0 + c16) * 1024 + head0 * 64;
#pragma unroll
        for (int h = 0; h < 4; ++h)
#pragma unroll
            for (int db = 0; db < 4; ++db) *(uint2*)(op + h * 64 + db * 16 + q4 * 4) = pack4(O[h][db] * linv[h]);
    }
}

__device__ __forceinline__ void nsa_phase(const Params& p, unsigned char* smem, int tid_, int bid_, int probe_rep, int layer) {
    const int lane0 = tid_ & 63, w = tid_ >> 6;
    float* R = (float*)(smem + w * 16384);
    unsigned* tm = (unsigned*)(smem + NW * 16384 + w * 1024);
    unsigned char* sel = smem + NW * 16384 + NW * 1024 + w * 256;
    const int bg = bid_ & 7, b = bg >> 2, g = bg & 3;
    const u16* Q = (const u16*)(p.ws + OFF_Q); u16* Ob = (u16*)(p.ws + OFF_O);
    const u16* KCC = (const u16*)(p.ws + OFF_KCC) + (size_t)bg * 1024 * 64;
    const u16* VCCT = (const u16*)(p.ws + OFF_VCCT) + (size_t)bg * 64 * 1024;
    const u16* KS = (const u16*)(p.ws + OFF_KS) + (size_t)bg * S_ * 64;
    const u16* VST = (const u16*)(p.ws + OFF_VST) + (size_t)bg * 64 * S_;
    const u16* KW = (const u16*)(p.ws + OFF_KW) + (size_t)bg * S_ * 64;
    const u16* VWT = (const u16*)(p.ws + OFF_VWT) + (size_t)bg * 64 * S_;
    const float* GATES = (const float*)(p.ws + OFF_GATES);
    const float SC = 0.125f * LOG2E;
    const int nslots = (gridDim.x >> 3) * NW;
    unsigned* qhead = (unsigned*)(p.ws + OFF_BAR) + 4096 + (layer * 8 + bg) * 64;
    for (;;) {
        int tile_ = 0;
        if (lane0 == 0) tile_ = (int)__hip_atomic_fetch_add(qhead, 1u, __ATOMIC_RELAXED, __HIP_MEMORY_SCOPE_AGENT);
        tile_ = 1023 - __builtin_amdgcn_readfirstlane(tile_);
        if (tile_ < 0) break;
        const int tile = __builtin_amdgcn_readfirstlane(tile_);
        int lane = lane0; asm volatile("" : "+v"(lane));
        const int c16 = lane & 15, q4 = lane >> 4, kr = kperm(c16);
        const int t0 = tile * 16, cur = t0 >> 6, t = t0 + c16;
        const u16* qrow = Q + ((size_t)b * S_ + t) * 1024 + g * 256;
        const float* grow = GATES + ((size_t)b * S_ + t) * 48 + g * 12;
        const int nvl = (t >= 31) ? ((t - 31) >> 4) : -1;
        const int nvmax = (t0 + 15 >= 31) ? ((t0 + 15 - 31) >> 4) : -1;
        const int ng = (nvmax >= 0) ? ((nvmax >> 5) + 1) : 0;
        f32x4 Oc[4][4];
#pragma unroll
        for (int h = 0; h < 4; ++h)
#pragma unroll
            for (int db = 0; db < 4; ++db) Oc[h][db] = (f32x4){0.f, 0.f, 0.f, 0.f};
        {
            bf16x8 qf[4][2];
#pragma unroll
            for (int h = 0; h < 4; ++h)
#pragma unroll
                for (int ks = 0; ks < 2; ++ks) qf[h][ks] = *(const bf16x8*)(qrow + h * 64 + ks * 32 + q4 * 8);
            float m[4], l[4];
#pragma unroll
            for (int h = 0; h < 4; ++h) { m[h] = NEGBIG; l[h] = 0.f; }
            const int nvmin = (t0 >= 31) ? ((t0 - 31) >> 4) : -1;
            for (int grp = 0; grp < ng; ++grp) {
                const int kb = grp << 5;
                const unsigned kof = (unsigned)(kb + kr) * 64u + (unsigned)q4 * 8u;
                const bf16x8 k1a = *(const bf16x8*)(KCC + kof), k1b = *(const bf16x8*)(KCC + (kof + 32u)), k2a = *(const bf16x8*)(KCC + (kof + 256u)), k2b = *(const bf16x8*)(KCC + (kof + 288u));
                const int kpos = kb + q4 * 8;
                f32x4 cm1 = {0.f, 0.f, 0.f, 0.f}, cm2 = cm1;
                if (kb + 31 > nvmin) {
#pragma unroll
                    for (int i = 0; i < 4; ++i) { if (kpos + i > nvl) cm1[i] = NEGBIG; if (kpos + 4 + i > nvl) cm2[i] = NEGBIG; }
                }
#pragma unroll
                for (int h = 0; h < 4; ++h) {
                    f32x4 s1 = mfma16(k1a, qf[h][0], cm1); s1 = mfma16(k1b, qf[h][1], s1);
                    f32x4 s2 = mfma16(k2a, qf[h][0], cm2); s2 = mfma16(k2b, qf[h][1], s2);
                    float mx = fmaxf(fmaxf(fmaxf(s1[0], s1[1]), fmaxf(s1[2], s1[3])), fmaxf(fmaxf(s2[0], s2[1]), fmaxf(s2[2], s2[3])));
                    mx = xmax32(xmax16(mx));
                    const float mn = fmaxf(fmaxf(m[h], mx * SC), -1e20f);
                    if (__ballot(mn != m[h])) l[h] *= fexp2(m[h] - mn);
                    m[h] = mn;
                    float ps = 0.f;
#pragma unroll
                    for (int i = 0; i < 4; ++i) ps += fexp2(fmaf(s1[i], SC, -mn)) + fexp2(fmaf(s2[i], SC, -mn));
                    l[h] += ps;
                }
            }
            float linv[4];
#pragma unroll
            for (int h = 0; h < 4; ++h) { float lt = l[h]; lt += __shfl_xor(lt, 16); lt += __shfl_xor(lt, 32); linv[h] = lt > 0.f ? 1.f / lt : 0.f; }
            float carry = 0.f;
            for (int grp = 0; grp < ng; ++grp) {
                const int kb = grp << 5;
                const unsigned kof = (unsigned)(kb + kr) * 64u + (unsigned)q4 * 8u;
                const bf16x8 k1a = *(const bf16x8*)(KCC + kof), k1b = *(const bf16x8*)(KCC + (kof + 32u)), k2a = *(const bf16x8*)(KCC + (kof + 256u)), k2b = *(const bf16x8*)(KCC + (kof + 288u));
                bf16x8 vf[4];
#pragma unroll
                for (int db = 0; db < 4; ++db) vf[db] = *(const bf16x8*)(VCCT + (unsigned)(db * 16 * 1024) + ((unsigned)c16 * 1024u + (unsigned)kb + (unsigned)q4 * 8u));
                const int kpos = kb + q4 * 8;
                float psum[8];
#pragma unroll
                for (int i = 0; i < 8; ++i) psum[i] = 0.f;
                f32x4 cm1 = {0.f, 0.f, 0.f, 0.f}, cm2 = cm1;
                if (kb + 31 > nvmin) {
#pragma unroll
                    for (int i = 0; i < 4; ++i) { if (kpos + i > nvl) cm1[i] = NEGBIG; if (kpos + 4 + i > nvl) cm2[i] = NEGBIG; }
                }
#pragma unroll
                for (int h = 0; h < 4; ++h) {
                    f32x4 s1 = mfma16(k1a, qf[h][0], cm1); s1 = mfma16(k1b, qf[h][1], s1);
                    f32x4 s2 = mfma16(k2a, qf[h][0], cm2); s2 = mfma16(k2b, qf[h][1], s2);
                    float pv[8];
#pragma unroll
                    for (int i = 0; i < 4; ++i) {
                        pv[i] = fexp2(fmaf(s1[i], SC, -m[h])) * linv[h];
                        pv[4 + i] = fexp2(fmaf(s2[i], SC, -m[h])) * linv[h];
                    }
#pragma unroll
                    for (int i = 0; i < 8; ++i) psum[i] += pv[i];
                    const bf16x8 pf = pack8(pv);
#pragma unroll
                    for (int db = 0; db < 4; ++db) Oc[h][db] = mfma16(vf[db], pf, Oc[h][db]);
                }
                const float prev = __shfl(psum[7], (lane + 48) & 63);
                const float left = (q4 == 0) ? carry : prev;
                carry = prev;
                const float impA = left + 2.f * (psum[0] + psum[1] + psum[2]) + psum[3];
                const float impB = psum[3] + 2.f * (psum[4] + psum[5] + psum[6]) + psum[7];
                *(float2*)(R + c16 * 256 + (kb >> 2) + 2 * q4) = make_float2(impA, impB);
            }
        }
        wsync();
        const int ncand = cur - 2;
        const int npick = ncand < 0 ? 0 : (ncand < 13 ? ncand : 13);
        const int nforced = (cur < 2 ? cur : 2) + 1;
        const int nsel = npick + nforced;
        for (int tk = 0; tk < 8; ++tk) {
            float a0 = -1.f, a1 = -1.f, a2 = -1.f, a3 = -1.f, b0 = -1.f, b1 = -1.f, b2 = -1.f, b3 = -1.f;
            if (npick > 0) {
                const float4 va = *(const float4*)(R + tk * 256 + lane * 4), vb = *(const float4*)(R + (tk + 8) * 256 + lane * 4);
                const int j0 = lane * 4;
                const bool k0 = (j0 >= 1 && j0 <= ncand), k1 = (j0 + 1 <= ncand), k2 = (j0 + 2 <= ncand), k3 = (j0 + 3 <= ncand);
                a0 = k0 ? va.x : -1.f; a1 = k1 ? va.y : -1.f; a2 = k2 ? va.z : -1.f; a3 = k3 ? va.w : -1.f;
                b0 = k0 ? vb.x : -1.f; b1 = k1 ? vb.y : -1.f; b2 = k2 ? vb.z : -1.f; b3 = k3 ? vb.w : -1.f;
            }
            for (int it = 0; it < npick; ++it) {
                const float ma = wave_max(fmaxf(fmaxf(a0, a1), fmaxf(a2, a3)));
                const float mb = wave_max(fmaxf(fmaxf(b0, b1), fmaxf(b2, b3)));
                const unsigned long long bala = __ballot((a0 == ma) || (a1 == ma) || (a2 == ma) || (a3 == ma));
                const unsigned long long balb = __ballot((b0 == mb) || (b1 == mb) || (b2 == mb) || (b3 == mb));
                const int fa = __ffsll((long long)bala) - 1, fb = __ffsll((long long)balb) - 1;
                if (lane == fa) {
                    int sl;
                    if (a0 == ma) { sl = 0; a0 = -1.f; } else if (a1 == ma) { sl = 1; a1 = -1.f; } else if (a2 == ma) { sl = 2; a2 = -1.f; } else { sl = 3; a3 = -1.f; }
                    sel[tk * 16 + it] = (unsigned char)(lane * 4 + sl);
                }
                if (lane == fb) {
                    int sl;
                    if (b0 == mb) { sl = 0; b0 = -1.f; } else if (b1 == mb) { sl = 1; b1 = -1.f; } else if (b2 == mb) { sl = 2; b2 = -1.f; } else { sl = 3; b3 = -1.f; }
                    sel[(tk + 8) * 16 + it] = (unsigned char)(lane * 4 + sl);
                }
            }
            if (lane < 2) {
                const int tq = tk + lane * 8;
                sel[tq * 16 + npick] = 0;
                if (cur >= 1) sel[tq * 16 + npick + 1] = (unsigned char)cur;
                if (cur >= 2) sel[tq * 16 + npick + 2] = (unsigned char)(cur - 1);
            }
        }
        { unsigned zz = 0u; asm volatile("" : "+v"(zz)); *(uint4*)(tm + lane * 4) = make_uint4(zz, zz, zz, zz); }
        wsync();
        if (lane < 16) {
            for (int si = 0; si < nsel; ++si) atomicOr(&tm[sel[lane * 16 + si]], 1u << lane);
        }
        wsync();
        int n_act;
        {
            const uint4 mm = *(const uint4*)(tm + lane * 4);
            wsync();
            const bool f0 = mm.x != 0u, f1 = mm.y != 0u, f2 = mm.z != 0u, f3 = mm.w != 0u;
            const unsigned long long b0 = __ballot(f0), b1 = __ballot(f1), b2 = __ballot(f2), b3 = __ballot(f3);
            const unsigned long long below = (1ull << lane) - 1ull;
            int pos = __popcll(b0 & below) + __popcll(b1 & below) + __popcll(b2 & below) + __popcll(b3 & below);
            if (f0) { sel[pos] = (unsigned char)(lane * 4 + 0); ++pos; }
            if (f1) { sel[pos] = (unsigned char)(lane * 4 + 1); ++pos; }
            if (f2) { sel[pos] = (unsigned char)(lane * 4 + 2); ++pos; }
            if (f3) { sel[pos] = (unsigned char)(lane * 4 + 3); ++pos; }
            n_act = __popcll(b0) + __popcll(b1) + __popcll(b2) + __popcll(b3);
        }
        wsync();
        u16* PL = (u16*)R + 4096;
        {
            int t3 = t; asm volatile("" : "+v"(t3));
            const float* grow3 = GATES + ((size_t)b * S_ + t3) * 48 + g * 12;
#pragma unroll
            for (int h = 0; h < 4; ++h) {
                const float g0 = grow3[h * 3 + 0];
#pragma unroll
                for (int db = 0; db < 4; ++db) *(uint2*)(PL + (c16 * 4 + h) * 64 + db * 16 + q4 * 4) = pack4(Oc[h][db] * g0);
            }
        }
        wsync();
        for (int rep = 0; rep <= probe_rep; ++rep) {
            const int tg = c16 >> 2, hh = c16 & 3;
            f32x4 Os[4][4], Ol[4]; float m[4];
#pragma unroll
            for (int gq = 0; gq < 4; ++gq) {
                m[gq] = NEGBIG; Ol[gq] = (f32x4){0.f, 0.f, 0.f, 0.f};
#pragma unroll
                for (int db = 0; db < 4; ++db) Os[gq][db] = (f32x4){0.f, 0.f, 0.f, 0.f};
            }
            const long ones8 = 0x3838383838383838L;
            long qf8[4][2];
#pragma unroll
            for (int gq = 0; gq < 4; ++gq)
#pragma unroll
                for (int ks = 0; ks < 2; ++ks) {
                    const uint4 qv = *(const uint4*)(Q + ((size_t)b * S_ + t0 + gq * 4 + tg) * 1024 + g * 256 + hh * 64 + ks * 32 + q4 * 8);
                    const float f[8] = {__uint_as_float(qv.x << 16), __uint_as_float(qv.x & 0xffff0000u), __uint_as_float(qv.y << 16), __uint_as_float(qv.y & 0xffff0000u),
                                        __uint_as_float(qv.z << 16), __uint_as_float(qv.z & 0xffff0000u), __uint_as_float(qv.w << 16), __uint_as_float(qv.w & 0xffff0000u)};
                    qf8[gq][ks] = pk8_fp8(f);
                }
            const unsigned char* KS8 = (const unsigned char*)KS;
            const unsigned char* VS8 = (const unsigned char*)VST;
            auto ld = [&](int s, long (&K)[4], long (&V)[4]) __attribute__((always_inline)) {
                const int j = __builtin_amdgcn_readfirstlane((int)sel[s >> 1]);
                const int kb = j * 64 + (s & 1) * 32;
                const unsigned kof = (unsigned)(kb + kr) * 64u + (unsigned)q4 * 8u;
                K[0] = *(const long*)(KS8 + kof); K[1] = *(const long*)(KS8 + (kof + 32u)); K[2] = *(const long*)(KS8 + (kof + 256u)); K[3] = *(const long*)(KS8 + (kof + 288u));
                const unsigned vof = (unsigned)j * 4096u + (unsigned)c16 * 64u + (unsigned)(s & 1) * 32u + (unsigned)q4 * 8u;
#pragma unroll
                for (int db = 0; db < 4; ++db) V[db] = *(const long*)(VS8 + (vof + (unsigned)(db * 1024)));
            };
            auto cp = [&](int s, const long (&K)[4], const long (&V)[4]) __attribute__((always_inline)) {
                const int j = __builtin_amdgcn_readfirstlane((int)sel[s >> 1]);
                const unsigned mk = __builtin_amdgcn_readfirstlane(tm[j]);
                const int kpos = j * 64 + (s & 1) * 32 + q4 * 8;
#pragma unroll
                for (int gq = 0; gq < 4; ++gq) {
                    const unsigned gm = (mk >> (gq * 4)) & 0xFu;
                    if (gm == 0u) continue;
                    const float cmv = ((gm >> tg) & 1u) ? 0.f : NEGBIG;
                    f32x4 cm1 = {cmv, cmv, cmv, cmv}, cm2 = cm1;
                    if (j == cur) {
                        const int tc = t0 + gq * 4 + tg;
#pragma unroll
                        for (int i = 0; i < 4; ++i) { if (kpos + i > tc) cm1[i] = NEGBIG; if (kpos + 4 + i > tc) cm2[i] = NEGBIG; }
                    }
                    f32x4 s1 = mfma8(K[0], qf8[gq][0], cm1); s1 = mfma8(K[1], qf8[gq][1], s1);
                    f32x4 s2 = mfma8(K[2], qf8[gq][0], cm2); s2 = mfma8(K[3], qf8[gq][1], s2);
                    float mx = fmaxf(fmaxf(fmaxf(s1[0], s1[1]), fmaxf(s1[2], s1[3])), fmaxf(fmaxf(s2[0], s2[1]), fmaxf(s2[2], s2[3])));
                    mx = xmax32(xmax16(mx));
                    const float mn = fmaxf(m[gq], mx * SC);
                    if (__ballot(mn != m[gq])) {
                        const float alpha = fexp2(m[gq] - mn);
                        Ol[gq] = Ol[gq] * alpha;
#pragma unroll
                        for (int db = 0; db < 4; ++db) Os[gq][db] = Os[gq][db] * alpha;
                    }
                    m[gq] = mn;
                    float pv[8];
#pragma unroll
                    for (int i = 0; i < 4; ++i) { pv[i] = fexp2(fmaf(s1[i], SC, 7.f - mn)); pv[4 + i] = fexp2(fmaf(s2[i], SC, 7.f - mn)); }
                    const long pf = pk8_fp8(pv);
#pragma unroll
                    for (int db = 0; db < 4; ++db) Os[gq][db] = mfma8(V[db], pf, Os[gq][db]);
                    Ol[gq] = mfma8(ones8, pf, Ol[gq]);
                }
            };
            {
                long KA[4], VA[4], KB[4], VB[4];
                const int ns = 2 * n_act;
                ld(0, KA, VA);
                for (int s = 0; s < ns; s += 2) {
                    ld(s + 1, KB, VB);
                    cp(s, KA, VA);
                    if (s + 2 < ns) ld(s + 2, KA, VA);
                    cp(s + 1, KB, VB);
                }
            }
            const float repsc = (rep == 0) ? 1.f : 0.f;
#pragma unroll
            for (int gq = 0; gq < 4; ++gq) {
                const float lt = Ol[gq][0];
                const int tok = gq * 4 + tg;
                const float sc = repsc * GATES[((size_t)b * S_ + t0 + tok) * 48 + g * 12 + hh * 3 + 1] / lt;
#pragma unroll
                for (int db = 0; db < 4; ++db) {
                    u16* rp = PL + (tok * 4 + hh) * 64 + db * 16 + q4 * 4;
                    *(uint2*)rp = pack4(unpack4(*(const uint2*)rp) + Os[gq][db] * sc);
                }
            }
        }
        wsync();
        {
            f32x4 Ow[4][4]; float linv[4];
            int t2 = t; asm volatile("" : "+v"(t2));
            const u16* qrow2 = Q + ((size_t)b * S_ + t2) * 1024 + g * 256;
            const float* grow2 = GATES + ((size_t)b * S_ + t2) * 48 + g * 12;
            band_attn<false>(qrow2, KW, VWT, t0, 512, nullptr, Ow, linv, lane);
            u16* op = Ob + ((size_t)b * S_ + t2) * 1024 + g * 256;
#pragma unroll
            for (int h = 0; h < 4; ++h) {
                const float g2 = grow2[h * 3 + 2] * linv[h];
#pragma unroll
                for (int db = 0; db < 4; ++db) {
                    const f32x4 part = unpack4(*(const uint2*)(PL + (c16 * 4 + h) * 64 + db * 16 + q4 * 4));
                    *(uint2*)(op + h * 64 + db * 16 + q4 * 4) = pack4(part + Ow[h][db] * g2);
                }
            }
        }
        wsync();
    }
}


#define XB_TMO      128
#define XB_XCNT(j)  (256  + 64 * (j))
#define XB_XSUB(j)  (1280 + 64 * (j))
#define XB_XGEN(j)  (2304 + 64 * (j))
#define XB_TOP      3328
#define XB_TOPGEN   3392
#define XCD_BAR_WORDS 3456
#define XB_SPIN_CAP (1u << 22)
#define LAS __attribute__((address_space(3)))
__device__ __forceinline__ unsigned xb_ld(unsigned* p)              { return __hip_atomic_load(p, __ATOMIC_RELAXED, __HIP_MEMORY_SCOPE_AGENT); }
__device__ __forceinline__ unsigned xb_add(unsigned* p, unsigned v) { return __hip_atomic_fetch_add(p, v, __ATOMIC_RELAXED, __HIP_MEMORY_SCOPE_AGENT); }
__device__ __forceinline__ unsigned xb_xcc_id() { return (unsigned)__builtin_amdgcn_s_getreg((3 << 11) | 20) & 0xFu; }
#define XB_SPIN(cond, bar) do { unsigned _sp = 0; while (cond) { __builtin_amdgcn_s_sleep(1); \
    if ((++_sp & 255u) == 0u) { if (xb_ld(&(bar)[XB_TMO])) break; if (_sp > XB_SPIN_CAP) { atomicAdd(&(bar)[XB_TMO], 1u); break; } } } } while (0)
__device__ __forceinline__ void xcd_barrier_complete(unsigned* bar, unsigned x, unsigned& nloc, unsigned& nx) {
    const unsigned G = gridDim.x * gridDim.y * gridDim.z;
    unsigned sum, cnt, mine, sp = 0u;
    for (;;) {
        sum = 0u; cnt = 0u; mine = 0u;
#pragma unroll
        for (unsigned j = 0; j < 16; ++j) { const unsigned c = xb_ld(&bar[XB_XCNT(j)]); sum += c; cnt += (c > 0u) ? 1u : 0u; mine = (j == x) ? c : mine; }
        if (sum == G) break;
        __builtin_amdgcn_s_sleep(1);
        if ((++sp & 255u) == 0u) { if (xb_ld(&bar[XB_TMO])) break; if (sp > XB_SPIN_CAP) { atomicAdd(&bar[XB_TMO], 1u); break; } }
    }
    nloc = mine > 0u ? mine : 1u; nx = cnt > 0u ? cnt : 1u;
}
__device__ __forceinline__ void xcd_barrier(unsigned* bar, unsigned x, volatile LAS unsigned* st, int tid) {
    asm volatile("s_waitcnt vmcnt(0)" ::: "memory");
    __syncthreads();
    if (tid == 0) {
        __builtin_amdgcn_s_waitcnt(0);
        unsigned nloc = st[0], nx = st[1];
        if (nloc == 0u) { xcd_barrier_complete(bar, x, nloc, nx); st[0] = nloc; st[1] = nx; }
        const unsigned old = xb_add(&bar[XB_XSUB(x)], 1u);
        const unsigned gen = old / nloc;
        if (old + 1u == (gen + 1u) * nloc) {
            __builtin_amdgcn_fence(__ATOMIC_RELEASE, "agent");
            asm volatile("s_waitcnt vmcnt(0)" ::: "memory");
            const unsigned og = xb_add(&bar[XB_TOP], 1u);
            const unsigned tg = og / nx;
            if (og + 1u == (tg + 1u) * nx) xb_add(&bar[XB_TOPGEN], 1u);
            else XB_SPIN(xb_ld(&bar[XB_TOPGEN]) == tg, bar);
            __builtin_amdgcn_fence(__ATOMIC_ACQUIRE, "agent");
            xb_add(&bar[XB_XGEN(x)], 1u);
            asm volatile("s_waitcnt vmcnt(0)" ::: "memory");
        } else {
            XB_SPIN(xb_ld(&bar[XB_XGEN(x)]) == gen, bar);
            __builtin_amdgcn_fence(__ATOMIC_ACQUIRE, "agent");
            asm volatile("s_waitcnt vmcnt(0)" ::: "memory");
        }
    }
    __syncthreads();
}

enum { PT_PREP = 0, PT_NORM, PT_AIN, PT_CMP1, PT_CMP2, PT_NSA, PT_BKV, PT_BQ, PT_SWA, PT_AOUT, PT_FFNIN, PT_FIXUP, PT_FOUT, PT_FINAL };

__global__ void __launch_bounds__(NTHR, 2) mega(Params p) {
#if defined(__HIP_DEVICE_COMPILE__)
    extern __shared__ __attribute__((aligned(16))) unsigned char smem[];
    cg::grid_group grid = cg::this_grid();
    typedef const Params __attribute__((address_space(4)))* KP;
    const int ph_lo = p.ph_lo, ph_hi = p.ph_hi;
    const int wave_id = __builtin_amdgcn_readfirstlane((int)(threadIdx.x >> 6));
    unsigned* bar = (unsigned*)(p.ws + OFF_BAR);
    volatile LAS unsigned* xst = (volatile LAS unsigned*)(smem + LDS_USER);
    const unsigned xcc = __builtin_amdgcn_readfirstlane(xb_xcc_id());
    if (ph_hi - ph_lo > 1) {
        if (threadIdx.x == 0) { xst[0] = 0u; xst[1] = 0u; (void)xb_add(&bar[XB_XCNT(xcc)], 1u); }
        __syncthreads();
    }
    for (int ph = ph_lo; ph < ph_hi; ++ph) {
        int tid_, bid_ = blockIdx.x;
        asm volatile("v_mbcnt_lo_u32_b32 %0, -1, 0\n\tv_mbcnt_hi_u32_b32 %0, -1, %0" : "=v"(tid_));
        tid_ += wave_id * 64;
        asm volatile("" : "+s"(bid_));
        KP kp = (KP)__builtin_amdgcn_kernarg_segment_ptr();
        asm volatile("" : "+s"(kp));
        unsigned char* ws = kp->ws;
        u16* HN = (u16*)(ws + OFF_HN);
        const int d = kp->desc[ph], type = d & 255, sub = (d >> 8) & 255, L = d >> 16;
        const float* hsrc = (L == 0) ? kp->x : kp->out;
        EpiArgs e; e.resid = nullptr; e.out = kp->out; e.bias = nullptr; e.hid = nullptr; e.convw = nullptr; e.convb = nullptr; e.ws = ws;
        switch (type) {
        case PT_PREP: { const Params pl = *kp; prep_phase(pl, smem, tid_, bid_); } break;
        case PT_NORM: {
            const float* src = (sub == 1) ? kp->out : hsrc;
            const float* g = (sub == 0) ? kp->norm_attn + L * 1024 : (sub == 1) ? kp->norm_ffn + L * 1024 : kp->kv_norm;
            norm_phase<false>(src, g, HN, nullptr, tid_, bid_);
        } break;
        case PT_AIN: gemm_phase<AM_PLAIN, EPI_AIN>(HN, 1024, (const u16*)(ws + OFF_WT_AIN + L * SZ_WT_AIN), T_, 2688, 1024, 0, e, smem, tid_, bid_); break;
        case PT_CMP1:
            for (int kv = 0; kv < 2; ++kv) {
                e.bias = (const float*)(ws + OFF_CBIAS) + (L * 2 + kv) * 256; e.hid = (u16*)(ws + OFF_HID) + (size_t)kv * 8192 * 256;
                gemm_phase<AM_GATHER, EPI_CMP1>((const u16*)(ws + (kv == 0 ? OFF_KC : OFF_VC)), 0, (const u16*)(ws + OFF_WT_CW1 + (L * 2 + kv) * SZ_WT_CW1), 8184, 256, 2048,
                                                kv == 0 ? 0 : (int)(gridDim.x >> 1), e, smem, tid_, bid_);
            }
            break;
        case PT_CMP2: { const Params pl = *kp; cmp2_phase(pl, L, tid_, bid_); } break;
        case PT_NSA: { const Params pl = *kp; nsa_phase(pl, smem, tid_, bid_, sub, L); } break;
        case PT_BKV: gemm_phase<AM_PLAIN, EPI_BKV>(HN, 1024, (const u16*)(ws + OFF_WT_KV), T_, 256, 1024, 0, e, smem, tid_, bid_); break;
        case PT_BQ: gemm_phase<AM_PLAIN, EPI_BQ>(HN, 1024, (const u16*)(ws + OFF_WT_BQ + (L - 2) * SZ_WT_SQ), T_, 1024, 1024, 0, e, smem, tid_, bid_); break;
        case PT_SWA: { const Params pl = *kp; swa_phase(pl, L - 2, tid_, bid_); } break;
        case PT_AOUT:
        case PT_FOUT: {
            const bool ff = (type == PT_FOUT);
            e.resid = ff ? kp->out : hsrc;
            const u16* A = (const u16*)(ws + (ff ? OFF_ACT : OFF_O));
            const u16* Bt = (const u16*)(ws + (ff ? OFF_WT_FOUT + L * SZ_WT_FOUT : (L < 2 ? OFF_WT_AOUT + L * SZ_WT_SQ : OFF_WT_BOUT + (L - 2) * SZ_WT_SQ)));
            const int K = ff ? DFF : 1024;
            gemm_big<AM_PLAIN, EPI_RESID>(A, K, Bt, T_, 1024, K, 0, e, smem, tid_, bid_);
        } break;
        case PT_FFNIN:
            e.convw = kp->ffn_conv_w + (size_t)L * 3 * NFF2; e.convb = kp->ffn_conv_b + (size_t)L * NFF2;
            gemm_big<AM_PLAIN, EPI_FFNIN>(HN, 1024, (const u16*)(ws + OFF_WT_FIN + L * SZ_WT_FIN), T_, NFF2, 1024, 0, e, smem, tid_, bid_);
            break;
        case PT_FIXUP: { const Params pl = *kp; fixup_phase(pl, L, tid_, bid_); } break;
        case PT_FINAL: norm_phase<true>(kp->out, kp->final_norm, nullptr, kp->out, tid_, bid_); break;
        default: break;
        }
        if (ph + 1 < ph_hi) { if (ph == ph_lo) grid.sync(); else xcd_barrier(bar, xcc, xst, tid_); }
    }
#endif
}

static int build_program(int* desc) {
    int n = 0;
    auto add = [&](int type, int sub, int L) { desc[n++] = type | (sub << 8) | (L << 16); };
    add(PT_PREP, 0, 0);
    for (int L = 0; L < 4; ++L) {
        if (L < 2) {
            add(PT_NORM, 0, L); add(PT_AIN, 0, L); add(PT_CMP1, 0, L); add(PT_CMP2, 0, L); add(PT_NSA, NSA_PROBE_REP, L);
        } else {
            if (L == 2) { add(PT_NORM, 2, L); add(PT_BKV, 0, L); }
            add(PT_NORM, 0, L); add(PT_BQ, 0, L); add(PT_SWA, 0, L);
        }
        add(PT_AOUT, 0, L); add(PT_NORM, 1, L); add(PT_FFNIN, 0, L); add(PT_FIXUP, 0, L); add(PT_FOUT, 0, L);
    }
    add(PT_FINAL, 0, 0);
    return n;
}

extern "C" void kernel_launch(void* const* d_in, const int* in_sizes, int n_in, void* d_out, int out_size, void* d_ws, size_t ws_size, hipStream_t stream) {
    (void)in_sizes; (void)n_in; (void)out_size;
    static int grid_blocks = 0;
    if (!grid_blocks) {
        (void)hipFuncSetAttribute((const void*)mega, hipFuncAttributeMaxDynamicSharedMemorySize, LDS_BYTES);
        int dev = 0, cus = 0, per_cu = 0;
        (void)hipGetDevice(&dev);
        (void)hipDeviceGetAttribute(&cus, hipDeviceAttributeMultiprocessorCount, dev);
        (void)hipOccupancyMaxActiveBlocksPerMultiprocessor(&per_cu, mega, NTHR, LDS_BYTES);
        if (per_cu > 1) per_cu = 1;
        if (per_cu < 1) per_cu = 1;
        grid_blocks = (cus * per_cu) & ~7;
        if (grid_blocks < 8) grid_blocks = 8;
        if (ws_size < WS_NEED) fprintf(stderr, "workspace too small: %zu < %zu\n", ws_size, (size_t)WS_NEED);
    }
    Params p{};
    const float** pp = (const float**)&p;
    for (int i = 0; i < 18; ++i) pp[i] = (const float*)d_in[i];
    p.out = (float*)d_out;
    p.ws = (unsigned char*)d_ws;
    const int nph = build_program(p.desc);
#if MULTI_LAUNCH
    for (int ph = 0; ph < nph; ++ph) {
        p.ph_lo = ph; p.ph_hi = ph + 1;
        hipLaunchKernelGGL(mega, dim3(grid_blocks), dim3(NTHR), LDS_BYTES, stream, p);
    }
#else
    p.ph_lo = 0; p.ph_hi = nph;
    (void)hipMemsetAsync((unsigned char*)d_ws + OFF_BAR, 0, 32768, stream);
    void* args[] = {&p};
    hipError_t err = hipLaunchCooperativeKernel((const void*)mega, dim3(grid_blocks), dim3(NTHR), args, LDS_BYTES, stream);
    if (err != hipSuccess) fprintf(stderr, "cooperative launch failed: %s (grid %d)\n", hipGetErrorString(err), grid_blocks);
#endif
}
```

```cpp
#include <hip/hip_runtime.h>
#include <hip/hip_cooperative_groups.h>
#include <cstdio>
#include <cmath>
namespace cg = cooperative_groups;

typedef unsigned short u16;
typedef short bf16x8 __attribute__((ext_vector_type(8)));
typedef float f32x4 __attribute__((ext_vector_type(4)));

#ifndef NSA_PROBE_REP
#define NSA_PROBE_REP 0
#endif
#ifndef MULTI_LAUNCH
#define MULTI_LAUNCH 0
#endif

constexpr int S_ = 16384, T_ = 32768, D_ = 1024, DFF = 2816, NFF2 = 5632;
constexpr int NTHR = 512, NW = NTHR / 64;
constexpr int LDS_USER = NW * 16384 + NW * 1024 + NW * 256;
constexpr int LDS_BYTES = LDS_USER + 16;
constexpr float LOG2E = 1.4426950408889634f;
constexpr float NEGBIG = -1e30f;

constexpr size_t al256(size_t x) { return (x + 255) & ~(size_t)255; }
constexpr size_t SZ_WT_AIN = (size_t)2688 * 1024 * 2;
constexpr size_t SZ_WT_CW1 = (size_t)256 * 2048 * 2;
constexpr size_t SZ_WT_CW2 = (size_t)64 * 256 * 2;
constexpr size_t SZ_WT_SQ = (size_t)1024 * 1024 * 2;
constexpr size_t SZ_WT_KV = (size_t)256 * 1024 * 2;
constexpr size_t SZ_WT_FIN = (size_t)5632 * 1024 * 2;
constexpr size_t SZ_WT_FOUT = (size_t)1024 * 2816 * 2;
constexpr size_t OFF_WT_AIN = 0;
constexpr size_t OFF_WT_CW1 = OFF_WT_AIN + 2 * SZ_WT_AIN;
constexpr size_t OFF_WT_CW2 = OFF_WT_CW1 + 4 * SZ_WT_CW1;
constexpr size_t OFF_WT_AOUT = OFF_WT_CW2 + 4 * SZ_WT_CW2;
constexpr size_t OFF_WT_KV = OFF_WT_AOUT + 2 * SZ_WT_SQ;
constexpr size_t OFF_WT_BQ = OFF_WT_KV + SZ_WT_KV;
constexpr size_t OFF_WT_BOUT = OFF_WT_BQ + 2 * SZ_WT_SQ;
constexpr size_t OFF_WT_FIN = OFF_WT_BOUT + 2 * SZ_WT_SQ;
constexpr size_t OFF_WT_FOUT = OFF_WT_FIN + 4 * SZ_WT_FIN;
constexpr size_t OFF_COS = OFF_WT_FOUT + 4 * SZ_WT_FOUT;
constexpr size_t OFF_SIN = OFF_COS + (size_t)S_ * 32 * 4;
constexpr size_t OFF_CBIAS = OFF_SIN + (size_t)S_ * 32 * 4;
constexpr size_t OFF_HN = OFF_CBIAS + 4096;
constexpr size_t OFF_KSH = OFF_HN + (size_t)T_ * 1024 * 2;
constexpr size_t OFF_VSHT = OFF_KSH + (size_t)T_ * 128 * 2;
constexpr size_t OFF_HEAD = OFF_VSHT + (size_t)T_ * 128 * 2;
constexpr size_t OFF_HALO = OFF_HEAD + (size_t)256 * 2 * NFF2 * 4;
constexpr size_t OFF_R1 = OFF_HALO + (size_t)256 * 2 * NFF2 * 4;
constexpr size_t OFF_Q = OFF_R1;
constexpr size_t OFF_KC = OFF_Q + (size_t)T_ * 1024 * 2;
constexpr size_t OFF_VC = OFF_KC + (size_t)T_ * 256 * 2;
constexpr size_t OFF_KS = OFF_VC + (size_t)T_ * 256 * 2;
constexpr size_t OFF_VST = OFF_KS + (size_t)T_ * 256 * 2;
constexpr size_t OFF_KW = OFF_VST + (size_t)T_ * 256 * 2;
constexpr size_t OFF_VWT = OFF_KW + (size_t)T_ * 256 * 2;
constexpr size_t OFF_GATES = OFF_VWT + (size_t)T_ * 256 * 2;
constexpr size_t OFF_HID = OFF_GATES + (size_t)T_ * 48 * 4;
constexpr size_t OFF_KCC = OFF_HID + (size_t)2 * 8192 * 256 * 2;
constexpr size_t OFF_VCCT = OFF_KCC + (size_t)8 * 1024 * 64 * 2;
constexpr size_t OFF_O = OFF_VCCT + (size_t)8 * 1024 * 64 * 2;
constexpr size_t OFF_END = OFF_O + (size_t)T_ * 1024 * 2;
constexpr size_t OFF_BAR = OFF_END;
constexpr size_t WS_NEED = OFF_BAR + 32768;
constexpr size_t OFF_ACT = OFF_R1;
static_assert(OFF_ACT + (size_t)T_ * DFF * 2 <= OFF_END, "act alias");

struct Params {
    const float *x, *norm_attn, *norm_ffn, *a_w_in, *a_cmp_pos, *a_cmp_w1, *a_cmp_w2, *a_w_out, *kv_norm, *b_w_kv, *b_w_q, *b_sinks, *b_w_out,
        *ffn_w_in, *ffn_conv_w, *ffn_conv_b, *ffn_w_out, *final_norm;
    float* out;
    unsigned char* ws;
    int desc[48];
    int ph_lo, ph_hi;
};

__device__ __forceinline__ u16 f2bf(float f) {
    unsigned u = __float_as_uint(f);
    u += 0x7fffu + ((u >> 16) & 1u);
    return (u16)(u >> 16);
}
typedef __bf16 bf16x2_t __attribute__((ext_vector_type(2)));
typedef float f32x2_t __attribute__((ext_vector_type(2)));
__device__ __forceinline__ unsigned pack2(float lo, float hi) { f32x2_t v = {lo, hi}; bf16x2_t r = __builtin_convertvector(v, bf16x2_t); return __builtin_bit_cast(unsigned, r); }
typedef unsigned u32x4 __attribute__((ext_vector_type(4)));
__device__ __forceinline__ bf16x8 pack8(const float (&v)[8]) {
    u32x4 r;
    unsigned r0, r1, r2, r3;
    asm("v_cvt_pk_bf16_f32 %0, %4, %5\n\tv_cvt_pk_bf16_f32 %1, %6, %7\n\tv_cvt_pk_bf16_f32 %2, %8, %9\n\tv_cvt_pk_bf16_f32 %3, %10, %11\n\ts_nop 3"
        : "=&v"(r0), "=&v"(r1), "=&v"(r2), "=&v"(r3)
        : "v"(v[0]), "v"(v[1]), "v"(v[2]), "v"(v[3]), "v"(v[4]), "v"(v[5]), "v"(v[6]), "v"(v[7]));
    r[0] = r0; r[1] = r1; r[2] = r2; r[3] = r3;
    return __builtin_bit_cast(bf16x8, r);
}
__device__ __forceinline__ uint2 pack4(f32x4 v) { uint2 r; r.x = pack2(v[0], v[1]); r.y = pack2(v[2], v[3]); return r; }
__device__ __forceinline__ f32x4 unpack4(uint2 v) { return (f32x4){__uint_as_float(v.x << 16), __uint_as_float(v.x & 0xffff0000u), __uint_as_float(v.y << 16), __uint_as_float(v.y & 0xffff0000u)}; }
__device__ __forceinline__ unsigned pk4_fp8(float a, float b, float c, float d) { int r = __builtin_amdgcn_cvt_pk_fp8_f32(a, b, 0, false); r = __builtin_amdgcn_cvt_pk_fp8_f32(c, d, r, true); return (unsigned)r; }
__device__ __forceinline__ long pk8_fp8(const float (&v)[8]) { const unsigned lo = pk4_fp8(v[0], v[1], v[2], v[3]), hi = pk4_fp8(v[4], v[5], v[6], v[7]); return (long)(((unsigned long long)hi << 32) | lo); }
__device__ __forceinline__ f32x4 mfma8(long a, long b, f32x4 c) { return __builtin_amdgcn_mfma_f32_16x16x32_fp8_fp8(a, b, c, 0, 0, 0); }
__device__ __forceinline__ f32x4 mfma16(bf16x8 a, bf16x8 b, f32x4 c) { return __builtin_amdgcn_mfma_f32_16x16x32_bf16(a, b, c, 0, 0, 0); }
__device__ __forceinline__ float fexp2(float x) { return __builtin_amdgcn_exp2f(x); }
__device__ __forceinline__ void wsync() { __builtin_amdgcn_fence(__ATOMIC_ACQ_REL, "wavefront"); asm volatile("s_waitcnt lgkmcnt(0)" ::: "memory"); __builtin_amdgcn_wave_barrier(); }
typedef unsigned u32x2 __attribute__((ext_vector_type(2)));
__device__ __forceinline__ float xmax16(float x) { const unsigned u = __float_as_uint(x); const u32x2 r = __builtin_amdgcn_permlane16_swap(u, u, false, false); return fmaxf(__uint_as_float(r[0]), __uint_as_float(r[1])); }
__device__ __forceinline__ float xmax32(float x) { const unsigned u = __float_as_uint(x); const u32x2 r = __builtin_amdgcn_permlane32_swap(u, u, false, false); return fmaxf(__uint_as_float(r[0]), __uint_as_float(r[1])); }
template <int CTRL> __device__ __forceinline__ float dppf(float x) { return __int_as_float(__builtin_amdgcn_update_dpp(0, __float_as_int(x), CTRL, 0xf, 0xf, true)); }
__device__ __forceinline__ float wave_max(float x) {
    x = fmaxf(x, dppf<0xB1>(x)); x = fmaxf(x, dppf<0x4E>(x)); x = fmaxf(x, dppf<0x141>(x)); x = fmaxf(x, dppf<0x140>(x));
    return xmax32(xmax16(x));
}
__device__ __forceinline__ int kperm(int m) { return ((m >> 2) << 3) + (m & 3); }
__device__ __forceinline__ float sigmoidf_(float x) { return 1.f / (1.f + __expf(-x)); }
__device__ __forceinline__ float gelu_tanh(float x) {
    float u = 0.7978845608028654f * (x + 0.044715f * x * x * x);
    float e = __expf(2.f * u);
    float th = 1.f - 2.f / (e + 1.f);
    return 0.5f * x * (1.f + th);
}

__device__ __forceinline__ void cvt_transpose(const float* __restrict__ src, u16* __restrict__ dst, int K, int N, int Npad, int mode, unsigned char* smem, int tid_, int bid_) {
    const int half = tid_ >> 8, tid = tid_ & 255;
    float* ts = (float*)smem + half * (64 * 65);
    const int ntk = K >> 6, ntn = Npad >> 6, ntiles = ntk * ntn;
    for (int tile2 = bid_ * 2; tile2 < ntiles; tile2 += gridDim.x * 2) {
        const int tile = tile2 + half;
        const bool live = tile < ntiles;
        const int tk = live ? tile % ntk : 0, tn = live ? tile / ntk : 0;
        const int k0 = tk << 6, n0 = tn << 6;
        __syncthreads();
        if (live) {
#pragma unroll
            for (int i = 0; i < 4; ++i) {
                const int k = (tid >> 4) + 16 * i, n = (tid & 15) * 4;
                float4 v = make_float4(0.f, 0.f, 0.f, 0.f);
                if (n0 + n < N) v = *(const float4*)(src + (size_t)(k0 + k) * N + n0 + n);
                ts[k * 65 + n + 0] = v.x; ts[k * 65 + n + 1] = v.y; ts[k * 65 + n + 2] = v.z; ts[k * 65 + n + 3] = v.w;
            }
        }
        __syncthreads();
        if (!live) continue;
        const int n = tid >> 2, kq = (tid & 3) * 16;
        unsigned pk[8];
#pragma unroll
        for (int j = 0; j < 8; ++j) pk[j] = pack2(ts[(kq + 2 * j) * 65 + n], ts[(kq + 2 * j + 1) * 65 + n]);
        int drow;
        if (mode == 0) drow = n0 + n;
        else { const int nn = n0 + n; drow = (nn < DFF) ? ((nn >> 6) * 128 + (nn & 63)) : ((((nn - DFF) >> 6) * 128) + 64 + ((nn - DFF) & 63)); }
        uint4* dp = (uint4*)(dst + (size_t)drow * K + k0 + kq);
        dp[0] = make_uint4(pk[0], pk[1], pk[2], pk[3]);
        dp[1] = make_uint4(pk[4], pk[5], pk[6], pk[7]);
    }
}

__device__ __forceinline__ void prep_phase(const Params& p, unsigned char* smem, int tid_, int bid_) {
    unsigned char* ws = p.ws;
    for (int L = 0; L < 2; ++L) {
        cvt_transpose(p.a_w_in + (size_t)L * 1024 * 2608, (u16*)(ws + OFF_WT_AIN + L * SZ_WT_AIN), 1024, 2608, 2688, 0, smem, tid_, bid_);
        for (int kv = 0; kv < 2; ++kv) {
            cvt_transpose(p.a_cmp_w1 + (size_t)(L * 2 + kv) * 2048 * 256, (u16*)(ws + OFF_WT_CW1 + (L * 2 + kv) * SZ_WT_CW1), 2048, 256, 256, 0, smem, tid_, bid_);
            cvt_transpose(p.a_cmp_w2 + (size_t)(L * 2 + kv) * 256 * 64, (u16*)(ws + OFF_WT_CW2 + (L * 2 + kv) * SZ_WT_CW2), 256, 64, 64, 0, smem, tid_, bid_);
        }
        cvt_transpose(p.a_w_out + (size_t)L * 1024 * 1024, (u16*)(ws + OFF_WT_AOUT + L * SZ_WT_SQ), 1024, 1024, 1024, 0, smem, tid_, bid_);
        cvt_transpose(p.b_w_q + (size_t)L * 1024 * 1024, (u16*)(ws + OFF_WT_BQ + L * SZ_WT_SQ), 1024, 1024, 1024, 0, smem, tid_, bid_);
        cvt_transpose(p.b_w_out + (size_t)L * 1024 * 1024, (u16*)(ws + OFF_WT_BOUT + L * SZ_WT_SQ), 1024, 1024, 1024, 0, smem, tid_, bid_);
    }
    cvt_transpose(p.b_w_kv, (u16*)(ws + OFF_WT_KV), 1024, 256, 256, 0, smem, tid_, bid_);
    for (int L = 0; L < 4; ++L) {
        cvt_transpose(p.ffn_w_in + (size_t)L * 1024 * NFF2, (u16*)(ws + OFF_WT_FIN + L * SZ_WT_FIN), 1024, NFF2, NFF2, 1, smem, tid_, bid_);
        cvt_transpose(p.ffn_w_out + (size_t)L * DFF * 1024, (u16*)(ws + OFF_WT_FOUT + L * SZ_WT_FOUT), DFF, 1024, 1024, 0, smem, tid_, bid_);
    }
    {
        float* cb = (float*)(ws + OFF_CBIAS);
        const int lane = tid_ & 63, w = tid_ >> 6;
        for (int task = bid_ * NW + w; task < 256; task += gridDim.x * NW) {
            const int lk = task >> 6, j4 = (task & 63) * 4;
            const float* pos = p.a_cmp_pos + (size_t)lk * 2048;
            const float* w1 = p.a_cmp_w1 + (size_t)lk * 2048 * 256;
            float4 a = make_float4(0.f, 0.f, 0.f, 0.f);
            for (int i = 0; i < 32; ++i) {
                const int k = lane + 64 * i;
                const float pv = pos[k];
                const float4 wv = *(const float4*)(w1 + (size_t)k * 256 + j4);
                a.x += pv * wv.x; a.y += pv * wv.y; a.z += pv * wv.z; a.w += pv * wv.w;
            }
#pragma unroll
            for (int off = 32; off >= 1; off >>= 1) {
                a.x += __shfl_xor(a.x, off); a.y += __shfl_xor(a.y, off); a.z += __shfl_xor(a.z, off); a.w += __shfl_xor(a.w, off);
            }
            if (lane == 0) *(float4*)(cb + lk * 256 + j4) = a;
        }
    }
}

template <bool OUT_F32>
__device__ __forceinline__ void norm_phase(const float* __restrict__ src, const float* __restrict__ g, u16* __restrict__ dst, float* __restrict__ dstf, int tid_, int bid_) {
    const int lane = tid_ & 63, w = tid_ >> 6;
    float4 gv[4];
#pragma unroll
    for (int i = 0; i < 4; ++i) gv[i] = *(const float4*)(g + lane * 4 + 256 * i);
    for (int row = bid_ * NW + w; row < T_; row += gridDim.x * NW) {
        const float* sp = src + (size_t)row * 1024;
        float4 v[4];
        float ss = 0.f;
#pragma unroll
        for (int i = 0; i < 4; ++i) { v[i] = *(const float4*)(sp + lane * 4 + 256 * i); ss += v[i].x * v[i].x + v[i].y * v[i].y + v[i].z * v[i].z + v[i].w * v[i].w; }
#pragma unroll
        for (int off = 32; off >= 1; off >>= 1) ss += __shfl_xor(ss, off);
        const float r = rsqrtf(ss * (1.f / 1024.f) + 1e-6f);
#pragma unroll
        for (int i = 0; i < 4; ++i) {
            f32x4 o = {v[i].x * r * gv[i].x, v[i].y * r * gv[i].y, v[i].z * r * gv[i].z, v[i].w * r * gv[i].w};
            if (OUT_F32) *(float4*)(dstf + (size_t)row * 1024 + lane * 4 + 256 * i) = make_float4(o[0], o[1], o[2], o[3]);
            else *(uint2*)(dst + (size_t)row * 1024 + lane * 4 + 256 * i) = pack4(o);
        }
    }
}

enum { AM_PLAIN = 0, AM_GATHER = 1 };
enum { EPI_AIN = 0, EPI_CMP1 = 1, EPI_RESID = 2, EPI_FFNIN = 3, EPI_BQ = 4, EPI_BKV = 5 };

struct EpiArgs {
    const float* resid; float* out;
    const float* bias; u16* hid;
    const float *convw, *convb;
    unsigned char* ws;
};

template <int NM>
__device__ __forceinline__ void rope_store(const f32x4 (&acc)[4][NM], int mi, u16* dstrow  , const float* cosT, const float* sinT, int pos, int q4) {
#pragma unroll
    for (int ni = 0; ni < 2; ++ni) {
        const int d = ni * 16 + q4 * 4;
        const float4 c = *(const float4*)(cosT + pos * 32 + d), s = *(const float4*)(sinT + pos * 32 + d);
        const f32x4 x1 = acc[ni][mi], x2 = acc[ni + 2][mi];
        f32x4 o1 = {x1[0] * c.x - x2[0] * s.x, x1[1] * c.y - x2[1] * s.y, x1[2] * c.z - x2[2] * s.z, x1[3] * c.w - x2[3] * s.w};
        f32x4 o2 = {x2[0] * c.x + x1[0] * s.x, x2[1] * c.y + x1[1] * s.y, x2[2] * c.z + x1[2] * s.z, x2[3] * c.w + x1[3] * s.w};
        *(uint2*)(dstrow + d) = pack4(o1);
        *(uint2*)(dstrow + d + 32) = pack4(o2);
    }
}

__device__ __forceinline__ void rope_ivr(float (&ivr)[8], int q4) {
#pragma unroll
    for (int k = 0; k < 8; ++k) { const int d = (k >> 2) * 16 + q4 * 4 + (k & 3); ivr[k] = exp2f(-(float)d * (13.287712379549449f / 32.0f)) * 0.15915494309189535f; }
}
__device__ __forceinline__ void rope_cs(const float (&ivr)[8], int ni, int pos, float (&c)[4], float (&s)[4]) {
#pragma unroll
    for (int i = 0; i < 4; ++i) { float rev = (float)pos * ivr[ni * 4 + i]; rev = rev - floorf(rev); c[i] = __builtin_amdgcn_cosf(rev); s[i] = __builtin_amdgcn_sinf(rev); }
}
template <int NM>
__device__ __forceinline__ void rope_store_fly(const f32x4 (&acc)[4][NM], int mi, u16* dstrow, const float (&ivr)[8], int pos, int q4) {
#pragma unroll
    for (int ni = 0; ni < 2; ++ni) {
        const int d = ni * 16 + q4 * 4;
        float c[4], s[4];
        rope_cs(ivr, ni, pos, c, s);
        const f32x4 x1 = acc[ni][mi], x2 = acc[ni + 2][mi];
        f32x4 o1 = {x1[0] * c[0] - x2[0] * s[0], x1[1] * c[1] - x2[1] * s[1], x1[2] * c[2] - x2[2] * s[2], x1[3] * c[3] - x2[3] * s[3]};
        f32x4 o2 = {x2[0] * c[0] + x1[0] * s[0], x2[1] * c[1] + x1[1] * s[1], x2[2] * c[2] + x1[2] * s[2], x2[3] * c[3] + x1[3] * s[3]};
        *(uint2*)(dstrow + d) = pack4(o1);
        *(uint2*)(dstrow + d + 32) = pack4(o2);
    }
}

template <int AMODE, int EPI>
__device__ __forceinline__ void gemm_phase(const u16* __restrict__ A, int lda, const u16* __restrict__ Bt, int M, int Npad, int K, int vboff, const EpiArgs& e, unsigned char* smem, int tid_, int bid_) {
    const int tid = tid_, lane = tid & 63, w = tid >> 6, wm = w & 3, wn = w >> 2;
    const int c16 = lane & 15, q4 = lane >> 4;
    const int ntm = (M + 255) >> 8, ntn = Npad >> 7, nk = K >> 6;
    const int kstride = (AMODE == AM_GATHER) ? 256 : 64;
    const int ldc = tid & 7, ldr = tid >> 3;
    const unsigned wofs = ldr * 128 + ((ldc ^ ((ldr >> 1) & 7)) << 4);
    const int swz = (c16 >> 1) & 7;
    const float* cosT = (const float*)(e.ws + OFF_COS);
    const float* sinT = (const float*)(e.ws + OFF_SIN);
    int vb = bid_ + vboff; if (vb >= (int)gridDim.x) vb -= gridDim.x;
    const int xcd = vb & 7, loc = vb >> 3, nloc = gridDim.x >> 3;
    const int mpx = ntm >> 3, nfull = (ntn >> 3), bwl = ntn - (nfull << 3);
    const int tfull = nfull * mpx * 8, ttotal = mpx * ntn;
    for (int tl = loc; tl < ttotal; tl += nloc) {
        int mloc, nt;
        if (tl < tfull) { const int band = tl / (mpx * 8), r = tl - band * (mpx * 8); mloc = r >> 3; nt = band * 8 + (r & 7); }
        else { const int r = tl - tfull; mloc = r / bwl; nt = (nfull << 3) + (r - mloc * bwl); }
        const int mt = xcd * mpx + mloc;
        const int m0 = mt << 8, n0 = nt << 7;
        unsigned aoff[4];
#pragma unroll
        for (int i = 0; i < 4; ++i) {
            int m = m0 + ldr + 64 * i; if (m > M - 1) m = M - 1;
            if (AMODE == AM_GATHER) { const int g = m & 3, bn = m >> 2, b = bn / 1023, n = bn - b * 1023; aoff[i] = (unsigned)((b * S_ + n * 16) * 256 + g * 64 + ldc * 8); }
            else aoff[i] = (unsigned)m * (unsigned)lda + ldc * 8;
        }
        const u16* bp = Bt + (size_t)(n0 + ldr) * K + ldc * 8;
        u32x4 ra0[4], rb0[2], ra1[4], rb1[2];
        f32x4 acc[4][4];
#pragma unroll
        for (int a = 0; a < 4; ++a)
#pragma unroll
            for (int b = 0; b < 4; ++b) acc[a][b] = (f32x4){0.f, 0.f, 0.f, 0.f};
        auto g_load = [&](u32x4 (&RA)[4], u32x4 (&RB)[2], int KT) __attribute__((always_inline)) {
#pragma unroll
            for (int i = 0; i < 4; ++i) RA[i] = *(const u32x4*)(A + aoff[i] + KT * kstride);
#pragma unroll
            for (int i = 0; i < 2; ++i) RB[i] = *(const u32x4*)(bp + (size_t)i * 64 * K + KT * 64);
        };
        auto g_store = [&](const u32x4 (&RA)[4], const u32x4 (&RB)[2], int ST) __attribute__((always_inline)) {
            unsigned char* d_ = smem + ST * 49152;
#pragma unroll
            for (int i = 0; i < 4; ++i) *(u32x4*)(d_ + wofs + i * 8192) = RA[i];
#pragma unroll
            for (int i = 0; i < 2; ++i) *(u32x4*)(d_ + 32768 + wofs + i * 8192) = RB[i];
        };
        auto g_compute = [&](int ST) __attribute__((always_inline)) {
            const unsigned char* sA = smem + ST * 49152;
            const unsigned char* sB = sA + 32768;
#pragma unroll
            for (int ks = 0; ks < 2; ++ks) {
                bf16x8 wf[4], af[4];
                const int ch = ((ks * 4 + q4) ^ swz) << 4;
#pragma unroll
                for (int ni = 0; ni < 4; ++ni) wf[ni] = *(const bf16x8*)(sB + (wn * 64 + ni * 16 + c16) * 128 + ch);
#pragma unroll
                for (int mi = 0; mi < 4; ++mi) af[mi] = *(const bf16x8*)(sA + (wm * 64 + mi * 16 + c16) * 128 + ch);
#pragma unroll
                for (int ni = 0; ni < 4; ++ni)
#pragma unroll
                    for (int mi = 0; mi < 4; ++mi) acc[ni][mi] = mfma16(wf[ni], af[mi], acc[ni][mi]);
            }
        };
        g_load(ra0, rb0, 0);
        g_load(ra1, rb1, 1);
        g_store(ra0, rb0, 0);
        __syncthreads();
        for (int kt = 0; kt < nk; kt += 2) {
            if (kt + 2 < nk) g_load(ra0, rb0, kt + 2);
            g_compute(0);
            g_store(ra1, rb1, 1);
            __syncthreads();
            if (kt + 3 < nk) g_load(ra1, rb1, kt + 3);
            g_compute(1);
            if (kt + 2 < nk) g_store(ra0, rb0, 0);
            __syncthreads();
        }
        float ivr[8];
        if (EPI == EPI_AIN || EPI == EPI_BQ || EPI == EPI_BKV) rope_ivr(ivr, q4);
        const int nb = n0 + wn * 64;
        if (EPI == EPI_RESID) {
#pragma unroll
            for (int mi = 0; mi < 4; ++mi) {
                const size_t tok = m0 + wm * 64 + mi * 16 + c16;
#pragma unroll
                for (int ni = 0; ni < 4; ++ni) {
                    const int n = nb + ni * 16 + q4 * 4;
                    float4 r = *(const float4*)(e.resid + tok * 1024 + n);
                    r.x += acc[ni][mi][0]; r.y += acc[ni][mi][1]; r.z += acc[ni][mi][2]; r.w += acc[ni][mi][3];
                    *(float4*)(e.out + tok * 1024 + n) = r;
                }
            }
        } else if (EPI == EPI_CMP1) {
#pragma unroll
            for (int mi = 0; mi < 4; ++mi) {
                const int m = m0 + wm * 64 + mi * 16 + c16;
                if (m < M) {
#pragma unroll
                    for (int ni = 0; ni < 4; ++ni) {
                        const int n = nb + ni * 16 + q4 * 4;
                        const float4 bv = *(const float4*)(e.bias + n);
                        f32x4 o = {gelu_tanh(acc[ni][mi][0] + bv.x), gelu_tanh(acc[ni][mi][1] + bv.y), gelu_tanh(acc[ni][mi][2] + bv.z), gelu_tanh(acc[ni][mi][3] + bv.w)};
                        *(uint2*)(e.hid + (size_t)m * 256 + n) = pack4(o);
                    }
                }
            }
        } else if (EPI == EPI_BQ) {
            u16* Q = (u16*)(e.ws + OFF_Q);
#pragma unroll
            for (int mi = 0; mi < 4; ++mi) {
                const int tok = m0 + wm * 64 + mi * 16 + c16;
                rope_store_fly(acc, mi, Q + (size_t)tok * 1024 + nb, ivr, tok & (S_ - 1), q4);
            }
        } else if (EPI == EPI_BKV) {
            u16* KSH = (u16*)(e.ws + OFF_KSH); u16* VSHT = (u16*)(e.ws + OFF_VSHT);
#pragma unroll
            for (int mi = 0; mi < 4; ++mi) {
                const int tok = m0 + wm * 64 + mi * 16 + c16, b = tok >> 14, s = tok & (S_ - 1);
                if (nb < 128) {
                    const int g = nb >> 6;
                    rope_store_fly(acc, mi, KSH + ((size_t)(b * 2 + g) * S_ + s) * 64, ivr, s, q4);
                } else {
                    const int g = (nb - 128) >> 6;
#pragma unroll
                    for (int ni = 0; ni < 4; ++ni)
#pragma unroll
                        for (int i = 0; i < 4; ++i) VSHT[((size_t)(b * 2 + g) * 64 + ni * 16 + q4 * 4 + i) * S_ + s] = f2bf(acc[ni][mi][i]);
                }
            }
        } else if (EPI == EPI_AIN) {
            unsigned char* ws = e.ws;
#pragma unroll
            for (int mi = 0; mi < 4; ++mi) {
                const int tok = m0 + wm * 64 + mi * 16 + c16, b = tok >> 14, s = tok & (S_ - 1);
                if (nb < 1024) {
                    rope_store_fly(acc, mi, (u16*)(ws + OFF_Q) + (size_t)tok * 1024 + nb, ivr, s, q4);
                } else if (nb < 1536) {
                    u16* dst = (nb < 1280) ? ((u16*)(ws + OFF_KC) + (size_t)tok * 256 + (nb - 1024)) : ((u16*)(ws + OFF_VC) + (size_t)tok * 256 + (nb - 1280));
#pragma unroll
                    for (int ni = 0; ni < 4; ++ni) *(uint2*)(dst + ni * 16 + q4 * 4) = pack4(acc[ni][mi]);
                } else if (nb < 2560) {
                    const int r = (nb - 1536) >> 8;
                    const int g = ((nb - 1536) & 255) >> 6;
                    if (r == 0) {
                        unsigned char* kd = (unsigned char*)(ws + OFF_KS) + (size_t)(b * 4 + g) * S_ * 128 + (size_t)s * 64;
#pragma unroll
                        for (int ni = 0; ni < 2; ++ni) {
                            const int d = ni * 16 + q4 * 4;
                            float c[4], sn[4];
                            rope_cs(ivr, ni, s, c, sn);
                            const f32x4 x1 = acc[ni][mi], x2 = acc[ni + 2][mi];
                            *(unsigned*)(kd + d) = pk4_fp8(x1[0] * c[0] - x2[0] * sn[0], x1[1] * c[1] - x2[1] * sn[1], x1[2] * c[2] - x2[2] * sn[2], x1[3] * c[3] - x2[3] * sn[3]);
                            *(unsigned*)(kd + d + 32) = pk4_fp8(x2[0] * c[0] + x1[0] * sn[0], x2[1] * c[1] + x1[1] * sn[1], x2[2] * c[2] + x1[2] * sn[2], x2[3] * c[3] + x1[3] * sn[3]);
                        }
                    } else if (r == 2) {
                        u16* base = (u16*)(ws + OFF_KW);
                        rope_store_fly(acc, mi, base + ((size_t)(b * 4 + g) * S_ + s) * 64, ivr, s, q4);
                    } else {
                        if (r == 1) {
                            unsigned char* base = (unsigned char*)(ws + OFF_VST) + (size_t)(b * 4 + g) * 128 * S_ + (size_t)(s >> 6) * 4096 + (s & 63);
#pragma unroll
                            for (int ni = 0; ni < 4; ++ni) {
                                const unsigned pk = pk4_fp8(acc[ni][mi][0], acc[ni][mi][1], acc[ni][mi][2], acc[ni][mi][3]);
#pragma unroll
                                for (int i = 0; i < 4; ++i) base[(ni * 16 + q4 * 4 + i) * 64] = (unsigned char)(pk >> (8 * i));
                            }
                        } else {
                            u16* base = (u16*)(ws + OFF_VWT);
#pragma unroll
                            for (int ni = 0; ni < 4; ++ni)
#pragma unroll
                                for (int i = 0; i < 4; ++i) base[((size_t)(b * 4 + g) * 64 + ni * 16 + q4 * 4 + i) * S_ + s] = f2bf(acc[ni][mi][i]);
                        }
                    }
                } else if (nb == 2560) {
                    float* G = (float*)(ws + OFF_GATES) + (size_t)tok * 48;
#pragma unroll
                    for (int ni = 0; ni < 3; ++ni) {
                        const int n = ni * 16 + q4 * 4;
                        *(float4*)(G + n) = make_float4(sigmoidf_(acc[ni][mi][0]), sigmoidf_(acc[ni][mi][1]), sigmoidf_(acc[ni][mi][2]), sigmoidf_(acc[ni][mi][3]));
                    }
                }
            }
        } else if (EPI == EPI_FFNIN) {
            float* U = (float*)smem;
#pragma unroll
            for (int mi = 0; mi < 4; ++mi) {
                const int row = wm * 64 + mi * 16 + c16;
#pragma unroll
                for (int ni = 0; ni < 4; ++ni) {
                    const int chunk = wn * 16 + ni * 4 + q4;
                    *(f32x4*)(U + row * 128 + ((chunk ^ (row & 31)) << 2)) = acc[ni][mi];
                }
            }
            __syncthreads();
            {
                const int ca = tid & 15, seg = tid >> 4;
                const int ncol = nt * 64 + ca * 4;
                const float4 w0a = *(const float4*)(e.convw + ncol), w1a = *(const float4*)(e.convw + NFF2 + ncol), w2a = *(const float4*)(e.convw + 2 * NFF2 + ncol);
                const float4 w0g = *(const float4*)(e.convw + DFF + ncol), w1g = *(const float4*)(e.convw + NFF2 + DFF + ncol), w2g = *(const float4*)(e.convw + 2 * NFF2 + DFF + ncol);
                const float4 ba = *(const float4*)(e.convb + ncol), bg = *(const float4*)(e.convb + DFF + ncol);
                float* head = (float*)(e.ws + OFF_HEAD); float* halo = (float*)(e.ws + OFF_HALO);
                u16* act = (u16*)(e.ws + OFF_ACT);
                const int r0 = seg * 8;
                float4 a2 = make_float4(0.f, 0.f, 0.f, 0.f), a1 = a2, g2 = a2, g1 = a2;
                if (seg > 0) {
                    const int rA = r0 - 2, rB = r0 - 1;
                    a2 = *(const float4*)(U + rA * 128 + ((ca ^ (rA & 31)) << 2)); g2 = *(const float4*)(U + rA * 128 + (((16 + ca) ^ (rA & 31)) << 2));
                    a1 = *(const float4*)(U + rB * 128 + ((ca ^ (rB & 31)) << 2)); g1 = *(const float4*)(U + rB * 128 + (((16 + ca) ^ (rB & 31)) << 2));
                }
#pragma unroll
                for (int r = 0; r < 8; ++r) {
                    const int row = r0 + r;
                    const float4 ua = *(const float4*)(U + row * 128 + ((ca ^ (row & 31)) << 2));
                    const float4 ug = *(const float4*)(U + row * 128 + (((16 + ca) ^ (row & 31)) << 2));
                    if (seg > 0 || r >= 2) {
                        float ca_[4], cg_[4];
                        ca_[0] = ba.x + w0a.x * a2.x + w1a.x * a1.x + w2a.x * ua.x; ca_[1] = ba.y + w0a.y * a2.y + w1a.y * a1.y + w2a.y * ua.y;
                        ca_[2] = ba.z + w0a.z * a2.z + w1a.z * a1.z + w2a.z * ua.z; ca_[3] = ba.w + w0a.w * a2.w + w1a.w * a1.w + w2a.w * ua.w;
                        cg_[0] = bg.x + w0g.x * g2.x + w1g.x * g1.x + w2g.x * ug.x; cg_[1] = bg.y + w0g.y * g2.y + w1g.y * g1.y + w2g.y * ug.y;
                        cg_[2] = bg.z + w0g.z * g2.z + w1g.z * g1.z + w2g.z * ug.z; cg_[3] = bg.w + w0g.w * g2.w + w1g.w * g1.w + w2g.w * ug.w;
                        f32x4 o = {ca_[0] * sigmoidf_(ca_[0]) * cg_[0], ca_[1] * sigmoidf_(ca_[1]) * cg_[1], ca_[2] * sigmoidf_(ca_[2]) * cg_[2], ca_[3] * sigmoidf_(ca_[3]) * cg_[3]};
                        *(uint2*)(act + (size_t)(m0 + row) * DFF + ncol) = pack4(o);
                    }
                    if (seg == 0 && r < 2) { *(float4*)(head + (size_t)(mt * 2 + r) * NFF2 + ncol) = ua; *(float4*)(head + (size_t)(mt * 2 + r) * NFF2 + DFF + ncol) = ug; }
                    if (seg == 31 && r >= 6) { *(float4*)(halo + (size_t)(mt * 2 + r - 6) * NFF2 + ncol) = ua; *(float4*)(halo + (size_t)(mt * 2 + r - 6) * NFF2 + DFF + ncol) = ug; }
                    a2 = a1; a1 = ua; g2 = g1; g1 = ug;
                }
            }
            __syncthreads();
        }
    }
}

template <int AMODE, int EPI>
__device__ __forceinline__ void gemm_big(const u16* __restrict__ A, int lda, const u16* __restrict__ Bt, int M, int Npad, int K, int vboff, const EpiArgs& e, unsigned char* smem, int tid_, int bid_) {
    const int tid = tid_, lane = tid & 63, w = tid >> 6, wm = w & 1, wn = w >> 1;
    const int c16 = lane & 15, q4 = lane >> 4;
    constexpr int MI = 8;
    const int ntm = (M + 255) >> 8, ntn = Npad >> 8, nk = K >> 5;
    const int kstride = (AMODE == AM_GATHER) ? 128 : 32;
    const float* cosT = (const float*)(e.ws + OFF_COS);
    const float* sinT = (const float*)(e.ws + OFF_SIN);
    int vb = bid_ + vboff; if (vb >= (int)gridDim.x) vb -= gridDim.x;
    const int xcd = vb & 7, loc = vb >> 3, nloc = gridDim.x >> 3;
    const int mpx = ntm >> 3, nfull = (ntn >> 3), bwl = ntn - (nfull << 3);
    const int tfull = nfull * mpx * 8, ttotal = mpx * ntn;
    for (int tl = loc; tl < ttotal; tl += nloc) {
        int mloc, nt;
        if (tl < tfull) { const int band = tl / (mpx * 8), r = tl - band * (mpx * 8); mloc = r >> 3; nt = band * 8 + (r & 7); }
        else { const int r = tl - tfull; mloc = r / bwl; nt = (nfull << 3) + (r - mloc * bwl); }
        const int mt = xcd * mpx + mloc;
        const int m0 = mt << 8, n0 = nt << 8;
        const int prow = ((w & 3) << 6) + (lane >> 3);
        const int pch = lane & 7;
        unsigned goff[8];
#pragma unroll
        for (int i = 0; i < 8; ++i) {
            const int row = prow + 8 * i;
            const int lc = pch ^ ((row >> 1) & 7);
            if (w < 4) {
                int m = m0 + row; if (m > M - 1) m = M - 1;
                if (AMODE == AM_GATHER) { const int gq = m & 3, bn = m >> 2, bb = bn / 1023, n = bn - bb * 1023; goff[i] = (unsigned)((bb * S_ + n * 16) * 256 + gq * 64 + lc * 8); }
                else goff[i] = (unsigned)m * (unsigned)lda + (unsigned)(lc * 8);
            } else goff[i] = (unsigned)(n0 + row) * (unsigned)K + (unsigned)(lc * 8);
        }
        const u16* gbase = (w < 4) ? A : Bt;
        const unsigned kst = (w < 4 && AMODE == AM_GATHER) ? 256u : 64u;
        typedef __attribute__((address_space(3))) unsigned* lds_u32p;
        const unsigned lbase = ((w < 4) ? 0u : 32768u) + (unsigned)(((w & 3) << 6) * 128) + (unsigned)lane * 16u;
        f32x4 acc[4][MI];
#pragma unroll
        for (int a2 = 0; a2 < 4; ++a2)
#pragma unroll
            for (int b2 = 0; b2 < MI; ++b2) acc[a2][b2] = (f32x4){0.f, 0.f, 0.f, 0.f};
        const int swz = (c16 >> 1) & 7;
        const int nk2 = nk >> 1;
#pragma unroll
        for (int i = 0; i < 8; ++i) __builtin_amdgcn_global_load_lds((const unsigned*)(gbase + goff[i]), (lds_u32p)(smem + lbase + i * 1024), 16, 0, 0);
        for (int kt = 0; kt < nk2; ++kt) {
            asm volatile("s_waitcnt vmcnt(0)" ::: "memory");
            __builtin_amdgcn_s_barrier();
            const unsigned char* sA = smem + (kt & 1) * 65536;
            const unsigned char* sB = sA + 32768;
            const bool more = kt + 1 < nk2;
            const unsigned ko = (unsigned)(kt + 1) * kst;
            unsigned char* sbn = smem + ((kt + 1) & 1) * 65536 + lbase;
#pragma unroll
            for (int ks = 0; ks < 2; ++ks) {
                bf16x8 wf[4], af[MI];
                const int ch = ((ks * 4 + q4) ^ swz) << 4;
#pragma unroll
                for (int ni = 0; ni < 4; ++ni) wf[ni] = *(const bf16x8*)(sB + (wn * 64 + ni * 16 + c16) * 128 + ch);
#pragma unroll
                for (int mi = 0; mi < MI; ++mi) af[mi] = *(const bf16x8*)(sA + (wm * 128 + mi * 16 + c16) * 128 + ch);
#pragma unroll
                for (int ni = 0; ni < 4; ++ni) {
                    if (more) __builtin_amdgcn_global_load_lds((const unsigned*)(gbase + (goff[ks * 4 + ni] + ko)), (lds_u32p)(sbn + (ks * 4 + ni) * 1024), 16, 0, 0);
#pragma unroll
                    for (int mi = 0; mi < MI; ++mi) acc[ni][mi] = mfma16(wf[ni], af[mi], acc[ni][mi]);
                }
            }
        }
        __syncthreads();
        const int nb = n0 + wn * 64;
        if (EPI == EPI_RESID) {
#pragma unroll
            for (int mi = 0; mi < MI; ++mi) { __builtin_amdgcn_sched_barrier(0);
                const size_t tok = m0 + wm * 128 + mi * 16 + c16;
#pragma unroll
                for (int ni = 0; ni < 4; ++ni) {
                    const int n = nb + ni * 16 + q4 * 4;
                    float4 r = *(const float4*)(e.resid + tok * 1024 + n);
                    r.x += acc[ni][mi][0]; r.y += acc[ni][mi][1]; r.z += acc[ni][mi][2]; r.w += acc[ni][mi][3];
                    *(float4*)(e.out + tok * 1024 + n) = r;
                }
            }
        } else if (EPI == EPI_CMP1) {
#pragma unroll
            for (int mi = 0; mi < MI; ++mi) { __builtin_amdgcn_sched_barrier(0);
                const int m = m0 + wm * 128 + mi * 16 + c16;
                if (m < M) {
#pragma unroll
                    for (int ni = 0; ni < 4; ++ni) {
                        const int n = nb + ni * 16 + q4 * 4;
                        const float4 bv = *(const float4*)(e.bias + n);
                        f32x4 o = {gelu_tanh(acc[ni][mi][0] + bv.x), gelu_tanh(acc[ni][mi][1] + bv.y), gelu_tanh(acc[ni][mi][2] + bv.z), gelu_tanh(acc[ni][mi][3] + bv.w)};
                        *(uint2*)(e.hid + (size_t)m * 256 + n) = pack4(o);
                    }
                }
            }
        } else if (EPI == EPI_BQ) {
            u16* Q = (u16*)(e.ws + OFF_Q);
#pragma unroll
            for (int mi = 0; mi < MI; ++mi) { __builtin_amdgcn_sched_barrier(0);
                const int tok = m0 + wm * 128 + mi * 16 + c16;
                rope_store(acc, mi, Q + (size_t)tok * 1024 + nb, cosT, sinT, tok & (S_ - 1), q4);
            }
        } else if (EPI == EPI_BKV) {
            u16* KSH = (u16*)(e.ws + OFF_KSH); u16* VSHT = (u16*)(e.ws + OFF_VSHT);
#pragma unroll
            for (int mi = 0; mi < MI; ++mi) { __builtin_amdgcn_sched_barrier(0);
                const int tok = m0 + wm * 128 + mi * 16 + c16, b = tok >> 14, s = tok & (S_ - 1);
                if (nb < 128) {
                    const int g = nb >> 6;
                    rope_store(acc, mi, KSH + ((size_t)(b * 2 + g) * S_ + s) * 64, cosT, sinT, s, q4);
                } else {
                    const int g = (nb - 128) >> 6;
#pragma unroll
                    for (int ni = 0; ni < 4; ++ni)
#pragma unroll
                        for (int i = 0; i < 4; ++i) VSHT[((size_t)(b * 2 + g) * 64 + ni * 16 + q4 * 4 + i) * S_ + s] = f2bf(acc[ni][mi][i]);
                }
            }
        } else if (EPI == EPI_AIN) {
            unsigned char* ws = e.ws;
#pragma unroll
            for (int mi = 0; mi < MI; ++mi) { __builtin_amdgcn_sched_barrier(0);
                const int tok = m0 + wm * 128 + mi * 16 + c16, b = tok >> 14, s = tok & (S_ - 1);
                if (nb < 1024) {
                    rope_store(acc, mi, (u16*)(ws + OFF_Q) + (size_t)tok * 1024 + nb, cosT, sinT, s, q4);
                } else if (nb < 1536) {
                    u16* dst = (nb < 1280) ? ((u16*)(ws + OFF_KC) + (size_t)tok * 256 + (nb - 1024)) : ((u16*)(ws + OFF_VC) + (size_t)tok * 256 + (nb - 1280));
#pragma unroll
                    for (int ni = 0; ni < 4; ++ni) *(uint2*)(dst + ni * 16 + q4 * 4) = pack4(acc[ni][mi]);
                } else if (nb < 2560) {
                    const int r = (nb - 1536) >> 8;
                    const int g = ((nb - 1536) & 255) >> 6;
                    if (r == 0) {
                        unsigned char* kd = (unsigned char*)(ws + OFF_KS) + (size_t)(b * 4 + g) * S_ * 128 + (size_t)s * 64;
#pragma unroll
                        for (int ni = 0; ni < 2; ++ni) {
                            const int d = ni * 16 + q4 * 4;
                            const float4 c = *(const float4*)(cosT + s * 32 + d), sn = *(const float4*)(sinT + s * 32 + d);
                            const f32x4 x1 = acc[ni][mi], x2 = acc[ni + 2][mi];
                            *(unsigned*)(kd + d) = pk4_fp8(x1[0] * c.x - x2[0] * sn.x, x1[1] * c.y - x2[1] * sn.y, x1[2] * c.z - x2[2] * sn.z, x1[3] * c.w - x2[3] * sn.w);
                            *(unsigned*)(kd + d + 32) = pk4_fp8(x2[0] * c.x + x1[0] * sn.x, x2[1] * c.y + x1[1] * sn.y, x2[2] * c.z + x1[2] * sn.z, x2[3] * c.w + x1[3] * sn.w);
                        }
                    } else if (r == 2) {
                        u16* base = (u16*)(ws + OFF_KW);
                        rope_store(acc, mi, base + ((size_t)(b * 4 + g) * S_ + s) * 64, cosT, sinT, s, q4);
                    } else {
                        if (r == 1) {
                            unsigned char* base = (unsigned char*)(ws + OFF_VST) + (size_t)(b * 4 + g) * 128 * S_ + (size_t)(s >> 6) * 4096 + (s & 63);
#pragma unroll
                            for (int ni = 0; ni < 4; ++ni) {
                                const unsigned pk = pk4_fp8(acc[ni][mi][0], acc[ni][mi][1], acc[ni][mi][2], acc[ni][mi][3]);
#pragma unroll
                                for (int i = 0; i < 4; ++i) base[(ni * 16 + q4 * 4 + i) * 64] = (unsigned char)(pk >> (8 * i));
                            }
                        } else {
                            u16* base = (u16*)(ws + OFF_VWT);
#pragma unroll
                            for (int ni = 0; ni < 4; ++ni)
#pragma unroll
                                for (int i = 0; i < 4; ++i) base[((size_t)(b * 4 + g) * 64 + ni * 16 + q4 * 4 + i) * S_ + s] = f2bf(acc[ni][mi][i]);
                        }
                    }
                } else if (nb == 2560) {
                    float* G = (float*)(ws + OFF_GATES) + (size_t)tok * 48;
#pragma unroll
                    for (int ni = 0; ni < 3; ++ni) {
                        const int n = ni * 16 + q4 * 4;
                        *(float4*)(G + n) = make_float4(sigmoidf_(acc[ni][mi][0]), sigmoidf_(acc[ni][mi][1]), sigmoidf_(acc[ni][mi][2]), sigmoidf_(acc[ni][mi][3]));
                    }
                }
            }
        } else if (EPI == EPI_FFNIN) {
            u16* U = (u16*)smem;
#pragma unroll
            for (int mi = 0; mi < MI; ++mi) {
                const int row = wm * 128 + mi * 16 + c16;
#pragma unroll
                for (int ni = 0; ni < 4; ++ni) {
                    const int cch = wn * 16 + ni * 4 + q4;
                    *(uint2*)(U + row * 256 + ((cch ^ (row & 15)) << 2)) = pack4(acc[ni][mi]);
                }
            }
            __syncthreads();
            {
                const int cc = tid & 31, gsel = cc >> 4, ca = cc & 15, seg = tid >> 5;
                const int ncol = (nt * 2 + gsel) * 64 + ca * 4;
                const int cha = gsel * 32 + ca, chg = cha + 16;
                const float4 w0a = *(const float4*)(e.convw + ncol), w1a = *(const float4*)(e.convw + NFF2 + ncol), w2a = *(const float4*)(e.convw + 2 * NFF2 + ncol);
                const float4 w0g = *(const float4*)(e.convw + DFF + ncol), w1g = *(const float4*)(e.convw + NFF2 + DFF + ncol), w2g = *(const float4*)(e.convw + 2 * NFF2 + DFF + ncol);
                const float4 ba = *(const float4*)(e.convb + ncol), bg = *(const float4*)(e.convb + DFF + ncol);
                float* head = (float*)(e.ws + OFF_HEAD); float* halo = (float*)(e.ws + OFF_HALO);
                u16* act = (u16*)(e.ws + OFF_ACT);
                auto ldu = [&](int row, int ch) __attribute__((always_inline)) -> float4 {
                    const uint2 v = *(const uint2*)(U + row * 256 + ((ch ^ (row & 15)) << 2));
                    return make_float4(__uint_as_float(v.x << 16), __uint_as_float(v.x & 0xffff0000u), __uint_as_float(v.y << 16), __uint_as_float(v.y & 0xffff0000u));
                };
                const int r0 = seg * 16;
                float4 a2 = make_float4(0.f, 0.f, 0.f, 0.f), a1 = a2, g2 = a2, g1 = a2;
                if (seg > 0) { a2 = ldu(r0 - 2, cha); g2 = ldu(r0 - 2, chg); a1 = ldu(r0 - 1, cha); g1 = ldu(r0 - 1, chg); }
#pragma unroll 2
                for (int r = 0; r < 16; ++r) {
                    const int row = r0 + r;
                    const float4 ua = ldu(row, cha), ug = ldu(row, chg);
                    if (seg > 0 || r >= 2) {
                        float ca_[4], cg_[4];
                        ca_[0] = ba.x + w0a.x * a2.x + w1a.x * a1.x + w2a.x * ua.x; ca_[1] = ba.y + w0a.y * a2.y + w1a.y * a1.y + w2a.y * ua.y;
                        ca_[2] = ba.z + w0a.z * a2.z + w1a.z * a1.z + w2a.z * ua.z; ca_[3] = ba.w + w0a.w * a2.w + w1a.w * a1.w + w2a.w * ua.w;
                        cg_[0] = bg.x + w0g.x * g2.x + w1g.x * g1.x + w2g.x * ug.x; cg_[1] = bg.y + w0g.y * g2.y + w1g.y * g1.y + w2g.y * ug.y;
                        cg_[2] = bg.z + w0g.z * g2.z + w1g.z * g1.z + w2g.z * ug.z; cg_[3] = bg.w + w0g.w * g2.w + w1g.w * g1.w + w2g.w * ug.w;
                        f32x4 o = {ca_[0] * sigmoidf_(ca_[0]) * cg_[0], ca_[1] * sigmoidf_(ca_[1]) * cg_[1], ca_[2] * sigmoidf_(ca_[2]) * cg_[2], ca_[3] * sigmoidf_(ca_[3]) * cg_[3]};
                        *(uint2*)(act + (size_t)(m0 + row) * DFF + ncol) = pack4(o);
                    }
                    if (seg == 0 && r < 2) { *(float4*)(head + (size_t)(mt * 2 + r) * NFF2 + ncol) = ua; *(float4*)(head + (size_t)(mt * 2 + r) * NFF2 + DFF + ncol) = ug; }
                    if (seg == 15 && r >= 14) { *(float4*)(halo + (size_t)(mt * 2 + r - 14) * NFF2 + ncol) = ua; *(float4*)(halo + (size_t)(mt * 2 + r - 14) * NFF2 + DFF + ncol) = ug; }
                    a2 = a1; a1 = ua; g2 = g1; g1 = ug;
                }
            }
            __syncthreads();
        }
    }
}

__device__ __forceinline__ void fixup_phase(const Params& p, int L, int tid_, int bid_) {
    const float* head = (const float*)(p.ws + OFF_HEAD); const float* halo = (const float*)(p.ws + OFF_HALO);
    u16* act = (u16*)(p.ws + OFF_ACT);
    const float* cw = p.ffn_conv_w + (size_t)L * 3 * NFF2; const float* cb = p.ffn_conv_b + (size_t)L * NFF2;
    const int gt = bid_ * NTHR + tid_, nthr = gridDim.x * NTHR;
    for (int idx = gt; idx < 128 * 704; idx += nthr) {
        const int i = idx / 704, n = (idx - i * 704) * 4;
        const int t0 = i * 256;
        const bool first = (t0 & (S_ - 1)) == 0;
        const float4 z = make_float4(0.f, 0.f, 0.f, 0.f);
        const float4 ha0 = *(const float4*)(head + (size_t)(i * 2) * NFF2 + n), ha1 = *(const float4*)(head + (size_t)(i * 2 + 1) * NFF2 + n);
        const float4 hg0 = *(const float4*)(head + (size_t)(i * 2) * NFF2 + DFF + n), hg1 = *(const float4*)(head + (size_t)(i * 2 + 1) * NFF2 + DFF + n);
        float4 pa0 = z, pa1 = z, pg0 = z, pg1 = z;
        if (!first) {
            pa0 = *(const float4*)(halo + (size_t)(i * 2 - 2) * NFF2 + n); pa1 = *(const float4*)(halo + (size_t)(i * 2 - 1) * NFF2 + n);
            pg0 = *(const float4*)(halo + (size_t)(i * 2 - 2) * NFF2 + DFF + n); pg1 = *(const float4*)(halo + (size_t)(i * 2 - 1) * NFF2 + DFF + n);
        }
        const float4 w0a = *(const float4*)(cw + n), w1a = *(const float4*)(cw + NFF2 + n), w2a = *(const float4*)(cw + 2 * NFF2 + n);
        const float4 w0g = *(const float4*)(cw + DFF + n), w1g = *(const float4*)(cw + NFF2 + DFF + n), w2g = *(const float4*)(cw + 2 * NFF2 + DFF + n);
        const float4 ba = *(const float4*)(cb + n), bg = *(const float4*)(cb + DFF + n);
#define CONV3(b_, w0_, w1_, w2_, x0_, x1_, x2_) make_float4(b_.x + w0_.x * x0_.x + w1_.x * x1_.x + w2_.x * x2_.x, b_.y + w0_.y * x0_.y + w1_.y * x1_.y + w2_.y * x2_.y, \
                                                             b_.z + w0_.z * x0_.z + w1_.z * x1_.z + w2_.z * x2_.z, b_.w + w0_.w * x0_.w + w1_.w * x1_.w + w2_.w * x2_.w)
        const float4 ca0 = CONV3(ba, w0a, w1a, w2a, pa0, pa1, ha0), cg0 = CONV3(bg, w0g, w1g, w2g, pg0, pg1, hg0);
        const float4 ca1 = CONV3(ba, w0a, w1a, w2a, pa1, ha0, ha1), cg1 = CONV3(bg, w0g, w1g, w2g, pg1, hg0, hg1);
        f32x4 o0 = {ca0.x * sigmoidf_(ca0.x) * cg0.x, ca0.y * sigmoidf_(ca0.y) * cg0.y, ca0.z * sigmoidf_(ca0.z) * cg0.z, ca0.w * sigmoidf_(ca0.w) * cg0.w};
        f32x4 o1 = {ca1.x * sigmoidf_(ca1.x) * cg1.x, ca1.y * sigmoidf_(ca1.y) * cg1.y, ca1.z * sigmoidf_(ca1.z) * cg1.z, ca1.w * sigmoidf_(ca1.w) * cg1.w};
        *(uint2*)(act + (size_t)t0 * DFF + n) = pack4(o0);
        *(uint2*)(act + (size_t)(t0 + 1) * DFF + n) = pack4(o1);
    }
}

__device__ __forceinline__ void cmp2_phase(const Params& p, int L, int tid_, int bid_) {
    const int lane = tid_ & 63, w = tid_ >> 6, c16 = lane & 15, q4 = lane >> 4;
    const float* cosT = (const float*)(p.ws + OFF_COS); const float* sinT = (const float*)(p.ws + OFF_SIN);
    u16* KCC = (u16*)(p.ws + OFF_KCC); u16* VCCT = (u16*)(p.ws + OFF_VCCT);
    float ivr[8];
    rope_ivr(ivr, q4);
    for (int task = bid_ * NW + w; task < 1024; task += gridDim.x * NW) {
        const int kv = task >> 9, r0 = (task & 511) * 16;
        const u16* hid = (const u16*)(p.ws + OFF_HID) + (size_t)kv * 8192 * 256;
        const u16* w2t = (const u16*)(p.ws + OFF_WT_CW2 + (L * 2 + kv) * SZ_WT_CW2);
        const int row = r0 + c16, rowc = row < 8184 ? row : 8183;
        f32x4 acc[4][1];
        f32x4 accq[4][4];
#pragma unroll
        for (int a = 0; a < 4; ++a) accq[a][0] = (f32x4){0.f, 0.f, 0.f, 0.f};
#pragma unroll
        for (int kk = 0; kk < 8; ++kk) {
            const bf16x8 bfr = *(const bf16x8*)(hid + (size_t)rowc * 256 + kk * 32 + q4 * 8);
#pragma unroll
            for (int nbk = 0; nbk < 4; ++nbk) {
                const bf16x8 afr = *(const bf16x8*)(w2t + (nbk * 16 + c16) * 256 + kk * 32 + q4 * 8);
                accq[nbk][0] = mfma16(afr, bfr, accq[nbk][0]);
            }
        }
        (void)acc;
        if (row < 8184) {
            const int g = row & 3, bn = row >> 2, b = bn / 1023, n = bn - b * 1023, bg = b * 4 + g;
            if (kv == 0) {
                rope_store_fly(accq, 0, KCC + ((size_t)bg * 1024 + n) * 64, ivr, n * 16 + 31, q4);
            } else {
#pragma unroll
                for (int nbk = 0; nbk < 4; ++nbk)
#pragma unroll
                    for (int i = 0; i < 4; ++i) VCCT[((size_t)bg * 64 + nbk * 16 + q4 * 4 + i) * 1024 + n] = f2bf(accq[nbk][0][i]);
            }
        }
    }
    const int gt = bid_ * NTHR + tid_;
    if (gt < 512) {
        const int bg = gt >> 6, d = gt & 63;
        KCC[((size_t)bg * 1024 + 1023) * 64 + d] = 0;
        VCCT[((size_t)bg * 64 + d) * 1024 + 1023] = 0;
    }
}

template <bool SINK>
__device__ __forceinline__ void band_attn(const u16* __restrict__ qrow, const u16* __restrict__ Kh, const u16* __restrict__ VT, int t0, int W, const float* sinks4,
                                          f32x4 (&O)[4][4], float (&linv)[4], int lane) {
    const int c16 = lane & 15, q4 = lane >> 4;
    const float SC = 0.125f * LOG2E;
    bf16x8 qf[4][2];
#pragma unroll
    for (int h = 0; h < 4; ++h)
#pragma unroll
        for (int ks = 0; ks < 2; ++ks) qf[h][ks] = *(const bf16x8*)(qrow + h * 64 + ks * 32 + q4 * 8);
    float m[4], l[4];
#pragma unroll
    for (int h = 0; h < 4; ++h) {
        if (SINK) { m[h] = sinks4[h] * LOG2E; l[h] = (q4 == 0) ? 1.f : 0.f; }
        else { m[h] = NEGBIG; l[h] = 0.f; }
#pragma unroll
        for (int db = 0; db < 4; ++db) O[h][db] = (f32x4){0.f, 0.f, 0.f, 0.f};
    }
    const int t = t0 + c16;
    int lo = t0 - W + 1; if (lo < 0) lo = 0;
    const int g0 = lo >> 5, g1 = (t0 + 15) >> 5;
    const int kr = kperm(c16);
    for (int grp = g0; grp <= g1; ++grp) {
        const int kb = grp << 5;
        const unsigned kof = (unsigned)(kb + kr) * 64u + (unsigned)q4 * 8u;
        const bf16x8 k1a = *(const bf16x8*)(Kh + kof), k1b = *(const bf16x8*)(Kh + (kof + 32u)), k2a = *(const bf16x8*)(Kh + (kof + 256u)), k2b = *(const bf16x8*)(Kh + (kof + 288u));
        bf16x8 vf[4];
        const unsigned vof = (unsigned)c16 * (unsigned)S_ + (unsigned)kb + (unsigned)q4 * 8u;
#pragma unroll
        for (int db = 0; db < 4; ++db) vf[db] = *(const bf16x8*)(VT + (size_t)(db * 16 * S_) + vof);
        const int kpos = kb + q4 * 8;
        f32x4 cm1 = {0.f, 0.f, 0.f, 0.f}, cm2 = cm1;
        if (!((kb + 31 <= t0) && (kb > t0 + 15 - W))) {
#pragma unroll
            for (int i = 0; i < 4; ++i) {
                const int d1 = t - (kpos + i), d2 = t - (kpos + 4 + i);
                if (!((d1 >= 0) && (d1 < W))) cm1[i] = NEGBIG;
                if (!((d2 >= 0) && (d2 < W))) cm2[i] = NEGBIG;
            }
        }
#pragma unroll
        for (int h = 0; h < 4; ++h) {
            f32x4 s1 = mfma16(k1a, qf[h][0], cm1); s1 = mfma16(k1b, qf[h][1], s1);
            f32x4 s2 = mfma16(k2a, qf[h][0], cm2); s2 = mfma16(k2b, qf[h][1], s2);
            float mx = fmaxf(fmaxf(fmaxf(s1[0], s1[1]), fmaxf(s1[2], s1[3])), fmaxf(fmaxf(s2[0], s2[1]), fmaxf(s2[2], s2[3])));
            mx = xmax32(xmax16(mx));
            const float mn = fmaxf(fmaxf(m[h], mx * SC), -1e20f);
            if (__ballot(mn != m[h])) {
                const float alpha = fexp2(m[h] - mn);
                l[h] *= alpha;
#pragma unroll
                for (int db = 0; db < 4; ++db) O[h][db] = O[h][db] * alpha;
            }
            m[h] = mn;
            float pv[8]; float ps = 0.f;
#pragma unroll
            for (int i = 0; i < 4; ++i) { pv[i] = fexp2(fmaf(s1[i], SC, -mn)); pv[4 + i] = fexp2(fmaf(s2[i], SC, -mn)); }
#pragma unroll
            for (int i = 0; i < 8; ++i) ps += pv[i];
            l[h] += ps;
            const bf16x8 pf = pack8(pv);
#pragma unroll
            for (int db = 0; db < 4; ++db) O[h][db] = mfma16(vf[db], pf, O[h][db]);
        }
    }
#pragma unroll
    for (int h = 0; h < 4; ++h) { float lt = l[h]; lt += __shfl_xor(lt, 16); lt += __shfl_xor(lt, 32); linv[h] = 1.f / lt; }
}

__device__ __forceinline__ void swa_phase(const Params& p, int j, int tid_, int bid_) {
    const int lane = tid_ & 63, w = tid_ >> 6, c16 = lane & 15, q4 = lane >> 4;
    const int x = bid_ & 7, b = x >> 2, kvh = (x >> 1) & 1, hq = x & 1;
    const int head0 = kvh * 8 + hq * 4;
    const u16* Q = (const u16*)(p.ws + OFF_Q); u16* Ob = (u16*)(p.ws + OFF_O);
    const u16* Kh = (const u16*)(p.ws + OFF_KSH) + (size_t)(b * 2 + kvh) * S_ * 64;
    const u16* VT = (const u16*)(p.ws + OFF_VSHT) + (size_t)(b * 2 + kvh) * 64 * S_;
    const float* sk = p.b_sinks + j * 16 + head0;
    const int nslots = (gridDim.x >> 3) * NW;
    for (int tile = (bid_ >> 3) * NW + w; tile < 1024; tile += nslots) {
        const int t0 = tile * 16;
        f32x4 O[4][4]; float linv[4];
        band_attn<true>(Q + ((size_t)b * S_ + t0 + c16) * 1024 + head0 * 64, Kh, VT, t0, 128, sk, O, linv, lane);
        u16* op = Ob + ((size_t)b * S_ + t0 + c16) * 1024 + head0 * 64;
#pragma unroll
        for (int h = 0; h < 4; ++h)
#pragma unroll
            for (int db = 0; db < 4; ++db) *(uint2*)(op + h * 64 + db * 16 + q4 * 4) = pack4(O[h][db] * linv[h]);
    }
}

__device__ __forceinline__ void nsa_phase(const Params& p, unsigned char* smem, int tid_, int bid_, int probe_rep, int layer) {
    const int lane0 = tid_ & 63, w = tid_ >> 6;
    float* R = (float*)(smem + w * 16384);
    unsigned* tm = (unsigned*)(smem + NW * 16384 + w * 1024);
    unsigned char* sel = smem + NW * 16384 + NW * 1024 + w * 256;
    const int bg = bid_ & 7, b = bg >> 2, g = bg & 3;
    const u16* Q = (const u16*)(p.ws + OFF_Q); u16* Ob = (u16*)(p.ws + OFF_O);
    const u16* KCC = (const u16*)(p.ws + OFF_KCC) + (size_t)bg * 1024 * 64;
    const u16* VCCT = (const u16*)(p.ws + OFF_VCCT) + (size_t)bg * 64 * 1024;
    const u16* KS = (const u16*)(p.ws + OFF_KS) + (size_t)bg * S_ * 64;
    const u16* VST = (const u16*)(p.ws + OFF_VST) + (size_t)bg * 64 * S_;
    const u16* KW = (const u16*)(p.ws + OFF_KW) + (size_t)bg * S_ * 64;
    const u16* VWT = (const u16*)(p.ws + OFF_VWT) + (size_t)bg * 64 * S_;
    const float* GATES = (const float*)(p.ws + OFF_GATES);
    const float SC = 0.125f * LOG2E;
    const int nslots = (gridDim.x >> 3) * NW;
    unsigned* qhead = (unsigned*)(p.ws + OFF_BAR) + 4096 + (layer * 8 + bg) * 64;
    for (;;) {
        int tile_ = 0;
        if (lane0 == 0) tile_ = (int)__hip_atomic_fetch_add(qhead, 1u, __ATOMIC_RELAXED, __HIP_MEMORY_SCOPE_AGENT);
        tile_ = 1023 - __builtin_amdgcn_readfirstlane(tile_);
        if (tile_ < 0) break;
        const int tile = __builtin_amdgcn_readfirstlane(tile_);
        int lane = lane0; asm volatile("" : "+v"(lane));
        const int c16 = lane & 15, q4 = lane >> 4, kr = kperm(c16);
        const int t0 = tile * 16, cur = t0 >> 6, t = t0 + c16;
        const u16* qrow = Q + ((size_t)b * S_ + t) * 1024 + g * 256;
        const float* grow = GATES + ((size_t)b * S_ + t) * 48 + g * 12;
        const int nvl = (t >= 31) ? ((t - 31) >> 4) : -1;
        const int nvmax = (t0 + 15 >= 31) ? ((t0 + 15 - 31) >> 4) : -1;
        const int ng = (nvmax >= 0) ? ((nvmax >> 5) + 1) : 0;
        f32x4 Oc[4][4];
#pragma unroll
        for (int h = 0; h < 4; ++h)
#pragma unroll
            for (int db = 0; db < 4; ++db) Oc[h][db] = (f32x4){0.f, 0.f, 0.f, 0.f};
        {
            bf16x8 qf[4][2];
#pragma unroll
            for (int h = 0; h < 4; ++h)
#pragma unroll
                for (int ks = 0; ks < 2; ++ks) qf[h][ks] = *(const bf16x8*)(qrow + h * 64 + ks * 32 + q4 * 8);
            float m[4], l[4];
#pragma unroll
            for (int h = 0; h < 4; ++h) { m[h] = NEGBIG; l[h] = 0.f; }
            const int nvmin = (t0 >= 31) ? ((t0 - 31) >> 4) : -1;
            for (int grp = 0; grp < ng; ++grp) {
                const int kb = grp << 5;
                const unsigned kof = (unsigned)(kb + kr) * 64u + (unsigned)q4 * 8u;
                const bf16x8 k1a = *(const bf16x8*)(KCC + kof), k1b = *(const bf16x8*)(KCC + (kof + 32u)), k2a = *(const bf16x8*)(KCC + (kof + 256u)), k2b = *(const bf16x8*)(KCC + (kof + 288u));
                const int kpos = kb + q4 * 8;
                f32x4 cm1 = {0.f, 0.f, 0.f, 0.f}, cm2 = cm1;
                if (kb + 31 > nvmin) {
#pragma unroll
                    for (int i = 0; i < 4; ++i) { if (kpos + i > nvl) cm1[i] = NEGBIG; if (kpos + 4 + i > nvl) cm2[i] = NEGBIG; }
                }
#pragma unroll
                for (int h = 0; h < 4; ++h) {
                    f32x4 s1 = mfma16(k1a, qf[h][0], cm1); s1 = mfma16(k1b, qf[h][1], s1);
                    f32x4 s2 = mfma16(k2a, qf[h][0], cm2); s2 = mfma16(k2b, qf[h][1], s2);
                    float mx = fmaxf(fmaxf(fmaxf(s1[0], s1[1]), fmaxf(s1[2], s1[3])), fmaxf(fmaxf(s2[0], s2[1]), fmaxf(s2[2], s2[3])));
                    mx = xmax32(xmax16(mx));
                    const float mn = fmaxf(fmaxf(m[h], mx * SC), -1e20f);
                    if (__ballot(mn != m[h])) l[h] *= fexp2(m[h] - mn);
                    m[h] = mn;
                    float ps = 0.f;
#pragma unroll
                    for (int i = 0; i < 4; ++i) ps += fexp2(fmaf(s1[i], SC, -mn)) + fexp2(fmaf(s2[i], SC, -mn));
                    l[h] += ps;
                }
            }
            float linv[4];
#pragma unroll
            for (int h = 0; h < 4; ++h) { float lt = l[h]; lt += __shfl_xor(lt, 16); lt += __shfl_xor(lt, 32); linv[h] = lt > 0.f ? 1.f / lt : 0.f; }
            float carry = 0.f;
            for (int grp = 0; grp < ng; ++grp) {
                const int kb = grp << 5;
                const unsigned kof = (unsigned)(kb + kr) * 64u + (unsigned)q4 * 8u;
                const bf16x8 k1a = *(const bf16x8*)(KCC + kof), k1b = *(const bf16x8*)(KCC + (kof + 32u)), k2a = *(const bf16x8*)(KCC + (kof + 256u)), k2b = *(const bf16x8*)(KCC + (kof + 288u));
                bf16x8 vf[4];
#pragma unroll
                for (int db = 0; db < 4; ++db) vf[db] = *(const bf16x8*)(VCCT + (unsigned)(db * 16 * 1024) + ((unsigned)c16 * 1024u + (unsigned)kb + (unsigned)q4 * 8u));
                const int kpos = kb + q4 * 8;
                float psum[8];
#pragma unroll
                for (int i = 0; i < 8; ++i) psum[i] = 0.f;
                f32x4 cm1 = {0.f, 0.f, 0.f, 0.f}, cm2 = cm1;
                if (kb + 31 > nvmin) {
#pragma unroll
                    for (int i = 0; i < 4; ++i) { if (kpos + i > nvl) cm1[i] = NEGBIG; if (kpos + 4 + i > nvl) cm2[i] = NEGBIG; }
                }
#pragma unroll
                for (int h = 0; h < 4; ++h) {
                    f32x4 s1 = mfma16(k1a, qf[h][0], cm1); s1 = mfma16(k1b, qf[h][1], s1);
                    f32x4 s2 = mfma16(k2a, qf[h][0], cm2); s2 = mfma16(k2b, qf[h][1], s2);
                    float pv[8];
#pragma unroll
                    for (int i = 0; i < 4; ++i) {
                        pv[i] = fexp2(fmaf(s1[i], SC, -m[h])) * linv[h];
                        pv[4 + i] = fexp2(fmaf(s2[i], SC, -m[h])) * linv[h];
                    }
#pragma unroll
                    for (int i = 0; i < 8; ++i) psum[i] += pv[i];
                    const bf16x8 pf = pack8(pv);
#pragma unroll
                    for (int db = 0; db < 4; ++db) Oc[h][db] = mfma16(vf[db], pf, Oc[h][db]);
                }
                const float prev = __shfl(psum[7], (lane + 48) & 63);
                const float left = (q4 == 0) ? carry : prev;
                carry = prev;
                const float impA = left + 2.f * (psum[0] + psum[1] + psum[2]) + psum[3];
                const float impB = psum[3] + 2.f * (psum[4] + psum[5] + psum[6]) + psum[7];
                *(float2*)(R + c16 * 256 + (kb >> 2) + 2 * q4) = make_float2(impA, impB);
            }
        }
        wsync();
        const int ncand = cur - 2;
        const int npick = ncand < 0 ? 0 : (ncand < 13 ? ncand : 13);
        const int nforced = (cur < 2 ? cur : 2) + 1;
        const int nsel = npick + nforced;
        for (int tk = 0; tk < 8; ++tk) {
            float a0 = -1.f, a1 = -1.f, a2 = -1.f, a3 = -1.f, b0 = -1.f, b1 = -1.f, b2 = -1.f, b3 = -1.f;
            if (npick > 0) {
                const float4 va = *(const float4*)(R + tk * 256 + lane * 4), vb = *(const float4*)(R + (tk + 8) * 256 + lane * 4);
                const int j0 = lane * 4;
                const bool k0 = (j0 >= 1 && j0 <= ncand), k1 = (j0 + 1 <= ncand), k2 = (j0 + 2 <= ncand), k3 = (j0 + 3 <= ncand);
                a0 = k0 ? va.x : -1.f; a1 = k1 ? va.y : -1.f; a2 = k2 ? va.z : -1.f; a3 = k3 ? va.w : -1.f;
                b0 = k0 ? vb.x : -1.f; b1 = k1 ? vb.y : -1.f; b2 = k2 ? vb.z : -1.f; b3 = k3 ? vb.w : -1.f;
            }
            for (int it = 0; it < npick; ++it) {
                const float ma = wave_max(fmaxf(fmaxf(a0, a1), fmaxf(a2, a3)));
                const float mb = wave_max(fmaxf(fmaxf(b0, b1), fmaxf(b2, b3)));
                const unsigned long long bala = __ballot((a0 == ma) || (a1 == ma) || (a2 == ma) || (a3 == ma));
                const unsigned long long balb = __ballot((b0 == mb) || (b1 == mb) || (b2 == mb) || (b3 == mb));
                const int fa = __ffsll((long long)bala) - 1, fb = __ffsll((long long)balb) - 1;
                if (lane == fa) {
                    int sl;
                    if (a0 == ma) { sl = 0; a0 = -1.f; } else if (a1 == ma) { sl = 1; a1 = -1.f; } else if (a2 == ma) { sl = 2; a2 = -1.f; } else { sl = 3; a3 = -1.f; }
                    sel[tk * 16 + it] = (unsigned char)(lane * 4 + sl);
                }
                if (lane == fb) {
                    int sl;
                    if (b0 == mb) { sl = 0; b0 = -1.f; } else if (b1 == mb) { sl = 1; b1 = -1.f; } else if (b2 == mb) { sl = 2; b2 = -1.f; } else { sl = 3; b3 = -1.f; }
                    sel[(tk + 8) * 16 + it] = (unsigned char)(lane * 4 + sl);
                }
            }
            if (lane < 2) {
                const int tq = tk + lane * 8;
                sel[tq * 16 + npick] = 0;
                if (cur >= 1) sel[tq * 16 + npick + 1] = (unsigned char)cur;
                if (cur >= 2) sel[tq * 16 + npick + 2] = (unsigned char)(cur - 1);
            }
        }
        { unsigned zz = 0u; asm volatile("" : "+v"(zz)); *(uint4*)(tm + lane * 4) = make_uint4(zz, zz, zz, zz); }
        wsync();
        if (lane < 16) {
            for (int si = 0; si < nsel; ++si) atomicOr(&tm[sel[lane * 16 + si]], 1u << lane);
        }
        wsync();
        int n_act;
        {
            const uint4 mm = *(const uint4*)(tm + lane * 4);
            wsync();
            const bool f0 = mm.x != 0u, f1 = mm.y != 0u, f2 = mm.z != 0u, f3 = mm.w != 0u;
            const unsigned long long b0 = __ballot(f0), b1 = __ballot(f1), b2 = __ballot(f2), b3 = __ballot(f3);
            const unsigned long long below = (1ull << lane) - 1ull;
            int pos = __popcll(b0 & below) + __popcll(b1 & below) + __popcll(b2 & below) + __popcll(b3 & below);
            if (f0) { sel[pos] = (unsigned char)(lane * 4 + 0); ++pos; }
            if (f1) { sel[pos] = (unsigned char)(lane * 4 + 1); ++pos; }
            if (f2) { sel[pos] = (unsigned char)(lane * 4 + 2); ++pos; }
            if (f3) { sel[pos] = (unsigned char)(lane * 4 + 3); ++pos; }
            n_act = __popcll(b0) + __popcll(b1) + __popcll(b2) + __popcll(b3);
        }
        wsync();
        u16* PL = (u16*)R + 4096;
        {
            int t3 = t; asm volatile("" : "+v"(t3));
            const float* grow3 = GATES + ((size_t)b * S_ + t3) * 48 + g * 12;
#pragma unroll
            for (int h = 0; h < 4; ++h) {
                const float g0 = grow3[h * 3 + 0];
#pragma unroll
                for (int db = 0; db < 4; ++db) *(uint2*)(PL + (c16 * 4 + h) * 64 + db * 16 + q4 * 4) = pack4(Oc[h][db] * g0);
            }
        }
        wsync();
        for (int rep = 0; rep <= probe_rep; ++rep) {
            const int tg = c16 >> 2, hh = c16 & 3;
            f32x4 Os[4][4], Ol[4]; float m[4];
#pragma unroll
            for (int gq = 0; gq < 4; ++gq) {
                m[gq] = NEGBIG; Ol[gq] = (f32x4){0.f, 0.f, 0.f, 0.f};
#pragma unroll
                for (int db = 0; db < 4; ++db) Os[gq][db] = (f32x4){0.f, 0.f, 0.f, 0.f};
            }
            const long ones8 = 0x3838383838383838L;
            long qf8[4][2];
#pragma unroll
            for (int gq = 0; gq < 4; ++gq)
#pragma unroll
                for (int ks = 0; ks < 2; ++ks) {
                    const uint4 qv = *(const uint4*)(Q + ((size_t)b * S_ + t0 + gq * 4 + tg) * 1024 + g * 256 + hh * 64 + ks * 32 + q4 * 8);
                    const float f[8] = {__uint_as_float(qv.x << 16), __uint_as_float(qv.x & 0xffff0000u), __uint_as_float(qv.y << 16), __uint_as_float(qv.y & 0xffff0000u),
                                        __uint_as_float(qv.z << 16), __uint_as_float(qv.z & 0xffff0000u), __uint_as_float(qv.w << 16), __uint_as_float(qv.w & 0xffff0000u)};
                    qf8[gq][ks] = pk8_fp8(f);
                }
            const unsigned char* KS8 = (const unsigned char*)KS;
            const unsigned char* VS8 = (const unsigned char*)VST;
            auto ld = [&](int s, long (&K)[4], long (&V)[4]) __attribute__((always_inline)) {
                const int j = __builtin_amdgcn_readfirstlane((int)sel[s >> 1]);
                const int kb = j * 64 + (s & 1) * 32;
                const unsigned kof = (unsigned)(kb + kr) * 64u + (unsigned)q4 * 8u;
                K[0] = *(const long*)(KS8 + kof); K[1] = *(const long*)(KS8 + (kof + 32u)); K[2] = *(const long*)(KS8 + (kof + 256u)); K[3] = *(const long*)(KS8 + (kof + 288u));
                const unsigned vof = (unsigned)j * 4096u + (unsigned)c16 * 64u + (unsigned)(s & 1) * 32u + (unsigned)q4 * 8u;
#pragma unroll
                for (int db = 0; db < 4; ++db) V[db] = *(const long*)(VS8 + (vof + (unsigned)(db * 1024)));
            };
            auto cp = [&](int s, const long (&K)[4], const long (&V)[4]) __attribute__((always_inline)) {
                const int j = __builtin_amdgcn_readfirstlane((int)sel[s >> 1]);
                const unsigned mk = __builtin_amdgcn_readfirstlane(tm[j]);
                const int kpos = j * 64 + (s & 1) * 32 + q4 * 8;
#pragma unroll
                for (int gq = 0; gq < 4; ++gq) {
                    const unsigned gm = (mk >> (gq * 4)) & 0xFu;
                    if (gm == 0u) continue;
                    const float cmv = ((gm >> tg) & 1u) ? 0.f : NEGBIG;
                    f32x4 cm1 = {cmv, cmv, cmv, cmv}, cm2 = cm1;
                    if (j == cur) {
                        const int tc = t0 + gq * 4 + tg;
#pragma unroll
                        for (int i = 0; i < 4; ++i) { if (kpos + i > tc) cm1[i] = NEGBIG; if (kpos + 4 + i > tc) cm2[i] = NEGBIG; }
                    }
                    f32x4 s1 = mfma8(K[0], qf8[gq][0], cm1); s1 = mfma8(K[1], qf8[gq][1], s1);
                    f32x4 s2 = mfma8(K[2], qf8[gq][0], cm2); s2 = mfma8(K[3], qf8[gq][1], s2);
                    float mx = fmaxf(fmaxf(fmaxf(s1[0], s1[1]), fmaxf(s1[2], s1[3])), fmaxf(fmaxf(s2[0], s2[1]), fmaxf(s2[2], s2[3])));
                    mx = xmax32(xmax16(mx));
                    const float mn = fmaxf(m[gq], mx * SC);
                    if (__ballot(mn != m[gq])) {
                        const float alpha = fexp2(m[gq] - mn);
                        Ol[gq] = Ol[gq] * alpha;
#pragma unroll
                        for (int db = 0; db < 4; ++db) Os[gq][db] = Os[gq][db] * alpha;
                    }
                    m[gq] = mn;
                    float pv[8];
#pragma unroll
                    for (int i = 0; i < 4; ++i) { pv[i] = fexp2(fmaf(s1[i], SC, 7.f - mn)); pv[4 + i] = fexp2(fmaf(s2[i], SC, 7.f - mn)); }
                    const long pf = pk8_fp8(pv);
#pragma unroll
                    for (int db = 0; db < 4; ++db) Os[gq][db] = mfma8(V[db], pf, Os[gq][db]);
                    Ol[gq] = mfma8(ones8, pf, Ol[gq]);
                }
            };
            {
                long KA[4], VA[4], KB[4], VB[4];
                const int ns = 2 * n_act;
                ld(0, KA, VA);
                for (int s = 0; s < ns; s += 2) {
                    ld(s + 1, KB, VB);
                    cp(s, KA, VA);
                    if (s + 2 < ns) ld(s + 2, KA, VA);
                    cp(s + 1, KB, VB);
                }
            }
            const float repsc = (rep == 0) ? 1.f : 0.f;
#pragma unroll
            for (int gq = 0; gq < 4; ++gq) {
                const float lt = Ol[gq][0];
                const int tok = gq * 4 + tg;
                const float sc = repsc * GATES[((size_t)b * S_ + t0 + tok) * 48 + g * 12 + hh * 3 + 1] / lt;
#pragma unroll
                for (int db = 0; db < 4; ++db) {
                    u16* rp = PL + (tok * 4 + hh) * 64 + db * 16 + q4 * 4;
                    *(uint2*)rp = pack4(unpack4(*(const uint2*)rp) + Os[gq][db] * sc);
                }
            }
        }
        wsync();
        {
            f32x4 Ow[4][4]; float linv[4];
            int t2 = t; asm volatile("" : "+v"(t2));
            const u16* qrow2 = Q + ((size_t)b * S_ + t2) * 1024 + g * 256;
            const float* grow2 = GATES + ((size_t)b * S_ + t2) * 48 + g * 12;
            band_attn<false>(qrow2, KW, VWT, t0, 512, nullptr, Ow, linv, lane);
            u16* op = Ob + ((size_t)b * S_ + t2) * 1024 + g * 256;
#pragma unroll
            for (int h = 0; h < 4; ++h) {
                const float g2 = grow2[h * 3 + 2] * linv[h];
#pragma unroll
                for (int db = 0; db < 4; ++db) {
                    const f32x4 part = unpack4(*(const uint2*)(PL + (c16 * 4 + h) * 64 + db * 16 + q4 * 4));
                    *(uint2*)(op + h * 64 + db * 16 + q4 * 4) = pack4(part + Ow[h][db] * g2);
                }
            }
        }
        wsync();
    }
}


#define XB_TMO      128
#define XB_XCNT(j)  (256  + 64 * (j))
#define XB_XSUB(j)  (1280 + 64 * (j))
#define XB_XGEN(j)  (2304 + 64 * (j))
#define XB_TOP      3328
#define XB_TOPGEN   3392
#define XCD_BAR_WORDS 3456
#define XB_SPIN_CAP (1u << 22)
#define LAS __attribute__((address_space(3)))
__device__ __forceinline__ unsigned xb_ld(unsigned* p)              { return __hip_atomic_load(p, __ATOMIC_RELAXED, __HIP_MEMORY_SCOPE_AGENT); }
__device__ __forceinline__ unsigned xb_add(unsigned* p, unsigned v) { return __hip_atomic_fetch_add(p, v, __ATOMIC_RELAXED, __HIP_MEMORY_SCOPE_AGENT); }
__device__ __forceinline__ unsigned xb_xcc_id() { return (unsigned)__builtin_amdgcn_s_getreg((3 << 11) | 20) & 0xFu; }
#define XB_SPIN(cond, bar) do { unsigned _sp = 0; while (cond) { __builtin_amdgcn_s_sleep(1); \
    if ((++_sp & 255u) == 0u) { if (xb_ld(&(bar)[XB_TMO])) break; if (_sp > XB_SPIN_CAP) { atomicAdd(&(bar)[XB_TMO], 1u); break; } } } } while (0)
__device__ __forceinline__ void xcd_barrier_complete(unsigned* bar, unsigned x, unsigned& nloc, unsigned& nx) {
    const unsigned G = gridDim.x * gridDim.y * gridDim.z;
    unsigned sum, cnt, mine, sp = 0u;
    for (;;) {
        sum = 0u; cnt = 0u; mine = 0u;
#pragma unroll
        for (unsigned j = 0; j < 16; ++j) { const unsigned c = xb_ld(&bar[XB_XCNT(j)]); sum += c; cnt += (c > 0u) ? 1u : 0u; mine = (j == x) ? c : mine; }
        if (sum == G) break;
        __builtin_amdgcn_s_sleep(1);
        if ((++sp & 255u) == 0u) { if (xb_ld(&bar[XB_TMO])) break; if (sp > XB_SPIN_CAP) { atomicAdd(&bar[XB_TMO], 1u); break; } }
    }
    nloc = mine > 0u ? mine : 1u; nx = cnt > 0u ? cnt : 1u;
}
__device__ __forceinline__ void xcd_barrier(unsigned* bar, unsigned x, volatile LAS unsigned* st, int tid) {
    asm volatile("s_waitcnt vmcnt(0)" ::: "memory");
    __syncthreads();
    if (tid == 0) {
        __builtin_amdgcn_s_waitcnt(0);
        unsigned nloc = st[0], nx = st[1];
        if (nloc == 0u) { xcd_barrier_complete(bar, x, nloc, nx); st[0] = nloc; st[1] = nx; }
        const unsigned old = xb_add(&bar[XB_XSUB(x)], 1u);
        const unsigned gen = old / nloc;
        if (old + 1u == (gen + 1u) * nloc) {
            __builtin_amdgcn_fence(__ATOMIC_RELEASE, "agent");
            asm volatile("s_waitcnt vmcnt(0)" ::: "memory");
            const unsigned og = xb_add(&bar[XB_TOP], 1u);
            const unsigned tg = og / nx;
            if (og + 1u == (tg + 1u) * nx) xb_add(&bar[XB_TOPGEN], 1u);
            else XB_SPIN(xb_ld(&bar[XB_TOPGEN]) == tg, bar);
            __builtin_amdgcn_fence(__ATOMIC_ACQUIRE, "agent");
            xb_add(&bar[XB_XGEN(x)], 1u);
            asm volatile("s_waitcnt vmcnt(0)" ::: "memory");
        } else {
            XB_SPIN(xb_ld(&bar[XB_XGEN(x)]) == gen, bar);
            __builtin_amdgcn_fence(__ATOMIC_ACQUIRE, "agent");
            asm volatile("s_waitcnt vmcnt(0)" ::: "memory");
        }
    }
    __syncthreads();
}

enum { PT_PREP = 0, PT_NORM, PT_AIN, PT_CMP1, PT_CMP2, PT_NSA, PT_BKV, PT_BQ, PT_SWA, PT_AOUT, PT_FFNIN, PT_FIXUP, PT_FOUT, PT_FINAL };

__global__ void __launch_bounds__(NTHR, 2) mega(Params p) {
#if defined(__HIP_DEVICE_COMPILE__)
    extern __shared__ __attribute__((aligned(16))) unsigned char smem[];
    cg::grid_group grid = cg::this_grid();
    typedef const Params __attribute__((address_space(4)))* KP;
    const int ph_lo = p.ph_lo, ph_hi = p.ph_hi;
    const int wave_id = __builtin_amdgcn_readfirstlane((int)(threadIdx.x >> 6));
    unsigned* bar = (unsigned*)(p.ws + OFF_BAR);
    volatile LAS unsigned* xst = (volatile LAS unsigned*)(smem + LDS_USER);
    const unsigned xcc = __builtin_amdgcn_readfirstlane(xb_xcc_id());
    if (ph_hi - ph_lo > 1) {
        if (threadIdx.x == 0) { xst[0] = 0u; xst[1] = 0u; (void)xb_add(&bar[XB_XCNT(xcc)], 1u); }
        __syncthreads();
    }
    for (int ph = ph_lo; ph < ph_hi; ++ph) {
        int tid_, bid_ = blockIdx.x;
        asm volatile("v_mbcnt_lo_u32_b32 %0, -1, 0\n\tv_mbcnt_hi_u32_b32 %0, -1, %0" : "=v"(tid_));
        tid_ += wave_id * 64;
        asm volatile("" : "+s"(bid_));
        KP kp = (KP)__builtin_amdgcn_kernarg_segment_ptr();
        asm volatile("" : "+s"(kp));
        unsigned char* ws = kp->ws;
        u16* HN = (u16*)(ws + OFF_HN);
        const int d = kp->desc[ph], type = d & 255, sub = (d >> 8) & 255, L = d >> 16;
        const float* hsrc = (L == 0) ? kp->x : kp->out;
        EpiArgs e; e.resid = nullptr; e.out = kp->out; e.bias = nullptr; e.hid = nullptr; e.convw = nullptr; e.convb = nullptr; e.ws = ws;
        switch (type) {
        case PT_PREP: { const Params pl = *kp; prep_phase(pl, smem, tid_, bid_); } break;
        case PT_NORM: {
            const float* src = (sub == 1) ? kp->out : hsrc;
            const float* g = (sub == 0) ? kp->norm_attn + L * 1024 : (sub == 1) ? kp->norm_ffn + L * 1024 : kp->kv_norm;
            norm_phase<false>(src, g, HN, nullptr, tid_, bid_);
        } break;
        case PT_AIN: gemm_phase<AM_PLAIN, EPI_AIN>(HN, 1024, (const u16*)(ws + OFF_WT_AIN + L * SZ_WT_AIN), T_, 2688, 1024, 0, e, smem, tid_, bid_); break;
        case PT_CMP1:
            for (int kv = 0; kv < 2; ++kv) {
                e.bias = (const float*)(ws + OFF_CBIAS) + (L * 2 + kv) * 256; e.hid = (u16*)(ws + OFF_HID) + (size_t)kv * 8192 * 256;
                gemm_phase<AM_GATHER, EPI_CMP1>((const u16*)(ws + (kv == 0 ? OFF_KC : OFF_VC)), 0, (const u16*)(ws + OFF_WT_CW1 + (L * 2 + kv) * SZ_WT_CW1), 8184, 256, 2048,
                                                kv == 0 ? 0 : (int)(gridDim.x >> 1), e, smem, tid_, bid_);
            }
            break;
        case PT_CMP2: { const Params pl = *kp; cmp2_phase(pl, L, tid_, bid_); } break;
        case PT_NSA: { const Params pl = *kp; nsa_phase(pl, smem, tid_, bid_, sub, L); } break;
        case PT_BKV: gemm_phase<AM_PLAIN, EPI_BKV>(HN, 1024, (const u16*)(ws + OFF_WT_KV), T_, 256, 1024, 0, e, smem, tid_, bid_); break;
        case PT_BQ: gemm_phase<AM_PLAIN, EPI_BQ>(HN, 1024, (const u16*)(ws + OFF_WT_BQ + (L - 2) * SZ_WT_SQ), T_, 1024, 1024, 0, e, smem, tid_, bid_); break;
        case PT_SWA: { const Params pl = *kp; swa_phase(pl, L - 2, tid_, bid_); } break;
        case PT_AOUT:
        case PT_FOUT: {
            const bool ff = (type == PT_FOUT);
            e.resid = ff ? kp->out : hsrc;
            const u16* A = (const u16*)(ws + (ff ? OFF_ACT : OFF_O));
            const u16* Bt = (const u16*)(ws + (ff ? OFF_WT_FOUT + L * SZ_WT_FOUT : (L < 2 ? OFF_WT_AOUT + L * SZ_WT_SQ : OFF_WT_BOUT + (L - 2) * SZ_WT_SQ)));
            const int K = ff ? DFF : 1024;
            gemm_big<AM_PLAIN, EPI_RESID>(A, K, Bt, T_, 1024, K, 0, e, smem, tid_, bid_);
        } break;
        case PT_FFNIN:
            e.convw = kp->ffn_conv_w + (size_t)L * 3 * NFF2; e.convb = kp->ffn_conv_b + (size_t)L * NFF2;
            gemm_big<AM_PLAIN, EPI_FFNIN>(HN, 1024, (const u16*)(ws + OFF_WT_FIN + L * SZ_WT_FIN), T_, NFF2, 1024, 0, e, smem, tid_, bid_);
            break;
        case PT_FIXUP: { const Params pl = *kp; fixup_phase(pl, L, tid_, bid_); } break;
        case PT_FINAL: norm_phase<true>(kp->out, kp->final_norm, nullptr, kp->out, tid_, bid_); break;
        default: break;
        }
        if (ph + 1 < ph_hi) { if (ph == ph_lo) grid.sync(); else xcd_barrier(bar, xcc, xst, tid_); }
    }
#endif
}

static int build_program(int* desc) {
    int n = 0;
    auto add = [&](int type, int sub, int L) { desc[n++] = type | (sub << 8) | (L << 16); };
    add(PT_PREP, 0, 0);
    for (int L = 0; L < 4; ++L) {
        if (L < 2) {
            add(PT_NORM, 0, L); add(PT_AIN, 0, L); add(PT_CMP1, 0, L); add(PT_CMP2, 0, L); add(PT_NSA, NSA_PROBE_REP, L);
        } else {
            if (L == 2) { add(PT_NORM, 2, L); add(PT_BKV, 0, L); }
            add(PT_NORM, 0, L); add(PT_BQ, 0, L); add(PT_SWA, 0, L);
        }
        add(PT_AOUT, 0, L); add(PT_NORM, 1, L); add(PT_FFNIN, 0, L); add(PT_FIXUP, 0, L); add(PT_FOUT, 0, L);
    }
    add(PT_FINAL, 0, 0);
    return n;
}

extern "C" void kernel_launch(void* const* d_in, const int* in_sizes, int n_in, void* d_out, int out_size, void* d_ws, size_t ws_size, hipStream_t stream) {
    (void)in_sizes; (void)n_in; (void)out_size;
    static int grid_blocks = 0;
    if (!grid_blocks) {
        (void)hipFuncSetAttribute((const void*)mega, hipFuncAttributeMaxDynamicSharedMemorySize, LDS_BYTES);
        int dev = 0, cus = 0, per_cu = 0;
        (void)hipGetDevice(&dev);
        (void)hipDeviceGetAttribute(&cus, hipDeviceAttributeMultiprocessorCount, dev);
        (void)hipOccupancyMaxActiveBlocksPerMultiprocessor(&per_cu, mega, NTHR, LDS_BYTES);
        if (per_cu > 1) per_cu = 1;
        if (per_cu < 1) per_cu = 1;
        grid_blocks = (cus * per_cu) & ~7;
        if (grid_blocks < 8) grid_blocks = 8;
        if (ws_size < WS_NEED) fprintf(stderr, "workspace too small: %zu < %zu\n", ws_size, (size_t)WS_NEED);
    }
    Params p{};
    const float** pp = (const float**)&p;
    for (int i = 0; i < 18; ++i) pp[i] = (const float*)d_in[i];
    p.out = (float*)d_out;
    p.ws = (unsigned char*)d_ws;
    const int nph = build_program(p.desc);
#if MULTI_LAUNCH
    for (int ph = 0; ph < nph; ++ph) {
        p.ph_lo = ph; p.ph_hi = ph + 1;
        hipLaunchKernelGGL(mega, dim3(grid_blocks), dim3(NTHR), LDS_BYTES, stream, p);
    }
#else
    p.ph_lo = 0; p.ph_hi = nph;
    (void)hipMemsetAsync((unsigned char*)d_ws + OFF_BAR, 0, 32768, stream);
    void* args[] = {&p};
    hipError_t err = hipLaunchCooperativeKernel((const void*)mega, dim3(grid_blocks), dim3(NTHR), args, LDS_BYTES, stream);
    if (err != hipSuccess) fprintf(stderr, "cooperative launch failed: %s (grid %d)\n", hipGetErrorString(err), grid_blocks);
#endif
}
```

```cpp
#include <hip/hip_runtime.h>
#include <hip/hip_cooperative_groups.h>
#include <cstdio>
#include <cmath>
namespace cg = cooperative_groups;

typedef unsigned short u16;
typedef short bf16x8 __attribute__((ext_vector_type(8)));
typedef float f32x4 __attribute__((ext_vector_type(4)));

#ifndef NSA_PROBE_REP
#define NSA_PROBE_REP 0
#endif
#ifndef MULTI_LAUNCH
#define MULTI_LAUNCH 0
#endif

constexpr int S_ = 16384, T_ = 32768, D_ = 1024, DFF = 2816, NFF2 = 5632;
constexpr int NTHR = 512, NW = NTHR / 64;
constexpr int LDS_USER = NW * 16384 + NW * 1024 + NW * 256;
constexpr int LDS_BYTES = LDS_USER + 16;
constexpr float LOG2E = 1.4426950408889634f;
constexpr float NEGBIG = -1e30f;

constexpr size_t al256(size_t x) { return (x + 255) & ~(size_t)255; }
constexpr size_t SZ_WT_AIN = (size_t)2688 * 1024 * 2;
constexpr size_t SZ_WT_CW1 = (size_t)256 * 2048 * 2;
constexpr size_t SZ_WT_CW2 = (size_t)64 * 256 * 2;
constexpr size_t SZ_WT_SQ = (size_t)1024 * 1024 * 2;
constexpr size_t SZ_WT_KV = (size_t)256 * 1024 * 2;
constexpr size_t SZ_WT_FIN = (size_t)5632 * 1024 * 2;
constexpr size_t SZ_WT_FOUT = (size_t)1024 * 2816 * 2;
constexpr size_t OFF_WT_AIN = 0;
constexpr size_t OFF_WT_CW1 = OFF_WT_AIN + 2 * SZ_WT_AIN;
constexpr size_t OFF_WT_CW2 = OFF_WT_CW1 + 4 * SZ_WT_CW1;
constexpr size_t OFF_WT_AOUT = OFF_WT_CW2 + 4 * SZ_WT_CW2;
constexpr size_t OFF_WT_KV = OFF_WT_AOUT + 2 * SZ_WT_SQ;
constexpr size_t OFF_WT_BQ = OFF_WT_KV + SZ_WT_KV;
constexpr size_t OFF_WT_BOUT = OFF_WT_BQ + 2 * SZ_WT_SQ;
constexpr size_t OFF_WT_FIN = OFF_WT_BOUT + 2 * SZ_WT_SQ;
constexpr size_t OFF_WT_FOUT = OFF_WT_FIN + 4 * SZ_WT_FIN;
constexpr size_t OFF_COS = OFF_WT_FOUT + 4 * SZ_WT_FOUT;
constexpr size_t OFF_SIN = OFF_COS + (size_t)S_ * 32 * 4;
constexpr size_t OFF_CBIAS = OFF_SIN + (size_t)S_ * 32 * 4;
constexpr size_t OFF_HN = OFF_CBIAS + 4096;
constexpr size_t OFF_KSH = OFF_HN + (size_t)T_ * 1024 * 2;
constexpr size_t OFF_VSHT = OFF_KSH + (size_t)T_ * 128 * 2;
constexpr size_t OFF_HEAD = OFF_VSHT + (size_t)T_ * 128 * 2;
constexpr size_t OFF_HALO = OFF_HEAD + (size_t)256 * 2 * NFF2 * 4;
constexpr size_t OFF_R1 = OFF_HALO + (size_t)256 * 2 * NFF2 * 4;
constexpr size_t OFF_Q = OFF_R1;
constexpr size_t OFF_KC = OFF_Q + (size_t)T_ * 1024 * 2;
constexpr size_t OFF_VC = OFF_KC + (size_t)T_ * 256 * 2;
constexpr size_t OFF_KS = OFF_VC + (size_t)T_ * 256 * 2;
constexpr size_t OFF_VST = OFF_KS + (size_t)T_ * 256 * 2;
constexpr size_t OFF_KW = OFF_VST + (size_t)T_ * 256 * 2;
constexpr size_t OFF_VWT = OFF_KW + (size_t)T_ * 256 * 2;
constexpr size_t OFF_GATES = OFF_VWT + (size_t)T_ * 256 * 2;
constexpr size_t OFF_HID = OFF_GATES + (size_t)T_ * 48 * 4;
constexpr size_t OFF_KCC = OFF_HID + (size_t)2 * 8192 * 256 * 2;
constexpr size_t OFF_VCCT = OFF_KCC + (size_t)8 * 1024 * 64 * 2;
constexpr size_t OFF_O = OFF_VCCT + (size_t)8 * 1024 * 64 * 2;
constexpr size_t OFF_END = OFF_O + (size_t)T_ * 1024 * 2;
constexpr size_t OFF_BAR = OFF_END;
constexpr size_t WS_NEED = OFF_BAR + 32768;
constexpr size_t OFF_ACT = OFF_R1;
static_assert(OFF_ACT + (size_t)T_ * DFF * 2 <= OFF_END, "act alias");

struct Params {
    const float *x, *norm_attn, *norm_ffn, *a_w_in, *a_cmp_pos, *a_cmp_w1, *a_cmp_w2, *a_w_out, *kv_norm, *b_w_kv, *b_w_q, *b_sinks, *b_w_out,
        *ffn_w_in, *ffn_conv_w, *ffn_conv_b, *ffn_w_out, *final_norm;
    float* out;
    unsigned char* ws;
    int desc[48];
    int ph_lo, ph_hi;
};

__device__ __forceinline__ u16 f2bf(float f) {
    unsigned u = __float_as_uint(f);
    u += 0x7fffu + ((u >> 16) & 1u);
    return (u16)(u >> 16);
}
typedef __bf16 bf16x2_t __attribute__((ext_vector_type(2)));
typedef float f32x2_t __attribute__((ext_vector_type(2)));
__device__ __forceinline__ unsigned pack2(float lo, float hi) { f32x2_t v = {lo, hi}; bf16x2_t r = __builtin_convertvector(v, bf16x2_t); return __builtin_bit_cast(unsigned, r); }
typedef unsigned u32x4 __attribute__((ext_vector_type(4)));
__device__ __forceinline__ bf16x8 pack8(const float (&v)[8]) {
    u32x4 r;
    unsigned r0, r1, r2, r3;
    asm("v_cvt_pk_bf16_f32 %0, %4, %5\n\tv_cvt_pk_bf16_f32 %1, %6, %7\n\tv_cvt_pk_bf16_f32 %2, %8, %9\n\tv_cvt_pk_bf16_f32 %3, %10, %11\n\ts_nop 3"
        : "=&v"(r0), "=&v"(r1), "=&v"(r2), "=&v"(r3)
        : "v"(v[0]), "v"(v[1]), "v"(v[2]), "v"(v[3]), "v"(v[4]), "v"(v[5]), "v"(v[6]), "v"(v[7]));
    r[0] = r0; r[1] = r1; r[2] = r2; r[3] = r3;
    return __builtin_bit_cast(bf16x8, r);
}
__device__ __forceinline__ uint2 pack4(f32x4 v) { uint2 r; r.x = pack2(v[0], v[1]); r.y = pack2(v[2], v[3]); return r; }
__device__ __forceinline__ f32x4 unpack4(uint2 v) { return (f32x4){__uint_as_float(v.x << 16), __uint_as_float(v.x & 0xffff0000u), __uint_as_float(v.y << 16), __uint_as_float(v.y & 0xffff0000u)}; }
__device__ __forceinline__ unsigned pk4_fp8(float a, float b, float c, float d) { int r = __builtin_amdgcn_cvt_pk_fp8_f32(a, b, 0, false); r = __builtin_amdgcn_cvt_pk_fp8_f32(c, d, r, true); return (unsigned)r; }
__device__ __forceinline__ long pk8_fp8(const float (&v)[8]) { const unsigned lo = pk4_fp8(v[0], v[1], v[2], v[3]), hi = pk4_fp8(v[4], v[5], v[6], v[7]); return (long)(((unsigned long long)hi << 32) | lo); }
__device__ __forceinline__ f32x4 mfma8(long a, long b, f32x4 c) { return __builtin_amdgcn_mfma_f32_16x16x32_fp8_fp8(a, b, c, 0, 0, 0); }
__device__ __forceinline__ f32x4 mfma16(bf16x8 a, bf16x8 b, f32x4 c) { return __builtin_amdgcn_mfma_f32_16x16x32_bf16(a, b, c, 0, 0, 0); }
__device__ __forceinline__ float fexp2(float x) { return __builtin_amdgcn_exp2f(x); }
__device__ __forceinline__ void wsync() { __builtin_amdgcn_fence(__ATOMIC_ACQ_REL, "wavefront"); asm volatile("s_waitcnt lgkmcnt(0)" ::: "memory"); __builtin_amdgcn_wave_barrier(); }
typedef unsigned u32x2 __attribute__((ext_vector_type(2)));
__device__ __forceinline__ float xmax16(float x) { const unsigned u = __float_as_uint(x); const u32x2 r = __builtin_amdgcn_permlane16_swap(u, u, false, false); return fmaxf(__uint_as_float(r[0]), __uint_as_float(r[1])); }
__device__ __forceinline__ float xmax32(float x) { const unsigned u = __float_as_uint(x); const u32x2 r = __builtin_amdgcn_permlane32_swap(u, u, false, false); return fmaxf(__uint_as_float(r[0]), __uint_as_float(r[1])); }
template <int CTRL> __device__ __forceinline__ float dppf(float x) { return __int_as_float(__builtin_amdgcn_update_dpp(0, __float_as_int(x), CTRL, 0xf, 0xf, true)); }
__device__ __forceinline__ float wave_max(float x) {
    x = fmaxf(x, dppf<0xB1>(x)); x = fmaxf(x, dppf<0x4E>(x)); x = fmaxf(x, dppf<0x141>(x)); x = fmaxf(x, dppf<0x140>(x));
    return xmax32(xmax16(x));
}
__device__ __forceinline__ int kperm(int m) { return ((m >> 2) << 3) + (m & 3); }
__device__ __forceinline__ float sigmoidf_(float x) { return 1.f / (1.f + __expf(-x)); }
__device__ __forceinline__ float gelu_tanh(float x) {
    float u = 0.7978845608028654f * (x + 0.044715f * x * x * x);
    float e = __expf(2.f * u);
    float th = 1.f - 2.f / (e + 1.f);
    return 0.5f * x * (1.f + th);
}

__device__ __forceinline__ void cvt_transpose(const float* __restrict__ src, u16* __restrict__ dst, int K, int N, int Npad, int mode, unsigned char* smem, int tid_, int bid_) {
    const int half = tid_ >> 8, tid = tid_ & 255;
    float* ts = (float*)smem + half * (64 * 65);
    const int ntk = K >> 6, ntn = Npad >> 6, ntiles = ntk * ntn;
    for (int tile2 = bid_ * 2; tile2 < ntiles; tile2 += gridDim.x * 2) {
        const int tile = tile2 + half;
        const bool live = tile < ntiles;
        const int tk = live ? tile % ntk : 0, tn = live ? tile / ntk : 0;
        const int k0 = tk << 6, n0 = tn << 6;
        __syncthreads();
        if (live) {
#pragma unroll
            for (int i = 0; i < 4; ++i) {
                const int k = (tid >> 4) + 16 * i, n = (tid & 15) * 4;
                float4 v = make_float4(0.f, 0.f, 0.f, 0.f);
                if (n0 + n < N) v = *(const float4*)(src + (size_t)(k0 + k) * N + n0 + n);
                ts[k * 65 + n + 0] = v.x; ts[k * 65 + n + 1] = v.y; ts[k * 65 + n + 2] = v.z; ts[k * 65 + n + 3] = v.w;
            }
        }
        __syncthreads();
        if (!live) continue;
        const int n = tid >> 2, kq = (tid & 3) * 16;
        unsigned pk[8];
#pragma unroll
        for (int j = 0; j < 8; ++j) pk[j] = pack2(ts[(kq + 2 * j) * 65 + n], ts[(kq + 2 * j + 1) * 65 + n]);
        int drow;
        if (mode == 0) drow = n0 + n;
        else { const int nn = n0 + n; drow = (nn < DFF) ? ((nn >> 6) * 128 + (nn & 63)) : ((((nn - DFF) >> 6) * 128) + 64 + ((nn - DFF) & 63)); }
        uint4* dp = (uint4*)(dst + (size_t)drow * K + k0 + kq);
        dp[0] = make_uint4(pk[0], pk[1], pk[2], pk[3]);
        dp[1] = make_uint4(pk[4], pk[5], pk[6], pk[7]);
    }
}

__device__ __forceinline__ void prep_phase(const Params& p, unsigned char* smem, int tid_, int bid_) {
    unsigned char* ws = p.ws;
    for (int L = 0; L < 2; ++L) {
        cvt_transpose(p.a_w_in + (size_t)L * 1024 * 2608, (u16*)(ws + OFF_WT_AIN + L * SZ_WT_AIN), 1024, 2608, 2688, 0, smem, tid_, bid_);
        for (int kv = 0; kv < 2; ++kv) {
            cvt_transpose(p.a_cmp_w1 + (size_t)(L * 2 + kv) * 2048 * 256, (u16*)(ws + OFF_WT_CW1 + (L * 2 + kv) * SZ_WT_CW1), 2048, 256, 256, 0, smem, tid_, bid_);
            cvt_transpose(p.a_cmp_w2 + (size_t)(L * 2 + kv) * 256 * 64, (u16*)(ws + OFF_WT_CW2 + (L * 2 + kv) * SZ_WT_CW2), 256, 64, 64, 0, smem, tid_, bid_);
        }
        cvt_transpose(p.a_w_out + (size_t)L * 1024 * 1024, (u16*)(ws + OFF_WT_AOUT + L * SZ_WT_SQ), 1024, 1024, 1024, 0, smem, tid_, bid_);
        cvt_transpose(p.b_w_q + (size_t)L * 1024 * 1024, (u16*)(ws + OFF_WT_BQ + L * SZ_WT_SQ), 1024, 1024, 1024, 0, smem, tid_, bid_);
        cvt_transpose(p.b_w_out + (size_t)L * 1024 * 1024, (u16*)(ws + OFF_WT_BOUT + L * SZ_WT_SQ), 1024, 1024, 1024, 0, smem, tid_, bid_);
    }
    cvt_transpose(p.b_w_kv, (u16*)(ws + OFF_WT_KV), 1024, 256, 256, 0, smem, tid_, bid_);
    for (int L = 0; L < 4; ++L) {
        cvt_transpose(p.ffn_w_in + (size_t)L * 1024 * NFF2, (u16*)(ws + OFF_WT_FIN + L * SZ_WT_FIN), 1024, NFF2, NFF2, 1, smem, tid_, bid_);
        cvt_transpose(p.ffn_w_out + (size_t)L * DFF * 1024, (u16*)(ws + OFF_WT_FOUT + L * SZ_WT_FOUT), DFF, 1024, 1024, 0, smem, tid_, bid_);
    }
    {
        float* cb = (float*)(ws + OFF_CBIAS);
        const int lane = tid_ & 63, w = tid_ >> 6;
        for (int task = bid_ * NW + w; task < 256; task += gridDim.x * NW) {
            const int lk = task >> 6, j4 = (task & 63) * 4;
            const float* pos = p.a_cmp_pos + (size_t)lk * 2048;
            const float* w1 = p.a_cmp_w1 + (size_t)lk * 2048 * 256;
            float4 a = make_float4(0.f, 0.f, 0.f, 0.f);
            for (int i = 0; i < 32; ++i) {
                const int k = lane + 64 * i;
                const float pv = pos[k];
                const float4 wv = *(const float4*)(w1 + (size_t)k * 256 + j4);
                a.x += pv * wv.x; a.y += pv * wv.y; a.z += pv * wv.z; a.w += pv * wv.w;
            }
#pragma unroll
            for (int off = 32; off >= 1; off >>= 1) {
                a.x += __shfl_xor(a.x, off); a.y += __shfl_xor(a.y, off); a.z += __shfl_xor(a.z, off); a.w += __shfl_xor(a.w, off);
            }
            if (lane == 0) *(float4*)(cb + lk * 256 + j4) = a;
        }
    }
}

template <bool OUT_F32>
__device__ __forceinline__ void norm_phase(const float* __restrict__ src, const float* __restrict__ g, u16* __restrict__ dst, float* __restrict__ dstf, int tid_, int bid_) {
    const int lane = tid_ & 63, w = tid_ >> 6;
    float4 gv[4];
#pragma unroll
    for (int i = 0; i < 4; ++i) gv[i] = *(const float4*)(g + lane * 4 + 256 * i);
    for (int row = bid_ * NW + w; row < T_; row += gridDim.x * NW) {
        const float* sp = src + (size_t)row * 1024;
        float4 v[4];
        float ss = 0.f;
#pragma unroll
        for (int i = 0; i < 4; ++i) { v[i] = *(const float4*)(sp + lane * 4 + 256 * i); ss += v[i].x * v[i].x + v[i].y * v[i].y + v[i].z * v[i].z + v[i].w * v[i].w; }
#pragma unroll
        for (int off = 32; off >= 1; off >>= 1) ss += __shfl_xor(ss, off);
        const float r = rsqrtf(ss * (1.f / 1024.f) + 1e-6f);
#pragma unroll
        for (int i = 0; i < 4; ++i) {
            f32x4 o = {v[i].x * r * gv[i].x, v[i].y * r * gv[i].y, v[i].z * r * gv[i].z, v[i].w * r * gv[i].w};
            if (OUT_F32) *(float4*)(dstf + (size_t)row * 1024 + lane * 4 + 256 * i) = make_float4(o[0], o[1], o[2], o[3]);
            else *(uint2*)(dst + (size_t)row * 1024 + lane * 4 + 256 * i) = pack4(o);
        }
    }
}

enum { AM_PLAIN = 0, AM_GATHER = 1 };
enum { EPI_AIN = 0, EPI_CMP1 = 1, EPI_RESID = 2, EPI_FFNIN = 3, EPI_BQ = 4, EPI_BKV = 5 };

struct EpiArgs {
    const float* resid; float* out;
    const float* bias; u16* hid;
    const float *convw, *convb;
    unsigned char* ws;
};

template <int NM>
__device__ __forceinline__ void rope_store(const f32x4 (&acc)[4][NM], int mi, u16* dstrow  , const float* cosT, const float* sinT, int pos, int q4) {
#pragma unroll
    for (int ni = 0; ni < 2; ++ni) {
        const int d = ni * 16 + q4 * 4;
        const float4 c = *(const float4*)(cosT + pos * 32 + d), s = *(const float4*)(sinT + pos * 32 + d);
        const f32x4 x1 = acc[ni][mi], x2 = acc[ni + 2][mi];
        f32x4 o1 = {x1[0] * c.x - x2[0] * s.x, x1[1] * c.y - x2[1] * s.y, x1[2] * c.z - x2[2] * s.z, x1[3] * c.w - x2[3] * s.w};
        f32x4 o2 = {x2[0] * c.x + x1[0] * s.x, x2[1] * c.y + x1[1] * s.y, x2[2] * c.z + x1[2] * s.z, x2[3] * c.w + x1[3] * s.w};
        *(uint2*)(dstrow + d) = pack4(o1);
        *(uint2*)(dstrow + d + 32) = pack4(o2);
    }
}

__device__ __forceinline__ void rope_ivr(float (&ivr)[8], int q4) {
#pragma unroll
    for (int k = 0; k < 8; ++k) { const int d = (k >> 2) * 16 + q4 * 4 + (k & 3); ivr[k] = exp2f(-(float)d * (13.287712379549449f / 32.0f)) * 0.15915494309189535f; }
}
__device__ __forceinline__ void rope_cs(const float (&ivr)[8], int ni, int pos, float (&c)[4], float (&s)[4]) {
#pragma unroll
    for (int i = 0; i < 4; ++i) { float rev = (float)pos * ivr[ni * 4 + i]; rev = rev - floorf(rev); c[i] = __builtin_amdgcn_cosf(rev); s[i] = __builtin_amdgcn_sinf(rev); }
}
template <int NM>
__device__ __forceinline__ void rope_store_fly(const f32x4 (&acc)[4][NM], int mi, u16* dstrow, const float (&ivr)[8], int pos, int q4) {
#pragma unroll
    for (int ni = 0; ni < 2; ++ni) {
        const int d = ni * 16 + q4 * 4;
        float c[4], s[4];
        rope_cs(ivr, ni, pos, c, s);
        const f32x4 x1 = acc[ni][mi], x2 = acc[ni + 2][mi];
        f32x4 o1 = {x1[0] * c[0] - x2[0] * s[0], x1[1] * c[1] - x2[1] * s[1], x1[2] * c[2] - x2[2] * s[2], x1[3] * c[3] - x2[3] * s[3]};
        f32x4 o2 = {x2[0] * c[0] + x1[0] * s[0], x2[1] * c[1] + x1[1] * s[1], x2[2] * c[2] + x1[2] * s[2], x2[3] * c[3] + x1[3] * s[3]};
        *(uint2*)(dstrow + d) = pack4(o1);
        *(uint2*)(dstrow + d + 32) = pack4(o2);
    }
}

template <int AMODE, int EPI>
__device__ __forceinline__ void gemm_phase(const u16* __restrict__ A, int lda, const u16* __restrict__ Bt, int M, int Npad, int K, int vboff, const EpiArgs& e, unsigned char* smem, int tid_, int bid_) {
    const int tid = tid_, lane = tid & 63, w = tid >> 6, wm = w & 3, wn = w >> 2;
    const int c16 = lane & 15, q4 = lane >> 4;
    const int ntm = (M + 255) >> 8, ntn = Npad >> 7, nk = K >> 6;
    const int kstride = (AMODE == AM_GATHER) ? 256 : 64;
    const int ldc = tid & 7, ldr = tid >> 3;
    const unsigned wofs = ldr * 128 + ((ldc ^ ((ldr >> 1) & 7)) << 4);
    const int swz = (c16 >> 1) & 7;
    const float* cosT = (const float*)(e.ws + OFF_COS);
    const float* sinT = (const float*)(e.ws + OFF_SIN);
    int vb = bid_ + vboff; if (vb >= (int)gridDim.x) vb -= gridDim.x;
    const int xcd = vb & 7, loc = vb >> 3, nloc = gridDim.x >> 3;
    const int mpx = ntm >> 3, nfull = (ntn >> 3), bwl = ntn - (nfull << 3);
    const int tfull = nfull * mpx * 8, ttotal = mpx * ntn;
    for (int tl = loc; tl < ttotal; tl += nloc) {
        int mloc, nt;
        if (tl < tfull) { const int band = tl / (mpx * 8), r = tl - band * (mpx * 8); mloc = r >> 3; nt = band * 8 + (r & 7); }
        else { const int r = tl - tfull; mloc = r / bwl; nt = (nfull << 3) + (r - mloc * bwl); }
        const int mt = xcd * mpx + mloc;
        const int m0 = mt << 8, n0 = nt << 7;
        unsigned aoff[4];
#pragma unroll
        for (int i = 0; i < 4; ++i) {
            int m = m0 + ldr + 64 * i; if (m > M - 1) m = M - 1;
            if (AMODE == AM_GATHER) { const int g = m & 3, bn = m >> 2, b = bn / 1023, n = bn - b * 1023; aoff[i] = (unsigned)((b * S_ + n * 16) * 256 + g * 64 + ldc * 8); }
            else aoff[i] = (unsigned)m * (unsigned)lda + ldc * 8;
        }
        const u16* bp = Bt + (size_t)(n0 + ldr) * K + ldc * 8;
        u32x4 ra0[4], rb0[2], ra1[4], rb1[2];
        f32x4 acc[4][4];
#pragma unroll
        for (int a = 0; a < 4; ++a)
#pragma unroll
            for (int b = 0; b < 4; ++b) acc[a][b] = (f32x4){0.f, 0.f, 0.f, 0.f};
        auto g_load = [&](u32x4 (&RA)[4], u32x4 (&RB)[2], int KT) __attribute__((always_inline)) {
#pragma unroll
            for (int i = 0; i < 4; ++i) RA[i] = *(const u32x4*)(A + aoff[i] + KT * kstride);
#pragma unroll
            for (int i = 0; i < 2; ++i) RB[i] = *(const u32x4*)(bp + (size_t)i * 64 * K + KT * 64);
        };
        auto g_store = [&](const u32x4 (&RA)[4], const u32x4 (&RB)[2], int ST) __attribute__((always_inline)) {
            unsigned char* d_ = smem + ST * 49152;
#pragma unroll
            for (int i = 0; i < 4; ++i) *(u32x4*)(d_ + wofs + i * 8192) = RA[i];
#pragma unroll
            for (int i = 0; i < 2; ++i) *(u32x4*)(d_ + 32768 + wofs + i * 8192) = RB[i];
        };
        auto g_compute = [&](int ST) __attribute__((always_inline)) {
            const unsigned char* sA = smem + ST * 49152;
            const unsigned char* sB = sA + 32768;
#pragma unroll
            for (int ks = 0; ks < 2; ++ks) {
                bf16x8 wf[4], af[4];
                const int ch = ((ks * 4 + q4) ^ swz) << 4;
#pragma unroll
                for (int ni = 0; ni < 4; ++ni) wf[ni] = *(const bf16x8*)(sB + (wn * 64 + ni * 16 + c16) * 128 + ch);
#pragma unroll
                for (int mi = 0; mi < 4; ++mi) af[mi] = *(const bf16x8*)(sA + (wm * 64 + mi * 16 + c16) * 128 + ch);
#pragma unroll
                for (int ni = 0; ni < 4; ++ni)
#pragma unroll
                    for (int mi = 0; mi < 4; ++mi) acc[ni][mi] = mfma16(wf[ni], af[mi], acc[ni][mi]);
            }
        };
        g_load(ra0, rb0, 0);
        g_load(ra1, rb1, 1);
        g_store(ra0, rb0, 0);
        __syncthreads();
        for (int kt = 0; kt < nk; kt += 2) {
            if (kt + 2 < nk) g_load(ra0, rb0, kt + 2);
            g_compute(0);
            g_store(ra1, rb1, 1);
            __syncthreads();
            if (kt + 3 < nk) g_load(ra1, rb1, kt + 3);
            g_compute(1);
            if (kt + 2 < nk) g_store(ra0, rb0, 0);
            __syncthreads();
        }
        float ivr[8];
        if (EPI == EPI_AIN || EPI == EPI_BQ || EPI == EPI_BKV) rope_ivr(ivr, q4);
        const int nb = n0 + wn * 64;
        if (EPI == EPI_RESID) {
#pragma unroll
            for (int mi = 0; mi < 4; ++mi) {
                const size_t tok = m0 + wm * 64 + mi * 16 + c16;
#pragma unroll
                for (int ni = 0; ni < 4; ++ni) {
                    const int n = nb + ni * 16 + q4 * 4;
                    float4 r = *(const float4*)(e.resid + tok * 1024 + n);
                    r.x += acc[ni][mi][0]; r.y += acc[ni][mi][1]; r.z += acc[ni][mi][2]; r.w += acc[ni][mi][3];
                    *(float4*)(e.out + tok * 1024 + n) = r;
                }
            }
        } else if (EPI == EPI_CMP1) {
#pragma unroll
            for (int mi = 0; mi < 4; ++mi) {
                const int m = m0 + wm * 64 + mi * 16 + c16;
                if (m < M) {
#pragma unroll
                    for (int ni = 0; ni < 4; ++ni) {
                        const int n = nb + ni * 16 + q4 * 4;
                        const float4 bv = *(const float4*)(e.bias + n);
                        f32x4 o = {gelu_tanh(acc[ni][mi][0] + bv.x), gelu_tanh(acc[ni][mi][1] + bv.y), gelu_tanh(acc[ni][mi][2] + bv.z), gelu_tanh(acc[ni][mi][3] + bv.w)};
                        *(uint2*)(e.hid + (size_t)m * 256 + n) = pack4(o);
                    }
                }
            }
        } else if (EPI == EPI_BQ) {
            u16* Q = (u16*)(e.ws + OFF_Q);
#pragma unroll
            for (int mi = 0; mi < 4; ++mi) {
                const int tok = m0 + wm * 64 + mi * 16 + c16;
                rope_store_fly(acc, mi, Q + (size_t)tok * 1024 + nb, ivr, tok & (S_ - 1), q4);
            }
        } else if (EPI == EPI_BKV) {
            u16* KSH = (u16*)(e.ws + OFF_KSH); u16* VSHT = (u16*)(e.ws + OFF_VSHT);
#pragma unroll
            for (int mi = 0; mi < 4; ++mi) {
                const int tok = m0 + wm * 64 + mi * 16 + c16, b = tok >> 14, s = tok & (S_ - 1);
                if (nb < 128) {
                    const int g = nb >> 6;
                    rope_store_fly(acc, mi, KSH + ((size_t)(b * 2 + g) * S_ + s) * 64, ivr, s, q4);
                } else {
                    const int g = (nb - 128) >> 6;
#pragma unroll
                    for (int ni = 0; ni < 4; ++ni)
#pragma unroll
                        for (int i = 0; i < 4; ++i) VSHT[((size_t)(b * 2 + g) * 64 + ni * 16 + q4 * 4 + i) * S_ + s] = f2bf(acc[ni][mi][i]);
                }
            }
        } else if (EPI == EPI_AIN) {
            unsigned char* ws = e.ws;
#pragma unroll
            for (int mi = 0; mi < 4; ++mi) {
                const int tok = m0 + wm * 64 + mi * 16 + c16, b = tok >> 14, s = tok & (S_ - 1);
                if (nb < 1024) {
                    rope_store_fly(acc, mi, (u16*)(ws + OFF_Q) + (size_t)tok * 1024 + nb, ivr, s, q4);
                } else if (nb < 1536) {
                    u16* dst = (nb < 1280) ? ((u16*)(ws + OFF_KC) + (size_t)tok * 256 + (nb - 1024)) : ((u16*)(ws + OFF_VC) + (size_t)tok * 256 + (nb - 1280));
#pragma unroll
                    for (int ni = 0; ni < 4; ++ni) *(uint2*)(dst + ni * 16 + q4 * 4) = pack4(acc[ni][mi]);
                } else if (nb < 2560) {
                    const int r = (nb - 1536) >> 8;
                    const int g = ((nb - 1536) & 255) >> 6;
                    if (r == 0) {
                        unsigned char* kd = (unsigned char*)(ws + OFF_KS) + (size_t)(b * 4 + g) * S_ * 128 + (size_t)s * 64;
#pragma unroll
                        for (int ni = 0; ni < 2; ++ni) {
                            const int d = ni * 16 + q4 * 4;
                            float c[4], sn[4];
                            rope_cs(ivr, ni, s, c, sn);
                            const f32x4 x1 = acc[ni][mi], x2 = acc[ni + 2][mi];
                            *(unsigned*)(kd + d) = pk4_fp8(x1[0] * c[0] - x2[0] * sn[0], x1[1] * c[1] - x2[1] * sn[1], x1[2] * c[2] - x2[2] * sn[2], x1[3] * c[3] - x2[3] * sn[3]);
                            *(unsigned*)(kd + d + 32) = pk4_fp8(x2[0] * c[0] + x1[0] * sn[0], x2[1] * c[1] + x1[1] * sn[1], x2[2] * c[2] + x1[2] * sn[2], x2[3] * c[3] + x1[3] * sn[3]);
                        }
                    } else if (r == 2) {
                        u16* base = (u16*)(ws + OFF_KW);
                        rope_store_fly(acc, mi, base + ((size_t)(b * 4 + g) * S_ + s) * 64, ivr, s, q4);
                    } else {
                        if (r == 1) {
                            unsigned char* base = (unsigned char*)(ws + OFF_VST) + (size_t)(b * 4 + g) * 128 * S_ + (size_t)(s >> 6) * 4096 + (s & 63);
#pragma unroll
                            for (int ni = 0; ni < 4; ++ni) {
                                const unsigned pk = pk4_fp8(acc[ni][mi][0], acc[ni][mi][1], acc[ni][mi][2], acc[ni][mi][3]);
#pragma unroll
                                for (int i = 0; i < 4; ++i) base[(ni * 16 + q4 * 4 + i) * 64] = (unsigned char)(pk >> (8 * i));
                            }
                        } else {
                            u16* base = (u16*)(ws + OFF_VWT);
#pragma unroll
                            for (int ni = 0; ni < 4; ++ni)
#pragma unroll
                                for (int i = 0; i < 4; ++i) base[((size_t)(b * 4 + g) * 64 + ni * 16 + q4 * 4 + i) * S_ + s] = f2bf(acc[ni][mi][i]);
                        }
                    }
                } else if (nb == 2560) {
                    float* G = (float*)(ws + OFF_GATES) + (size_t)tok * 48;
#pragma unroll
                    for (int ni = 0; ni < 3; ++ni) {
                        const int n = ni * 16 + q4 * 4;
                        *(float4*)(G + n) = make_float4(sigmoidf_(acc[ni][mi][0]), sigmoidf_(acc[ni][mi][1]), sigmoidf_(acc[ni][mi][2]), sigmoidf_(acc[ni][mi][3]));
                    }
                }
            }
        } else if (EPI == EPI_FFNIN) {
            float* U = (float*)smem;
#pragma unroll
            for (int mi = 0; mi < 4; ++mi) {
                const int row = wm * 64 + mi * 16 + c16;
#pragma unroll
                for (int ni = 0; ni < 4; ++ni) {
                    const int chunk = wn * 16 + ni * 4 + q4;
                    *(f32x4*)(U + row * 128 + ((chunk ^ (row & 31)) << 2)) = acc[ni][mi];
                }
            }
            __syncthreads();
            {
                const int ca = tid & 15, seg = tid >> 4;
                const int ncol = nt * 64 + ca * 4;
                const float4 w0a = *(const float4*)(e.convw + ncol), w1a = *(const float4*)(e.convw + NFF2 + ncol), w2a = *(const float4*)(e.convw + 2 * NFF2 + ncol);
                const float4 w0g = *(const float4*)(e.convw + DFF + ncol), w1g = *(const float4*)(e.convw + NFF2 + DFF + ncol), w2g = *(const float4*)(e.convw + 2 * NFF2 + DFF + ncol);
                const float4 ba = *(const float4*)(e.convb + ncol), bg = *(const float4*)(e.convb + DFF + ncol);
                float* head = (float*)(e.ws + OFF_HEAD); float* halo = (float*)(e.ws + OFF_HALO);
                u16* act = (u16*)(e.ws + OFF_ACT);
                const int r0 = seg * 8;
                float4 a2 = make_float4(0.f, 0.f, 0.f, 0.f), a1 = a2, g2 = a2, g1 = a2;
                if (seg > 0) {
                    const int rA = r0 - 2, rB = r0 - 1;
                    a2 = *(const float4*)(U + rA * 128 + ((ca ^ (rA & 31)) << 2)); g2 = *(const float4*)(U + rA * 128 + (((16 + ca) ^ (rA & 31)) << 2));
                    a1 = *(const float4*)(U + rB * 128 + ((ca ^ (rB & 31)) << 2)); g1 = *(const float4*)(U + rB * 128 + (((16 + ca) ^ (rB & 31)) << 2));
                }
#pragma unroll
                for (int r = 0; r < 8; ++r) {
                    const int row = r0 + r;
                    const float4 ua = *(const float4*)(U + row * 128 + ((ca ^ (row & 31)) << 2));
                    const float4 ug = *(const float4*)(U + row * 128 + (((16 + ca) ^ (row & 31)) << 2));
                    if (seg > 0 || r >= 2) {
                        float ca_[4], cg_[4];
                        ca_[0] = ba.x + w0a.x * a2.x + w1a.x * a1.x + w2a.x * ua.x; ca_[1] = ba.y + w0a.y * a2.y + w1a.y * a1.y + w2a.y * ua.y;
                        ca_[2] = ba.z + w0a.z * a2.z + w1a.z * a1.z + w2a.z * ua.z; ca_[3] = ba.w + w0a.w * a2.w + w1a.w * a1.w + w2a.w * ua.w;
                        cg_[0] = bg.x + w0g.x * g2.x + w1g.x * g1.x + w2g.x * ug.x; cg_[1] = bg.y + w0g.y * g2.y + w1g.y * g1.y + w2g.y * ug.y;
                        cg_[2] = bg.z + w0g.z * g2.z + w1g.z * g1.z + w2g.z * ug.z; cg_[3] = bg.w + w0g.w * g2.w + w1g.w * g1.w + w2g.w * ug.w;
                        f32x4 o = {ca_[0] * sigmoidf_(ca_[0]) * cg_[0], ca_[1] * sigmoidf_(ca_[1]) * cg_[1], ca_[2] * sigmoidf_(ca_[2]) * cg_[2], ca_[3] * sigmoidf_(ca_[3]) * cg_[3]};
                        *(uint2*)(act + (size_t)(m0 + row) * DFF + ncol) = pack4(o);
                    }
                    if (seg == 0 && r < 2) { *(float4*)(head + (size_t)(mt * 2 + r) * NFF2 + ncol) = ua; *(float4*)(head + (size_t)(mt * 2 + r) * NFF2 + DFF + ncol) = ug; }
                    if (seg == 31 && r >= 6) { *(float4*)(halo + (size_t)(mt * 2 + r - 6) * NFF2 + ncol) = ua; *(float4*)(halo + (size_t)(mt * 2 + r - 6) * NFF2 + DFF + ncol) = ug; }
                    a2 = a1; a1 = ua; g2 = g1; g1 = ug;
                }
            }
            __syncthreads();
        }
    }
}

template <int AMODE, int EPI>
__device__ __forceinline__ void gemm_big(const u16* __restrict__ A, int lda, const u16* __restrict__ Bt, int M, int Npad, int K, int vboff, const EpiArgs& e, unsigned char* smem, int tid_, int bid_) {
    const int tid = tid_, lane = tid & 63, w = tid >> 6, wm = w & 1, wn = w >> 1;
    const int c16 = lane & 15, q4 = lane >> 4;
    constexpr int MI = 8;
    const int ntm = (M + 255) >> 8, ntn = Npad >> 8, nk = K >> 5;
    const int kstride = (AMODE == AM_GATHER) ? 128 : 32;
    const float* cosT = (const float*)(e.ws + OFF_COS);
    const float* sinT = (const float*)(e.ws + OFF_SIN);
    int vb = bid_ + vboff; if (vb >= (int)gridDim.x) vb -= gridDim.x;
    const int xcd = vb & 7, loc = vb >> 3, nloc = gridDim.x >> 3;
    const int mpx = ntm >> 3, nfull = (ntn >> 3), bwl = ntn - (nfull << 3);
    const int tfull = nfull * mpx * 8, ttotal = mpx * ntn;
    for (int tl = loc; tl < ttotal; tl += nloc) {
        int mloc, nt;
        if (tl < tfull) { const int band = tl / (mpx * 8), r = tl - band * (mpx * 8); mloc = r >> 3; nt = band * 8 + (r & 7); }
        else { const int r = tl - tfull; mloc = r / bwl; nt = (nfull << 3) + (r - mloc * bwl); }
        const int mt = xcd * mpx + mloc;
        const int m0 = mt << 8, n0 = nt << 8;
        const int prow = ((w & 3) << 6) + (lane >> 3);
        const int pch = lane & 7;
        unsigned goff[8];
#pragma unroll
        for (int i = 0; i < 8; ++i) {
            const int row = prow + 8 * i;
            const int lc = pch ^ ((row >> 1) & 7);
            if (w < 4) {
                int m = m0 + row; if (m > M - 1) m = M - 1;
                if (AMODE == AM_GATHER) { const int gq = m & 3, bn = m >> 2, bb = bn / 1023, n = bn - bb * 1023; goff[i] = (unsigned)((bb * S_ + n * 16) * 256 + gq * 64 + lc * 8); }
                else goff[i] = (unsigned)m * (unsigned)lda + (unsigned)(lc * 8);
            } else goff[i] = (unsigned)(n0 + row) * (unsigned)K + (unsigned)(lc * 8);
        }
        const u16* gbase = (w < 4) ? A : Bt;
        const unsigned kst = (w < 4 && AMODE == AM_GATHER) ? 256u : 64u;
        typedef __attribute__((address_space(3))) unsigned* lds_u32p;
        const unsigned lbase = ((w < 4) ? 0u : 32768u) + (unsigned)(((w & 3) << 6) * 128) + (unsigned)lane * 16u;
        f32x4 acc[4][MI];
#pragma unroll
        for (int a2 = 0; a2 < 4; ++a2)
#pragma unroll
            for (int b2 = 0; b2 < MI; ++b2) acc[a2][b2] = (f32x4){0.f, 0.f, 0.f, 0.f};
        const int swz = (c16 >> 1) & 7;
        const int nk2 = nk >> 1;
#pragma unroll
        for (int i = 0; i < 8; ++i) __builtin_amdgcn_global_load_lds((const unsigned*)(gbase + goff[i]), (lds_u32p)(smem + lbase + i * 1024), 16, 0, 0);
        for (int kt = 0; kt < nk2; ++kt) {
            asm volatile("s_waitcnt vmcnt(0)" ::: "memory");
            __builtin_amdgcn_s_barrier();
            const unsigned char* sA = smem + (kt & 1) * 65536;
            const unsigned char* sB = sA + 32768;
            const bool more = kt + 1 < nk2;
            const unsigned ko = (unsigned)(kt + 1) * kst;
            unsigned char* sbn = smem + ((kt + 1) & 1) * 65536 + lbase;
#pragma unroll
            for (int ks = 0; ks < 2; ++ks) {
                bf16x8 wf[4], af[MI];
                const int ch = ((ks * 4 + q4) ^ swz) << 4;
#pragma unroll
                for (int ni = 0; ni < 4; ++ni) wf[ni] = *(const bf16x8*)(sB + (wn * 64 + ni * 16 + c16) * 128 + ch);
#pragma unroll
                for (int mi = 0; mi < MI; ++mi) af[mi] = *(const bf16x8*)(sA + (wm * 128 + mi * 16 + c16) * 128 + ch);
#pragma unroll
                for (int ni = 0; ni < 4; ++ni) {
                    if (more) __builtin_amdgcn_global_load_lds((const unsigned*)(gbase + (goff[ks * 4 + ni] + ko)), (lds_u32p)(sbn + (ks * 4 + ni) * 1024), 16, 0, 0);
#pragma unroll
                    for (int mi = 0; mi < MI; ++mi) acc[ni][mi] = mfma16(wf[ni], af[mi], acc[ni][mi]);
                }
            }
        }
        __syncthreads();
        const int nb = n0 + wn * 64;
        if (EPI == EPI_RESID) {
#pragma unroll
            for (int mi = 0; mi < MI; ++mi) { __builtin_amdgcn_sched_barrier(0);
                const size_t tok = m0 + wm * 128 + mi * 16 + c16;
#pragma unroll
                for (int ni = 0; ni < 4; ++ni) {
                    const int n = nb + ni * 16 + q4 * 4;
                    float4 r = *(const float4*)(e.resid + tok * 1024 + n);
                    r.x += acc[ni][mi][0]; r.y += acc[ni][mi][1]; r.z += acc[ni][mi][2]; r.w += acc[ni][mi][3];
                    *(float4*)(e.out + tok * 1024 + n) = r;
                }
            }
        } else if (EPI == EPI_CMP1) {
#pragma unroll
            for (int mi = 0; mi < MI; ++mi) { __builtin_amdgcn_sched_barrier(0);
                const int m = m0 + wm * 128 + mi * 16 + c16;
                if (m < M) {
#pragma unroll
                    for (int ni = 0; ni < 4; ++ni) {
                        const int n = nb + ni * 16 + q4 * 4;
                        const float4 bv = *(const float4*)(e.bias + n);
                        f32x4 o = {gelu_tanh(acc[ni][mi][0] + bv.x), gelu_tanh(acc[ni][mi][1] + bv.y), gelu_tanh(acc[ni][mi][2] + bv.z), gelu_tanh(acc[ni][mi][3] + bv.w)};
                        *(uint2*)(e.hid + (size_t)m * 256 + n) = pack4(o);
                    }
                }
            }
        } else if (EPI == EPI_BQ) {
            u16* Q = (u16*)(e.ws + OFF_Q);
#pragma unroll
            for (int mi = 0; mi < MI; ++mi) { __builtin_amdgcn_sched_barrier(0);
                const int tok = m0 + wm * 128 + mi * 16 + c16;
                rope_store(acc, mi, Q + (size_t)tok * 1024 + nb, cosT, sinT, tok & (S_ - 1), q4);
            }
        } else if (EPI == EPI_BKV) {
            u16* KSH = (u16*)(e.ws + OFF_KSH); u16* VSHT = (u16*)(e.ws + OFF_VSHT);
#pragma unroll
            for (int mi = 0; mi < MI; ++mi) { __builtin_amdgcn_sched_barrier(0);
                const int tok = m0 + wm * 128 + mi * 16 + c16, b = tok >> 14, s = tok & (S_ - 1);
                if (nb < 128) {
                    const int g = nb >> 6;
                    rope_store(acc, mi, KSH + ((size_t)(b * 2 + g) * S_ + s) * 64, cosT, sinT, s, q4);
                } else {
                    const int g = (nb - 128) >> 6;
#pragma unroll
                    for (int ni = 0; ni < 4; ++ni)
#pragma unroll
                        for (int i = 0; i < 4; ++i) VSHT[((size_t)(b * 2 + g) * 64 + ni * 16 + q4 * 4 + i) * S_ + s] = f2bf(acc[ni][mi][i]);
                }
            }
        } else if (EPI == EPI_AIN) {
            unsigned char* ws = e.ws;
#pragma unroll
            for (int mi = 0; mi < MI; ++mi) { __builtin_amdgcn_sched_barrier(0);
                const int tok = m0 + wm * 128 + mi * 16 + c16, b = tok >> 14, s = tok & (S_ - 1);
                if (nb < 1024) {
                    rope_store(acc, mi, (u16*)(ws + OFF_Q) + (size_t)tok * 1024 + nb, cosT, sinT, s, q4);
                } else if (nb < 1536) {
                    u16* dst = (nb < 1280) ? ((u16*)(ws + OFF_KC) + (size_t)tok * 256 + (nb - 1024)) : ((u16*)(ws + OFF_VC) + (size_t)tok * 256 + (nb - 1280));
#pragma unroll
                    for (int ni = 0; ni < 4; ++ni) *(uint2*)(dst + ni * 16 + q4 * 4) = pack4(acc[ni][mi]);
                } else if (nb < 2560) {
                    const int r = (nb - 1536) >> 8;
                    const int g = ((nb - 1536) & 255) >> 6;
                    if (r == 0) {
                        unsigned char* kd = (unsigned char*)(ws + OFF_KS) + (size_t)(b * 4 + g) * S_ * 128 + (size_t)s * 64;
#pragma unroll
                        for (int ni = 0; ni < 2; ++ni) {
                            const int d = ni * 16 + q4 * 4;
                            const float4 c = *(const float4*)(cosT + s * 32 + d), sn = *(const float4*)(sinT + s * 32 + d);
                            const f32x4 x1 = acc[ni][mi], x2 = acc[ni + 2][mi];
                            *(unsigned*)(kd + d) = pk4_fp8(x1[0] * c.x - x2[0] * sn.x, x1[1] * c.y - x2[1] * sn.y, x1[2] * c.z - x2[2] * sn.z, x1[3] * c.w - x2[3] * sn.w);
                            *(unsigned*)(kd + d + 32) = pk4_fp8(x2[0] * c.x + x1[0] * sn.x, x2[1] * c.y + x1[1] * sn.y, x2[2] * c.z + x1[2] * sn.z, x2[3] * c.w + x1[3] * sn.w);
                        }
                    } else if (r == 2) {
                        u16* base = (u16*)(ws + OFF_KW);
                        rope_store(acc, mi, base + ((size_t)(b * 4 + g) * S_ + s) * 64, cosT, sinT, s, q4);
                    } else {
                        if (r == 1) {
                            unsigned char* base = (unsigned char*)(ws + OFF_VST) + (size_t)(b * 4 + g) * 128 * S_ + (size_t)(s >> 6) * 4096 + (s & 63);
#pragma unroll
                            for (int ni = 0; ni < 4; ++ni) {
                                const unsigned pk = pk4_fp8(acc[ni][mi][0], acc[ni][mi][1], acc[ni][mi][2], acc[ni][mi][3]);
#pragma unroll
                                for (int i = 0; i < 4; ++i) base[(ni * 16 + q4 * 4 + i) * 64] = (unsigned char)(pk >> (8 * i));
                            }
                        } else {
                            u16* base = (u16*)(ws + OFF_VWT);
#pragma unroll
                            for (int ni = 0; ni < 4; ++ni)
#pragma unroll
                                for (int i = 0; i < 4; ++i) base[((size_t)(b * 4 + g) * 64 + ni * 16 + q4 * 4 + i) * S_ + s] = f2bf(acc[ni][mi][i]);
                        }
                    }
                } else if (nb == 2560) {
                    float* G = (float*)(ws + OFF_GATES) + (size_t)tok * 48;
#pragma unroll
                    for (int ni = 0; ni < 3; ++ni) {
                        const int n = ni * 16 + q4 * 4;
                        *(float4*)(G + n) = make_float4(sigmoidf_(acc[ni][mi][0]), sigmoidf_(acc[ni][mi][1]), sigmoidf_(acc[ni][mi][2]), sigmoidf_(acc[ni][mi][3]));
                    }
                }
            }
        } else if (EPI == EPI_FFNIN) {
            u16* U = (u16*)smem;
#pragma unroll
            for (int mi = 0; mi < MI; ++mi) {
                const int row = wm * 128 + mi * 16 + c16;
#pragma unroll
                for (int ni = 0; ni < 4; ++ni) {
                    const int cch = wn * 16 + ni * 4 + q4;
                    *(uint2*)(U + row * 256 + ((cch ^ (row & 15)) << 2)) = pack4(acc[ni][mi]);
                }
            }
            __syncthreads();
            {
                const int cc = tid & 31, gsel = cc >> 4, ca = cc & 15, seg = tid >> 5;
                const int ncol = (nt * 2 + gsel) * 64 + ca * 4;
                const int cha = gsel * 32 + ca, chg = cha + 16;
                const float4 w0a = *(const float4*)(e.convw + ncol), w1a = *(const float4*)(e.convw + NFF2 + ncol), w2a = *(const float4*)(e.convw + 2 * NFF2 + ncol);
                const float4 w0g = *(const float4*)(e.convw + DFF + ncol), w1g = *(const float4*)(e.convw + NFF2 + DFF + ncol), w2g = *(const float4*)(e.convw + 2 * NFF2 + DFF + ncol);
                const float4 ba = *(const float4*)(e.convb + ncol), bg = *(const float4*)(e.convb + DFF + ncol);
                float* head = (float*)(e.ws + OFF_HEAD); float* halo = (float*)(e.ws + OFF_HALO);
                u16* act = (u16*)(e.ws + OFF_ACT);
                auto ldu = [&](int row, int ch) __attribute__((always_inline)) -> float4 {
                    const uint2 v = *(const uint2*)(U + row * 256 + ((ch ^ (row & 15)) << 2));
                    return make_float4(__uint_as_float(v.x << 16), __uint_as_float(v.x & 0xffff0000u), __uint_as_float(v.y << 16), __uint_as_float(v.y & 0xffff0000u));
                };
                const int r0 = seg * 16;
                float4 a2 = make_float4(0.f, 0.f, 0.f, 0.f), a1 = a2, g2 = a2, g1 = a2;
                if (seg > 0) { a2 = ldu(r0 - 2, cha); g2 = ldu(r0 - 2, chg); a1 = ldu(r0 - 1, cha); g1 = ldu(r0 - 1, chg); }
#pragma unroll 2
                for (int r = 0; r < 16; ++r) {
                    const int row = r0 + r;
                    const float4 ua = ldu(row, cha), ug = ldu(row, chg);
                    if (seg > 0 || r >= 2) {
                        float ca_[4], cg_[4];
                        ca_[0] = ba.x + w0a.x * a2.x + w1a.x * a1.x + w2a.x * ua.x; ca_[1] = ba.y + w0a.y * a2.y + w1a.y * a1.y + w2a.y * ua.y;
                        ca_[2] = ba.z + w0a.z * a2.z + w1a.z * a1.z + w2a.z * ua.z; ca_[3] = ba.w + w0a.w * a2.w + w1a.w * a1.w + w2a.w * ua.w;
                        cg_[0] = bg.x + w0g.x * g2.x + w1g.x * g1.x + w2g.x * ug.x; cg_[1] = bg.y + w0g.y * g2.y + w1g.y * g1.y + w2g.y * ug.y;
                        cg_[2] = bg.z + w0g.z * g2.z + w1g.z * g1.z + w2g.z * ug.z; cg_[3] = bg.w + w0g.w * g2.w + w1g.w * g1.w + w2g.w * ug.w;
                        f32x4 o = {ca_[0] * sigmoidf_(ca_[0]) * cg_[0], ca_[1] * sigmoidf_(ca_[1]) * cg_[1], ca_[2] * sigmoidf_(ca_[2]) * cg_[2], ca_[3] * sigmoidf_(ca_[3]) * cg_[3]};
                        *(uint2*)(act + (size_t)(m0 + row) * DFF + ncol) = pack4(o);
                    }
                    if (seg == 0 && r < 2) { *(float4*)(head + (size_t)(mt * 2 + r) * NFF2 + ncol) = ua; *(float4*)(head + (size_t)(mt * 2 + r) * NFF2 + DFF + ncol) = ug; }
                    if (seg == 15 && r >= 14) { *(float4*)(halo + (size_t)(mt * 2 + r - 14) * NFF2 + ncol) = ua; *(float4*)(halo + (size_t)(mt * 2 + r - 14) * NFF2 + DFF + ncol) = ug; }
                    a2 = a1; a1 = ua; g2 = g1; g1 = ug;
                }
            }
            __syncthreads();
        }
    }
}

__device__ __forceinline__ void fixup_phase(const Params& p, int L, int tid_, int bid_) {
    const float* head = (const float*)(p.ws + OFF_HEAD); const float* halo = (const float*)(p.ws + OFF_HALO);
    u16* act = (u16*)(p.ws + OFF_ACT);
    const float* cw = p.ffn_conv_w + (size_t)L * 3 * NFF2; const float* cb = p.ffn_conv_b + (size_t)L * NFF2;
    const int gt = bid_ * NTHR + tid_, nthr = gridDim.x * NTHR;
    for (int idx = gt; idx < 128 * 704; idx += nthr) {
        const int i = idx / 704, n = (idx - i * 704) * 4;
        const int t0 = i * 256;
        const bool first = (t0 & (S_ - 1)) == 0;
        const float4 z = make_float4(0.f, 0.f, 0.f, 0.f);
        const float4 ha0 = *(const float4*)(head + (size_t)(i * 2) * NFF2 + n), ha1 = *(const float4*)(head + (size_t)(i * 2 + 1) * NFF2 + n);
        const float4 hg0 = *(const float4*)(head + (size_t)(i * 2) * NFF2 + DFF + n), hg1 = *(const float4*)(head + (size_t)(i * 2 + 1) * NFF2 + DFF + n);
        float4 pa0 = z, pa1 = z, pg0 = z, pg1 = z;
        if (!first) {
            pa0 = *(const float4*)(halo + (size_t)(i * 2 - 2) * NFF2 + n); pa1 = *(const float4*)(halo + (size_t)(i * 2 - 1) * NFF2 + n);
            pg0 = *(const float4*)(halo + (size_t)(i * 2 - 2) * NFF2 + DFF + n); pg1 = *(const float4*)(halo + (size_t)(i * 2 - 1) * NFF2 + DFF + n);
        }
        const float4 w0a = *(const float4*)(cw + n), w1a = *(const float4*)(cw + NFF2 + n), w2a = *(const float4*)(cw + 2 * NFF2 + n);
        const float4 w0g = *(const float4*)(cw + DFF + n), w1g = *(const float4*)(cw + NFF2 + DFF + n), w2g = *(const float4*)(cw + 2 * NFF2 + DFF + n);
        const float4 ba = *(const float4*)(cb + n), bg = *(const float4*)(cb + DFF + n);
#define CONV3(b_, w0_, w1_, w2_, x0_, x1_, x2_) make_float4(b_.x + w0_.x * x0_.x + w1_.x * x1_.x + w2_.x * x2_.x, b_.y + w0_.y * x0_.y + w1_.y * x1_.y + w2_.y * x2_.y, \
                                                             b_.z + w0_.z * x0_.z + w1_.z * x1_.z + w2_.z * x2_.z, b_.w + w0_.w * x0_.w + w1_.w * x1_.w + w2_.w * x2_.w)
        const float4 ca0 = CONV3(ba, w0a, w1a, w2a, pa0, pa1, ha0), cg0 = CONV3(bg, w0g, w1g, w2g, pg0, pg1, hg0);
        const float4 ca1 = CONV3(ba, w0a, w1a, w2a, pa1, ha0, ha1), cg1 = CONV3(bg, w0g, w1g, w2g, pg1, hg0, hg1);
        f32x4 o0 = {ca0.x * sigmoidf_(ca0.x) * cg0.x, ca0.y * sigmoidf_(ca0.y) * cg0.y, ca0.z * sigmoidf_(ca0.z) * cg0.z, ca0.w * sigmoidf_(ca0.w) * cg0.w};
        f32x4 o1 = {ca1.x * sigmoidf_(ca1.x) * cg1.x, ca1.y * sigmoidf_(ca1.y) * cg1.y, ca1.z * sigmoidf_(ca1.z) * cg1.z, ca1.w * sigmoidf_(ca1.w) * cg1.w};
        *(uint2*)(act + (size_t)t0 * DFF + n) = pack4(o0);
        *(uint2*)(act + (size_t)(t0 + 1) * DFF + n) = pack4(o1);
    }
}

__device__ __forceinline__ void cmp2_phase(const Params& p, int L, int tid_, int bid_) {
    const int lane = tid_ & 63, w = tid_ >> 6, c16 = lane & 15, q4 = lane >> 4;
    const float* cosT = (const float*)(p.ws + OFF_COS); const float* sinT = (const float*)(p.ws + OFF_SIN);
    u16* KCC = (u16*)(p.ws + OFF_KCC); u16* VCCT = (u16*)(p.ws + OFF_VCCT);
    float ivr[8];
    rope_ivr(ivr, q4);
    for (int task = bid_ * NW + w; task < 1024; task += gridDim.x * NW) {
        const int kv = task >> 9, r0 = (task & 511) * 16;
        const u16* hid = (const u16*)(p.ws + OFF_HID) + (size_t)kv * 8192 * 256;
        const u16* w2t = (const u16*)(p.ws + OFF_WT_CW2 + (L * 2 + kv) * SZ_WT_CW2);
        const int row = r0 + c16, rowc = row < 8184 ? row : 8183;
        f32x4 acc[4][1];
        f32x4 accq[4][4];
#pragma unroll
        for (int a = 0; a < 4; ++a) accq[a][0] = (f32x4){0.f, 0.f, 0.f, 0.f};
#pragma unroll
        for (int kk = 0; kk < 8; ++kk) {
            const bf16x8 bfr = *(const bf16x8*)(hid + (size_t)rowc * 256 + kk * 32 + q4 * 8);
#pragma unroll
            for (int nbk = 0; nbk < 4; ++nbk) {
                const bf16x8 afr = *(const bf16x8*)(w2t + (nbk * 16 + c16) * 256 + kk * 32 + q4 * 8);
                accq[nbk][0] = mfma16(afr, bfr, accq[nbk][0]);
            }
        }
        (void)acc;
        if (row < 8184) {
            const int g = row & 3, bn = row >> 2, b = bn / 1023, n = bn - b * 1023, bg = b * 4 + g;
            if (kv == 0) {
                rope_store_fly(accq, 0, KCC + ((size_t)bg * 1024 + n) * 64, ivr, n * 16 + 31, q4);
            } else {
#pragma unroll
                for (int nbk = 0; nbk < 4; ++nbk)
#pragma unroll
                    for (int i = 0; i < 4; ++i) VCCT[((size_t)bg * 64 + nbk * 16 + q4 * 4 + i) * 1024 + n] = f2bf(accq[nbk][0][i]);
            }
        }
    }
    const int gt = bid_ * NTHR + tid_;
    if (gt < 512) {
        const int bg = gt >> 6, d = gt & 63;
        KCC[((size_t)bg * 1024 + 1023) * 64 + d] = 0;
        VCCT[((size_t)bg * 64 + d) * 1024 + 1023] = 0;
    }
}

template <bool SINK>
__device__ __forceinline__ void band_attn(const u16* __restrict__ qrow, const u16* __restrict__ Kh, const u16* __restrict__ VT, int t0, int W, const float* sinks4,
                                          f32x4 (&O)[4][4], float (&linv)[4], int lane) {
    const int c16 = lane & 15, q4 = lane >> 4;
    const float SC = 0.125f * LOG2E;
    bf16x8 qf[4][2];
#pragma unroll
    for (int h = 0; h < 4; ++h)
#pragma unroll
        for (int ks = 0; ks < 2; ++ks) qf[h][ks] = *(const bf16x8*)(qrow + h * 64 + ks * 32 + q4 * 8);
    float m[4], l[4];
#pragma unroll
    for (int h = 0; h < 4; ++h) {
        if (SINK) { m[h] = sinks4[h] * LOG2E; l[h] = (q4 == 0) ? 1.f : 0.f; }
        else { m[h] = NEGBIG; l[h] = 0.f; }
#pragma unroll
        for (int db = 0; db < 4; ++db) O[h][db] = (f32x4){0.f, 0.f, 0.f, 0.f};
    }
    const int t = t0 + c16;
    int lo = t0 - W + 1; if (lo < 0) lo = 0;
    const int g0 = lo >> 5, g1 = (t0 + 15) >> 5;
    const int kr = kperm(c16);
    for (int grp = g0; grp <= g1; ++grp) {
        const int kb = grp << 5;
        const unsigned kof = (unsigned)(kb + kr) * 64u + (unsigned)q4 * 8u;
        const bf16x8 k1a = *(const bf16x8*)(Kh + kof), k1b = *(const bf16x8*)(Kh + (kof + 32u)), k2a = *(const bf16x8*)(Kh + (kof + 256u)), k2b = *(const bf16x8*)(Kh + (kof + 288u));
        bf16x8 vf[4];
        const unsigned vof = (unsigned)c16 * (unsigned)S_ + (unsigned)kb + (unsigned)q4 * 8u;
#pragma unroll
        for (int db = 0; db < 4; ++db) vf[db] = *(const bf16x8*)(VT + (size_t)(db * 16 * S_) + vof);
        const int kpos = kb + q4 * 8;
        f32x4 cm1 = {0.f, 0.f, 0.f, 0.f}, cm2 = cm1;
        if (!((kb + 31 <= t0) && (kb > t0 + 15 - W))) {
#pragma unroll
            for (int i = 0; i < 4; ++i) {
                const int d1 = t - (kpos + i), d2 = t - (kpos + 4 + i);
                if (!((d1 >= 0) && (d1 < W))) cm1[i] = NEGBIG;
                if (!((d2 >= 0) && (d2 < W))) cm2[i] = NEGBIG;
            }
        }
#pragma unroll
        for (int h = 0; h < 4; ++h) {
            f32x4 s1 = mfma16(k1a, qf[h][0], cm1); s1 = mfma16(k1b, qf[h][1], s1);
            f32x4 s2 = mfma16(k2a, qf[h][0], cm2); s2 = mfma16(k2b, qf[h][1], s2);
            float mx = fmaxf(fmaxf(fmaxf(s1[0], s1[1]), fmaxf(s1[2], s1[3])), fmaxf(fmaxf(s2[0], s2[1]), fmaxf(s2[2], s2[3])));
            mx = xmax32(xmax16(mx));
            const float mn = fmaxf(fmaxf(m[h], mx * SC), -1e20f);
            if (__ballot(mn != m[h])) {
                const float alpha = fexp2(m[h] - mn);
                l[h] *= alpha;
#pragma unroll
                for (int db = 0; db < 4; ++db) O[h][db] = O[h][db] * alpha;
            }
            m[h] = mn;
            float pv[8]; float ps = 0.f;
#pragma unroll
            for (int i = 0; i < 4; ++i) { pv[i] = fexp2(fmaf(s1[i], SC, -mn)); pv[4 + i] = fexp2(fmaf(s2[i], SC, -mn)); }
#pragma unroll
            for (int i = 0; i < 8; ++i) ps += pv[i];
            l[h] += ps;
            const bf16x8 pf = pack8(pv);
#pragma unroll
            for (int db = 0; db < 4; ++db) O[h][db] = mfma16(vf[db], pf, O[h][db]);
        }
    }
#pragma unroll
    for (int h = 0; h < 4; ++h) { float lt = l[h]; lt += __shfl_xor(lt, 16); lt += __shfl_xor(lt, 32); linv[h] = 1.f / lt; }
}

__device__ __forceinline__ void swa_phase(const Params& p, int j, int tid_, int bid_) {
    const int lane = tid_ & 63, w = tid_ >> 6, c16 = lane & 15, q4 = lane >> 4;
    const int x = bid_ & 7, b = x >> 2, kvh = (x >> 1) & 1, hq = x & 1;
    const int head0 = kvh * 8 + hq * 4;
    const u16* Q = (const u16*)(p.ws + OFF_Q); u16* Ob = (u16*)(p.ws + OFF_O);
    const u16* Kh = (const u16*)(p.ws + OFF_KSH) + (size_t)(b * 2 + kvh) * S_ * 64;
    const u16* VT = (const u16*)(p.ws + OFF_VSHT) + (size_t)(b * 2 + kvh) * 64 * S_;
    const float* sk = p.b_sinks + j * 16 + head0;
    const int nslots = (gridDim.x >> 3) * NW;
    for (int tile = (bid_ >> 3) * NW + w; tile < 1024; tile += nslots) {
        const int t0 = tile * 16;
        f32x4 O[4][4]; float linv[4];
        band_attn<true>(Q + ((size_t)b * S_ + t0 + c16) * 1024 + head0 * 64, Kh, VT, t0, 128, sk, O, linv, lane);
        u16* op = Ob + ((size_t)b * S_ + t0 + c16) * 1024 + head0 * 64;
#pragma unroll
        for (int h = 0; h < 4; ++h)
#pragma unroll
            for (int db = 0; db < 4; ++db) *(uint2*)(op + h * 64 + db * 16 + q4 * 4) = pack4(O[h][db] * linv[h]);
    }
}

__device__ __forceinline__ void nsa_phase(const Params& p, unsigned char* smem, int tid_, int bid_, int probe_rep, int layer) {
    const int lane0 = tid_ & 63, w = tid_ >> 6;
    float* R = (float*)(smem + w * 16384);
    unsigned* tm = (unsigned*)(smem + NW * 16384 + w * 1024);
    unsigned char* sel = smem + NW * 16384 + NW * 1024 + w * 256;
    const int bg = bid_ & 7, b = bg >> 2, g = bg & 3;
    const u16* Q = (const u16*)(p.ws + OFF_Q); u16* Ob = (u16*)(p.ws + OFF_O);
    const u16* KCC = (const u16*)(p.ws + OFF_KCC) + (size_t)bg * 1024 * 64;
    const u16* VCCT = (const u16*)(p.ws + OFF_VCCT) + (size_t)bg * 64 * 1024;
    const u16* KS = (const u16*)(p.ws + OFF_KS) + (size_t)bg * S_ * 64;
    const u16* VST = (const u16*)(p.ws + OFF_VST) + (size_t)bg * 64 * S_;
    const u16* KW = (const u16*)(p.ws + OFF_KW) + (size_t)bg * S_ * 64;
    const u16* VWT = (const u16*)(p.ws + OFF_VWT) + (size_t)bg * 64 * S_;
    const float* GATES = (const float*)(p.ws + OFF_GATES);
    const float SC = 0.125f * LOG2E;
    const int nslots = (gridDim.x >> 3) * NW;
    unsigned* qhead = (unsigned*)(p.ws + OFF_BAR) + 4096 + (layer * 8 + bg) * 64;
    for (;;) {
        int tile_ = 0;
        if (lane0 == 0) tile_ = (int)__hip_atomic_fetch_add(qhead, 1u, __ATOMIC_RELAXED, __HIP_MEMORY_SCOPE_AGENT);
        tile_ = 1023 - __builtin_amdgcn_readfirstlane(tile_);
        if (tile_ < 0) break;
        const int tile = __builtin_amdgcn_readfirstlane(tile_);
        int lane = lane0; asm volatile("" : "+v"(lane));
        const int c16 = lane & 15, q4 = lane >> 4, kr = kperm(c16);
        const int t0 = tile * 16, cur = t0 >> 6, t = t0 + c16;
        const u16* qrow = Q + ((size_t)b * S_ + t) * 1024 + g * 256;
        const float* grow = GATES + ((size_t)b * S_ + t) * 48 + g * 12;
        const int nvl = (t >= 31) ? ((t - 31) >> 4) : -1;
        const int nvmax = (t0 + 15 >= 31) ? ((t0 + 15 - 31) >> 4) : -1;
        const int ng = (nvmax >= 0) ? ((nvmax >> 5) + 1) : 0;
        f32x4 Oc[4][4];
#pragma unroll
        for (int h = 0; h < 4; ++h)
#pragma unroll
            for (int db = 0; db < 4; ++db) Oc[h][db] = (f32x4){0.f, 0.f, 0.f, 0.f};
        {
            bf16x8 qf[4][2];
#pragma unroll
            for (int h = 0; h < 4; ++h)
#pragma unroll
                for (int ks = 0; ks < 2; ++ks) qf[h][ks] = *(const bf16x8*)(qrow + h * 64 + ks * 32 + q4 * 8);
            float m[4], l[4];
#pragma unroll
            for (int h = 0; h < 4; ++h) { m[h] = NEGBIG; l[h] = 0.f; }
            const int nvmin = (t0 >= 31) ? ((t0 - 31) >> 4) : -1;
            for (int grp = 0; grp < ng; ++grp) {
                const int kb = grp << 5;
                const unsigned kof = (unsigned)(kb + kr) * 64u + (unsigned)q4 * 8u;
                const bf16x8 k1a = *(const bf16x8*)(KCC + kof), k1b = *(const bf16x8*)(KCC + (kof + 32u)), k2a = *(const bf16x8*)(KCC + (kof + 256u)), k2b = *(const bf16x8*)(KCC + (kof + 288u));
                const int kpos = kb + q4 * 8;
                f32x4 cm1 = {0.f, 0.f, 0.f, 0.f}, cm2 = cm1;
                if (kb + 31 > nvmin) {
#pragma unroll
                    for (int i = 0; i < 4; ++i) { if (kpos + i > nvl) cm1[i] = NEGBIG; if (kpos + 4 + i > nvl) cm2[i] = NEGBIG; }
                }
#pragma unroll
                for (int h = 0; h < 4; ++h) {
                    f32x4 s1 = mfma16(k1a, qf[h][0], cm1); s1 = mfma16(k1b, qf[h][1], s1);
                    f32x4 s2 = mfma16(k2a, qf[h][0], cm2); s2 = mfma16(k2b, qf[h][1], s2);
                    float mx = fmaxf(fmaxf(fmaxf(s1[0], s1[1]), fmaxf(s1[2], s1[3])), fmaxf(fmaxf(s2[0], s2[1]), fmaxf(s2[2], s2[3])));
                    mx = xmax32(xmax16(mx));
                    const float mn = fmaxf(fmaxf(m[h], mx * SC), -1e20f);
                    if (__ballot(mn != m[h])) l[h] *= fexp2(m[h] - mn);
                    m[h] = mn;
                    float ps = 0.f;
#pragma unroll
                    for (int i = 0; i < 4; ++i) ps += fexp2(fmaf(s1[i], SC, -mn)) + fexp2(fmaf(s2[i], SC, -mn));
                    l[h] += ps;
                }
            }
            float linv[4];
#pragma unroll
            for (int h = 0; h < 4; ++h) { float lt = l[h]; lt += __shfl_xor(lt, 16); lt += __shfl_xor(lt, 32); linv[h] = lt > 0.f ? 1.f / lt : 0.f; }
            float carry = 0.f;
            for (int grp = 0; grp < ng; ++grp) {
                const int kb = grp << 5;
                const unsigned kof = (unsigned)(kb + kr) * 64u + (unsigned)q4 * 8u;
                const bf16x8 k1a = *(const bf16x8*)(KCC + kof), k1b = *(const bf16x8*)(KCC + (kof + 32u)), k2a = *(const bf16x8*)(KCC + (kof + 256u)), k2b = *(const bf16x8*)(KCC + (kof + 288u));
                bf16x8 vf[4];
#pragma unroll
                for (int db = 0; db < 4; ++db) vf[db] = *(const bf16x8*)(VCCT + (unsigned)(db * 16 * 1024) + ((unsigned)c16 * 1024u + (unsigned)kb + (unsigned)q4 * 8u));
                const int kpos = kb + q4 * 8;
                float psum[8];
#pragma unroll
                for (int i = 0; i < 8; ++i) psum[i] = 0.f;
                f32x4 cm1 = {0.f, 0.f, 0.f, 0.f}, cm2 = cm1;
                if (kb + 31 > nvmin) {
#pragma unroll
                    for (int i = 0; i < 4; ++i) { if (kpos + i > nvl) cm1[i] = NEGBIG; if (kpos + 4 + i > nvl) cm2[i] = NEGBIG; }
                }
#pragma unroll
                for (int h = 0; h < 4; ++h) {
                    f32x4 s1 = mfma16(k1a, qf[h][0], cm1); s1 = mfma16(k1b, qf[h][1], s1);
                    f32x4 s2 = mfma16(k2a, qf[h][0], cm2); s2 = mfma16(k2b, qf[h][1], s2);
                    float pv[8];
#pragma unroll
                    for (int i = 0; i < 4; ++i) {
                        pv[i] = fexp2(fmaf(s1[i], SC, -m[h])) * linv[h];
                        pv[4 + i] = fexp2(fmaf(s2[i], SC, -m[h])) * linv[h];
                    }
#pragma unroll
                    for (int i = 0; i < 8; ++i) psum[i] += pv[i];
                    const bf16x8 pf = pack8(pv);
#pragma unroll
                    for (int db = 0; db < 4; ++db) Oc[h][db] = mfma16(vf[db], pf, Oc[h][db]);
                }
                const float prev = __shfl(psum[7], (lane + 48) & 63);
                const float left = (q4 == 0) ? carry : prev;
                carry = prev;
                const float impA = left + 2.f * (psum[0] + psum[1] + psum[2]) + psum[3];
                const float impB = psum[3] + 2.f * (psum[4] + psum[5] + psum[6]) + psum[7];
                *(float2*)(R + c16 * 256 + (kb >> 2) + 2 * q4) = make_float2(impA, impB);
            }
        }
        wsync();
        const int ncand = cur - 2;
        const int npick = ncand < 0 ? 0 : (ncand < 13 ? ncand : 13);
        const int nforced = (cur < 2 ? cur : 2) + 1;
        const int nsel = npick + nforced;
        for (int tk = 0; tk < 8; ++tk) {
            float a0 = -1.f, a1 = -1.f, a2 = -1.f, a3 = -1.f, b0 = -1.f, b1 = -1.f, b2 = -1.f, b3 = -1.f;
            if (npick > 0) {
                const float4 va = *(const float4*)(R + tk * 256 + lane * 4), vb = *(const float4*)(R + (tk + 8) * 256 + lane * 4);
                const int j0 = lane * 4;
                const bool k0 = (j0 >= 1 && j0 <= ncand), k1 = (j0 + 1 <= ncand), k2 = (j0 + 2 <= ncand), k3 = (j0 + 3 <= ncand);
                a0 = k0 ? va.x : -1.f; a1 = k1 ? va.y : -1.f; a2 = k2 ? va.z : -1.f; a3 = k3 ? va.w : -1.f;
                b0 = k0 ? vb.x : -1.f; b1 = k1 ? vb.y : -1.f; b2 = k2 ? vb.z : -1.f; b3 = k3 ? vb.w : -1.f;
            }
            for (int it = 0; it < npick; ++it) {
                const float ma = wave_max(fmaxf(fmaxf(a0, a1), fmaxf(a2, a3)));
                const float mb = wave_max(fmaxf(fmaxf(b0, b1), fmaxf(b2, b3)));
                const unsigned long long bala = __ballot((a0 == ma) || (a1 == ma) || (a2 == ma) || (a3 == ma));
                const unsigned long long balb = __ballot((b0 == mb) || (b1 == mb) || (b2 == mb) || (b3 == mb));
                const int fa = __ffsll((long long)bala) - 1, fb = __ffsll((long long)balb) - 1;
                if (lane == fa) {
                    int sl;
                    if (a0 == ma) { sl = 0; a0 = -1.f; } else if (a1 == ma) { sl = 1; a1 = -1.f; } else if (a2 == ma) { sl = 2; a2 = -1.f; } else { sl = 3; a3 = -1.f; }
                    sel[tk * 16 + it] = (unsigned char)(lane * 4 + sl);
                }
                if (lane == fb) {
                    int sl;
                    if (b0 == mb) { sl = 0; b0 = -1.f; } else if (b1 == mb) { sl = 1; b1 = -1.f; } else if (b2 == mb) { sl = 2; b2 = -1.f; } else { sl = 3; b3 = -1.f; }
                    sel[(tk + 8) * 16 + it] = (unsigned char)(lane * 4 + sl);
                }
            }
            if (lane < 2) {
                const int tq = tk + lane * 8;
                sel[tq * 16 + npick] = 0;
                if (cur >= 1) sel[tq * 16 + npick + 1] = (unsigned char)cur;
                if (cur >= 2) sel[tq * 16 + npick + 2] = (unsigned char)(cur - 1);
            }
        }
        { unsigned zz = 0u; asm volatile("" : "+v"(zz)); *(uint4*)(tm + lane * 4) = make_uint4(zz, zz, zz, zz); }
        wsync();
        if (lane < 16) {
            for (int si = 0; si < nsel; ++si) atomicOr(&tm[sel[lane * 16 + si]], 1u << lane);
        }
        wsync();
        int n_act;
        {
            const uint4 mm = *(const uint4*)(tm + lane * 4);
            wsync();
            const bool f0 = mm.x != 0u, f1 = mm.y != 0u, f2 = mm.z != 0u, f3 = mm.w != 0u;
            const unsigned long long b0 = __ballot(f0), b1 = __ballot(f1), b2 = __ballot(f2), b3 = __ballot(f3);
            const unsigned long long below = (1ull << lane) - 1ull;
            int pos = __popcll(b0 & below) + __popcll(b1 & below) + __popcll(b2 & below) + __popcll(b3 & below);
            if (f0) { sel[pos] = (unsigned char)(lane * 4 + 0); ++pos; }
            if (f1) { sel[pos] = (unsigned char)(lane * 4 + 1); ++pos; }
            if (f2) { sel[pos] = (unsigned char)(lane * 4 + 2); ++pos; }
            if (f3) { sel[pos] = (unsigned char)(lane * 4 + 3); ++pos; }
            n_act = __popcll(b0) + __popcll(b1) + __popcll(b2) + __popcll(b3);
        }
        wsync();
        u16* PL = (u16*)R + 4096;
        {
            int t3 = t; asm volatile("" : "+v"(t3));
            const float* grow3 = GATES + ((size_t)b * S_ + t3) * 48 + g * 12;
#pragma unroll
            for (int h = 0; h < 4; ++h) {
                const float g0 = grow3[h * 3 + 0];
#pragma unroll
                for (int db = 0; db < 4; ++db) *(uint2*)(PL + (c16 * 4 + h) * 64 + db * 16 + q4 * 4) = pack4(Oc[h][db] * g0);
            }
        }
        wsync();
        for (int rep = 0; rep <= probe_rep; ++rep) {
            const int tg = c16 >> 2, hh = c16 & 3;
            f32x4 Os[4][4], Ol[4]; float m[4];
#pragma unroll
            for (int gq = 0; gq < 4; ++gq) {
                m[gq] = NEGBIG; Ol[gq] = (f32x4){0.f, 0.f, 0.f, 0.f};
#pragma unroll
                for (int db = 0; db < 4; ++db) Os[gq][db] = (f32x4){0.f, 0.f, 0.f, 0.f};
            }
            const long ones8 = 0x3838383838383838L;
            typedef long l64x2 __attribute__((ext_vector_type(2)));
            long qf8[4][2];
#pragma unroll
            for (int gq = 0; gq < 4; ++gq)
#pragma unroll
                for (int ks = 0; ks < 2; ++ks) {
                    const uint4 qv = *(const uint4*)(Q + ((size_t)b * S_ + t0 + gq * 4 + tg) * 1024 + g * 256 + hh * 64 + q4 * 16 + ks * 8);
                    const float f[8] = {__uint_as_float(qv.x << 16), __uint_as_float(qv.x & 0xffff0000u), __uint_as_float(qv.y << 16), __uint_as_float(qv.y & 0xffff0000u),
                                        __uint_as_float(qv.z << 16), __uint_as_float(qv.z & 0xffff0000u), __uint_as_float(qv.w << 16), __uint_as_float(qv.w & 0xffff0000u)};
                    qf8[gq][ks] = pk8_fp8(f);
                }
            const unsigned char* KS8 = (const unsigned char*)KS;
            const unsigned char* VS8 = (const unsigned char*)VST;
            const unsigned krow = (unsigned)((c16 >> 2) * 16 + (c16 & 3));
            for (int ib = 0; ib < n_act; ++ib) {
                const int j = __builtin_amdgcn_readfirstlane((int)sel[ib]);
                const unsigned mk = __builtin_amdgcn_readfirstlane(tm[j]);
                l64x2 KK[4], VV[4];
                const unsigned kof = ((unsigned)j * 64u + krow) * 64u + (unsigned)q4 * 16u;
#pragma unroll
                for (int r = 0; r < 4; ++r) KK[r] = *(const l64x2*)(KS8 + (kof + (unsigned)((r >> 1) * 8 + (r & 1) * 4) * 64u));
                const unsigned vof = (unsigned)j * 4096u + (unsigned)c16 * 64u + (unsigned)q4 * 16u;
#pragma unroll
                for (int db = 0; db < 4; ++db) VV[db] = *(const l64x2*)(VS8 + (vof + (unsigned)(db * 1024)));
#pragma unroll
                for (int h = 0; h < 2; ++h) {
                    const int kpos = j * 64 + q4 * 16 + h * 8;
#pragma unroll
                    for (int gq = 0; gq < 4; ++gq) {
                        const unsigned gm = (mk >> (gq * 4)) & 0xFu;
                        if (gm == 0u) continue;
                        const float cmv = ((gm >> tg) & 1u) ? 0.f : NEGBIG;
                        f32x4 cm1 = {cmv, cmv, cmv, cmv}, cm2 = cm1;
                        if (j == cur) {
                            const int tc = t0 + gq * 4 + tg;
#pragma unroll
                            for (int i = 0; i < 4; ++i) { if (kpos + i > tc) cm1[i] = NEGBIG; if (kpos + 4 + i > tc) cm2[i] = NEGBIG; }
                        }
                        f32x4 s1 = mfma8(KK[h * 2][0], qf8[gq][0], cm1); s1 = mfma8(KK[h * 2][1], qf8[gq][1], s1);
                        f32x4 s2 = mfma8(KK[h * 2 + 1][0], qf8[gq][0], cm2); s2 = mfma8(KK[h * 2 + 1][1], qf8[gq][1], s2);
                        float mx = fmaxf(fmaxf(fmaxf(s1[0], s1[1]), fmaxf(s1[2], s1[3])), fmaxf(fmaxf(s2[0], s2[1]), fmaxf(s2[2], s2[3])));
                        mx = xmax32(xmax16(mx));
                        const float mn = fmaxf(m[gq], mx * SC);
                        if (__ballot(mn != m[gq])) {
                            const float alpha = fexp2(m[gq] - mn);
                            Ol[gq] = Ol[gq] * alpha;
#pragma unroll
                            for (int db = 0; db < 4; ++db) Os[gq][db] = Os[gq][db] * alpha;
                        }
                        m[gq] = mn;
                        float pv[8];
#pragma unroll
                        for (int i = 0; i < 4; ++i) { pv[i] = fexp2(fmaf(s1[i], SC, 7.f - mn)); pv[4 + i] = fexp2(fmaf(s2[i], SC, 7.f - mn)); }
                        const long pf = pk8_fp8(pv);
#pragma unroll
                        for (int db = 0; db < 4; ++db) Os[gq][db] = mfma8(VV[db][h], pf, Os[gq][db]);
                        Ol[gq] = mfma8(ones8, pf, Ol[gq]);
                    }
                }
            }
            const float repsc = (rep == 0) ? 1.f : 0.f;
#pragma unroll
            for (int gq = 0; gq < 4; ++gq) {
                const float lt = Ol[gq][0];
                const int tok = gq * 4 + tg;
                const float sc = repsc * GATES[((size_t)b * S_ + t0 + tok) * 48 + g * 12 + hh * 3 + 1] / lt;
#pragma unroll
                for (int db = 0; db < 4; ++db) {
                    u16* rp = PL + (tok * 4 + hh) * 64 + db * 16 + q4 * 4;
                    *(uint2*)rp = pack4(unpack4(*(const uint2*)rp) + Os[gq][db] * sc);
                }
            }
        }
        wsync();
        {
            f32x4 Ow[4][4]; float linv[4];
            int t2 = t; asm volatile("" : "+v"(t2));
            const u16* qrow2 = Q + ((size_t)b * S_ + t2) * 1024 + g * 256;
            const float* grow2 = GATES + ((size_t)b * S_ + t2) * 48 + g * 12;
            band_attn<false>(qrow2, KW, VWT, t0, 512, nullptr, Ow, linv, lane);
            u16* op = Ob + ((size_t)b * S_ + t2) * 1024 + g * 256;
#pragma unroll
            for (int h = 0; h < 4; ++h) {
                const float g2 = grow2[h * 3 + 2] * linv[h];
#pragma unroll
                for (int db = 0; db < 4; ++db) {
                    const f32x4 part = unpack4(*(const uint2*)(PL + (c16 * 4 + h) * 64 + db * 16 + q4 * 4));
                    *(uint2*)(op + h * 64 + db * 16 + q4 * 4) = pack4(part + Ow[h][db] * g2);
                }
            }
        }
        wsync();
    }
}


#define XB_TMO      128
#define XB_XCNT(j)  (256  + 64 * (j))
#define XB_XSUB(j)  (1280 + 64 * (j))
#define XB_XGEN(j)  (2304 + 64 * (j))
#define XB_TOP      3328
#define XB_TOPGEN   3392
#define XCD_BAR_WORDS 3456
#define XB_SPIN_CAP (1u << 22)
#define LAS __attribute__((address_space(3)))
__device__ __forceinline__ unsigned xb_ld(unsigned* p)              { return __hip_atomic_load(p, __ATOMIC_RELAXED, __HIP_MEMORY_SCOPE_AGENT); }
__device__ __forceinline__ unsigned xb_add(unsigned* p, unsigned v) { return __hip_atomic_fetch_add(p, v, __ATOMIC_RELAXED, __HIP_MEMORY_SCOPE_AGENT); }
__device__ __forceinline__ unsigned xb_xcc_id() { return (unsigned)__builtin_amdgcn_s_getreg((3 << 11) | 20) & 0xFu; }
#define XB_SPIN(cond, bar) do { unsigned _sp = 0; while (cond) { __builtin_amdgcn_s_sleep(1); \
    if ((++_sp & 255u) == 0u) { if (xb_ld(&(bar)[XB_TMO])) break; if (_sp > XB_SPIN_CAP) { atomicAdd(&(bar)[XB_TMO], 1u); break; } } } } while (0)
__device__ __forceinline__ void xcd_barrier_complete(unsigned* bar, unsigned x, unsigned& nloc, unsigned& nx) {
    const unsigned G = gridDim.x * gridDim.y * gridDim.z;
    unsigned sum, cnt, mine, sp = 0u;
    for (;;) {
        sum = 0u; cnt = 0u; mine = 0u;
#pragma unroll
        for (unsigned j = 0; j < 16; ++j) { const unsigned c = xb_ld(&bar[XB_XCNT(j)]); sum += c; cnt += (c > 0u) ? 1u : 0u; mine = (j == x) ? c : mine; }
        if (sum == G) break;
        __builtin_amdgcn_s_sleep(1);
        if ((++sp & 255u) == 0u) { if (xb_ld(&bar[XB_TMO])) break; if (sp > XB_SPIN_CAP) { atomicAdd(&bar[XB_TMO], 1u); break; } }
    }
    nloc = mine > 0u ? mine : 1u; nx = cnt > 0u ? cnt : 1u;
}
__device__ __forceinline__ void xcd_barrier(unsigned* bar, unsigned x, volatile LAS unsigned* st, int tid) {
    asm volatile("s_waitcnt vmcnt(0)" ::: "memory");
    __syncthreads();
    if (tid == 0) {
        __builtin_amdgcn_s_waitcnt(0);
        unsigned nloc = st[0], nx = st[1];
        if (nloc == 0u) { xcd_barrier_complete(bar, x, nloc, nx); st[0] = nloc; st[1] = nx; }
        const unsigned old = xb_add(&bar[XB_XSUB(x)], 1u);
        const unsigned gen = old / nloc;
        if (old + 1u == (gen + 1u) * nloc) {
            __builtin_amdgcn_fence(__ATOMIC_RELEASE, "agent");
            asm volatile("s_waitcnt vmcnt(0)" ::: "memory");
            const unsigned og = xb_add(&bar[XB_TOP], 1u);
            const unsigned tg = og / nx;
            if (og + 1u == (tg + 1u) * nx) xb_add(&bar[XB_TOPGEN], 1u);
            else XB_SPIN(xb_ld(&bar[XB_TOPGEN]) == tg, bar);
            __builtin_amdgcn_fence(__ATOMIC_ACQUIRE, "agent");
            xb_add(&bar[XB_XGEN(x)], 1u);
            asm volatile("s_waitcnt vmcnt(0)" ::: "memory");
        } else {
            XB_SPIN(xb_ld(&bar[XB_XGEN(x)]) == gen, bar);
            __builtin_amdgcn_fence(__ATOMIC_ACQUIRE, "agent");
            asm volatile("s_waitcnt vmcnt(0)" ::: "memory");
        }
    }
    __syncthreads();
}

enum { PT_PREP = 0, PT_NORM, PT_AIN, PT_CMP1, PT_CMP2, PT_NSA, PT_BKV, PT_BQ, PT_SWA, PT_AOUT, PT_FFNIN, PT_FIXUP, PT_FOUT, PT_FINAL };

__global__ void __launch_bounds__(NTHR, 2) mega(Params p) {
#if defined(__HIP_DEVICE_COMPILE__)
    extern __shared__ __attribute__((aligned(16))) unsigned char smem[];
    cg::grid_group grid = cg::this_grid();
    typedef const Params __attribute__((address_space(4)))* KP;
    const int ph_lo = p.ph_lo, ph_hi = p.ph_hi;
    const int wave_id = __builtin_amdgcn_readfirstlane((int)(threadIdx.x >> 6));
    unsigned* bar = (unsigned*)(p.ws + OFF_BAR);
    volatile LAS unsigned* xst = (volatile LAS unsigned*)(smem + LDS_USER);
    const unsigned xcc = __builtin_amdgcn_readfirstlane(xb_xcc_id());
    if (ph_hi - ph_lo > 1) {
        if (threadIdx.x == 0) { xst[0] = 0u; xst[1] = 0u; (void)xb_add(&bar[XB_XCNT(xcc)], 1u); }
        __syncthreads();
    }
    for (int ph = ph_lo; ph < ph_hi; ++ph) {
        int tid_, bid_ = blockIdx.x;
        asm volatile("v_mbcnt_lo_u32_b32 %0, -1, 0\n\tv_mbcnt_hi_u32_b32 %0, -1, %0" : "=v"(tid_));
        tid_ += wave_id * 64;
        asm volatile("" : "+s"(bid_));
        KP kp = (KP)__builtin_amdgcn_kernarg_segment_ptr();
        asm volatile("" : "+s"(kp));
        unsigned char* ws = kp->ws;
        u16* HN = (u16*)(ws + OFF_HN);
        const int d = kp->desc[ph], type = d & 255, sub = (d >> 8) & 255, L = d >> 16;
        const float* hsrc = (L == 0) ? kp->x : kp->out;
        EpiArgs e; e.resid = nullptr; e.out = kp->out; e.bias = nullptr; e.hid = nullptr; e.convw = nullptr; e.convb = nullptr; e.ws = ws;
        switch (type) {
        case PT_PREP: { const Params pl = *kp; prep_phase(pl, smem, tid_, bid_); } break;
        case PT_NORM: {
            const float* src = (sub == 1) ? kp->out : hsrc;
            const float* g = (sub == 0) ? kp->norm_attn + L * 1024 : (sub == 1) ? kp->norm_ffn + L * 1024 : kp->kv_norm;
            norm_phase<false>(src, g, HN, nullptr, tid_, bid_);
        } break;
        case PT_AIN: gemm_phase<AM_PLAIN, EPI_AIN>(HN, 1024, (const u16*)(ws + OFF_WT_AIN + L * SZ_WT_AIN), T_, 2688, 1024, 0, e, smem, tid_, bid_); break;
        case PT_CMP1:
            for (int kv = 0; kv < 2; ++kv) {
                e.bias = (const float*)(ws + OFF_CBIAS) + (L * 2 + kv) * 256; e.hid = (u16*)(ws + OFF_HID) + (size_t)kv * 8192 * 256;
                gemm_phase<AM_GATHER, EPI_CMP1>((const u16*)(ws + (kv == 0 ? OFF_KC : OFF_VC)), 0, (const u16*)(ws + OFF_WT_CW1 + (L * 2 + kv) * SZ_WT_CW1), 8184, 256, 2048,
                                                kv == 0 ? 0 : (int)(gridDim.x >> 1), e, smem, tid_, bid_);
            }
            break;
        case PT_CMP2: { const Params pl = *kp; cmp2_phase(pl, L, tid_, bid_); } break;
        case PT_NSA: { const Params pl = *kp; nsa_phase(pl, smem, tid_, bid_, sub, L); } break;
        case PT_BKV: gemm_phase<AM_PLAIN, EPI_BKV>(HN, 1024, (const u16*)(ws + OFF_WT_KV), T_, 256, 1024, 0, e, smem, tid_, bid_); break;
        case PT_BQ: gemm_phase<AM_PLAIN, EPI_BQ>(HN, 1024, (const u16*)(ws + OFF_WT_BQ + (L - 2) * SZ_WT_SQ), T_, 1024, 1024, 0, e, smem, tid_, bid_); break;
        case PT_SWA: { const Params pl = *kp; swa_phase(pl, L - 2, tid_, bid_); } break;
        case PT_AOUT:
        case PT_FOUT: {
            const bool ff = (type == PT_FOUT);
            e.resid = ff ? kp->out : hsrc;
            const u16* A = (const u16*)(ws + (ff ? OFF_ACT : OFF_O));
            const u16* Bt = (const u16*)(ws + (ff ? OFF_WT_FOUT + L * SZ_WT_FOUT : (L < 2 ? OFF_WT_AOUT + L * SZ_WT_SQ : OFF_WT_BOUT + (L - 2) * SZ_WT_SQ)));
            const int K = ff ? DFF : 1024;
            gemm_big<AM_PLAIN, EPI_RESID>(A, K, Bt, T_, 1024, K, 0, e, smem, tid_, bid_);
        } break;
        case PT_FFNIN:
            e.convw = kp->ffn_conv_w + (size_t)L * 3 * NFF2; e.convb = kp->ffn_conv_b + (size_t)L * NFF2;
            gemm_big<AM_PLAIN, EPI_FFNIN>(HN, 1024, (const u16*)(ws + OFF_WT_FIN + L * SZ_WT_FIN), T_, NFF2, 1024, 0, e, smem, tid_, bid_);
            break;
        case PT_FIXUP: { const Params pl = *kp; fixup_phase(pl, L, tid_, bid_); } break;
        case PT_FINAL: norm_phase<true>(kp->out, kp->final_norm, nullptr, kp->out, tid_, bid_); break;
        default: break;
        }
        if (ph + 1 < ph_hi) { if (ph == ph_lo) grid.sync(); else xcd_barrier(bar, xcc, xst, tid_); }
    }
#endif
}

static int build_program(int* desc) {
    int n = 0;
    auto add = [&](int type, int sub, int L) { desc[n++] = type | (sub << 8) | (L << 16); };
    add(PT_PREP, 0, 0);
    for (int L = 0; L < 4; ++L) {
        if (L < 2) {
            add(PT_NORM, 0, L); add(PT_AIN, 0, L); add(PT_CMP1, 0, L); add(PT_CMP2, 0, L); add(PT_NSA, NSA_PROBE_REP, L);
        } else {
            if (L == 2) { add(PT_NORM, 2, L); add(PT_BKV, 0, L); }
            add(PT_NORM, 0, L); add(PT_BQ, 0, L); add(PT_SWA, 0, L);
        }
        add(PT_AOUT, 0, L); add(PT_NORM, 1, L); add(PT_FFNIN, 0, L); add(PT_FIXUP, 0, L); add(PT_FOUT, 0, L);
    }
    add(PT_FINAL, 0, 0);
    return n;
}

extern "C" void kernel_launch(void* const* d_in, const int* in_sizes, int n_in, void* d_out, int out_size, void* d_ws, size_t ws_size, hipStream_t stream) {
    (void)in_sizes; (void)n_in; (void)out_size;
    static int grid_blocks = 0;
    if (!grid_blocks) {
        (void)hipFuncSetAttribute((const void*)mega, hipFuncAttributeMaxDynamicSharedMemorySize, LDS_BYTES);
        int dev = 0, cus = 0, per_cu = 0;
        (void)hipGetDevice(&dev);
        (void)hipDeviceGetAttribute(&cus, hipDeviceAttributeMultiprocessorCount, dev);
        (void)hipOccupancyMaxActiveBlocksPerMultiprocessor(&per_cu, mega, NTHR, LDS_BYTES);
        if (per_cu > 1) per_cu = 1;
        if (per_cu < 1) per_cu = 1;
        grid_blocks = (cus * per_cu) & ~7;
        if (grid_blocks < 8) grid_blocks = 8;
        if (ws_size < WS_NEED) fprintf(stderr, "workspace too small: %zu < %zu\n", ws_size, (size_t)WS_NEED);
    }
    Params p{};
    const float** pp = (const float**)&p;
    for (int i = 0; i < 18; ++i) pp[i] = (const float*)d_in[i];
    p.out = (float*)d_out;
    p.ws = (unsigned char*)d_ws;
    const int nph = build_program(p.desc);
#if MULTI_LAUNCH
    for (int ph = 0; ph < nph; ++ph) {
        p.ph_lo = ph; p.ph_hi = ph + 1;
        hipLaunchKernelGGL(mega, dim3(grid_blocks), dim3(NTHR), LDS_BYTES, stream, p);
    }
#else
    p.ph_lo = 0; p.ph_hi = nph;
    (void)hipMemsetAsync((unsigned char*)d_ws + OFF_BAR, 0, 32768, stream);
    void* args[] = {&p};
    hipError_t err = hipLaunchCooperativeKernel((const void*)mega, dim3(grid_blocks), dim3(NTHR), args, LDS_BYTES, stream);
    if (err != hipSuccess) fprintf(stderr, "cooperative launch failed: %s (grid %d)\n", hipGetErrorString(err), grid_blocks);
#endif
}
```
